# Optimizing an MI355X kernel written in HIP

```python
import math
import jax
import jax.numpy as jnp
from jax import lax
import numpy as np

D_MODEL = 1024
BATCH = 4
SEQ = 4096
DEPTH = 1

N_MEM = 256
ATTN_GROUPS = ((128, 1), (512, 4), (2048, 16))
N_GROUPS = len(ATTN_GROUPS)
ATTN_HEADS = 8
HEAD_DIM = 64
ATTN_WIDTH = ATTN_HEADS * HEAD_DIM
Q_BLOCK = 128
CONV_WIDTH = D_MODEL
CONV_K = 3
ATTN_COLS = N_GROUPS * 3 * ATTN_WIDTH
IN_WIDTH = ATTN_COLS + 3 * CONV_WIDTH
N_BRANCHES = 2
MEM_HEADS = 4
MEM_HEAD_DIM = 128
MEM_WIDTH = MEM_HEADS * MEM_HEAD_DIM
N_EXPERTS = 32
TOP_K = 4
D_FF = D_MODEL
SWIGLU_LIMIT = 7.0
SWIGLU_ALPHA = 1.702
MOE_BLOCK = 128
EPS = 1e-6
NEG_INF = -1e30

kernel_name = "hybrid_dilated_attn_shortconv_moe"


def rms_norm(x, g):
    xf = x.astype(jnp.float32)
    y = xf * lax.rsqrt(jnp.mean(xf * xf, axis=-1, keepdims=True) + EPS)
    return (y * g.astype(jnp.float32)).astype(x.dtype)


def alibi_slopes(n_heads):
    return jnp.power(2.0, -8.0 * jnp.arange(1, n_heads + 1, dtype=jnp.float32) / n_heads)


def dilated_window_attention(q, k, v, window, dilation, slopes):
    B, S, H, Dh = q.shape
    L = S // dilation
    w_sub = window // dilation
    nb = -(-L // Q_BLOCK)
    Lp = nb * Q_BLOCK

    def to_blocks(a):
        a = a.reshape(B, L, dilation, H, Dh).transpose(0, 2, 1, 3, 4)
        a = jnp.pad(a, ((0, 0), (0, 0), (0, Lp - L), (0, 0), (0, 0)))
        return a.reshape(B, dilation, nb, Q_BLOCK, H, Dh)

    def with_prev(a):
        prev = jnp.pad(a[:, :, :-1], ((0, 0), (0, 0), (1, 0), (0, 0), (0, 0), (0, 0)))
        return jnp.concatenate([prev, a], axis=3)

    qb, kb, vb = to_blocks(q), to_blocks(k), to_blocks(v)
    kk, vv = with_prev(kb), with_prev(vb)
    s = jnp.einsum('brnqhd,brnkhd->brnhqk', qb, kk).astype(jnp.float32) * (Dh ** -0.5)
    iq = jnp.arange(Q_BLOCK)
    ik = jnp.arange(2 * Q_BLOCK)
    dist = iq[:, None] + Q_BLOCK - ik[None, :]
    key_ok = (jnp.arange(nb)[:, None] * Q_BLOCK + ik[None, :] - Q_BLOCK) >= 0
    mask = ((dist >= 0) & (dist <= w_sub))[None] & key_ok[:, None, :]
    bias = -slopes[:, None, None] * (dist * dilation).astype(jnp.float32)[None]
    s = jnp.where(mask[None, None, :, None], s + bias[None, None, None], NEG_INF)
    lse = jax.nn.logsumexp(s, axis=-1)
    p = jnp.exp(s - lse[..., None])
    o = jnp.einsum('brnhqk,brnkhd->brnqhd', p.astype(v.dtype), vv)
    o = o.reshape(B, dilation, Lp, H, Dh)[:, :, :L].transpose(0, 2, 1, 3, 4).reshape(B, S, H, Dh)
    lse = lse.transpose(0, 1, 2, 4, 3).reshape(B, dilation, Lp, H)[:, :, :L]
    lse = lse.transpose(0, 2, 1, 3).reshape(B, S, H)
    return o, lse


def short_conv_causal(z, conv_w):
    S = z.shape[1]
    zp = jnp.pad(z, ((0, 0), (CONV_K - 1, 0), (0, 0)))
    return sum(zp[:, k:k + S] * conv_w[k] for k in range(CONV_K))


def hybrid_mixer(u, w_in, conv_w, w_branch_attn, w_branch_conv, w_gate, b_gate, w_out):
    B, S, _ = u.shape
    proj = u @ w_in
    attn_cols, conv_cols = proj[..., :ATTN_COLS], proj[..., ATTN_COLS:]
    slopes = alibi_slopes(ATTN_HEADS)
    outs, lses = [], []
    for g, (window, dil) in enumerate(ATTN_GROUPS):
        cols = attn_cols[..., g * 3 * ATTN_WIDTH:(g + 1) * 3 * ATTN_WIDTH]
        cols = cols.reshape(B, S, 3, ATTN_HEADS, HEAD_DIM)
        o, lse = dilated_window_attention(cols[:, :, 0], cols[:, :, 1], cols[:, :, 2], window, dil, slopes)
        outs.append(o)
        lses.append(lse)
    wts = jax.nn.softmax(jnp.stack(lses), axis=0)
    y_attn = jnp.einsum('gbsh,gbshd->bshd', wts, jnp.stack(outs).astype(jnp.float32))
    y_attn = y_attn.reshape(B, S, ATTN_WIDTH).astype(u.dtype)
    gb, gc, xc = jnp.split(conv_cols, 3, axis=-1)
    y_conv = gb * short_conv_causal(gc * xc, conv_w)
    gates = jax.nn.sigmoid(u @ w_gate + b_gate)
    g_attn, g_conv = jnp.split(gates, N_BRANCHES, axis=-1)
    mixed = g_attn * (y_attn @ w_branch_attn) + g_conv * (y_conv @ w_branch_conv)
    return mixed @ w_out


def memory_cross_attention(u, m, w_cq, w_ckv, w_co):
    B, S, _ = u.shape
    q = (u @ w_cq).reshape(B, S, MEM_HEADS, MEM_HEAD_DIM)
    k, v = jnp.split((m @ w_ckv).reshape(B, m.shape[1], 2, MEM_HEADS, MEM_HEAD_DIM), 2, axis=2)
    k, v = k[:, :, 0], v[:, :, 0]
    s = jnp.einsum('bshd,bmhd->bhsm', q, k).astype(jnp.float32) * (MEM_HEAD_DIM ** -0.5)
    p = jax.nn.softmax(s, axis=-1)
    o = jnp.einsum('bhsm,bmhd->bshd', p.astype(v.dtype), v).reshape(B, S, MEM_WIDTH)
    return o @ w_co


def moe_ffn(u, router_w, router_b, w_eg, b_eg, w_eu, b_eu, w_ed, b_ed):
    T, D = u.shape
    logits = (u @ router_w + router_b).astype(jnp.float32)
    top_logit, top_idx = lax.top_k(logits, TOP_K)
    top_w = jax.nn.softmax(top_logit, axis=-1)
    n_assign = T * TOP_K
    flat_e = top_idx.reshape(-1)
    flat_tok = jnp.arange(n_assign, dtype=jnp.int32) // TOP_K
    order = jnp.argsort(flat_e)
    e_sorted = flat_e[order]
    tok_sorted = flat_tok[order]
    w_sorted = top_w.reshape(-1)[order]
    counts = jnp.bincount(flat_e, length=N_EXPERTS)
    padded = (counts + MOE_BLOCK - 1) // MOE_BLOCK * MOE_BLOCK
    start = jnp.cumsum(counts) - counts
    pend = jnp.cumsum(padded)
    pstart = pend - padded
    row = pstart[e_sorted] + jnp.arange(n_assign) - start[e_sorted]
    n_rows = (-(-n_assign // MOE_BLOCK)) * MOE_BLOCK + N_EXPERTS * MOE_BLOCK
    n_blocks = n_rows // MOE_BLOCK
    row_tok = jnp.full((n_rows,), T, jnp.int32).at[row].set(tok_sorted)
    block_expert = jnp.clip(jnp.searchsorted(pend, jnp.arange(n_blocks) * MOE_BLOCK, side='right'),
                            0, N_EXPERTS - 1)
    u_pad = jnp.concatenate([u, jnp.zeros((1, D), u.dtype)], axis=0)
    xb = u_pad[row_tok].reshape(n_blocks, MOE_BLOCK, D)

    def expert_block(args):
        xblk, e = args
        gate = jnp.minimum(xblk @ w_eg[e] + b_eg[e], SWIGLU_LIMIT)
        lin = jnp.clip(xblk @ w_eu[e] + b_eu[e], -SWIGLU_LIMIT, SWIGLU_LIMIT)
        hdn = gate * jax.nn.sigmoid(SWIGLU_ALPHA * gate) * (lin + 1.0)
        return hdn @ w_ed[e] + b_ed[e]

    y_rows = lax.map(expert_block, (xb, block_expert)).reshape(n_rows, D)
    y_assign = y_rows[row].astype(jnp.float32) * w_sorted[:, None]
    return jax.ops.segment_sum(y_assign, tok_sorted, num_segments=T).astype(u.dtype)


def setup_inputs(seed: int = 0) -> dict:
    key = jax.random.key(seed)
    ks = jax.random.split(key, 26)
    nrm = lambda k, shape, fan_in: jax.random.normal(k, shape, jnp.float32) * (fan_in ** -0.5)
    gain = lambda k, shape: 1.0 + 0.02 * jax.random.normal(k, shape, jnp.float32)
    small = lambda k, shape: 0.01 * jax.random.normal(k, shape, jnp.float32)
    L, D, E = DEPTH, D_MODEL, N_EXPERTS
    return {
        "x": jax.random.normal(ks[0], (BATCH, SEQ, D), jnp.float32),
        "mem": jax.random.normal(ks[1], (BATCH, N_MEM, D), jnp.float32),
        "norm_mix": gain(ks[2], (L, D)),
        "w_in": nrm(ks[3], (L, D, IN_WIDTH), D),
        "conv_w": nrm(ks[4], (L, CONV_K, CONV_WIDTH), CONV_K),
        "w_branch_attn": nrm(ks[5], (L, ATTN_WIDTH, D), ATTN_WIDTH),
        "w_branch_conv": nrm(ks[6], (L, CONV_WIDTH, D), CONV_WIDTH),
        "w_gate": nrm(ks[7], (L, D, N_BRANCHES * D), D),
        "b_gate": small(ks[8], (L, N_BRANCHES * D)),
        "w_out": nrm(ks[9], (L, D, D), D),
        "norm_cross": gain(ks[10], (L, D)),
        "norm_mem": gain(ks[11], (L, D)),
        "w_cq": nrm(ks[12], (L, D, MEM_WIDTH), D),
        "w_ckv": nrm(ks[13], (L, D, 2 * MEM_WIDTH), D),
        "w_co": nrm(ks[14], (L, MEM_WIDTH, D), MEM_WIDTH),
        "norm_moe": gain(ks[15], (L, D)),
        "router_w": nrm(ks[16], (L, D, E), D),
        "router_b": small(ks[17], (L, E)),
        "w_exp_gate": nrm(ks[18], (L, E, D, D_FF), D),
        "b_exp_gate": small(ks[19], (L, E, D_FF)),
        "w_exp_up": nrm(ks[20], (L, E, D, D_FF), D),
        "b_exp_up": small(ks[21], (L, E, D_FF)),
        "w_exp_down": nrm(ks[22], (L, E, D_FF, D), D_FF),
        "b_exp_down": small(ks[23], (L, E, D)),
        "norm_final": gain(ks[24], (D,)),
    }


def reference(x, mem, norm_mix, w_in, conv_w, w_branch_attn, w_branch_conv, w_gate, b_gate, w_out,
              norm_cross, norm_mem, w_cq, w_ckv, w_co, norm_moe, router_w, router_b,
              w_exp_gate, b_exp_gate, w_exp_up, b_exp_up, w_exp_down, b_exp_down, norm_final):
    B, S, D = x.shape
    h = x
    for l in range(DEPTH):
        u = rms_norm(h, norm_mix[l])
        h = h + hybrid_mixer(u, w_in[l], conv_w[l], w_branch_attn[l], w_branch_conv[l],
                             w_gate[l], b_gate[l], w_out[l])
        u = rms_norm(h, norm_cross[l])
        m = rms_norm(mem, norm_mem[l])
        h = h + memory_cross_attention(u, m, w_cq[l], w_ckv[l], w_co[l])
        u = rms_norm(h, norm_moe[l]).reshape(B * S, D)
        h = h + moe_ffn(u, router_w[l], router_b[l], w_exp_gate[l], b_exp_gate[l],
                        w_exp_up[l], b_exp_up[l], w_exp_down[l], b_exp_down[l]).reshape(B, S, D)
    return rms_norm(h, norm_final)
```

```cpp
#include <hip/hip_runtime.h>
#include <cstdio>
#include <cstdint>
namespace pg8 {
#define PG8_LAS __attribute__((address_space(3)))
typedef unsigned short bf16_t;
typedef short bf16x8 __attribute__((ext_vector_type(8)));
typedef float f32x4 __attribute__((ext_vector_type(4)));
typedef unsigned u32x4 __attribute__((ext_vector_type(4)));
constexpr int BM = 256, BK = 64, HALF = 128, HTB = HALF * BK * 2  , STAGE_BYTES = 8 * HTB, NXCD = 8, WGM = 8;

__host__ __device__ __forceinline__ int lds_byte(int r, int c) { const int st = (r >> 4) * 2 + (c >> 5), rr = r & 15, cc = c & 31, ob = rr * 64 + cc * 2; return st * 1024 + (ob ^ (((ob >> 9) & 1) << 5)); }
__host__ __device__ __forceinline__ void stage_rc(int b, int& R, int& C) { const int st = b / 1024, sb = b % 1024, swz = sb ^ (((sb >> 9) & 1) << 5); R = (st >> 1) * 16 + swz / 64; C = (st & 1) * 32 + (swz % 64) / 2; }
__host__ __device__ __forceinline__ int perm32(int rho) { const int n = rho >> 4, i = rho & 15; return 8 * (i >> 2) + 4 * n + (i & 3); }

struct Unit { int pm, pn; };
struct Gemm { const bf16_t* A; const bf16_t* Bt; int M, N, K; };

struct StaticOrder {
    int nM, nN, nwg, G, c;
    __host__ __device__ void init(int M, int N, int G_, int c_) { nM = M / BM; nN = N / BM; nwg = nM * nN; G = G_; c = c_; }
    __host__ __device__ bool next(int i, Unit& u) const {
        const long L = (long)i * G + c; if (L >= nwg) return false;
        int wgid = (int)L; { const int q = nwg / NXCD, r = nwg % NXCD, xcd = wgid % NXCD, off = wgid / NXCD; wgid = (xcd < r ? xcd * (q + 1) : r * (q + 1) + (xcd - r) * q) + off; }
        const int nig = WGM * nN, gid = wgid / nig, fm = gid * WGM, gsz = (nM - fm) < WGM ? (nM - fm) : WGM;
        u.pm = fm + ((wgid % nig) % gsz); u.pn = (wgid % nig) / gsz; return true;
    }
    __device__ __forceinline__ void a_ready(const Unit&) const {}
    __device__ __forceinline__ void done(const Unit&) const {}
};

__device__ __forceinline__ unsigned cvt_pk_bf16(float lo, float hi) { unsigned r; asm volatile("v_cvt_pk_bf16_f32 %0, %1, %2" : "=v"(r) : "v"(lo), "v"(hi)); return r; }
__device__ __forceinline__ float bflo(unsigned w) { return __builtin_bit_cast(float, w << 16); }
__device__ __forceinline__ float bfhi(unsigned w) { return __builtin_bit_cast(float, w & 0xffff0000u); }
__device__ __forceinline__ void unpack8(const u32x4 w, f32x4& a, f32x4& b) { a = (f32x4){bflo(w.x), bfhi(w.x), bflo(w.y), bfhi(w.y)}; b = (f32x4){bflo(w.z), bfhi(w.z), bflo(w.w), bfhi(w.w)}; }
__device__ __forceinline__ u32x4 pack8(const f32x4 a, const f32x4 b) { u32x4 w; w.x = cvt_pk_bf16(a[0], a[1]); w.y = cvt_pk_bf16(a[2], a[3]); w.z = cvt_pk_bf16(b[0], b[1]); w.w = cvt_pk_bf16(b[2], b[3]); return w; }
__device__ __forceinline__ float sigmoidf_fast(float x) { return __builtin_amdgcn_rcpf(1.0f + __builtin_amdgcn_exp2f(-1.4426950408889634f * x)); }
__device__ __forceinline__ f32x4 sig4(f32x4 v) { return (f32x4){sigmoidf_fast(v[0]), sigmoidf_fast(v[1]), sigmoidf_fast(v[2]), sigmoidf_fast(v[3])}; }

#define EPI_ROWS_BEGIN _Pragma("unroll") for (int ai = 0; ai < 2; ++ai) _Pragma("unroll") for (int m = 0; m < 4; ++m) { const int rowl = ai * HALF + wr * 64 + m * 16 + fr;
#define EPI_COLS_BEGIN _Pragma("unroll") for (int bj = 0; bj < 2; ++bj) { const int coll = bj * HALF + wc * 32 + 8 * fq; f32x4 v0 = acc[ai][bj][m][0], v1 = acc[ai][bj][m][1];
#define EPI_END }

struct EpiProj {
    static constexpr bool PERM = true, AFTER_DRAIN = false;
    bf16_t* O; const float* bgate;
    __device__ __forceinline__ void operator()(const f32x4 (&acc)[2][2][4][2], const Unit& u, int wr, int wc, int fr, int fq) const {
        const int row0 = u.pm * BM, col0 = u.pn * BM; const bool gate = col0 >= 7680;
        EPI_ROWS_BEGIN EPI_COLS_BEGIN
            const int row = row0 + rowl, col = col0 + coll;
            if (gate) { const f32x4 b0 = *(const f32x4*)(bgate + (col - 7680)), b1 = *(const f32x4*)(bgate + (col - 7680) + 4); v0 = sig4(v0 + b0); v1 = sig4(v1 + b1); }
            *(u32x4*)(O + (size_t)row * 9728 + col) = pack8(v0, v1);
        EPI_END EPI_END
    }
};
struct EpiPlain {
    static constexpr bool PERM = true, AFTER_DRAIN = false;
    bf16_t* O; int ldc;
    __device__ __forceinline__ void operator()(const f32x4 (&acc)[2][2][4][2], const Unit& u, int wr, int wc, int fr, int fq) const {
        const int row0 = u.pm * BM, col0 = u.pn * BM;
        EPI_ROWS_BEGIN EPI_COLS_BEGIN
            *(u32x4*)(O + (size_t)(row0 + rowl) * ldc + col0 + coll) = pack8(v0, v1);
        EPI_END EPI_END
    }
};
template <bool SECOND> struct EpiMix {
    static constexpr bool PERM = true, AFTER_DRAIN = false;
    bf16_t* MIX; const bf16_t* PROJ;
    __device__ __forceinline__ void operator()(const f32x4 (&acc)[2][2][4][2], const Unit& u, int wr, int wc, int fr, int fq) const {
        const int row0 = u.pm * BM, col0 = u.pn * BM;
        EPI_ROWS_BEGIN EPI_COLS_BEGIN
            const int row = row0 + rowl, col = col0 + coll;
            f32x4 g0, g1; unpack8(*(const u32x4*)(PROJ + (size_t)row * 9728 + (SECOND ? 8704 : 7680) + col), g0, g1);
            v0 = v0 * g0; v1 = v1 * g1;
            if (SECOND) { f32x4 t0, t1; unpack8(*(const u32x4*)(MIX + (size_t)row * 1024 + col), t0, t1); v0 = v0 + t0; v1 = v1 + t1; }
            *(u32x4*)(MIX + (size_t)row * 1024 + col) = pack8(v0, v1);
        EPI_END EPI_END
    }
};
struct EpiH1 {
    static constexpr bool PERM = true, AFTER_DRAIN = false;
    const float* X; float* H1; bf16_t* H1B; float* ss;
    __device__ __forceinline__ void operator()(const f32x4 (&acc)[2][2][4][2], const Unit& u, int wr, int wc, int fr, int fq) const {
        const int row0 = u.pm * BM, col0 = u.pn * BM;
        EPI_ROWS_BEGIN
            float s = 0.f; const int row = row0 + rowl;
            EPI_COLS_BEGIN
                const int col = col0 + coll; const size_t o = (size_t)row * 1024 + col;
                v0 = v0 + *(const f32x4*)(X + o); v1 = v1 + *(const f32x4*)(X + o + 4);
                *(f32x4*)(H1 + o) = v0; *(f32x4*)(H1 + o + 4) = v1; *(u32x4*)(H1B + o) = pack8(v0, v1);
                s += (v0[0] * v0[0] + v0[1] * v0[1]) + (v0[2] * v0[2] + v0[3] * v0[3]) + (v1[0] * v1[0] + v1[1] * v1[1]) + (v1[2] * v1[2] + v1[3] * v1[3]);
            EPI_END
            s += __shfl_xor(s, 16); s += __shfl_xor(s, 32);
            if (fq == 0) atomicAdd(ss + row, s);
        EPI_END
    }
};
struct EpiQ2 {
    static constexpr bool PERM = true, AFTER_DRAIN = false;
    bf16_t* Q2; const float* ss;
    __device__ __forceinline__ void operator()(const f32x4 (&acc)[2][2][4][2], const Unit& u, int wr, int wc, int fr, int fq) const {
        const int row0 = u.pm * BM, col0 = u.pn * BM;
        EPI_ROWS_BEGIN
            const int row = row0 + rowl; const float rs = __builtin_amdgcn_rsqf(__hip_atomic_load(ss + row, __ATOMIC_RELAXED, __HIP_MEMORY_SCOPE_AGENT) * (1.f / 1024.f) + 1e-6f);
            EPI_COLS_BEGIN
                *(u32x4*)(Q2 + (size_t)row * 512 + col0 + coll) = pack8(v0 * rs, v1 * rs);
            EPI_END
        EPI_END
    }
};
struct EpiH2 {
    static constexpr bool PERM = true, AFTER_DRAIN = false;
    const float* H1; float* OUT;
    __device__ __forceinline__ void operator()(const f32x4 (&acc)[2][2][4][2], const Unit& u, int wr, int wc, int fr, int fq) const {
        const int row0 = u.pm * BM, col0 = u.pn * BM;
        EPI_ROWS_BEGIN EPI_COLS_BEGIN
            const size_t o = (size_t)(row0 + rowl) * 1024 + col0 + coll;
            *(f32x4*)(OUT + o) = v0 + *(const f32x4*)(H1 + o); *(f32x4*)(OUT + o + 4) = v1 + *(const f32x4*)(H1 + o + 4);
        EPI_END EPI_END
    }
};
struct EpiHdn {
    static constexpr bool PERM = true, AFTER_DRAIN = false;
    bf16_t* HDN; const float* bg; const float* bu;
    __device__ __forceinline__ void operator()(const f32x4 (&acc)[2][2][4][2], const Unit& u, int wr, int wc, int fr, int fq) const {
        const int row0 = u.pm * BM, e = u.pn >> 3, hc = (u.pn & 7) * 128 + wc * 32 + 8 * fq;
        const float* pg = bg + e * 1024 + hc; const float* pu = bu + e * 1024 + hc;
        const f32x4 bg0 = *(const f32x4*)pg, bg1 = *(const f32x4*)(pg + 4), bu0 = *(const f32x4*)pu, bu1 = *(const f32x4*)(pu + 4);
        EPI_ROWS_BEGIN
            f32x4 g0 = acc[ai][0][m][0] + bg0, g1 = acc[ai][0][m][1] + bg1, l0 = acc[ai][1][m][0] + bu0, l1 = acc[ai][1][m][1] + bu1, h0, h1;
#pragma unroll
            for (int j = 0; j < 4; ++j) {
                const float ga = fminf(g0[j], 7.f), gb = fminf(g1[j], 7.f), la = fminf(fmaxf(l0[j], -7.f), 7.f), lb = fminf(fmaxf(l1[j], -7.f), 7.f);
                h0[j] = ga * sigmoidf_fast(1.702f * ga) * (la + 1.f); h1[j] = gb * sigmoidf_fast(1.702f * gb) * (lb + 1.f); }
            *(u32x4*)(HDN + (size_t)(row0 + rowl) * 1024 + hc) = pack8(h0, h1);
        EPI_END
    }
};
struct EpiY {
    static constexpr bool PERM = true, AFTER_DRAIN = false;
    bf16_t* Y; const float* bd; const int* rowslot; const float* topw;
    __device__ __forceinline__ void operator()(const f32x4 (&acc)[2][2][4][2], const Unit& u, int wr, int wc, int fr, int fq) const {
        const int row0 = u.pm * BM, e = u.pn >> 2, col0 = (u.pn & 3) * BM;
        EPI_ROWS_BEGIN
            const int slot = rowslot[row0 + rowl];
            if (slot >= 0) { const float w = topw[slot];
                EPI_COLS_BEGIN
                    const int col = col0 + coll; const float* pb = bd + e * 1024 + col;
                    v0 = (v0 + *(const f32x4*)pb) * w; v1 = (v1 + *(const f32x4*)(pb + 4)) * w;
                    *(u32x4*)(Y + (size_t)slot * 1024 + col) = pack8(v0, v1);
                EPI_END }
        EPI_END
    }
};
template <class Epi, class Sched, bool ALIGN_EPI = false, bool SP2 = false>
__device__ __forceinline__ void gemm_phase(PG8_LAS unsigned char* lds, const Gemm g, const Sched& S, const Epi& E) {
    const int tid = threadIdx.x, wid = __builtin_amdgcn_readfirstlane(tid >> 6), lane = tid & 63, wr = wid >> 2, wc = wid & 3, fr = lane & 15, fq = lane >> 4;
    const int K = g.K, nt = K / BK;
    unsigned voffA[2], voffB[2];
#pragma unroll
    for (int i = 0; i < 2; ++i) { int R, C; stage_rc(tid * 16 + i * 8192, R, C); const int Rb = Epi::PERM ? ((R & ~31) + perm32(R & 31)) : R;
        voffA[i] = (unsigned)(R * K + C) * 2u; voffB[i] = (unsigned)(Rb * K + C) * 2u; }
    const size_t kstep = (size_t)(BK * 2);
    const size_t hstep = (size_t)HALF * K * 2;
    const size_t tstep = 2 * hstep;
    const unsigned ldsw = (unsigned)wid * 1024u;
    const int aoff = lds_byte(wr * 64 + fr, fq * 8), boff = lds_byte(wc * 32 + fr, fq * 8);
#define PG8_SA(b, h) (((b) * 2 + (h)) * HTB)
#define PG8_SB(b, h) ((4 + (b) * 2 + (h)) * HTB)
#define PG8_STAGE(bufoff, gbase, voff) do { _Pragma("unroll") for (int _i = 0; _i < 2; ++_i) \
        __builtin_amdgcn_global_load_lds((const unsigned*)((const char*)(gbase) + (voff)[_i]), (PG8_LAS unsigned*)(lds + (bufoff) + ldsw + _i * 8192), 16, 0, 0); } while (0)
#define PG8_LDA(dst, b, h) do { _Pragma("unroll") for (int m = 0; m < 4; ++m) _Pragma("unroll") for (int k = 0; k < 2; ++k) dst[m][k] = *(const PG8_LAS bf16x8*)(lds + PG8_SA(b, h) + aoff + m * 2048 + k * 1024); } while (0)
#define PG8_LDB(dst, b, h) do { _Pragma("unroll") for (int n = 0; n < 2; ++n) _Pragma("unroll") for (int k = 0; k < 2; ++k) dst[n][k] = *(const PG8_LAS bf16x8*)(lds + PG8_SB(b, h) + boff + n * 2048 + k * 1024); } while (0)
#define PG8_MMA(ai, bj, At, Bt) do { __builtin_amdgcn_s_setprio(1); _Pragma("unroll") for (int m = 0; m < 4; ++m) _Pragma("unroll") for (int n = 0; n < 2; ++n) _Pragma("unroll") for (int k = 0; k < 2; ++k) \
        acc[ai][bj][m][n] = __builtin_amdgcn_mfma_f32_16x16x32_bf16(Bt[n][k], At[m][k], acc[ai][bj][m][n], 0, 0, 0); __builtin_amdgcn_s_setprio(0); } while (0)
#define PG8_WAIT_V(n) asm volatile("s_waitcnt vmcnt(" #n ")" ::: "memory")
#define PG8_WAIT_L(n) asm volatile("s_waitcnt lgkmcnt(" #n ")" ::: "memory")
#define PG8_BAR __builtin_amdgcn_s_barrier()
#define PG8_SCHED __builtin_amdgcn_sched_barrier(0)
    Unit cur, nxt; int ui = 0;
    if (!S.next(0, cur)) return;
    f32x4 acc[2][2][4][2];
#pragma unroll
    for (int a = 0; a < 2; ++a)
#pragma unroll
        for (int b = 0; b < 2; ++b)
#pragma unroll
            for (int m = 0; m < 4; ++m)
#pragma unroll
                for (int n = 0; n < 2; ++n) acc[a][b][m][n] = (f32x4){0.f, 0.f, 0.f, 0.f};
    bf16x8 At[4][2], B0[2][2], B1[2][2];
    const char* cA = (const char*)g.A + (size_t)cur.pm * tstep; const char* cB = (const char*)g.Bt + (size_t)cur.pn * tstep;
    S.a_ready(cur);
    if constexpr (SP2) {
        PG8_STAGE(PG8_SB(0, 0), cB, voffB); PG8_STAGE(PG8_SB(0, 1), cB + hstep, voffB); PG8_STAGE(PG8_SA(0, 0), cA, voffA); PG8_STAGE(PG8_SA(0, 1), cA + hstep, voffA);
        if (wr == 1) PG8_BAR;
        PG8_WAIT_V(2); PG8_BAR;
        PG8_STAGE(PG8_SB(1, 0), cB + kstep, voffB); PG8_STAGE(PG8_SA(1, 0), cA + kstep, voffA); PG8_STAGE(PG8_SB(1, 1), cB + hstep + kstep, voffB);
        PG8_WAIT_V(6); PG8_BAR;
    } else {
        PG8_STAGE(PG8_SB(0, 0), cB, voffB); PG8_STAGE(PG8_SA(0, 0), cA, voffA); PG8_STAGE(PG8_SB(0, 1), cB + hstep, voffB); PG8_STAGE(PG8_SA(0, 1), cA + hstep, voffA);
        if (wr == 1) PG8_BAR;
        PG8_WAIT_V(4); PG8_BAR;
        PG8_STAGE(PG8_SB(1, 0), cB + kstep, voffB); PG8_STAGE(PG8_SA(1, 0), cA + kstep, voffA); PG8_STAGE(PG8_SB(1, 1), cB + hstep + kstep, voffB);
        PG8_WAIT_V(6); PG8_BAR;
    }
    for (;;) {
        const bool has_next = S.next(ui + 1, nxt);
        const char* nA = has_next ? (const char*)g.A + (size_t)nxt.pm * tstep : cA; const char* nB = has_next ? (const char*)g.Bt + (size_t)nxt.pn * tstep : cB;
        for (int t = 0; t < nt; t += 2) {
            const bool last = (t == nt - 2);
            const char* a1 = cA + (size_t)(t + 1) * kstep;
            const char* a2 = last ? nA : cA + (size_t)(t + 2) * kstep; const char* b2 = last ? nB : cB + (size_t)(t + 2) * kstep;
            const char* a3 = a2 + kstep; const char* b3 = b2 + kstep;
            if (last && has_next) S.a_ready(nxt);
            if constexpr (SP2) {
            PG8_LDB(B0, 0, 0); PG8_LDB(B1, 0, 1); PG8_SCHED; PG8_LDA(At, 0, 0); PG8_STAGE(PG8_SA(1, 1), a1 + hstep, voffA);
            PG8_WAIT_V(8); PG8_WAIT_L(0); PG8_BAR; PG8_MMA(0, 0, At, B0); PG8_MMA(0, 1, At, B1); PG8_BAR; PG8_SCHED;
            PG8_LDA(At, 0, 1); PG8_STAGE(PG8_SB(0, 0), b2, voffB); PG8_STAGE(PG8_SB(0, 1), b2 + hstep, voffB); PG8_STAGE(PG8_SA(0, 0), a2, voffA);
            PG8_WAIT_V(8); PG8_WAIT_L(0); PG8_BAR; PG8_MMA(1, 0, At, B0); PG8_MMA(1, 1, At, B1); PG8_BAR; PG8_SCHED;
            PG8_LDB(B0, 1, 0); PG8_LDB(B1, 1, 1); PG8_SCHED; PG8_LDA(At, 1, 0); PG8_STAGE(PG8_SA(0, 1), a2 + hstep, voffA);
            PG8_WAIT_V(8); PG8_WAIT_L(0); PG8_BAR; PG8_MMA(0, 0, At, B0); PG8_MMA(0, 1, At, B1); PG8_BAR; PG8_SCHED;
            PG8_LDA(At, 1, 1); PG8_STAGE(PG8_SB(1, 0), b3, voffB); PG8_STAGE(PG8_SB(1, 1), b3 + hstep, voffB); PG8_STAGE(PG8_SA(1, 0), a3, voffA);
            PG8_WAIT_V(8); PG8_WAIT_L(0); PG8_BAR; PG8_MMA(1, 0, At, B0); PG8_MMA(1, 1, At, B1); PG8_BAR; PG8_SCHED;
            } else {
            PG8_LDB(B0, 0, 0); PG8_SCHED; PG8_LDA(At, 0, 0); PG8_STAGE(PG8_SA(1, 1), a1 + hstep, voffA);
            PG8_WAIT_L(8); PG8_BAR; PG8_WAIT_L(0); PG8_MMA(0, 0, At, B0); PG8_BAR; PG8_SCHED;
            PG8_LDB(B1, 0, 1); PG8_STAGE(PG8_SB(0, 0), b2, voffB);
            PG8_BAR; PG8_WAIT_L(0); PG8_MMA(0, 1, At, B1); PG8_BAR;
            PG8_LDA(At, 0, 1); PG8_STAGE(PG8_SA(0, 0), a2, voffA);
            PG8_BAR; PG8_WAIT_L(0); PG8_MMA(1, 0, At, B0); PG8_BAR; PG8_SCHED;
            PG8_STAGE(PG8_SB(0, 1), b2 + hstep, voffB);
            PG8_WAIT_V(6); PG8_BAR; PG8_MMA(1, 1, At, B1); PG8_BAR;
            PG8_LDB(B0, 1, 0); PG8_SCHED; PG8_LDA(At, 1, 0); PG8_STAGE(PG8_SA(0, 1), a2 + hstep, voffA);
            PG8_WAIT_L(8); PG8_BAR; PG8_WAIT_L(0); PG8_MMA(0, 0, At, B0); PG8_BAR; PG8_SCHED;
            PG8_LDB(B1, 1, 1); PG8_STAGE(PG8_SB(1, 0), b3, voffB);
            PG8_BAR; PG8_WAIT_L(0); PG8_MMA(0, 1, At, B1); PG8_BAR;
            PG8_LDA(At, 1, 1); PG8_STAGE(PG8_SA(1, 0), a3, voffA);
            PG8_BAR; PG8_WAIT_L(0); PG8_MMA(1, 0, At, B0); PG8_BAR; PG8_SCHED;
            PG8_STAGE(PG8_SB(1, 1), b3 + hstep, voffB);
            PG8_WAIT_V(6); PG8_BAR; PG8_MMA(1, 1, At, B1); PG8_BAR;
            }
        }
        if constexpr (ALIGN_EPI) { if (wr == 0) PG8_BAR; }
        if constexpr (!Epi::AFTER_DRAIN) { E(acc, cur, wr, wc, fr, fq); S.done(cur); }
        if (!has_next) break;
#pragma unroll
        for (int a = 0; a < 2; ++a)
#pragma unroll
            for (int b = 0; b < 2; ++b)
#pragma unroll
                for (int m = 0; m < 4; ++m)
#pragma unroll
                    for (int n = 0; n < 2; ++n) acc[a][b][m][n] = (f32x4){0.f, 0.f, 0.f, 0.f};
        cur = nxt; cA = nA; cB = nB; ++ui;
        if constexpr (ALIGN_EPI) { if (wr == 1) PG8_BAR; }
    }
    PG8_WAIT_V(0);
    if constexpr (!ALIGN_EPI) { if (wr == 0) PG8_BAR; }
    PG8_BAR;
    if constexpr (Epi::AFTER_DRAIN) { E.fused(acc, cur, wr, wc, fr, fq, lds, wid, lane); S.done(cur); }
#undef PG8_SA
#undef PG8_SB
#undef PG8_STAGE
#undef PG8_LDA
#undef PG8_LDB
#undef PG8_MMA
#undef PG8_WAIT_V
#undef PG8_WAIT_L
#undef PG8_BAR
#undef PG8_SCHED
}
}
#define GAS __attribute__((address_space(1)))
#define LAS __attribute__((address_space(3)))
typedef unsigned short bf16;
typedef unsigned v4u __attribute__((ext_vector_type(4)));
typedef float f32x4 __attribute__((ext_vector_type(4)));
typedef short bf16x8 __attribute__((ext_vector_type(8)));
typedef GAS unsigned gu32;
typedef GAS unsigned long long gu64;
#define RLX_AGENT __ATOMIC_RELAXED, __HIP_MEMORY_SCOPE_AGENT
#define LDS_WAIT() asm volatile("s_waitcnt lgkmcnt(0)" ::: "memory")
#define VM_WAIT() asm volatile("s_waitcnt vmcnt(0)" ::: "memory")
__device__ __forceinline__ unsigned long long rt() { return __builtin_amdgcn_s_memrealtime(); }
__device__ __forceinline__ unsigned f2bf(float f) { unsigned u = __builtin_bit_cast(unsigned, f); return (u + 0x7fffu + ((u >> 16) & 1u)) >> 16; }
__device__ __forceinline__ unsigned pk2(float lo, float hi) { return f2bf(lo) | (f2bf(hi) << 16); }

#define XB_TMO      128
#define XB_XCNT(j)  (256  + 64 * (j))
#define XB_XSUB(j)  (1280 + 64 * (j))
#define XB_XGEN(j)  (2304 + 64 * (j))
#define XB_TOP      3328
#define XB_TOPGEN   3392
#define XCD_BAR_WORDS 3456
#define XB_SPIN_CAP (1u << 18)

__device__ __forceinline__ unsigned xb_ld(unsigned* p)              { return __hip_atomic_load(p, __ATOMIC_RELAXED, __HIP_MEMORY_SCOPE_AGENT); }
__device__ __forceinline__ unsigned xb_add(unsigned* p, unsigned v) { return __hip_atomic_fetch_add(p, v, __ATOMIC_RELAXED, __HIP_MEMORY_SCOPE_AGENT); }
__device__ __forceinline__ unsigned xb_xcc_id() { return (unsigned)__builtin_amdgcn_s_getreg((3 << 11) | 20) & 0xFu; }
#define XB_SPIN(cond, bar) do { unsigned _sp = 0; while (cond) { __builtin_amdgcn_s_sleep(1); \
    if ((++_sp & 255u) == 0u) { if (xb_ld(&(bar)[XB_TMO])) break; if (_sp > XB_SPIN_CAP) { atomicAdd(&(bar)[XB_TMO], 1u); break; } } } } while (0)

struct XcdBarrier {
    unsigned* bar; unsigned x;
    volatile LAS unsigned* st;
};

__device__ __forceinline__ XcdBarrier xcd_barrier_post(unsigned* bar, volatile LAS unsigned* st) {
    XcdBarrier b; b.bar = bar; b.x = xb_xcc_id(); b.st = st;
    if (threadIdx.x == 0) (void)xb_add(&bar[XB_XCNT(b.x)], 1u);
    return b;
}
__device__ __forceinline__ void xcd_barrier_complete(unsigned* bar, unsigned x, unsigned& nloc, unsigned& nx) {
    const unsigned G = gridDim.x * gridDim.y * gridDim.z;
    unsigned sum, cnt, mine, sp = 0u;
    for (;;) {
        sum = 0u; cnt = 0u; mine = 0u;
#pragma unroll
        for (unsigned j = 0; j < 16; ++j) { const unsigned c = xb_ld(&bar[XB_XCNT(j)]); sum += c; cnt += (c > 0u) ? 1u : 0u; mine = (j == x) ? c : mine; }
        if (sum == G) break;
        __builtin_amdgcn_s_sleep(1);
        if ((++sp & 255u) == 0u) { if (xb_ld(&bar[XB_TMO])) break; if (sp > XB_SPIN_CAP) { atomicAdd(&bar[XB_TMO], 1u); break; } }
    }
    nloc = mine > 0u ? mine : 1u; nx = cnt > 0u ? cnt : 1u;
}

__device__ __forceinline__ void xcd_barrier(const XcdBarrier& b) {
    asm volatile("s_waitcnt vmcnt(0)" ::: "memory");
    __syncthreads();
    if (threadIdx.x == 0) {
        unsigned* bar = b.bar;
        __builtin_amdgcn_s_waitcnt(0);
        unsigned nloc = b.st[0], nx = b.st[1];
        if (nloc == 0u) { xcd_barrier_complete(bar, b.x, nloc, nx); b.st[0] = nloc; b.st[1] = nx; }
        const unsigned old = xb_add(&bar[XB_XSUB(b.x)], 1u);
        const unsigned gen = old / nloc;
        if (old + 1u == (gen + 1u) * nloc) {
            __builtin_amdgcn_fence(__ATOMIC_RELEASE, "agent");
            asm volatile("s_waitcnt vmcnt(0)" ::: "memory");
            const unsigned og = xb_add(&bar[XB_TOP], 1u);
            const unsigned tg = og / nx;
            if (og + 1u == (tg + 1u) * nx) xb_add(&bar[XB_TOPGEN], 1u);
            else XB_SPIN(xb_ld(&bar[XB_TOPGEN]) == tg, bar);
            __builtin_amdgcn_fence(__ATOMIC_ACQUIRE, "agent");
            xb_add(&bar[XB_XGEN(b.x)], 1u);
            asm volatile("s_waitcnt vmcnt(0)" ::: "memory");
        } else {
            XB_SPIN(xb_ld(&bar[XB_XGEN(b.x)]) == gen, bar);
            __builtin_amdgcn_fence(__ATOMIC_ACQUIRE, "agent");
            asm volatile("s_waitcnt vmcnt(0)" ::: "memory");
        }
    }
    __syncthreads();
}
constexpr int NWAVES = 8, NTHREADS = 512;
constexpr int T = 16384, D = 1024, SEQ = 4096, NBATCH = 4, NMEM = 256, NEXP = 32, TOPK = 4;
constexpr int NPROJ = 9728;
constexpr int XS_ROWS = T * TOPK + NEXP * 256;
constexpr float EPS = 1e-6f, LOG2E = 1.4426950408889634f, LN2 = 0.6931471805599453f;
#ifndef MK_N_LAUNCHES
#define MK_N_LAUNCHES 1
#endif
constexpr int N_PHASES = 14;
constexpr int N_LAUNCHES = MK_N_LAUNCHES;

constexpr size_t MiB = 1u << 20;
constexpr size_t WS_CTL = 0, CTL_ZERO_BYTES = 1 * MiB;
constexpr size_t CTL_SS2 = 256 * 1024, CTL_CNT = 384 * 1024, CTL_FILL = 384 * 1024 + 256;
constexpr size_t WS_WCQ = 1 * MiB, WS_WCO = 2 * MiB, WS_WO = 3 * MiB, WS_KV = 5 * MiB;
constexpr size_t WS_TOPI = 7 * MiB, WS_TOPW = WS_TOPI + 256 * 1024, WS_RSTD3 = WS_TOPW + 256 * 1024, WS_ROWSLOT = WS_RSTD3 + 64 * 1024;
constexpr size_t WS_EXPGU = 8 * MiB, WS_EXPD = 136 * MiB;
constexpr size_t WS_PROJ = 8 * MiB, WS_U1 = 312 * MiB, WS_W1T = 344 * MiB, WS_OG = 312 * MiB, WS_LSE = 360 * MiB;
constexpr size_t WS_WBA = 363 * MiB, WS_WBC = 364 * MiB, WS_MN = 366 * MiB, WS_YA = 368 * MiB, WS_YC = 384 * MiB, WS_MIX = 416 * MiB, WS_WCKV = 448 * MiB;
constexpr size_t WS_H1 = 200 * MiB, WS_H1B = 264 * MiB, WS_Q2 = 296 * MiB, WS_O2 = 312 * MiB;
constexpr size_t WS_XS = 200 * MiB, WS_HDN = 344 * MiB, WS_Y = 200 * MiB, WS_END = 488 * MiB;
static_assert(WS_ROWSLOT + (size_t)XS_ROWS * 4 <= WS_EXPGU, "misc region");
static_assert(WS_XS + (size_t)XS_ROWS * D * 2 <= WS_HDN && WS_HDN + (size_t)XS_ROWS * D * 2 <= WS_END, "moe rows");
constexpr int CW_TMO = 0, CW_CODE = 1, CW_BAR = 4096;

constexpr int LDS_BYTES = 163840;
constexpr int TBL_OFF = 163840 - 2048;
constexpr int MISC_OFF = 163840 - 256;

struct Frame {
    LAS unsigned char* lds;
    volatile LAS unsigned* MISC;
    gu32* ctl;
    unsigned char* ws;
    int tid, lane, wave, vcu, G;
};
__device__ __forceinline__ float wave_sum(float v) {
#pragma unroll
    for (int o = 1; o < 64; o <<= 1) v += __shfl_xor(v, o);
    return v;
}
typedef unsigned long long u64;
__device__ __forceinline__ float bf_lo(unsigned w) { return __builtin_bit_cast(float, w << 16); }
__device__ __forceinline__ float bf_hi(unsigned w) { return __builtin_bit_cast(float, w & 0xffff0000u); }

__device__ __forceinline__ void transpose_item(const float* W, int K, int N, bf16* WT, int drow, int k0, int n0, const float* gain, LAS float* scr, int lane) {
#pragma unroll 8
    for (int i = 0; i < 32; ++i) { const int kk = 2 * i + (lane >> 5); float w = W[(size_t)(k0 + kk) * N + n0 + (lane & 31)]; if (gain) w *= gain[k0 + kk]; scr[kk * 33 + (lane & 31)] = w; }
    LDS_WAIT(); asm volatile("" ::: "memory");
    const int c = lane & 7;
#pragma unroll
    for (int j = 0; j < 4; ++j) { const int n = (lane >> 3) + 8 * j; const LAS float* s = scr + (8 * c) * 33 + n;
        v4u o; o.x = pk2(s[0 * 33], s[1 * 33]); o.y = pk2(s[2 * 33], s[3 * 33]); o.z = pk2(s[4 * 33], s[5 * 33]); o.w = pk2(s[6 * 33], s[7 * 33]);
        *(GAS v4u*)(WT + (size_t)(drow + n) * K + k0 + 8 * c) = o; }
    LDS_WAIT(); asm volatile("" ::: "memory");
}
__device__ __forceinline__ bool transpose_mat(int& r, const float* W, int K, int N, bf16* WT, int drow0, const float* gain, LAS float* scr, int lane) {
    const int nblk = N / 32, items = (K / 64) * nblk;
    if (r < items) { const int kb = r / nblk, nb = r % nblk; transpose_item(W, K, N, WT, drow0 + 32 * nb, 64 * kb, 32 * nb, gain, scr, lane); return true; }
    r -= items; return false;
}
__device__ __forceinline__ void rms_row_to_bf16(const float* xrow, const float* gain, bf16* orow, int lane) {
    const GAS f32x4* xr = (const GAS f32x4*)xrow + lane; const GAS f32x4* gr = (const GAS f32x4*)gain + lane;
    f32x4 v[4]; float s = 0.f;
#pragma unroll
    for (int j = 0; j < 4; ++j) { v[j] = xr[64 * j]; s += (v[j].x * v[j].x + v[j].y * v[j].y) + (v[j].z * v[j].z + v[j].w * v[j].w); }
    const float rstd = 1.f / sqrtf(wave_sum(s) * (1.f / D) + EPS);
    GAS u64* o8 = (GAS u64*)orow + lane;
#pragma unroll
    for (int j = 0; j < 4; ++j) { const f32x4 g = gr[64 * j]; o8[64 * j] = (u64)pk2(v[j].x * rstd * g.x, v[j].y * rstd * g.y) | ((u64)pk2(v[j].z * rstd * g.z, v[j].w * rstd * g.w) << 32); }
}

__device__ __forceinline__ int xcd_remap(int wgid, int nwg) { const int q = nwg / 8, r = nwg % 8, xcd = wgid % 8, off = wgid / 8; return (xcd < r ? xcd * (q + 1) : r * (q + 1) + (xcd - r) * q) + off; }
struct MoeOrder {
    const volatile LAS int* tpre; int npn, G, c;
    __device__ __forceinline__ bool next(int i, pg8::Unit& u) const {
        const int total = tpre[32] * npn; const long L = (long)i * G + c; if (L >= total) return false;
        const int U = xcd_remap((int)L, total);
        int e = 0;
#pragma unroll 1
        for (int k = 1; k < 32; ++k) if (tpre[k] * npn <= U) e = k;
        const int t0 = tpre[e], nt = tpre[e + 1] - t0, Ul = U - t0 * npn;
        u.pm = t0 + Ul % nt; u.pn = e * npn + Ul / nt; return true;
    }
    __device__ __forceinline__ void a_ready(const pg8::Unit&) const {}
    __device__ __forceinline__ void done(const pg8::Unit&) const {}
};
struct In {
    const float *x, *mem, *norm_mix, *w_in, *conv_w, *w_ba, *w_bc, *w_gate, *b_gate, *w_out, *norm_cross, *norm_mem, *w_cq, *w_ckv, *w_co, *norm_moe,
                *router_w, *router_b, *w_eg, *b_eg, *w_eu, *b_eu, *w_ed, *b_ed, *norm_final;
};

__device__ __forceinline__ void phase_prologue(Frame& F, const In& in) {
    LAS float* scr = (LAS float*)(F.lds + F.wave * 16384);
    const int gw = F.vcu * NWAVES + F.wave, NGW = F.G * NWAVES;
    unsigned char* ws = F.ws;
    constexpr int NITEMS = 16 * 240 + 16 * 64 + 8 * 32 + 16 * 32 + 16 * 32 + 16 * 16 + 16 * 32 + 8 * 32;
    for (int it = gw; it < NITEMS; it += NGW) {
        int r = it;
        if (transpose_mat(r, in.w_in, 1024, 7680, (bf16*)(ws + WS_W1T), 0, nullptr, scr, F.lane)) continue;
        if (transpose_mat(r, in.w_gate, 1024, 2048, (bf16*)(ws + WS_W1T), 7680, nullptr, scr, F.lane)) continue;
        if (transpose_mat(r, in.w_ba, 512, 1024, (bf16*)(ws + WS_WBA), 0, nullptr, scr, F.lane)) continue;
        if (transpose_mat(r, in.w_bc, 1024, 1024, (bf16*)(ws + WS_WBC), 0, nullptr, scr, F.lane)) continue;
        if (transpose_mat(r, in.w_out, 1024, 1024, (bf16*)(ws + WS_WO), 0, nullptr, scr, F.lane)) continue;
        if (transpose_mat(r, in.w_cq, 1024, 512, (bf16*)(ws + WS_WCQ), 0, in.norm_cross, scr, F.lane)) continue;
        if (transpose_mat(r, in.w_ckv, 1024, 1024, (bf16*)(ws + WS_WCKV), 0, nullptr, scr, F.lane)) continue;
        transpose_mat(r, in.w_co, 512, 1024, (bf16*)(ws + WS_WCO), 0, nullptr, scr, F.lane);
    }
    for (int m = gw; m < T; m += NGW) rms_row_to_bf16(in.x + (size_t)m * D, in.norm_mix, (bf16*)(ws + WS_U1) + (size_t)m * D, F.lane);
    for (int m = gw; m < NBATCH * NMEM; m += NGW) rms_row_to_bf16(in.mem + (size_t)m * D, in.norm_mem, (bf16*)(ws + WS_MN) + (size_t)m * D, F.lane);
}

__device__ __forceinline__ void phase_expert_convert(Frame& F, const In& in) {
    LAS float* scr = (LAS float*)(F.lds + F.wave * 16384);
    const int gw = F.vcu * NWAVES + F.wave, NGW = F.G * NWAVES;
    constexpr int PER = 16 * 32, NITEMS = NEXP * 3 * PER;
    for (int it = gw; it < NITEMS; it += NGW) {
        const int mtx = it / PER, r = it % PER, e = mtx / 3, which = mtx % 3, kb = r / 32, nb = r % 32, n0 = 32 * nb;
        if (which == 0)      transpose_item(in.w_eg + (size_t)e * D * D, D, D, (bf16*)(F.ws + WS_EXPGU) + (size_t)e * 2048 * D, (n0 >> 7) * 256 + (n0 & 127), 64 * kb, n0, nullptr, scr, F.lane);
        else if (which == 1) transpose_item(in.w_eu + (size_t)e * D * D, D, D, (bf16*)(F.ws + WS_EXPGU) + (size_t)e * 2048 * D, (n0 >> 7) * 256 + 128 + (n0 & 127), 64 * kb, n0, nullptr, scr, F.lane);
        else                 transpose_item(in.w_ed + (size_t)e * D * D, D, D, (bf16*)(F.ws + WS_EXPD) + (size_t)e * D * D, n0, 64 * kb, n0, nullptr, scr, F.lane);
    }
}

__device__ __forceinline__ void dil_attn_unit(Frame& F, int unit) {
    const int rn = unit & 31, bgh = unit >> 5, h = bgh & 7, bg = bgh >> 3, g = bg % 3, b = bg / 3;
    const int dil = g == 0 ? 1 : (g == 1 ? 4 : 16), nper = 32 / dil, r = rn / nper, n = rn % nper;
    const bf16* PROJ = (const bf16*)(F.ws + WS_PROJ);
    LAS bf16* Ks = (LAS bf16*)F.lds; LAS bf16* Vs = Ks + 256 * 72;
    const int tid = F.tid;
#pragma unroll
    for (int it = 0; it < 4; ++it) {
        const int row = (tid >> 3) + 64 * it, ch = tid & 7, j = 128 * (n - 1) + row;
        v4u kv = (v4u){0u, 0u, 0u, 0u}, vv = kv;
        if (j >= 0) { const size_t grow = (size_t)b * SEQ + (size_t)j * dil + r; const bf16* p = PROJ + grow * NPROJ + g * 1536 + h * 64 + ch * 8; kv = *(const GAS v4u*)(p + 512); vv = *(const GAS v4u*)(p + 1024); }
        *(LAS v4u*)(Ks + row * 72 + ch * 8) = kv; *(LAS v4u*)(Vs + row * 72 + ch * 8) = vv;
    }
    __syncthreads();
    const int ql = tid >> 2, part = tid & 3;
    const size_t growq = (size_t)b * SEQ + (size_t)(128 * n + ql) * dil + r;
    float q[16], acc[16];
    { const bf16* p = PROJ + growq * NPROJ + g * 1536 + h * 64 + part * 16; const v4u a = *(const GAS v4u*)p, c = *(const GAS v4u*)(p + 8);
      const float sc = 0.125f * LOG2E;
      q[0] = bf_lo(a.x) * sc; q[1] = bf_hi(a.x) * sc; q[2] = bf_lo(a.y) * sc; q[3] = bf_hi(a.y) * sc; q[4] = bf_lo(a.z) * sc; q[5] = bf_hi(a.z) * sc; q[6] = bf_lo(a.w) * sc; q[7] = bf_hi(a.w) * sc;
      q[8] = bf_lo(c.x) * sc; q[9] = bf_hi(c.x) * sc; q[10] = bf_lo(c.y) * sc; q[11] = bf_hi(c.y) * sc; q[12] = bf_lo(c.z) * sc; q[13] = bf_hi(c.z) * sc; q[14] = bf_lo(c.w) * sc; q[15] = bf_hi(c.w) * sc; }
#pragma unroll
    for (int i = 0; i < 16; ++i) acc[i] = 0.f;
    float mrun = -1e30f, l = 0.f;
    const float slope2 = exp2f(-(float)(h + 1)) * (float)dil * LOG2E;
    const int jbase = 128 * (n - 1) + ql;
#pragma unroll 1
    for (int kk = 0; kk <= 128; ++kk) {
        const int kl = ql + kk; const bool valid = (jbase + kk) >= 0;
        const LAS bf16* kp = Ks + kl * 72 + part * 16; const v4u a = *(const LAS v4u*)kp, c = *(const LAS v4u*)(kp + 8);
        float s = q[0] * bf_lo(a.x) + q[1] * bf_hi(a.x) + q[2] * bf_lo(a.y) + q[3] * bf_hi(a.y) + q[4] * bf_lo(a.z) + q[5] * bf_hi(a.z) + q[6] * bf_lo(a.w) + q[7] * bf_hi(a.w)
                + q[8] * bf_lo(c.x) + q[9] * bf_hi(c.x) + q[10] * bf_lo(c.y) + q[11] * bf_hi(c.y) + q[12] * bf_lo(c.z) + q[13] * bf_hi(c.z) + q[14] * bf_lo(c.w) + q[15] * bf_hi(c.w);
        s += __shfl_xor(s, 1); s += __shfl_xor(s, 2);
        s -= slope2 * (float)(128 - kk);
        const float mn = valid ? fmaxf(mrun, s) : mrun;
        const float alpha = __builtin_amdgcn_exp2f(mrun - mn), p = valid ? __builtin_amdgcn_exp2f(s - mn) : 0.f;
        mrun = mn; l = l * alpha + p;
        const LAS bf16* vp = Vs + kl * 72 + part * 16; const v4u va = *(const LAS v4u*)vp, vc = *(const LAS v4u*)(vp + 8);
        acc[0] = acc[0] * alpha + p * bf_lo(va.x); acc[1] = acc[1] * alpha + p * bf_hi(va.x); acc[2] = acc[2] * alpha + p * bf_lo(va.y); acc[3] = acc[3] * alpha + p * bf_hi(va.y);
        acc[4] = acc[4] * alpha + p * bf_lo(va.z); acc[5] = acc[5] * alpha + p * bf_hi(va.z); acc[6] = acc[6] * alpha + p * bf_lo(va.w); acc[7] = acc[7] * alpha + p * bf_hi(va.w);
        acc[8] = acc[8] * alpha + p * bf_lo(vc.x); acc[9] = acc[9] * alpha + p * bf_hi(vc.x); acc[10] = acc[10] * alpha + p * bf_lo(vc.y); acc[11] = acc[11] * alpha + p * bf_hi(vc.y);
        acc[12] = acc[12] * alpha + p * bf_lo(vc.z); acc[13] = acc[13] * alpha + p * bf_hi(vc.z); acc[14] = acc[14] * alpha + p * bf_lo(vc.w); acc[15] = acc[15] * alpha + p * bf_hi(vc.w);
    }
    const float inv = 1.f / l;
    bf16* og = (bf16*)(F.ws + WS_OG) + ((size_t)g * T + growq) * 512 + h * 64 + part * 16;
    v4u o0, o1;
    o0.x = pk2(acc[0] * inv, acc[1] * inv); o0.y = pk2(acc[2] * inv, acc[3] * inv); o0.z = pk2(acc[4] * inv, acc[5] * inv); o0.w = pk2(acc[6] * inv, acc[7] * inv);
    o1.x = pk2(acc[8] * inv, acc[9] * inv); o1.y = pk2(acc[10] * inv, acc[11] * inv); o1.z = pk2(acc[12] * inv, acc[13] * inv); o1.w = pk2(acc[14] * inv, acc[15] * inv);
    *(GAS v4u*)og = o0; *(GAS v4u*)(og + 8) = o1;
    if (part == 0) ((float*)(F.ws + WS_LSE))[((size_t)g * T + growq) * 8 + h] = (mrun + __builtin_amdgcn_logf(l)) * LN2;
    __syncthreads();
}

__device__ __forceinline__ void phase_combine_conv(Frame& F, const In& in) {
    const int gw = F.vcu * NWAVES + F.wave, NGW = F.G * NWAVES, lane = F.lane;
    const bf16* PROJ = (const bf16*)(F.ws + WS_PROJ); const bf16* OG = (const bf16*)(F.ws + WS_OG); const float* LSE = (const float*)(F.ws + WS_LSE);
    for (int t = gw; t < T; t += NGW) {
        { const int head = lane >> 3;
          const float l0 = LSE[((size_t)0 * T + t) * 8 + head], l1 = LSE[((size_t)1 * T + t) * 8 + head], l2 = LSE[((size_t)2 * T + t) * 8 + head];
          const float mx = fmaxf(l0, fmaxf(l1, l2)); float w0 = __expf(l0 - mx), w1 = __expf(l1 - mx), w2 = __expf(l2 - mx); const float inv = 1.f / (w0 + w1 + w2); w0 *= inv; w1 *= inv; w2 *= inv;
          const v4u a = *(const GAS v4u*)(OG + ((size_t)0 * T + t) * 512 + 8 * lane), b = *(const GAS v4u*)(OG + ((size_t)1 * T + t) * 512 + 8 * lane), c = *(const GAS v4u*)(OG + ((size_t)2 * T + t) * 512 + 8 * lane);
          v4u o;
          o.x = pk2(w0 * bf_lo(a.x) + w1 * bf_lo(b.x) + w2 * bf_lo(c.x), w0 * bf_hi(a.x) + w1 * bf_hi(b.x) + w2 * bf_hi(c.x));
          o.y = pk2(w0 * bf_lo(a.y) + w1 * bf_lo(b.y) + w2 * bf_lo(c.y), w0 * bf_hi(a.y) + w1 * bf_hi(b.y) + w2 * bf_hi(c.y));
          o.z = pk2(w0 * bf_lo(a.z) + w1 * bf_lo(b.z) + w2 * bf_lo(c.z), w0 * bf_hi(a.z) + w1 * bf_hi(b.z) + w2 * bf_hi(c.z));
          o.w = pk2(w0 * bf_lo(a.w) + w1 * bf_lo(b.w) + w2 * bf_lo(c.w), w0 * bf_hi(a.w) + w1 * bf_hi(b.w) + w2 * bf_hi(c.w));
          *(GAS v4u*)((bf16*)(F.ws + WS_YA) + (size_t)t * 512 + 8 * lane) = o; }
        const int pos = t & (SEQ - 1);
#pragma unroll
        for (int half = 0; half < 2; ++half) {
            const int c = 8 * lane + 512 * half;
            float z[3][8];
#pragma unroll
            for (int dd = 0; dd < 3; ++dd) {
                const int back = 2 - dd;
                if (pos - back >= 0) { const bf16* p = PROJ + (size_t)(t - back) * NPROJ + 4608 + c; const v4u gc = *(const GAS v4u*)(p + 1024), xc = *(const GAS v4u*)(p + 2048);
                    z[dd][0] = bf_lo(gc.x) * bf_lo(xc.x); z[dd][1] = bf_hi(gc.x) * bf_hi(xc.x); z[dd][2] = bf_lo(gc.y) * bf_lo(xc.y); z[dd][3] = bf_hi(gc.y) * bf_hi(xc.y);
                    z[dd][4] = bf_lo(gc.z) * bf_lo(xc.z); z[dd][5] = bf_hi(gc.z) * bf_hi(xc.z); z[dd][6] = bf_lo(gc.w) * bf_lo(xc.w); z[dd][7] = bf_hi(gc.w) * bf_hi(xc.w); }
                else {
#pragma unroll
                    for (int i = 0; i < 8; ++i) z[dd][i] = 0.f; }
            }
            const v4u gb = *(const GAS v4u*)(PROJ + (size_t)t * NPROJ + 4608 + c);
            float y[8];
#pragma unroll
            for (int i = 0; i < 8; ++i) y[i] = in.conv_w[c + i] * z[0][i] + in.conv_w[1024 + c + i] * z[1][i] + in.conv_w[2048 + c + i] * z[2][i];
            v4u o; o.x = pk2(bf_lo(gb.x) * y[0], bf_hi(gb.x) * y[1]); o.y = pk2(bf_lo(gb.y) * y[2], bf_hi(gb.y) * y[3]); o.z = pk2(bf_lo(gb.z) * y[4], bf_hi(gb.z) * y[5]); o.w = pk2(bf_lo(gb.w) * y[6], bf_hi(gb.w) * y[7]);
            *(GAS v4u*)((bf16*)(F.ws + WS_YC) + (size_t)t * 1024 + c) = o;
        }
    }
}

__device__ __forceinline__ void cross_attn_unit(Frame& F, int unit) {
    const int qc = unit & 31, bh = unit >> 5, h = bh & 3, b = bh >> 2, tid = F.tid;
    const bf16* KV = (const bf16*)(F.ws + WS_KV); const bf16* Q2 = (const bf16*)(F.ws + WS_Q2);
    LAS bf16* Ks = (LAS bf16*)F.lds; LAS bf16* Vs = Ks + 256 * 136;
#pragma unroll
    for (int it = 0; it < 8; ++it) {
        const int row = (tid >> 4) + 32 * it, ch = tid & 15; const bf16* p = KV + (size_t)(b * NMEM + row) * 1024 + h * 128 + ch * 8;
        *(LAS v4u*)(Ks + row * 136 + ch * 8) = *(const GAS v4u*)p; *(LAS v4u*)(Vs + row * 136 + ch * 8) = *(const GAS v4u*)(p + 512);
    }
    __syncthreads();
    const int ql = tid >> 2, part = tid & 3; const size_t grow = (size_t)b * SEQ + 128 * qc + ql;
    float q[32], acc[32];
    { const bf16* p = Q2 + grow * 512 + h * 128 + part * 32; const float sc = 0.08838834764831845f * LOG2E;
#pragma unroll
      for (int c4 = 0; c4 < 4; ++c4) { const v4u a = *(const GAS v4u*)(p + 8 * c4);
          q[8 * c4 + 0] = bf_lo(a.x) * sc; q[8 * c4 + 1] = bf_hi(a.x) * sc; q[8 * c4 + 2] = bf_lo(a.y) * sc; q[8 * c4 + 3] = bf_hi(a.y) * sc;
          q[8 * c4 + 4] = bf_lo(a.z) * sc; q[8 * c4 + 5] = bf_hi(a.z) * sc; q[8 * c4 + 6] = bf_lo(a.w) * sc; q[8 * c4 + 7] = bf_hi(a.w) * sc; } }
#pragma unroll
    for (int i = 0; i < 32; ++i) acc[i] = 0.f;
    float mrun = -1e30f, l = 0.f;
#pragma unroll 1
    for (int key = 0; key < NMEM; ++key) {
        const LAS bf16* kp = Ks + key * 136 + part * 32; float s = 0.f;
#pragma unroll
        for (int c4 = 0; c4 < 4; ++c4) { const v4u a = *(const LAS v4u*)(kp + 8 * c4);
            s += q[8 * c4 + 0] * bf_lo(a.x) + q[8 * c4 + 1] * bf_hi(a.x) + q[8 * c4 + 2] * bf_lo(a.y) + q[8 * c4 + 3] * bf_hi(a.y)
               + q[8 * c4 + 4] * bf_lo(a.z) + q[8 * c4 + 5] * bf_hi(a.z) + q[8 * c4 + 6] * bf_lo(a.w) + q[8 * c4 + 7] * bf_hi(a.w); }
        s += __shfl_xor(s, 1); s += __shfl_xor(s, 2);
        const float mn = fmaxf(mrun, s), alpha = __builtin_amdgcn_exp2f(mrun - mn), p = __builtin_amdgcn_exp2f(s - mn);
        mrun = mn; l = l * alpha + p;
        const LAS bf16* vp = Vs + key * 136 + part * 32;
#pragma unroll
        for (int c4 = 0; c4 < 4; ++c4) { const v4u a = *(const LAS v4u*)(vp + 8 * c4);
            acc[8 * c4 + 0] = acc[8 * c4 + 0] * alpha + p * bf_lo(a.x); acc[8 * c4 + 1] = acc[8 * c4 + 1] * alpha + p * bf_hi(a.x);
            acc[8 * c4 + 2] = acc[8 * c4 + 2] * alpha + p * bf_lo(a.y); acc[8 * c4 + 3] = acc[8 * c4 + 3] * alpha + p * bf_hi(a.y);
            acc[8 * c4 + 4] = acc[8 * c4 + 4] * alpha + p * bf_lo(a.z); acc[8 * c4 + 5] = acc[8 * c4 + 5] * alpha + p * bf_hi(a.z);
            acc[8 * c4 + 6] = acc[8 * c4 + 6] * alpha + p * bf_lo(a.w); acc[8 * c4 + 7] = acc[8 * c4 + 7] * alpha + p * bf_hi(a.w); }
    }
    const float inv = 1.f / l;
    bf16* op = (bf16*)(F.ws + WS_O2) + grow * 512 + h * 128 + part * 32;
#pragma unroll
    for (int c4 = 0; c4 < 4; ++c4) { v4u o; o.x = pk2(acc[8 * c4 + 0] * inv, acc[8 * c4 + 1] * inv); o.y = pk2(acc[8 * c4 + 2] * inv, acc[8 * c4 + 3] * inv);
        o.z = pk2(acc[8 * c4 + 4] * inv, acc[8 * c4 + 5] * inv); o.w = pk2(acc[8 * c4 + 6] * inv, acc[8 * c4 + 7] * inv); *(GAS v4u*)(op + 8 * c4) = o; }
    __syncthreads();
}

__device__ __forceinline__ float rlane(float x, int L) { int r = __builtin_amdgcn_readlane(__builtin_bit_cast(int, x), L); asm volatile("" : "+s"(r)); return __builtin_bit_cast(float, r); }
__device__ __forceinline__ void phase_router(Frame& F, const In& in, const float* H2) {
    LAS float* wl = (LAS float*)F.lds;
    for (int i = F.tid; i < 1024 * 32 / 4; i += NTHREADS) ((LAS f32x4*)wl)[i] = ((const GAS f32x4*)in.router_w)[i];
    __syncthreads();
    const int gw = F.vcu * NWAVES + F.wave, NGW = F.G * NWAVES, lane = F.lane, e = lane & 31;
    int* topi = (int*)(F.ws + WS_TOPI); float* topw = (float*)(F.ws + WS_TOPW); float* rstd3 = (float*)(F.ws + WS_RSTD3);
    unsigned* cnt = (unsigned*)(F.ws + WS_CTL + CTL_CNT);
    const float rb = in.router_b[e];
    for (int t = gw; t < T; t += NGW) {
        const GAS f32x4* xr = (const GAS f32x4*)(H2 + (size_t)t * D) + lane; const GAS f32x4* gr = (const GAS f32x4*)in.norm_moe + lane;
        f32x4 v[4]; float s = 0.f;
#pragma unroll
        for (int j = 0; j < 4; ++j) { v[j] = xr[64 * j]; s += (v[j].x * v[j].x + v[j].y * v[j].y) + (v[j].z * v[j].z + v[j].w * v[j].w); }
        const float rstd = 1.f / sqrtf(wave_sum(s) * (1.f / D) + EPS);
        if (lane == 0) rstd3[t] = rstd;
#pragma unroll
        for (int j = 0; j < 4; ++j) { const f32x4 g = gr[64 * j]; v[j] = v[j] * g * rstd; }
        float a0 = 0.f, a1 = 0.f, a2 = 0.f, a3 = 0.f;
#pragma unroll
        for (int j = 0; j < 4; ++j) {
#pragma unroll 4
            for (int L = 0; L < 64; ++L) {
                const LAS float* wp = wl + (size_t)(4 * (64 * j + L)) * 32 + e;
                a0 += rlane(v[j].x, L) * wp[0];
                a1 += rlane(v[j].y, L) * wp[32];
                a2 += rlane(v[j].z, L) * wp[64];
                a3 += rlane(v[j].w, L) * wp[96];
            }
        }
        float val = (a0 + a1) + (a2 + a3) + rb; const int idx = e;
        float tv0 = 0.f, tv1 = 0.f, tv2 = 0.f, tv3 = 0.f; int ti0 = 0, ti1 = 0, ti2 = 0, ti3 = 0;
#pragma unroll
        for (int k = 0; k < 4; ++k) {
            float bv = val; int bi = idx;
#pragma unroll
            for (int off = 1; off < 32; off <<= 1) { const float ov = __shfl_xor(bv, off); const int oi = __shfl_xor(bi, off); if (ov > bv || (ov == bv && oi < bi)) { bv = ov; bi = oi; } }
            if (k == 0) { tv0 = bv; ti0 = bi; } else if (k == 1) { tv1 = bv; ti1 = bi; } else if (k == 2) { tv2 = bv; ti2 = bi; } else { tv3 = bv; ti3 = bi; }
            if (idx == bi) val = -INFINITY;
        }
        const float e1 = __expf(tv1 - tv0), e2 = __expf(tv2 - tv0), e3 = __expf(tv3 - tv0), inv = 1.f / (1.f + e1 + e2 + e3);
        if (lane < 4) {
            const int ei = lane == 0 ? ti0 : (lane == 1 ? ti1 : (lane == 2 ? ti2 : ti3));
            const float wv = (lane == 0 ? 1.f : (lane == 1 ? e1 : (lane == 2 ? e2 : e3))) * inv;
            topi[t * 4 + lane] = ei; topw[t * 4 + lane] = wv;
            __hip_atomic_fetch_add(cnt + ei, 1u, __ATOMIC_RELAXED, __HIP_MEMORY_SCOPE_AGENT);
        }
    }
    __syncthreads();
}

__device__ __forceinline__ void build_tpre(Frame& F) {
    volatile LAS int* tpre = (volatile LAS int*)(F.lds + TBL_OFF);
    const unsigned* cnt = (const unsigned*)(F.ws + WS_CTL + CTL_CNT);
    if (F.tid == 0) { int acc = 0;
        for (int e = 0; e < NEXP; ++e) { tpre[e] = acc; const unsigned c = __hip_atomic_load(cnt + e, __ATOMIC_RELAXED, __HIP_MEMORY_SCOPE_AGENT); tpre[64 + e] = (int)c; acc += (int)((c + 255u) >> 8); }
        tpre[32] = acc; }
    __syncthreads();
}

__device__ __forceinline__ void phase_scatter(Frame& F, const In& in, const float* H2) {
    build_tpre(F);
    volatile LAS int* tpre = (volatile LAS int*)(F.lds + TBL_OFF);
    const int gw = F.vcu * NWAVES + F.wave, NGW = F.G * NWAVES, lane = F.lane;
    const int* topi = (const int*)(F.ws + WS_TOPI); const float* rstd3 = (const float*)(F.ws + WS_RSTD3);
    unsigned* fill = (unsigned*)(F.ws + WS_CTL + CTL_FILL); int* rowslot = (int*)(F.ws + WS_ROWSLOT); bf16* XS = (bf16*)(F.ws + WS_XS);
    if ((int)blockIdx.x < NEXP) { const int e = blockIdx.x; for (int R = tpre[e] * 256 + tpre[64 + e] + F.tid; R < tpre[e + 1] * 256; R += NTHREADS) rowslot[R] = -1; }
    for (int t = gw; t < T; t += NGW) {
        const GAS f32x4* xr = (const GAS f32x4*)(H2 + (size_t)t * D) + lane; const GAS f32x4* gr = (const GAS f32x4*)in.norm_moe + lane;
        const float rstd = rstd3[t];
        u64 o[4];
#pragma unroll
        for (int j = 0; j < 4; ++j) { const f32x4 v = xr[64 * j], g = gr[64 * j]; o[j] = (u64)pk2(v.x * rstd * g.x, v.y * rstd * g.y) | ((u64)pk2(v.z * rstd * g.z, v.w * rstd * g.w) << 32); }
#pragma unroll
        for (int k = 0; k < 4; ++k) {
            const int e = __builtin_amdgcn_readfirstlane(topi[t * 4 + k]);
            unsigned pos = 0; if (lane == 0) pos = __hip_atomic_fetch_add(fill + e, 1u, __ATOMIC_RELAXED, __HIP_MEMORY_SCOPE_AGENT);
            pos = __builtin_amdgcn_readfirstlane(pos);
            const int R = tpre[e] * 256 + (int)pos;
            GAS u64* dst = (GAS u64*)(XS + (size_t)R * D) + lane;
#pragma unroll
            for (int j = 0; j < 4; ++j) dst[64 * j] = o[j];
            if (lane == 0) rowslot[R] = t * 4 + k;
        }
    }
}

__device__ __forceinline__ void phase_final(Frame& F, const In& in, const float* H2, float* OUT) {
    const int gw = F.vcu * NWAVES + F.wave, NGW = F.G * NWAVES, lane = F.lane;
    const bf16* Y = (const bf16*)(F.ws + WS_Y);
    for (int t = gw; t < T; t += NGW) {
        const GAS f32x4* xr = (const GAS f32x4*)(H2 + (size_t)t * D) + lane; const GAS f32x4* gr = (const GAS f32x4*)in.norm_final + lane;
        f32x4 v[4]; float s = 0.f;
#pragma unroll
        for (int j = 0; j < 4; ++j) v[j] = xr[64 * j];
#pragma unroll
        for (int k = 0; k < 4; ++k) { const GAS u64* yr = (const GAS u64*)(Y + (size_t)(t * 4 + k) * D) + lane;
#pragma unroll
            for (int j = 0; j < 4; ++j) { const u64 w = yr[64 * j]; const unsigned lo = (unsigned)w, hi = (unsigned)(w >> 32); v[j].x += bf_lo(lo); v[j].y += bf_hi(lo); v[j].z += bf_lo(hi); v[j].w += bf_hi(hi); } }
#pragma unroll
        for (int j = 0; j < 4; ++j) s += (v[j].x * v[j].x + v[j].y * v[j].y) + (v[j].z * v[j].z + v[j].w * v[j].w);
        const float rstd = 1.f / sqrtf(wave_sum(s) * (1.f / D) + EPS);
        GAS f32x4* orow = (GAS f32x4*)(OUT + (size_t)t * D) + lane;
#pragma unroll
        for (int j = 0; j < 4; ++j) orow[64 * j] = v[j] * gr[64 * j] * rstd;
    }
}
struct Args { const float* in[25]; float* out; unsigned char* ws; int ph_lo, ph_hi; };
#ifndef PG8_SP2
#define PG8_SP2 true
#endif
#ifndef PG8_ALIGN
#define PG8_ALIGN true
#endif
__global__ void __launch_bounds__(NTHREADS, 2) mega_fwd(Args args) {
    extern __shared__ __attribute__((aligned(16))) unsigned char lds[];
    Frame F;
    F.lds = (LAS unsigned char*)lds; F.MISC = (volatile LAS unsigned*)(F.lds + MISC_OFF);
    F.tid = threadIdx.x; F.lane = F.tid & 63; F.wave = __builtin_amdgcn_readfirstlane(F.tid >> 6);
    F.G = gridDim.x; { const int bx = blockIdx.x; F.vcu = (F.G % 8 == 0) ? (bx % 8) * (F.G / 8) + bx / 8 : bx; }
    F.ws = args.ws; F.ctl = (gu32*)(args.ws + WS_CTL);
    In in;
    in.x = args.in[0]; in.mem = args.in[1]; in.norm_mix = args.in[2]; in.w_in = args.in[3]; in.conv_w = args.in[4]; in.w_ba = args.in[5]; in.w_bc = args.in[6];
    in.w_gate = args.in[7]; in.b_gate = args.in[8]; in.w_out = args.in[9]; in.norm_cross = args.in[10]; in.norm_mem = args.in[11]; in.w_cq = args.in[12];
    in.w_ckv = args.in[13]; in.w_co = args.in[14]; in.norm_moe = args.in[15]; in.router_w = args.in[16]; in.router_b = args.in[17]; in.w_eg = args.in[18];
    in.b_eg = args.in[19]; in.w_eu = args.in[20]; in.b_eu = args.in[21]; in.w_ed = args.in[22]; in.b_ed = args.in[23]; in.norm_final = args.in[24];
    unsigned char* ws = args.ws;
    for (int u = F.tid; u < 64; u += NTHREADS) ((LAS unsigned*)(F.lds + MISC_OFF))[u] = 0u;
    __syncthreads();
    XcdBarrier bar; bar.bar = (unsigned*)(F.ctl + CW_BAR); bar.x = 0; bar.st = nullptr;
    if (N_LAUNCHES == 1) bar = xcd_barrier_post((unsigned*)(F.ctl + CW_BAR), F.MISC + 8);
    const int lo = args.ph_lo, hi = args.ph_hi;
#define IN(k) (lo <= (k) && (k) < hi)
#define SEAM(k) do { if (IN(k) && IN((k) + 1)) xcd_barrier(bar); } while (0)
    typedef pg8::bf16_t b16;

    if (IN(0)) { phase_prologue(F, in); } SEAM(0);

    if (IN(1)) {
        pg8::Gemm g{(const b16*)(ws + WS_U1), (const b16*)(ws + WS_W1T), T, NPROJ, D}; pg8::StaticOrder S; S.init(T, NPROJ, F.G, (int)blockIdx.x);
        pg8::EpiProj E{(b16*)(ws + WS_PROJ), in.b_gate};
        pg8::gemm_phase<pg8::EpiProj, pg8::StaticOrder, PG8_ALIGN, PG8_SP2>(F.lds, g, S, E);
    } SEAM(1);

    if (IN(2)) { for (int u = blockIdx.x; u < NBATCH * 3 * 8 * 32; u += F.G) dil_attn_unit(F, u); } SEAM(2);

    if (IN(3)) { phase_combine_conv(F, in); } SEAM(3);

    if (IN(4)) {
        { pg8::Gemm g{(const b16*)(ws + WS_YA), (const b16*)(ws + WS_WBA), T, D, 512}; pg8::StaticOrder S; S.init(T, D, F.G, (int)blockIdx.x);
          pg8::EpiMix<false> E{(b16*)(ws + WS_MIX), (const b16*)(ws + WS_PROJ)};
          pg8::gemm_phase<pg8::EpiMix<false>, pg8::StaticOrder, PG8_ALIGN, PG8_SP2>(F.lds, g, S, E); }
        { pg8::Gemm g{(const b16*)(ws + WS_YC), (const b16*)(ws + WS_WBC), T, D, D}; pg8::StaticOrder S; S.init(T, D, F.G, (int)blockIdx.x);
          pg8::EpiMix<true> E{(b16*)(ws + WS_MIX), (const b16*)(ws + WS_PROJ)};
          pg8::gemm_phase<pg8::EpiMix<true>, pg8::StaticOrder, PG8_ALIGN, PG8_SP2>(F.lds, g, S, E); }
    } SEAM(4);

    if (IN(5)) {
        { pg8::Gemm g{(const b16*)(ws + WS_MIX), (const b16*)(ws + WS_WO), T, D, D}; pg8::StaticOrder S; S.init(T, D, F.G, (int)blockIdx.x);
          pg8::EpiH1 E{in.x, (float*)(ws + WS_H1), (b16*)(ws + WS_H1B), (float*)(ws + WS_CTL + CTL_SS2)};
          pg8::gemm_phase<pg8::EpiH1, pg8::StaticOrder, PG8_ALIGN, PG8_SP2>(F.lds, g, S, E); }
        phase_expert_convert(F, in);
    } SEAM(5);

    if (IN(6)) {
        { pg8::Gemm g{(const b16*)(ws + WS_H1B), (const b16*)(ws + WS_WCQ), T, 512, D}; pg8::StaticOrder S; S.init(T, 512, F.G, (int)blockIdx.x);
          pg8::EpiQ2 E{(b16*)(ws + WS_Q2), (const float*)(ws + WS_CTL + CTL_SS2)};
          pg8::gemm_phase<pg8::EpiQ2, pg8::StaticOrder, PG8_ALIGN, PG8_SP2>(F.lds, g, S, E); }
        { pg8::Gemm g{(const b16*)(ws + WS_MN), (const b16*)(ws + WS_WCKV), NBATCH * NMEM, D, D}; pg8::StaticOrder S; S.init(NBATCH * NMEM, D, F.G, ((int)blockIdx.x + F.G - 128) % F.G);
          pg8::EpiPlain E{(b16*)(ws + WS_KV), D};
          pg8::gemm_phase<pg8::EpiPlain, pg8::StaticOrder, PG8_ALIGN, PG8_SP2>(F.lds, g, S, E); }
    } SEAM(6);

    if (IN(7)) { for (int u = blockIdx.x; u < NBATCH * 4 * 32; u += F.G) cross_attn_unit(F, u); } SEAM(7);

    if (IN(8)) {
        pg8::Gemm g{(const b16*)(ws + WS_O2), (const b16*)(ws + WS_WCO), T, D, 512}; pg8::StaticOrder S; S.init(T, D, F.G, (int)blockIdx.x);
        pg8::EpiH2 E{(const float*)(ws + WS_H1), args.out};
        pg8::gemm_phase<pg8::EpiH2, pg8::StaticOrder, PG8_ALIGN, PG8_SP2>(F.lds, g, S, E);
    } SEAM(8);

    if (IN(9)) { phase_router(F, in, args.out); } SEAM(9);

    if (IN(10)) { phase_scatter(F, in, args.out); } SEAM(10);

    if (IN(11)) {
        build_tpre(F);
        pg8::Gemm g{(const b16*)(ws + WS_XS), (const b16*)(ws + WS_EXPGU), XS_ROWS, NEXP * 2048, D};
        MoeOrder S{(const volatile LAS int*)(F.lds + TBL_OFF), 8, F.G, (int)blockIdx.x};
        pg8::EpiHdn E{(b16*)(ws + WS_HDN), in.b_eg, in.b_eu};
        pg8::gemm_phase<pg8::EpiHdn, MoeOrder, PG8_ALIGN, PG8_SP2>(F.lds, g, S, E);
    } SEAM(11);

    if (IN(12)) {
        build_tpre(F);
        pg8::Gemm g{(const b16*)(ws + WS_HDN), (const b16*)(ws + WS_EXPD), XS_ROWS, NEXP * 1024, D};
        MoeOrder S{(const volatile LAS int*)(F.lds + TBL_OFF), 4, F.G, (int)blockIdx.x};
        pg8::EpiY E{(b16*)(ws + WS_Y), in.b_ed, (const int*)(ws + WS_ROWSLOT), (const float*)(ws + WS_TOPW)};
        pg8::gemm_phase<pg8::EpiY, MoeOrder, PG8_ALIGN, PG8_SP2>(F.lds, g, S, E);
    } SEAM(12);

    if (IN(13)) { phase_final(F, in, args.out, args.out); }
#undef IN
#undef SEAM
}

#ifdef MK_DEBUG
constexpr size_t CTL_DBG = 512 * 1024;
__device__ __forceinline__ float bfv(const bf16* p, size_t i) { return __builtin_bit_cast(float, (unsigned)p[i] << 16); }
__device__ __forceinline__ unsigned hsh(unsigned x) { x ^= x >> 16; x *= 0x7feb352du; x ^= x >> 15; x *= 0x846ca68bu; x ^= x >> 16; return x; }
__device__ __forceinline__ bool close_to(float a, float b, float tol) { return fabsf(a - b) <= tol * (1.f + fabsf(b)) && a == a; }
__device__ __forceinline__ float bfr(float f) { return __builtin_bit_cast(float, f2bf(f) << 16); }
__global__ void __launch_bounds__(256) dbg_check(Args args, int which) {
    In in;
    in.x = args.in[0]; in.mem = args.in[1]; in.norm_mix = args.in[2]; in.w_in = args.in[3]; in.conv_w = args.in[4]; in.w_ba = args.in[5]; in.w_bc = args.in[6];
    in.w_gate = args.in[7]; in.b_gate = args.in[8]; in.w_out = args.in[9]; in.norm_cross = args.in[10]; in.norm_mem = args.in[11]; in.w_cq = args.in[12];
    in.w_ckv = args.in[13]; in.w_co = args.in[14]; in.norm_moe = args.in[15]; in.router_w = args.in[16]; in.router_b = args.in[17]; in.w_eg = args.in[18];
    in.b_eg = args.in[19]; in.w_eu = args.in[20]; in.b_eu = args.in[21]; in.w_ed = args.in[22]; in.b_ed = args.in[23]; in.norm_final = args.in[24];
    unsigned char* ws = args.ws; unsigned* dbg = (unsigned*)(ws + WS_CTL + CTL_DBG);
    const unsigned sid = blockIdx.x * 256 + threadIdx.x; const unsigned h1 = hsh(sid * 2654435761u + 12345u + which * 977u), h2 = hsh(h1 + 0x9e3779b9u), h3 = hsh(h2 + 77u);
    bool bad = false;
    __shared__ float lgs[32 * 256]; __shared__ int tp[33];
    if (threadIdx.x == 0) { int acc = 0; const unsigned* c0 = (const unsigned*)(args.ws + WS_CTL + CTL_CNT); for (int e = 0; e < 32; ++e) { tp[e] = acc; acc += (int)((c0[e] + 255u) >> 8); } tp[32] = acc; }
    __syncthreads();
    float* lg = lgs + threadIdx.x;
    const bf16 *W1T = (const bf16*)(ws + WS_W1T), *U1 = (const bf16*)(ws + WS_U1), *PROJ = (const bf16*)(ws + WS_PROJ), *OG = (const bf16*)(ws + WS_OG), *YA = (const bf16*)(ws + WS_YA), *YC = (const bf16*)(ws + WS_YC),
               *MIX = (const bf16*)(ws + WS_MIX), *WBA = (const bf16*)(ws + WS_WBA), *WBC = (const bf16*)(ws + WS_WBC), *WO = (const bf16*)(ws + WS_WO), *H1B = (const bf16*)(ws + WS_H1B), *WCQ = (const bf16*)(ws + WS_WCQ),
               *Q2 = (const bf16*)(ws + WS_Q2), *KV = (const bf16*)(ws + WS_KV), *MN = (const bf16*)(ws + WS_MN), *WCKV = (const bf16*)(ws + WS_WCKV), *O2 = (const bf16*)(ws + WS_O2), *WCO = (const bf16*)(ws + WS_WCO),
               *XS = (const bf16*)(ws + WS_XS), *HDN = (const bf16*)(ws + WS_HDN), *EXPGU = (const bf16*)(ws + WS_EXPGU), *EXPD = (const bf16*)(ws + WS_EXPD), *Y = (const bf16*)(ws + WS_Y);
    const float *LSE = (const float*)(ws + WS_LSE), *H1 = (const float*)(ws + WS_H1), *ss2 = (const float*)(ws + WS_CTL + CTL_SS2), *topw = (const float*)(ws + WS_TOPW), *rstd3 = (const float*)(ws + WS_RSTD3);
    const int *topi = (const int*)(ws + WS_TOPI), *rowslot = (const int*)(ws + WS_ROWSLOT); const unsigned* cnt = (const unsigned*)(ws + WS_CTL + CTL_CNT);
    if (which == 0) {
        { const int n = h1 % 9728, k = h2 % 1024; const float w = n < 7680 ? in.w_in[(size_t)k * 7680 + n] : in.w_gate[(size_t)k * 2048 + n - 7680]; bad |= !close_to(bfv(W1T, (size_t)n * 1024 + k), w, 0.01f); }
        { const int n = h2 % 1024, k = h3 % 1024; bad |= !close_to(bfv(WBC, (size_t)n * 1024 + k), in.w_bc[(size_t)k * 1024 + n], 0.01f); }
        { const int n = h3 % 512, k = h1 % 1024; bad |= !close_to(bfv(WCQ, (size_t)n * 1024 + k), in.w_cq[(size_t)k * 512 + n] * in.norm_cross[k], 0.01f); }
        { const int n = h3 % 1024, k = h2 % 512; bad |= !close_to(bfv(WBA, (size_t)n * 512 + k), in.w_ba[(size_t)k * 1024 + n], 0.01f); bad |= !close_to(bfv(WCO, (size_t)n * 512 + k), in.w_co[(size_t)k * 1024 + n], 0.01f); }
        { const int r = h1 % T, c = h2 % 1024; float s = 0.f; for (int k = 0; k < 1024; ++k) { const float v = in.x[(size_t)r * 1024 + k]; s += v * v; }
          bad |= !close_to(bfv(U1, (size_t)r * 1024 + c), in.x[(size_t)r * 1024 + c] * in.norm_mix[c] / sqrtf(s / 1024.f + EPS), 0.01f); }
    } else if (which == 1) {
        const int r = h1 % T, c = h2 % 9728; float s = 0.f; for (int k = 0; k < 1024; ++k) s += bfv(U1, (size_t)r * 1024 + k) * bfv(W1T, (size_t)c * 1024 + k);
        if (c >= 7680) s = 1.f / (1.f + expf(-(s + in.b_gate[c - 7680])));
        bad |= !close_to(bfv(PROJ, (size_t)r * 9728 + c), s, 0.02f);
    } else if (which == 2) {
        const int t = h1 % T, g = h2 % 3, h = (h2 >> 8) % 8, d = h3 % 64, dil = g == 0 ? 1 : (g == 1 ? 4 : 16), b = t / SEQ, pos = t % SEQ;
        const float slope = exp2f(-(float)(h + 1));
        float mx = -1e30f;
        for (int pass = 0; pass < 2; ++pass) { float l = 0.f, o = 0.f;
            for (int j = 0; j <= 128; ++j) { const int kp = pos - j * dil; if (kp < 0) break;
                const bf16* qp = PROJ + (size_t)t * 9728 + g * 1536 + h * 64; const bf16* kq = PROJ + (size_t)(b * SEQ + kp) * 9728 + g * 1536 + 512 + h * 64;
                float s = 0.f; for (int e = 0; e < 64; ++e) s += bfv(qp, e) * bfv(kq, e);
                s = s * 0.125f - slope * (float)(j * dil);
                if (pass == 0) mx = fmaxf(mx, s); else { const float p = expf(s - mx); l += p; o += p * bfv(kq, 512 + d); } }
            if (pass == 1) { bad |= !close_to(bfv(OG, ((size_t)g * T + t) * 512 + h * 64 + d), o / l, 0.03f); bad |= !close_to(LSE[((size_t)g * T + t) * 8 + h], mx + logf(l), 0.01f); } }
    } else if (which == 3) {
        const int t = h1 % T, c = h2 % 512, h = c / 64; float l[3], m = -1e30f, den = 0.f, o = 0.f;
        for (int g = 0; g < 3; ++g) { l[g] = LSE[((size_t)g * T + t) * 8 + h]; m = fmaxf(m, l[g]); }
        for (int g = 0; g < 3; ++g) { const float w = expf(l[g] - m); den += w; o += w * bfv(OG, ((size_t)g * T + t) * 512 + c); }
        bad |= !close_to(bfv(YA, (size_t)t * 512 + c), o / den, 0.02f);
        const int c2 = h3 % 1024, pos = t % SEQ; float y = 0.f;
        for (int k = 0; k < 3; ++k) { const int back = 2 - k; if (pos - back >= 0) { const bf16* p = PROJ + (size_t)(t - back) * 9728 + 4608 + c2; y += in.conv_w[k * 1024 + c2] * bfv(p, 1024) * bfv(p, 2048); } }
        bad |= !close_to(bfv(YC, (size_t)t * 1024 + c2), y * bfv(PROJ, (size_t)t * 9728 + 4608 + c2), 0.02f);
    } else if (which == 4) {
        const int r = h1 % T, c = h2 % 1024; float a = 0.f, q = 0.f;
        for (int k = 0; k < 512; ++k) a += bfv(YA, (size_t)r * 512 + k) * bfv(WBA, (size_t)c * 512 + k);
        for (int k = 0; k < 1024; ++k) q += bfv(YC, (size_t)r * 1024 + k) * bfv(WBC, (size_t)c * 1024 + k);
        bad |= !close_to(bfv(MIX, (size_t)r * 1024 + c), bfv(PROJ, (size_t)r * 9728 + 7680 + c) * a + bfv(PROJ, (size_t)r * 9728 + 8704 + c) * q, 0.03f);
    } else if (which == 5) {
        const int r = h1 % T, c = h2 % 1024; float a = 0.f; for (int k = 0; k < 1024; ++k) a += bfv(MIX, (size_t)r * 1024 + k) * bfv(WO, (size_t)c * 1024 + k);
        a += in.x[(size_t)r * 1024 + c];
        bad |= !close_to(H1[(size_t)r * 1024 + c], a, 0.02f); bad |= !close_to(bfv(H1B, (size_t)r * 1024 + c), a, 0.02f);
        float s = 0.f; for (int k = 0; k < 1024; ++k) { const float v = H1[(size_t)r * 1024 + k]; s += v * v; }
        bad |= !close_to(ss2[r], s, 0.01f);
        const int e = h3 % 32, n = h1 % 1024, k = h2 % 1024;
        bad |= !close_to(bfv(EXPGU, ((size_t)e * 2048 + (n >> 7) * 256 + (n & 127)) * 1024 + k), in.w_eg[((size_t)e * 1024 + k) * 1024 + n], 0.01f);
        bad |= !close_to(bfv(EXPGU, ((size_t)e * 2048 + (n >> 7) * 256 + 128 + (n & 127)) * 1024 + k), in.w_eu[((size_t)e * 1024 + k) * 1024 + n], 0.01f);
        bad |= !close_to(bfv(EXPD, ((size_t)e * 1024 + n) * 1024 + k), in.w_ed[((size_t)e * 1024 + k) * 1024 + n], 0.01f);
    } else if (which == 6) {
        const int r = h1 % T, c = h2 % 512; float a = 0.f; for (int k = 0; k < 1024; ++k) a += bfv(H1B, (size_t)r * 1024 + k) * bfv(WCQ, (size_t)c * 1024 + k);
        bad |= !close_to(bfv(Q2, (size_t)r * 512 + c), a / sqrtf(ss2[r] / 1024.f + EPS), 0.03f);
        const int r2 = h3 % 1024, c2 = h1 % 1024; float q = 0.f; for (int k = 0; k < 1024; ++k) q += bfv(MN, (size_t)r2 * 1024 + k) * bfv(WCKV, (size_t)c2 * 1024 + k);
        bad |= !close_to(bfv(KV, (size_t)r2 * 1024 + c2), q, 0.03f);
    } else if (which == 7) {
        const int r = h1 % T, h = h2 % 4, d = h3 % 128, b = r / SEQ; float mx = -1e30f;
        for (int pass = 0; pass < 2; ++pass) { float l = 0.f, o = 0.f;
            for (int key = 0; key < 256; ++key) { const bf16* kp = KV + (size_t)(b * 256 + key) * 1024 + h * 128; float s = 0.f; for (int e = 0; e < 128; ++e) s += bfv(Q2, (size_t)r * 512 + h * 128 + e) * bfv(kp, e);
                s *= 0.08838834764831845f; if (pass == 0) mx = fmaxf(mx, s); else { const float p = expf(s - mx); l += p; o += p * bfv(kp, 512 + d); } }
            if (pass == 1) bad |= !close_to(bfv(O2, (size_t)r * 512 + h * 128 + d), o / l, 0.03f); }
    } else if (which == 8) {
        const int r = h1 % T, c = h2 % 1024; float a = 0.f; for (int k = 0; k < 512; ++k) a += bfv(O2, (size_t)r * 512 + k) * bfv(WCO, (size_t)c * 512 + k);
        bad |= !close_to(args.out[(size_t)r * 1024 + c], a + H1[(size_t)r * 1024 + c], 0.02f);
    } else if (which == 9) {
        const int t = h1 % T; float s = 0.f; for (int k = 0; k < 1024; ++k) { const float v = args.out[(size_t)t * 1024 + k]; s += v * v; }
        const float rstd = 1.f / sqrtf(s / 1024.f + EPS); if (!close_to(rstd3[t], rstd, 0.001f)) atomicAdd(dbg + 20, 1u);
        for (int e = 0; e < 32; ++e) lg[e * 256] = in.router_b[e];
        for (int k = 0; k < 1024; ++k) { const float u = args.out[(size_t)t * 1024 + k] * rstd * in.norm_moe[k]; for (int e = 0; e < 32; ++e) lg[e * 256] += u * in.router_w[k * 32 + e]; }
        float tv[4]; float den = 0.f;
#pragma unroll
        for (int k = 0; k < 4; ++k) { const int e = topi[t * 4 + k]; if (e < 0 || e >= 32) { atomicAdd(dbg + 21, 1u); tv[k] = 0.f; continue; } tv[k] = lg[e * 256]; if (k > 0 && tv[k] > tv[k - 1] + 1e-3f) atomicAdd(dbg + 22, 1u); }
        for (int e = 0; e < 32; ++e) { bool in4 = false; for (int k = 0; k < 4; ++k) in4 |= (topi[t * 4 + k] == e); if (!in4 && lg[e * 256] > tv[3] + 1e-3f) atomicAdd(dbg + 23, 1u); }
#pragma unroll
        for (int k = 0; k < 4; ++k) den += expf(tv[k] - tv[0]);
#pragma unroll
        for (int k = 0; k < 4; ++k) if (!close_to(topw[t * 4 + k], expf(tv[k] - tv[0]) / den, 0.01f)) atomicAdd(dbg + 24, 1u);
        if (sid == 0) { unsigned tot = 0; for (int e = 0; e < 32; ++e) tot += cnt[e]; if (tot != (unsigned)(T * 4)) atomicAdd(dbg + 25, 1u); }
    } else if (which == 10 || which == 11 || which == 12) {
        const int R = h1 % (tp[32] * 256); int e = 0; for (int k = 1; k < 32; ++k) if (tp[k] * 256 <= R) e = k;
        const int slot = rowslot[R]; const bool isvalid = (R - tp[e] * 256) < (int)cnt[e];
        if (isvalid != (slot >= 0)) bad = true;
        if (slot >= 0 && !bad) {
            if (slot >= T * 4) bad = true;
            else if (which == 10) { const int t = slot >> 2, k = h2 % 1024; if (topi[slot] != e) bad = true;
                bad |= !close_to(bfv(XS, (size_t)R * 1024 + k), args.out[(size_t)t * 1024 + k] * rstd3[t] * in.norm_moe[k], 0.01f); }
            else if (which == 11) { const int hc = h2 % 1024; float g = in.b_eg[e * 1024 + hc], u = in.b_eu[e * 1024 + hc];
                const bf16* wg = EXPGU + ((size_t)e * 2048 + (hc >> 7) * 256 + (hc & 127)) * 1024; const bf16* wu = wg + 128 * 1024;
                for (int k = 0; k < 1024; ++k) { const float xv = bfv(XS, (size_t)R * 1024 + k); g += xv * bfv(wg, k); u += xv * bfv(wu, k); }
                g = fminf(g, 7.f); u = fminf(fmaxf(u, -7.f), 7.f);
                bad |= !close_to(bfv(HDN, (size_t)R * 1024 + hc), g / (1.f + expf(-1.702f * g)) * (u + 1.f), 0.03f); }
            else { const int c = h2 % 1024; float a = in.b_ed[e * 1024 + c]; for (int k = 0; k < 1024; ++k) a += bfv(HDN, (size_t)R * 1024 + k) * bfv(EXPD, ((size_t)e * 1024 + c) * 1024 + k);
                bad |= !close_to(bfv(Y, (size_t)slot * 1024 + c), a * topw[slot], 0.03f); }
        }
    } else if (which == 100) {
        if (sid == 0) { int first = -1; for (int k = 0; k < 13; ++k) if (dbg[k] != 0u && first < 0) first = k; for (int k = 20; k < 26; ++k) if (dbg[k] != 0u && first < 0) first = k; if (first >= 0) args.out[0] = 20.f + 10.f * first; }
        return;
    }
    if (bad) atomicAdd(dbg + which, 1u);
}
#endif
extern "C" void kernel_launch(void* const* d_in, const int* in_sizes, int n_in, void* d_out, int out_size, void* d_ws, size_t ws_size, hipStream_t stream) {
    static int grid = 0;
    if (grid == 0) {
        if (n_in != 25 || in_sizes[0] != T * D || out_size != T * D || ws_size < WS_END) {
            fprintf(stderr, "kernel_launch: built for 25 inputs, x/out of %d floats, >= %zu bytes of workspace; got n_in %d, in0 %d, out %d, ws %zu; nothing launched\n", T * D, (size_t)WS_END, n_in, n_in > 0 ? in_sizes[0] : -1, out_size, ws_size);
            grid = -1; return; }
        int dev = 0, cus = 0, per_cu = 0;
        if (hipGetDevice(&dev) != hipSuccess || hipDeviceGetAttribute(&cus, hipDeviceAttributeMultiprocessorCount, dev) != hipSuccess) { fprintf(stderr, "kernel_launch: device query failed\n"); grid = -1; return; }
        if (hipFuncSetAttribute((const void*)mega_fwd, hipFuncAttributeMaxDynamicSharedMemorySize, LDS_BYTES) != hipSuccess) { fprintf(stderr, "kernel_launch: hipFuncSetAttribute(%d B LDS) failed\n", LDS_BYTES); grid = -1; return; }
        if (hipOccupancyMaxActiveBlocksPerMultiprocessor(&per_cu, (const void*)mega_fwd, NTHREADS, LDS_BYTES) != hipSuccess || per_cu < 1) { fprintf(stderr, "kernel_launch: occupancy query says %d workgroups per CU\n", per_cu); per_cu = 1; }
        (void)hipGetLastError();
        grid = cus;
    }
    if (grid < 0) return;
    (void)hipMemsetAsync((char*)d_ws + WS_CTL, 0, CTL_ZERO_BYTES, stream);
    Args a{};
    for (int i = 0; i < 25; ++i) a.in[i] = (const float*)d_in[i];
    a.out = (float*)d_out; a.ws = (unsigned char*)d_ws;
    if (N_LAUNCHES == 1) {
        a.ph_lo = 0; a.ph_hi = N_PHASES;
        void* kargs[] = {&a};
        hipError_t e = hipLaunchCooperativeKernel((const void*)mega_fwd, dim3(grid), dim3(NTHREADS), kargs, LDS_BYTES, stream);
        if (e != hipSuccess) fprintf(stderr, "kernel_launch: cooperative launch failed: %s (grid %d)\n", hipGetErrorString(e), grid);
    } else {
        for (int p = 0; p < N_PHASES; ++p) { a.ph_lo = p; a.ph_hi = p + 1; hipLaunchKernelGGL(mega_fwd, dim3(grid), dim3(NTHREADS), LDS_BYTES, stream, a);
#ifdef MK_DEBUG
            if (p < 13) hipLaunchKernelGGL(dbg_check, dim3(16), dim3(256), 0, stream, a, p);
#endif
        }
#ifdef MK_DEBUG
        hipLaunchKernelGGL(dbg_check, dim3(1), dim3(256), 0, stream, a, 100);
#endif
    }
}
```

```cpp
#include <hip/hip_runtime.h>
#include <cstdio>
#include <cstdint>
namespace pg8 {
#define PG8_LAS __attribute__((address_space(3)))
typedef unsigned short bf16_t;
typedef short bf16x8 __attribute__((ext_vector_type(8)));
typedef float f32x4 __attribute__((ext_vector_type(4)));
typedef unsigned u32x4 __attribute__((ext_vector_type(4)));
constexpr int BM = 256, BK = 64, HALF = 128, HTB = HALF * BK * 2  , STAGE_BYTES = 8 * HTB, NXCD = 8, WGM = 8;

__host__ __device__ __forceinline__ int lds_byte(int r, int c) { const int st = (r >> 4) * 2 + (c >> 5), rr = r & 15, cc = c & 31, ob = rr * 64 + cc * 2; return st * 1024 + (ob ^ (((ob >> 9) & 1) << 5)); }
__host__ __device__ __forceinline__ void stage_rc(int b, int& R, int& C) { const int st = b / 1024, sb = b % 1024, swz = sb ^ (((sb >> 9) & 1) << 5); R = (st >> 1) * 16 + swz / 64; C = (st & 1) * 32 + (swz % 64) / 2; }
__host__ __device__ __forceinline__ int perm32(int rho) { const int n = rho >> 4, i = rho & 15; return 8 * (i >> 2) + 4 * n + (i & 3); }

struct Unit { int pm, pn; };
struct Gemm { const bf16_t* A; const bf16_t* Bt; int M, N, K; };

struct StaticOrder {
    int nM, nN, nwg, G, c;
    __host__ __device__ void init(int M, int N, int G_, int c_) { nM = M / BM; nN = N / BM; nwg = nM * nN; G = G_; c = c_; }
    __host__ __device__ bool next(int i, Unit& u) const {
        const long L = (long)i * G + c; if (L >= nwg) return false;
        int wgid = (int)L; { const int q = nwg / NXCD, r = nwg % NXCD, xcd = wgid % NXCD, off = wgid / NXCD; wgid = (xcd < r ? xcd * (q + 1) : r * (q + 1) + (xcd - r) * q) + off; }
        const int nig = WGM * nN, gid = wgid / nig, fm = gid * WGM, gsz = (nM - fm) < WGM ? (nM - fm) : WGM;
        u.pm = fm + ((wgid % nig) % gsz); u.pn = (wgid % nig) / gsz; return true;
    }
    __device__ __forceinline__ void a_ready(const Unit&) const {}
    __device__ __forceinline__ void done(const Unit&) const {}
};

__device__ __forceinline__ unsigned cvt_pk_bf16(float lo, float hi) { unsigned r; asm volatile("v_cvt_pk_bf16_f32 %0, %1, %2" : "=v"(r) : "v"(lo), "v"(hi)); return r; }
__device__ __forceinline__ float bflo(unsigned w) { return __builtin_bit_cast(float, w << 16); }
__device__ __forceinline__ float bfhi(unsigned w) { return __builtin_bit_cast(float, w & 0xffff0000u); }
__device__ __forceinline__ void unpack8(const u32x4 w, f32x4& a, f32x4& b) { a = (f32x4){bflo(w.x), bfhi(w.x), bflo(w.y), bfhi(w.y)}; b = (f32x4){bflo(w.z), bfhi(w.z), bflo(w.w), bfhi(w.w)}; }
__device__ __forceinline__ u32x4 pack8(const f32x4 a, const f32x4 b) { u32x4 w; w.x = cvt_pk_bf16(a[0], a[1]); w.y = cvt_pk_bf16(a[2], a[3]); w.z = cvt_pk_bf16(b[0], b[1]); w.w = cvt_pk_bf16(b[2], b[3]); return w; }
__device__ __forceinline__ float sigmoidf_fast(float x) { return __builtin_amdgcn_rcpf(1.0f + __builtin_amdgcn_exp2f(-1.4426950408889634f * x)); }
__device__ __forceinline__ f32x4 sig4(f32x4 v) { return (f32x4){sigmoidf_fast(v[0]), sigmoidf_fast(v[1]), sigmoidf_fast(v[2]), sigmoidf_fast(v[3])}; }

#define EPI_ROWS_BEGIN _Pragma("unroll") for (int ai = 0; ai < 2; ++ai) _Pragma("unroll") for (int m = 0; m < 4; ++m) { const int rowl = ai * HALF + wr * 64 + m * 16 + fr;
#define EPI_COLS_BEGIN _Pragma("unroll") for (int bj = 0; bj < 2; ++bj) { const int coll = bj * HALF + wc * 32 + 8 * fq; f32x4 v0 = acc[ai][bj][m][0], v1 = acc[ai][bj][m][1];
#define EPI_END }

struct EpiProj {
    static constexpr bool PERM = true, AFTER_DRAIN = false;
    bf16_t* O; const float* bgate;
    __device__ __forceinline__ void operator()(const f32x4 (&acc)[2][2][4][2], const Unit& u, int wr, int wc, int fr, int fq) const {
        const int row0 = u.pm * BM, col0 = u.pn * BM; const bool gate = col0 >= 7680;
        EPI_ROWS_BEGIN EPI_COLS_BEGIN
            const int row = row0 + rowl, col = col0 + coll;
            if (gate) { const f32x4 b0 = *(const f32x4*)(bgate + (col - 7680)), b1 = *(const f32x4*)(bgate + (col - 7680) + 4); v0 = sig4(v0 + b0); v1 = sig4(v1 + b1); }
            *(u32x4*)(O + (size_t)row * 9728 + col) = pack8(v0, v1);
        EPI_END EPI_END
    }
};
struct EpiPlain {
    static constexpr bool PERM = true, AFTER_DRAIN = false;
    bf16_t* O; int ldc;
    __device__ __forceinline__ void operator()(const f32x4 (&acc)[2][2][4][2], const Unit& u, int wr, int wc, int fr, int fq) const {
        const int row0 = u.pm * BM, col0 = u.pn * BM;
        EPI_ROWS_BEGIN EPI_COLS_BEGIN
            *(u32x4*)(O + (size_t)(row0 + rowl) * ldc + col0 + coll) = pack8(v0, v1);
        EPI_END EPI_END
    }
};
template <bool SECOND> struct EpiMix {
    static constexpr bool PERM = true, AFTER_DRAIN = false;
    bf16_t* MIX; const bf16_t* PROJ;
    __device__ __forceinline__ void operator()(const f32x4 (&acc)[2][2][4][2], const Unit& u, int wr, int wc, int fr, int fq) const {
        const int row0 = u.pm * BM, col0 = u.pn * BM;
        EPI_ROWS_BEGIN EPI_COLS_BEGIN
            const int row = row0 + rowl, col = col0 + coll;
            f32x4 g0, g1; unpack8(*(const u32x4*)(PROJ + (size_t)row * 9728 + (SECOND ? 8704 : 7680) + col), g0, g1);
            v0 = v0 * g0; v1 = v1 * g1;
            if (SECOND) { f32x4 t0, t1; unpack8(*(const u32x4*)(MIX + (size_t)row * 1024 + col), t0, t1); v0 = v0 + t0; v1 = v1 + t1; }
            *(u32x4*)(MIX + (size_t)row * 1024 + col) = pack8(v0, v1);
        EPI_END EPI_END
    }
};
struct EpiH1 {
    static constexpr bool PERM = true, AFTER_DRAIN = false;
    const float* X; float* H1; bf16_t* H1B; float* ss;
    __device__ __forceinline__ void operator()(const f32x4 (&acc)[2][2][4][2], const Unit& u, int wr, int wc, int fr, int fq) const {
        const int row0 = u.pm * BM, col0 = u.pn * BM;
        EPI_ROWS_BEGIN
            float s = 0.f; const int row = row0 + rowl;
            EPI_COLS_BEGIN
                const int col = col0 + coll; const size_t o = (size_t)row * 1024 + col;
                v0 = v0 + *(const f32x4*)(X + o); v1 = v1 + *(const f32x4*)(X + o + 4);
                *(f32x4*)(H1 + o) = v0; *(f32x4*)(H1 + o + 4) = v1; *(u32x4*)(H1B + o) = pack8(v0, v1);
                s += (v0[0] * v0[0] + v0[1] * v0[1]) + (v0[2] * v0[2] + v0[3] * v0[3]) + (v1[0] * v1[0] + v1[1] * v1[1]) + (v1[2] * v1[2] + v1[3] * v1[3]);
            EPI_END
            s += __shfl_xor(s, 16); s += __shfl_xor(s, 32);
            if (fq == 0) atomicAdd(ss + row, s);
        EPI_END
    }
};
struct EpiQ2 {
    static constexpr bool PERM = true, AFTER_DRAIN = false;
    bf16_t* Q2; const float* ss;
    __device__ __forceinline__ void operator()(const f32x4 (&acc)[2][2][4][2], const Unit& u, int wr, int wc, int fr, int fq) const {
        const int row0 = u.pm * BM, col0 = u.pn * BM;
        EPI_ROWS_BEGIN
            const int row = row0 + rowl; const float rs = __builtin_amdgcn_rsqf(__hip_atomic_load(ss + row, __ATOMIC_RELAXED, __HIP_MEMORY_SCOPE_AGENT) * (1.f / 1024.f) + 1e-6f);
            EPI_COLS_BEGIN
                *(u32x4*)(Q2 + (size_t)row * 512 + col0 + coll) = pack8(v0 * rs, v1 * rs);
            EPI_END
        EPI_END
    }
};
struct EpiH2 {
    static constexpr bool PERM = true, AFTER_DRAIN = false;
    const float* H1; float* OUT;
    __device__ __forceinline__ void operator()(const f32x4 (&acc)[2][2][4][2], const Unit& u, int wr, int wc, int fr, int fq) const {
        const int row0 = u.pm * BM, col0 = u.pn * BM;
        EPI_ROWS_BEGIN EPI_COLS_BEGIN
            const size_t o = (size_t)(row0 + rowl) * 1024 + col0 + coll;
            *(f32x4*)(OUT + o) = v0 + *(const f32x4*)(H1 + o); *(f32x4*)(OUT + o + 4) = v1 + *(const f32x4*)(H1 + o + 4);
        EPI_END EPI_END
    }
};
struct EpiHdn {
    static constexpr bool PERM = true, AFTER_DRAIN = false;
    bf16_t* HDN; const float* bg; const float* bu;
    __device__ __forceinline__ void operator()(const f32x4 (&acc)[2][2][4][2], const Unit& u, int wr, int wc, int fr, int fq) const {
        const int row0 = u.pm * BM, e = u.pn >> 3, hc = (u.pn & 7) * 128 + wc * 32 + 8 * fq;
        const float* pg = bg + e * 1024 + hc; const float* pu = bu + e * 1024 + hc;
        const f32x4 bg0 = *(const f32x4*)pg, bg1 = *(const f32x4*)(pg + 4), bu0 = *(const f32x4*)pu, bu1 = *(const f32x4*)(pu + 4);
        EPI_ROWS_BEGIN
            f32x4 g0 = acc[ai][0][m][0] + bg0, g1 = acc[ai][0][m][1] + bg1, l0 = acc[ai][1][m][0] + bu0, l1 = acc[ai][1][m][1] + bu1, h0, h1;
#pragma unroll
            for (int j = 0; j < 4; ++j) {
                const float ga = fminf(g0[j], 7.f), gb = fminf(g1[j], 7.f), la = fminf(fmaxf(l0[j], -7.f), 7.f), lb = fminf(fmaxf(l1[j], -7.f), 7.f);
                h0[j] = ga * sigmoidf_fast(1.702f * ga) * (la + 1.f); h1[j] = gb * sigmoidf_fast(1.702f * gb) * (lb + 1.f); }
            *(u32x4*)(HDN + (size_t)(row0 + rowl) * 1024 + hc) = pack8(h0, h1);
        EPI_END
    }
};
struct EpiY {
    static constexpr bool PERM = true, AFTER_DRAIN = false;
    bf16_t* Y; const float* bd; const int* rowslot; const float* topw;
    __device__ __forceinline__ void operator()(const f32x4 (&acc)[2][2][4][2], const Unit& u, int wr, int wc, int fr, int fq) const {
        const int row0 = u.pm * BM, e = u.pn >> 2, col0 = (u.pn & 3) * BM;
        EPI_ROWS_BEGIN
            const int slot = rowslot[row0 + rowl];
            if (slot >= 0) { const float w = topw[slot];
                EPI_COLS_BEGIN
                    const int col = col0 + coll; const float* pb = bd + e * 1024 + col;
                    v0 = (v0 + *(const f32x4*)pb) * w; v1 = (v1 + *(const f32x4*)(pb + 4)) * w;
                    *(u32x4*)(Y + (size_t)slot * 1024 + col) = pack8(v0, v1);
                EPI_END }
        EPI_END
    }
};
template <class Epi, class Sched, bool ALIGN_EPI = false, bool SP2 = false>
__device__ __forceinline__ void gemm_phase(PG8_LAS unsigned char* lds, const Gemm g, const Sched& S, const Epi& E) {
    const int tid = threadIdx.x, wid = __builtin_amdgcn_readfirstlane(tid >> 6), lane = tid & 63, wr = wid >> 2, wc = wid & 3, fr = lane & 15, fq = lane >> 4;
    const int K = g.K, nt = K / BK;
    unsigned voffA[2], voffB[2];
#pragma unroll
    for (int i = 0; i < 2; ++i) { int R, C; stage_rc(tid * 16 + i * 8192, R, C); const int Rb = Epi::PERM ? ((R & ~31) + perm32(R & 31)) : R;
        voffA[i] = (unsigned)(R * K + C) * 2u; voffB[i] = (unsigned)(Rb * K + C) * 2u; }
    const size_t kstep = (size_t)(BK * 2);
    const size_t hstep = (size_t)HALF * K * 2;
    const size_t tstep = 2 * hstep;
    const unsigned ldsw = (unsigned)wid * 1024u;
    const int aoff = lds_byte(wr * 64 + fr, fq * 8), boff = lds_byte(wc * 32 + fr, fq * 8);
#define PG8_SA(b, h) (((b) * 2 + (h)) * HTB)
#define PG8_SB(b, h) ((4 + (b) * 2 + (h)) * HTB)
#define PG8_STAGE(bufoff, gbase, voff) do { _Pragma("unroll") for (int _i = 0; _i < 2; ++_i) \
        __builtin_amdgcn_global_load_lds((const unsigned*)((const char*)(gbase) + (voff)[_i]), (PG8_LAS unsigned*)(lds + (bufoff) + ldsw + _i * 8192), 16, 0, 0); } while (0)
#define PG8_LDA(dst, b, h) do { _Pragma("unroll") for (int m = 0; m < 4; ++m) _Pragma("unroll") for (int k = 0; k < 2; ++k) dst[m][k] = *(const PG8_LAS bf16x8*)(lds + PG8_SA(b, h) + aoff + m * 2048 + k * 1024); } while (0)
#define PG8_LDB(dst, b, h) do { _Pragma("unroll") for (int n = 0; n < 2; ++n) _Pragma("unroll") for (int k = 0; k < 2; ++k) dst[n][k] = *(const PG8_LAS bf16x8*)(lds + PG8_SB(b, h) + boff + n * 2048 + k * 1024); } while (0)
#define PG8_MMA(ai, bj, At, Bt) do { __builtin_amdgcn_s_setprio(1); _Pragma("unroll") for (int m = 0; m < 4; ++m) _Pragma("unroll") for (int n = 0; n < 2; ++n) _Pragma("unroll") for (int k = 0; k < 2; ++k) \
        acc[ai][bj][m][n] = __builtin_amdgcn_mfma_f32_16x16x32_bf16(Bt[n][k], At[m][k], acc[ai][bj][m][n], 0, 0, 0); __builtin_amdgcn_s_setprio(0); } while (0)
#define PG8_WAIT_V(n) asm volatile("s_waitcnt vmcnt(" #n ")" ::: "memory")
#define PG8_WAIT_L(n) asm volatile("s_waitcnt lgkmcnt(" #n ")" ::: "memory")
#define PG8_BAR __builtin_amdgcn_s_barrier()
#define PG8_SCHED __builtin_amdgcn_sched_barrier(0)
    Unit cur, nxt; int ui = 0;
    if (!S.next(0, cur)) return;
    f32x4 acc[2][2][4][2];
#pragma unroll
    for (int a = 0; a < 2; ++a)
#pragma unroll
        for (int b = 0; b < 2; ++b)
#pragma unroll
            for (int m = 0; m < 4; ++m)
#pragma unroll
                for (int n = 0; n < 2; ++n) acc[a][b][m][n] = (f32x4){0.f, 0.f, 0.f, 0.f};
    bf16x8 At[4][2], B0[2][2], B1[2][2];
    const char* cA = (const char*)g.A + (size_t)cur.pm * tstep; const char* cB = (const char*)g.Bt + (size_t)cur.pn * tstep;
    S.a_ready(cur);
    if constexpr (SP2) {
        PG8_STAGE(PG8_SB(0, 0), cB, voffB); PG8_STAGE(PG8_SB(0, 1), cB + hstep, voffB); PG8_STAGE(PG8_SA(0, 0), cA, voffA); PG8_STAGE(PG8_SA(0, 1), cA + hstep, voffA);
        if (wr == 1) PG8_BAR;
        PG8_WAIT_V(2); PG8_BAR;
        PG8_STAGE(PG8_SB(1, 0), cB + kstep, voffB); PG8_STAGE(PG8_SA(1, 0), cA + kstep, voffA); PG8_STAGE(PG8_SB(1, 1), cB + hstep + kstep, voffB);
        PG8_WAIT_V(6); PG8_BAR;
    } else {
        PG8_STAGE(PG8_SB(0, 0), cB, voffB); PG8_STAGE(PG8_SA(0, 0), cA, voffA); PG8_STAGE(PG8_SB(0, 1), cB + hstep, voffB); PG8_STAGE(PG8_SA(0, 1), cA + hstep, voffA);
        if (wr == 1) PG8_BAR;
        PG8_WAIT_V(4); PG8_BAR;
        PG8_STAGE(PG8_SB(1, 0), cB + kstep, voffB); PG8_STAGE(PG8_SA(1, 0), cA + kstep, voffA); PG8_STAGE(PG8_SB(1, 1), cB + hstep + kstep, voffB);
        PG8_WAIT_V(6); PG8_BAR;
    }
    for (;;) {
        const bool has_next = S.next(ui + 1, nxt);
        const char* nA = has_next ? (const char*)g.A + (size_t)nxt.pm * tstep : cA; const char* nB = has_next ? (const char*)g.Bt + (size_t)nxt.pn * tstep : cB;
        for (int t = 0; t < nt; t += 2) {
            const bool last = (t == nt - 2);
            const char* a1 = cA + (size_t)(t + 1) * kstep;
            const char* a2 = last ? nA : cA + (size_t)(t + 2) * kstep; const char* b2 = last ? nB : cB + (size_t)(t + 2) * kstep;
            const char* a3 = a2 + kstep; const char* b3 = b2 + kstep;
            if (last && has_next) S.a_ready(nxt);
            if constexpr (SP2) {
            PG8_LDB(B0, 0, 0); PG8_LDB(B1, 0, 1); PG8_SCHED; PG8_LDA(At, 0, 0); PG8_STAGE(PG8_SA(1, 1), a1 + hstep, voffA);
            PG8_WAIT_V(8); PG8_WAIT_L(0); PG8_BAR; PG8_MMA(0, 0, At, B0); PG8_MMA(0, 1, At, B1); PG8_BAR; PG8_SCHED;
            PG8_LDA(At, 0, 1); PG8_STAGE(PG8_SB(0, 0), b2, voffB); PG8_STAGE(PG8_SB(0, 1), b2 + hstep, voffB); PG8_STAGE(PG8_SA(0, 0), a2, voffA);
            PG8_WAIT_V(8); PG8_WAIT_L(0); PG8_BAR; PG8_MMA(1, 0, At, B0); PG8_MMA(1, 1, At, B1); PG8_BAR; PG8_SCHED;
            PG8_LDB(B0, 1, 0); PG8_LDB(B1, 1, 1); PG8_SCHED; PG8_LDA(At, 1, 0); PG8_STAGE(PG8_SA(0, 1), a2 + hstep, voffA);
            PG8_WAIT_V(8); PG8_WAIT_L(0); PG8_BAR; PG8_MMA(0, 0, At, B0); PG8_MMA(0, 1, At, B1); PG8_BAR; PG8_SCHED;
            PG8_LDA(At, 1, 1); PG8_STAGE(PG8_SB(1, 0), b3, voffB); PG8_STAGE(PG8_SB(1, 1), b3 + hstep, voffB); PG8_STAGE(PG8_SA(1, 0), a3, voffA);
            PG8_WAIT_V(8); PG8_WAIT_L(0); PG8_BAR; PG8_MMA(1, 0, At, B0); PG8_MMA(1, 1, At, B1); PG8_BAR; PG8_SCHED;
            } else {
            PG8_LDB(B0, 0, 0); PG8_SCHED; PG8_LDA(At, 0, 0); PG8_STAGE(PG8_SA(1, 1), a1 + hstep, voffA);
            PG8_WAIT_L(8); PG8_BAR; PG8_WAIT_L(0); PG8_MMA(0, 0, At, B0); PG8_BAR; PG8_SCHED;
            PG8_LDB(B1, 0, 1); PG8_STAGE(PG8_SB(0, 0), b2, voffB);
            PG8_BAR; PG8_WAIT_L(0); PG8_MMA(0, 1, At, B1); PG8_BAR;
            PG8_LDA(At, 0, 1); PG8_STAGE(PG8_SA(0, 0), a2, voffA);
            PG8_BAR; PG8_WAIT_L(0); PG8_MMA(1, 0, At, B0); PG8_BAR; PG8_SCHED;
            PG8_STAGE(PG8_SB(0, 1), b2 + hstep, voffB);
            PG8_WAIT_V(6); PG8_BAR; PG8_MMA(1, 1, At, B1); PG8_BAR;
            PG8_LDB(B0, 1, 0); PG8_SCHED; PG8_LDA(At, 1, 0); PG8_STAGE(PG8_SA(0, 1), a2 + hstep, voffA);
            PG8_WAIT_L(8); PG8_BAR; PG8_WAIT_L(0); PG8_MMA(0, 0, At, B0); PG8_BAR; PG8_SCHED;
            PG8_LDB(B1, 1, 1); PG8_STAGE(PG8_SB(1, 0), b3, voffB);
            PG8_BAR; PG8_WAIT_L(0); PG8_MMA(0, 1, At, B1); PG8_BAR;
            PG8_LDA(At, 1, 1); PG8_STAGE(PG8_SA(1, 0), a3, voffA);
            PG8_BAR; PG8_WAIT_L(0); PG8_MMA(1, 0, At, B0); PG8_BAR; PG8_SCHED;
            PG8_STAGE(PG8_SB(1, 1), b3 + hstep, voffB);
            PG8_WAIT_V(6); PG8_BAR; PG8_MMA(1, 1, At, B1); PG8_BAR;
            }
        }
        if constexpr (ALIGN_EPI) { if (wr == 0) PG8_BAR; }
        if constexpr (!Epi::AFTER_DRAIN) { E(acc, cur, wr, wc, fr, fq); S.done(cur); }
        if (!has_next) break;
#pragma unroll
        for (int a = 0; a < 2; ++a)
#pragma unroll
            for (int b = 0; b < 2; ++b)
#pragma unroll
                for (int m = 0; m < 4; ++m)
#pragma unroll
                    for (int n = 0; n < 2; ++n) acc[a][b][m][n] = (f32x4){0.f, 0.f, 0.f, 0.f};
        cur = nxt; cA = nA; cB = nB; ++ui;
        if constexpr (ALIGN_EPI) { if (wr == 1) PG8_BAR; }
    }
    PG8_WAIT_V(0);
    if constexpr (!ALIGN_EPI) { if (wr == 0) PG8_BAR; }
    PG8_BAR;
    if constexpr (Epi::AFTER_DRAIN) { E.fused(acc, cur, wr, wc, fr, fq, lds, wid, lane); S.done(cur); }
#undef PG8_SA
#undef PG8_SB
#undef PG8_STAGE
#undef PG8_LDA
#undef PG8_LDB
#undef PG8_MMA
#undef PG8_WAIT_V
#undef PG8_WAIT_L
#undef PG8_BAR
#undef PG8_SCHED
}
}
#define GAS __attribute__((address_space(1)))
#define LAS __attribute__((address_space(3)))
typedef unsigned short bf16;
typedef unsigned v4u __attribute__((ext_vector_type(4)));
typedef float f32x4 __attribute__((ext_vector_type(4)));
typedef short bf16x8 __attribute__((ext_vector_type(8)));
typedef GAS unsigned gu32;
typedef GAS unsigned long long gu64;
#define RLX_AGENT __ATOMIC_RELAXED, __HIP_MEMORY_SCOPE_AGENT
#define LDS_WAIT() asm volatile("s_waitcnt lgkmcnt(0)" ::: "memory")
#define VM_WAIT() asm volatile("s_waitcnt vmcnt(0)" ::: "memory")
__device__ __forceinline__ unsigned long long rt() { return __builtin_amdgcn_s_memrealtime(); }
__device__ __forceinline__ unsigned f2bf(float f) { unsigned u = __builtin_bit_cast(unsigned, f); return (u + 0x7fffu + ((u >> 16) & 1u)) >> 16; }
__device__ __forceinline__ unsigned pk2(float lo, float hi) { return f2bf(lo) | (f2bf(hi) << 16); }

#define XB_TMO      128
#define XB_XCNT(j)  (256  + 64 * (j))
#define XB_XSUB(j)  (1280 + 64 * (j))
#define XB_XGEN(j)  (2304 + 64 * (j))
#define XB_TOP      3328
#define XB_TOPGEN   3392
#define XCD_BAR_WORDS 3456
#define XB_SPIN_CAP (1u << 18)

__device__ __forceinline__ unsigned xb_ld(unsigned* p)              { return __hip_atomic_load(p, __ATOMIC_RELAXED, __HIP_MEMORY_SCOPE_AGENT); }
__device__ __forceinline__ unsigned xb_add(unsigned* p, unsigned v) { return __hip_atomic_fetch_add(p, v, __ATOMIC_RELAXED, __HIP_MEMORY_SCOPE_AGENT); }
__device__ __forceinline__ unsigned xb_xcc_id() { return (unsigned)__builtin_amdgcn_s_getreg((3 << 11) | 20) & 0xFu; }
#define XB_SPIN(cond, bar) do { unsigned _sp = 0; while (cond) { __builtin_amdgcn_s_sleep(1); \
    if ((++_sp & 255u) == 0u) { if (xb_ld(&(bar)[XB_TMO])) break; if (_sp > XB_SPIN_CAP) { atomicAdd(&(bar)[XB_TMO], 1u); break; } } } } while (0)

struct XcdBarrier {
    unsigned* bar; unsigned x;
    volatile LAS unsigned* st;
};

__device__ __forceinline__ XcdBarrier xcd_barrier_post(unsigned* bar, volatile LAS unsigned* st) {
    XcdBarrier b; b.bar = bar; b.x = xb_xcc_id(); b.st = st;
    if (threadIdx.x == 0) (void)xb_add(&bar[XB_XCNT(b.x)], 1u);
    return b;
}
__device__ __forceinline__ void xcd_barrier_complete(unsigned* bar, unsigned x, unsigned& nloc, unsigned& nx) {
    const unsigned G = gridDim.x * gridDim.y * gridDim.z;
    unsigned sum, cnt, mine, sp = 0u;
    for (;;) {
        sum = 0u; cnt = 0u; mine = 0u;
#pragma unroll
        for (unsigned j = 0; j < 16; ++j) { const unsigned c = xb_ld(&bar[XB_XCNT(j)]); sum += c; cnt += (c > 0u) ? 1u : 0u; mine = (j == x) ? c : mine; }
        if (sum == G) break;
        __builtin_amdgcn_s_sleep(1);
        if ((++sp & 255u) == 0u) { if (xb_ld(&bar[XB_TMO])) break; if (sp > XB_SPIN_CAP) { atomicAdd(&bar[XB_TMO], 1u); break; } }
    }
    nloc = mine > 0u ? mine : 1u; nx = cnt > 0u ? cnt : 1u;
}

__device__ __forceinline__ void xcd_barrier(const XcdBarrier& b) {
    asm volatile("s_waitcnt vmcnt(0)" ::: "memory");
    __syncthreads();
    if (threadIdx.x == 0) {
        unsigned* bar = b.bar;
        __builtin_amdgcn_s_waitcnt(0);
        unsigned nloc = b.st[0], nx = b.st[1];
        if (nloc == 0u) { xcd_barrier_complete(bar, b.x, nloc, nx); b.st[0] = nloc; b.st[1] = nx; }
        const unsigned old = xb_add(&bar[XB_XSUB(b.x)], 1u);
        const unsigned gen = old / nloc;
        if (old + 1u == (gen + 1u) * nloc) {
            __builtin_amdgcn_fence(__ATOMIC_RELEASE, "agent");
            asm volatile("s_waitcnt vmcnt(0)" ::: "memory");
            const unsigned og = xb_add(&bar[XB_TOP], 1u);
            const unsigned tg = og / nx;
            if (og + 1u == (tg + 1u) * nx) xb_add(&bar[XB_TOPGEN], 1u);
            else XB_SPIN(xb_ld(&bar[XB_TOPGEN]) == tg, bar);
            __builtin_amdgcn_fence(__ATOMIC_ACQUIRE, "agent");
            xb_add(&bar[XB_XGEN(b.x)], 1u);
            asm volatile("s_waitcnt vmcnt(0)" ::: "memory");
        } else {
            XB_SPIN(xb_ld(&bar[XB_XGEN(b.x)]) == gen, bar);
            __builtin_amdgcn_fence(__ATOMIC_ACQUIRE, "agent");
            asm volatile("s_waitcnt vmcnt(0)" ::: "memory");
        }
    }
    __syncthreads();
}
constexpr int NWAVES = 8, NTHREADS = 512;
constexpr int T = 16384, D = 1024, SEQ = 4096, NBATCH = 4, NMEM = 256, NEXP = 32, TOPK = 4;
constexpr int NPROJ = 9728;
constexpr int XS_ROWS = T * TOPK + NEXP * 256;
constexpr float EPS = 1e-6f, LOG2E = 1.4426950408889634f, LN2 = 0.6931471805599453f;
#ifndef MK_N_LAUNCHES
#define MK_N_LAUNCHES 1
#endif
constexpr int N_PHASES = 14;
constexpr int N_LAUNCHES = MK_N_LAUNCHES;

constexpr size_t MiB = 1u << 20;
constexpr size_t WS_CTL = 0, CTL_ZERO_BYTES = 1 * MiB;
constexpr size_t CTL_SS2 = 256 * 1024, CTL_CNT = 384 * 1024, CTL_FILL = 384 * 1024 + 256;
constexpr size_t WS_WCQ = 1 * MiB, WS_WCO = 2 * MiB, WS_WO = 3 * MiB, WS_KV = 5 * MiB;
constexpr size_t WS_TOPI = 7 * MiB, WS_TOPW = WS_TOPI + 256 * 1024, WS_RSTD3 = WS_TOPW + 256 * 1024, WS_ROWSLOT = WS_RSTD3 + 64 * 1024;
constexpr size_t WS_EXPGU = 8 * MiB, WS_EXPD = 136 * MiB;
constexpr size_t WS_PROJ = 8 * MiB, WS_U1 = 312 * MiB, WS_W1T = 344 * MiB, WS_OG = 312 * MiB, WS_LSE = 360 * MiB;
constexpr size_t WS_WBA = 363 * MiB, WS_WBC = 364 * MiB, WS_MN = 366 * MiB, WS_YA = 368 * MiB, WS_YC = 384 * MiB, WS_MIX = 416 * MiB, WS_WCKV = 448 * MiB;
constexpr size_t WS_H1 = 200 * MiB, WS_H1B = 264 * MiB, WS_Q2 = 296 * MiB, WS_O2 = 312 * MiB;
constexpr size_t WS_XS = 200 * MiB, WS_HDN = 344 * MiB, WS_Y = 200 * MiB, WS_END = 488 * MiB;
static_assert(WS_ROWSLOT + (size_t)XS_ROWS * 4 <= WS_EXPGU, "misc region");
static_assert(WS_XS + (size_t)XS_ROWS * D * 2 <= WS_HDN && WS_HDN + (size_t)XS_ROWS * D * 2 <= WS_END, "moe rows");
constexpr int CW_TMO = 0, CW_CODE = 1, CW_BAR = 4096;

constexpr int LDS_BYTES = 163840;
constexpr int TBL_OFF = 163840 - 2048;
constexpr int MISC_OFF = 163840 - 256;

struct Frame {
    LAS unsigned char* lds;
    volatile LAS unsigned* MISC;
    gu32* ctl;
    unsigned char* ws;
    int tid, lane, wave, vcu, G;
};
__device__ __forceinline__ float wave_sum(float v) {
#pragma unroll
    for (int o = 1; o < 64; o <<= 1) v += __shfl_xor(v, o);
    return v;
}
typedef unsigned long long u64;
__device__ __forceinline__ float bf_lo(unsigned w) { return __builtin_bit_cast(float, w << 16); }
__device__ __forceinline__ float bf_hi(unsigned w) { return __builtin_bit_cast(float, w & 0xffff0000u); }

__device__ __forceinline__ void transpose_item(const float* W, int K, int N, bf16* WT, int drow, int k0, int n0, const float* gain, LAS float* scr, int lane) {
#pragma unroll 8
    for (int i = 0; i < 32; ++i) { const int kk = 2 * i + (lane >> 5); float w = W[(size_t)(k0 + kk) * N + n0 + (lane & 31)]; if (gain) w *= gain[k0 + kk]; scr[kk * 33 + (lane & 31)] = w; }
    LDS_WAIT(); asm volatile("" ::: "memory");
    const int c = lane & 7;
#pragma unroll
    for (int j = 0; j < 4; ++j) { const int n = (lane >> 3) + 8 * j; const LAS float* s = scr + (8 * c) * 33 + n;
        v4u o; o.x = pk2(s[0 * 33], s[1 * 33]); o.y = pk2(s[2 * 33], s[3 * 33]); o.z = pk2(s[4 * 33], s[5 * 33]); o.w = pk2(s[6 * 33], s[7 * 33]);
        *(GAS v4u*)(WT + (size_t)(drow + n) * K + k0 + 8 * c) = o; }
    LDS_WAIT(); asm volatile("" ::: "memory");
}
__device__ __forceinline__ bool transpose_mat(int& r, const float* W, int K, int N, bf16* WT, int drow0, const float* gain, LAS float* scr, int lane) {
    const int nblk = N / 32, items = (K / 64) * nblk;
    if (r < items) { const int kb = r / nblk, nb = r % nblk; transpose_item(W, K, N, WT, drow0 + 32 * nb, 64 * kb, 32 * nb, gain, scr, lane); return true; }
    r -= items; return false;
}
__device__ __forceinline__ void rms_row_to_bf16(const float* xrow, const float* gain, bf16* orow, int lane) {
    const GAS f32x4* xr = (const GAS f32x4*)xrow + lane; const GAS f32x4* gr = (const GAS f32x4*)gain + lane;
    f32x4 v[4]; float s = 0.f;
#pragma unroll
    for (int j = 0; j < 4; ++j) { v[j] = xr[64 * j]; s += (v[j].x * v[j].x + v[j].y * v[j].y) + (v[j].z * v[j].z + v[j].w * v[j].w); }
    const float rstd = 1.f / sqrtf(wave_sum(s) * (1.f / D) + EPS);
    GAS u64* o8 = (GAS u64*)orow + lane;
#pragma unroll
    for (int j = 0; j < 4; ++j) { const f32x4 g = gr[64 * j]; o8[64 * j] = (u64)pk2(v[j].x * rstd * g.x, v[j].y * rstd * g.y) | ((u64)pk2(v[j].z * rstd * g.z, v[j].w * rstd * g.w) << 32); }
}

__device__ __forceinline__ int xcd_remap(int wgid, int nwg) { const int q = nwg / 8, r = nwg % 8, xcd = wgid % 8, off = wgid / 8; return (xcd < r ? xcd * (q + 1) : r * (q + 1) + (xcd - r) * q) + off; }
struct MoeOrder {
    const volatile LAS int* tpre; int npn, G, c;
    __device__ __forceinline__ bool next(int i, pg8::Unit& u) const {
        const int total = tpre[32] * npn; const long L = (long)i * G + c; if (L >= total) return false;
        const int U = xcd_remap((int)L, total);
        int e = 0;
#pragma unroll 1
        for (int k = 1; k < 32; ++k) if (tpre[k] * npn <= U) e = k;
        const int t0 = tpre[e], nt = tpre[e + 1] - t0, Ul = U - t0 * npn;
        u.pm = t0 + Ul % nt; u.pn = e * npn + Ul / nt; return true;
    }
    __device__ __forceinline__ void a_ready(const pg8::Unit&) const {}
    __device__ __forceinline__ void done(const pg8::Unit&) const {}
};
struct In {
    const float *x, *mem, *norm_mix, *w_in, *conv_w, *w_ba, *w_bc, *w_gate, *b_gate, *w_out, *norm_cross, *norm_mem, *w_cq, *w_ckv, *w_co, *norm_moe,
                *router_w, *router_b, *w_eg, *b_eg, *w_eu, *b_eu, *w_ed, *b_ed, *norm_final;
};

__device__ __forceinline__ void phase_prologue(Frame& F, const In& in) {
    LAS float* scr = (LAS float*)(F.lds + F.wave * 16384);
    const int gw = F.vcu * NWAVES + F.wave, NGW = F.G * NWAVES;
    unsigned char* ws = F.ws;
    constexpr int NITEMS = 16 * 240 + 16 * 64 + 8 * 32 + 16 * 32 + 16 * 32 + 16 * 16 + 16 * 32 + 8 * 32;
    for (int it = gw; it < NITEMS; it += NGW) {
        int r = it;
        if (transpose_mat(r, in.w_in, 1024, 7680, (bf16*)(ws + WS_W1T), 0, nullptr, scr, F.lane)) continue;
        if (transpose_mat(r, in.w_gate, 1024, 2048, (bf16*)(ws + WS_W1T), 7680, nullptr, scr, F.lane)) continue;
        if (transpose_mat(r, in.w_ba, 512, 1024, (bf16*)(ws + WS_WBA), 0, nullptr, scr, F.lane)) continue;
        if (transpose_mat(r, in.w_bc, 1024, 1024, (bf16*)(ws + WS_WBC), 0, nullptr, scr, F.lane)) continue;
        if (transpose_mat(r, in.w_out, 1024, 1024, (bf16*)(ws + WS_WO), 0, nullptr, scr, F.lane)) continue;
        if (transpose_mat(r, in.w_cq, 1024, 512, (bf16*)(ws + WS_WCQ), 0, in.norm_cross, scr, F.lane)) continue;
        if (transpose_mat(r, in.w_ckv, 1024, 1024, (bf16*)(ws + WS_WCKV), 0, nullptr, scr, F.lane)) continue;
        transpose_mat(r, in.w_co, 512, 1024, (bf16*)(ws + WS_WCO), 0, nullptr, scr, F.lane);
    }
    for (int m = gw; m < T; m += NGW) rms_row_to_bf16(in.x + (size_t)m * D, in.norm_mix, (bf16*)(ws + WS_U1) + (size_t)m * D, F.lane);
    for (int m = gw; m < NBATCH * NMEM; m += NGW) rms_row_to_bf16(in.mem + (size_t)m * D, in.norm_mem, (bf16*)(ws + WS_MN) + (size_t)m * D, F.lane);
}

__device__ __forceinline__ void phase_expert_convert(Frame& F, const In& in) {
    LAS float* scr = (LAS float*)(F.lds + F.wave * 16384);
    const int gw = F.vcu * NWAVES + F.wave, NGW = F.G * NWAVES;
    constexpr int PER = 16 * 32, NITEMS = NEXP * 3 * PER;
    for (int it = gw; it < NITEMS; it += NGW) {
        const int mtx = it / PER, r = it % PER, e = mtx / 3, which = mtx % 3, kb = r / 32, nb = r % 32, n0 = 32 * nb;
        if (which == 0)      transpose_item(in.w_eg + (size_t)e * D * D, D, D, (bf16*)(F.ws + WS_EXPGU) + (size_t)e * 2048 * D, (n0 >> 7) * 256 + (n0 & 127), 64 * kb, n0, nullptr, scr, F.lane);
        else if (which == 1) transpose_item(in.w_eu + (size_t)e * D * D, D, D, (bf16*)(F.ws + WS_EXPGU) + (size_t)e * 2048 * D, (n0 >> 7) * 256 + 128 + (n0 & 127), 64 * kb, n0, nullptr, scr, F.lane);
        else                 transpose_item(in.w_ed + (size_t)e * D * D, D, D, (bf16*)(F.ws + WS_EXPD) + (size_t)e * D * D, n0, 64 * kb, n0, nullptr, scr, F.lane);
    }
}

__device__ __forceinline__ void dil_attn_unit(Frame& F, int unit) {
    const int rn = unit & 31, bgh = unit >> 5, h = bgh & 7, bg = bgh >> 3, g = bg % 3, b = bg / 3;
    const int dil = g == 0 ? 1 : (g == 1 ? 4 : 16), nper = 32 / dil, r = rn / nper, n = rn % nper;
    const bf16* PROJ = (const bf16*)(F.ws + WS_PROJ);
    LAS bf16* Ks = (LAS bf16*)F.lds; LAS bf16* Vs = Ks + 256 * 72;
    const int tid = F.tid;
#pragma unroll
    for (int it = 0; it < 4; ++it) {
        const int row = (tid >> 3) + 64 * it, ch = tid & 7, j = 128 * (n - 1) + row;
        v4u kv = (v4u){0u, 0u, 0u, 0u}, vv = kv;
        if (j >= 0) { const size_t grow = (size_t)b * SEQ + (size_t)j * dil + r; const bf16* p = PROJ + grow * NPROJ + g * 1536 + h * 64 + ch * 8; kv = *(const GAS v4u*)(p + 512); vv = *(const GAS v4u*)(p + 1024); }
        *(LAS v4u*)(Ks + row * 72 + ch * 8) = kv; *(LAS v4u*)(Vs + row * 72 + ch * 8) = vv;
    }
    __syncthreads();
    const int ql = tid >> 2, part = tid & 3;
    const size_t growq = (size_t)b * SEQ + (size_t)(128 * n + ql) * dil + r;
    float q[16], acc[16];
    { const bf16* p = PROJ + growq * NPROJ + g * 1536 + h * 64 + part * 16; const v4u a = *(const GAS v4u*)p, c = *(const GAS v4u*)(p + 8);
      const float sc = 0.125f * LOG2E;
      q[0] = bf_lo(a.x) * sc; q[1] = bf_hi(a.x) * sc; q[2] = bf_lo(a.y) * sc; q[3] = bf_hi(a.y) * sc; q[4] = bf_lo(a.z) * sc; q[5] = bf_hi(a.z) * sc; q[6] = bf_lo(a.w) * sc; q[7] = bf_hi(a.w) * sc;
      q[8] = bf_lo(c.x) * sc; q[9] = bf_hi(c.x) * sc; q[10] = bf_lo(c.y) * sc; q[11] = bf_hi(c.y) * sc; q[12] = bf_lo(c.z) * sc; q[13] = bf_hi(c.z) * sc; q[14] = bf_lo(c.w) * sc; q[15] = bf_hi(c.w) * sc; }
#pragma unroll
    for (int i = 0; i < 16; ++i) acc[i] = 0.f;
    float mrun = -1e30f, l = 0.f;
    const float slope2 = exp2f(-(float)(h + 1)) * (float)dil * LOG2E;
    const int jbase = 128 * (n - 1) + ql;
#pragma unroll 1
    for (int kk = 0; kk <= 128; ++kk) {
        const int kl = ql + kk; const bool valid = (jbase + kk) >= 0;
        const LAS bf16* kp = Ks + kl * 72 + part * 16; const v4u a = *(const LAS v4u*)kp, c = *(const LAS v4u*)(kp + 8);
        float s = q[0] * bf_lo(a.x) + q[1] * bf_hi(a.x) + q[2] * bf_lo(a.y) + q[3] * bf_hi(a.y) + q[4] * bf_lo(a.z) + q[5] * bf_hi(a.z) + q[6] * bf_lo(a.w) + q[7] * bf_hi(a.w)
                + q[8] * bf_lo(c.x) + q[9] * bf_hi(c.x) + q[10] * bf_lo(c.y) + q[11] * bf_hi(c.y) + q[12] * bf_lo(c.z) + q[13] * bf_hi(c.z) + q[14] * bf_lo(c.w) + q[15] * bf_hi(c.w);
        s += __shfl_xor(s, 1); s += __shfl_xor(s, 2);
        s -= slope2 * (float)(128 - kk);
        const float mn = valid ? fmaxf(mrun, s) : mrun;
        const float alpha = __builtin_amdgcn_exp2f(mrun - mn), p = valid ? __builtin_amdgcn_exp2f(s - mn) : 0.f;
        mrun = mn; l = l * alpha + p;
        const LAS bf16* vp = Vs + kl * 72 + part * 16; const v4u va = *(const LAS v4u*)vp, vc = *(const LAS v4u*)(vp + 8);
        acc[0] = acc[0] * alpha + p * bf_lo(va.x); acc[1] = acc[1] * alpha + p * bf_hi(va.x); acc[2] = acc[2] * alpha + p * bf_lo(va.y); acc[3] = acc[3] * alpha + p * bf_hi(va.y);
        acc[4] = acc[4] * alpha + p * bf_lo(va.z); acc[5] = acc[5] * alpha + p * bf_hi(va.z); acc[6] = acc[6] * alpha + p * bf_lo(va.w); acc[7] = acc[7] * alpha + p * bf_hi(va.w);
        acc[8] = acc[8] * alpha + p * bf_lo(vc.x); acc[9] = acc[9] * alpha + p * bf_hi(vc.x); acc[10] = acc[10] * alpha + p * bf_lo(vc.y); acc[11] = acc[11] * alpha + p * bf_hi(vc.y);
        acc[12] = acc[12] * alpha + p * bf_lo(vc.z); acc[13] = acc[13] * alpha + p * bf_hi(vc.z); acc[14] = acc[14] * alpha + p * bf_lo(vc.w); acc[15] = acc[15] * alpha + p * bf_hi(vc.w);
    }
    const float inv = 1.f / l;
    bf16* og = (bf16*)(F.ws + WS_OG) + ((size_t)g * T + growq) * 512 + h * 64 + part * 16;
    v4u o0, o1;
    o0.x = pk2(acc[0] * inv, acc[1] * inv); o0.y = pk2(acc[2] * inv, acc[3] * inv); o0.z = pk2(acc[4] * inv, acc[5] * inv); o0.w = pk2(acc[6] * inv, acc[7] * inv);
    o1.x = pk2(acc[8] * inv, acc[9] * inv); o1.y = pk2(acc[10] * inv, acc[11] * inv); o1.z = pk2(acc[12] * inv, acc[13] * inv); o1.w = pk2(acc[14] * inv, acc[15] * inv);
    *(GAS v4u*)og = o0; *(GAS v4u*)(og + 8) = o1;
    if (part == 0) ((float*)(F.ws + WS_LSE))[((size_t)g * T + growq) * 8 + h] = (mrun + __builtin_amdgcn_logf(l)) * LN2;
    __syncthreads();
}


typedef short s16x4v __attribute__((ext_vector_type(4)));
typedef short bf16x8v __attribute__((ext_vector_type(8)));
__device__ __forceinline__ s16x4v lds_tr16(const LAS bf16* p) { return __builtin_bit_cast(s16x4v, __builtin_amdgcn_ds_read_tr16_b64_v4i16((LAS s16x4v*)p)); }
__device__ __forceinline__ void dil_attn_unit_mfma(Frame& F, int unit) {
    const int rn = unit & 31, bgh = unit >> 5, h = bgh & 7, bg = bgh >> 3, g = bg % 3, b = bg / 3;
    const int dil = g == 0 ? 1 : (g == 1 ? 4 : 16), nper = 32 / dil, r = rn / nper, n = rn % nper;
    const bf16* PROJ = (const bf16*)(F.ws + WS_PROJ);
    LAS bf16* Ks = (LAS bf16*)F.lds; LAS bf16* Vs = Ks + 256 * 72;
    const int tid = F.tid, lane = F.lane, w = F.wave, qi = lane & 15, G = lane >> 4;
#pragma unroll
    for (int it = 0; it < 4; ++it) {
        const int row = (tid >> 3) + 64 * it, ch = tid & 7, j = 128 * (n - 1) + row;
        v4u kv = (v4u){0u, 0u, 0u, 0u}, vv = kv;
        if (j >= 0) { const size_t grow = (size_t)b * SEQ + (size_t)j * dil + r; const bf16* p = PROJ + grow * NPROJ + g * 1536 + h * 64 + ch * 8; kv = *(const GAS v4u*)(p + 512); vv = *(const GAS v4u*)(p + 1024); }
        *(LAS v4u*)(Ks + row * 72 + ch * 8) = kv; *(LAS v4u*)(Vs + row * 72 + ch * 8) = vv;
    }
    if (tid < 128) *(LAS v4u*)(Vs + (256 + (tid >> 3)) * 72 + (tid & 7) * 8) = (v4u){0u, 0u, 0u, 0u};
    const int ql = 16 * w + qi;
    const size_t growq = (size_t)b * SEQ + (size_t)(128 * n + ql) * dil + r;
    const bf16* qp = PROJ + growq * NPROJ + g * 1536 + h * 64 + 8 * G;
    const bf16x8v q0 = *(const GAS bf16x8v*)qp, q1 = *(const GAS bf16x8v*)(qp + 32);
    __syncthreads();
    pg8::f32x4 st[9];
#pragma unroll
    for (int t = 0; t < 9; ++t) {
        const LAS bf16* kp = Ks + (16 * (w + t) + qi) * 72 + 8 * G;
        const bf16x8v k0 = *(const LAS bf16x8v*)kp, k1 = *(const LAS bf16x8v*)(kp + 32);
        pg8::f32x4 a = (pg8::f32x4){0.f, 0.f, 0.f, 0.f};
        a = __builtin_amdgcn_mfma_f32_16x16x32_bf16(k0, q0, a, 0, 0, 0);
        a = __builtin_amdgcn_mfma_f32_16x16x32_bf16(k1, q1, a, 0, 0, 0);
        st[t] = a;
    }
    const float slope2 = exp2f(-(float)(h + 1)) * (float)dil * LOG2E, sc = 0.125f * LOG2E;
    const int jq = 128 * (n - 1);
    float mx = -1e30f;
#pragma unroll
    for (int t = 0; t < 9; ++t)
#pragma unroll
        for (int i = 0; i < 4; ++i) {
            const int kl = 16 * (w + t) + 4 * G + i, dk = kl - ql;
            const bool ok = dk >= 0 && dk <= 128 && (jq + kl) >= 0;
            const float sv = ok ? st[t][i] * sc - slope2 * (float)(128 - dk) : -1e30f;
            st[t][i] = sv; mx = fmaxf(mx, sv);
        }
    mx = fmaxf(mx, __shfl_xor(mx, 16)); mx = fmaxf(mx, __shfl_xor(mx, 32));
    float l = 0.f;
#pragma unroll
    for (int t = 0; t < 9; ++t)
#pragma unroll
        for (int i = 0; i < 4; ++i) { const float pv = st[t][i] > -1e29f ? __builtin_amdgcn_exp2f(st[t][i] - mx) : 0.f; st[t][i] = pv; l += pv; }
    l += __shfl_xor(l, 16); l += __shfl_xor(l, 32);
    pg8::f32x4 o[4];
#pragma unroll
    for (int dm = 0; dm < 4; ++dm) o[dm] = (pg8::f32x4){0.f, 0.f, 0.f, 0.f};
#pragma unroll
    for (int s5 = 0; s5 < 5; ++s5) {
        const pg8::f32x4 pa = st[2 * s5], pb = (2 * s5 + 1 < 9) ? st[2 * s5 + 1] : (pg8::f32x4){0.f, 0.f, 0.f, 0.f};
        bf16x8v pf;
        { const unsigned w0 = pk2(pa[0], pa[1]), w1 = pk2(pa[2], pa[3]), w2 = pk2(pb[0], pb[1]), w3 = pk2(pb[2], pb[3]);
          pf = __builtin_bit_cast(bf16x8v, (v4u){w0, w1, w2, w3}); }
        const LAS bf16* vbase = Vs + (16 * (w + 2 * s5) + 4 * G + (qi >> 2)) * 72 + 4 * (qi & 3);
#pragma unroll
        for (int dm = 0; dm < 4; ++dm) {
            const s16x4v lo = lds_tr16(vbase + 16 * dm), hi = lds_tr16(vbase + 16 * 72 + 16 * dm);
            const bf16x8v vf = (bf16x8v){lo[0], lo[1], lo[2], lo[3], hi[0], hi[1], hi[2], hi[3]};
            o[dm] = __builtin_amdgcn_mfma_f32_16x16x32_bf16(vf, pf, o[dm], 0, 0, 0);
        }
    }
    const float inv = 1.f / l;
    bf16* og = (bf16*)(F.ws + WS_OG) + ((size_t)g * T + growq) * 512 + h * 64 + 4 * G;
#pragma unroll
    for (int dm = 0; dm < 4; ++dm) *(GAS u64*)(og + 16 * dm) = (u64)pk2(o[dm][0] * inv, o[dm][1] * inv) | ((u64)pk2(o[dm][2] * inv, o[dm][3] * inv) << 32);
    if (G == 0) ((float*)(F.ws + WS_LSE))[((size_t)g * T + growq) * 8 + h] = (mx + __builtin_amdgcn_logf(l)) * LN2;
    __syncthreads();
}

__device__ __forceinline__ void phase_combine_conv(Frame& F, const In& in) {
    const int gw = F.vcu * NWAVES + F.wave, NGW = F.G * NWAVES, lane = F.lane;
    const bf16* PROJ = (const bf16*)(F.ws + WS_PROJ); const bf16* OG = (const bf16*)(F.ws + WS_OG); const float* LSE = (const float*)(F.ws + WS_LSE);
    for (int t = gw; t < T; t += NGW) {
        { const int head = lane >> 3;
          const float l0 = LSE[((size_t)0 * T + t) * 8 + head], l1 = LSE[((size_t)1 * T + t) * 8 + head], l2 = LSE[((size_t)2 * T + t) * 8 + head];
          const float mx = fmaxf(l0, fmaxf(l1, l2)); float w0 = __expf(l0 - mx), w1 = __expf(l1 - mx), w2 = __expf(l2 - mx); const float inv = 1.f / (w0 + w1 + w2); w0 *= inv; w1 *= inv; w2 *= inv;
          const v4u a = *(const GAS v4u*)(OG + ((size_t)0 * T + t) * 512 + 8 * lane), b = *(const GAS v4u*)(OG + ((size_t)1 * T + t) * 512 + 8 * lane), c = *(const GAS v4u*)(OG + ((size_t)2 * T + t) * 512 + 8 * lane);
          v4u o;
          o.x = pk2(w0 * bf_lo(a.x) + w1 * bf_lo(b.x) + w2 * bf_lo(c.x), w0 * bf_hi(a.x) + w1 * bf_hi(b.x) + w2 * bf_hi(c.x));
          o.y = pk2(w0 * bf_lo(a.y) + w1 * bf_lo(b.y) + w2 * bf_lo(c.y), w0 * bf_hi(a.y) + w1 * bf_hi(b.y) + w2 * bf_hi(c.y));
          o.z = pk2(w0 * bf_lo(a.z) + w1 * bf_lo(b.z) + w2 * bf_lo(c.z), w0 * bf_hi(a.z) + w1 * bf_hi(b.z) + w2 * bf_hi(c.z));
          o.w = pk2(w0 * bf_lo(a.w) + w1 * bf_lo(b.w) + w2 * bf_lo(c.w), w0 * bf_hi(a.w) + w1 * bf_hi(b.w) + w2 * bf_hi(c.w));
          *(GAS v4u*)((bf16*)(F.ws + WS_YA) + (size_t)t * 512 + 8 * lane) = o; }
        const int pos = t & (SEQ - 1);
#pragma unroll
        for (int half = 0; half < 2; ++half) {
            const int c = 8 * lane + 512 * half;
            float z[3][8];
#pragma unroll
            for (int dd = 0; dd < 3; ++dd) {
                const int back = 2 - dd;
                if (pos - back >= 0) { const bf16* p = PROJ + (size_t)(t - back) * NPROJ + 4608 + c; const v4u gc = *(const GAS v4u*)(p + 1024), xc = *(const GAS v4u*)(p + 2048);
                    z[dd][0] = bf_lo(gc.x) * bf_lo(xc.x); z[dd][1] = bf_hi(gc.x) * bf_hi(xc.x); z[dd][2] = bf_lo(gc.y) * bf_lo(xc.y); z[dd][3] = bf_hi(gc.y) * bf_hi(xc.y);
                    z[dd][4] = bf_lo(gc.z) * bf_lo(xc.z); z[dd][5] = bf_hi(gc.z) * bf_hi(xc.z); z[dd][6] = bf_lo(gc.w) * bf_lo(xc.w); z[dd][7] = bf_hi(gc.w) * bf_hi(xc.w); }
                else {
#pragma unroll
                    for (int i = 0; i < 8; ++i) z[dd][i] = 0.f; }
            }
            const v4u gb = *(const GAS v4u*)(PROJ + (size_t)t * NPROJ + 4608 + c);
            float y[8];
#pragma unroll
            for (int i = 0; i < 8; ++i) y[i] = in.conv_w[c + i] * z[0][i] + in.conv_w[1024 + c + i] * z[1][i] + in.conv_w[2048 + c + i] * z[2][i];
            v4u o; o.x = pk2(bf_lo(gb.x) * y[0], bf_hi(gb.x) * y[1]); o.y = pk2(bf_lo(gb.y) * y[2], bf_hi(gb.y) * y[3]); o.z = pk2(bf_lo(gb.z) * y[4], bf_hi(gb.z) * y[5]); o.w = pk2(bf_lo(gb.w) * y[6], bf_hi(gb.w) * y[7]);
            *(GAS v4u*)((bf16*)(F.ws + WS_YC) + (size_t)t * 1024 + c) = o;
        }
    }
}

__device__ __forceinline__ void cross_attn_unit(Frame& F, int unit) {
    const int qc = unit & 31, bh = unit >> 5, h = bh & 3, b = bh >> 2, tid = F.tid;
    const bf16* KV = (const bf16*)(F.ws + WS_KV); const bf16* Q2 = (const bf16*)(F.ws + WS_Q2);
    LAS bf16* Ks = (LAS bf16*)F.lds; LAS bf16* Vs = Ks + 256 * 136;
#pragma unroll
    for (int it = 0; it < 8; ++it) {
        const int row = (tid >> 4) + 32 * it, ch = tid & 15; const bf16* p = KV + (size_t)(b * NMEM + row) * 1024 + h * 128 + ch * 8;
        *(LAS v4u*)(Ks + row * 136 + ch * 8) = *(const GAS v4u*)p; *(LAS v4u*)(Vs + row * 136 + ch * 8) = *(const GAS v4u*)(p + 512);
    }
    __syncthreads();
    const int ql = tid >> 2, part = tid & 3; const size_t grow = (size_t)b * SEQ + 128 * qc + ql;
    float q[32], acc[32];
    { const bf16* p = Q2 + grow * 512 + h * 128 + part * 32; const float sc = 0.08838834764831845f * LOG2E;
#pragma unroll
      for (int c4 = 0; c4 < 4; ++c4) { const v4u a = *(const GAS v4u*)(p + 8 * c4);
          q[8 * c4 + 0] = bf_lo(a.x) * sc; q[8 * c4 + 1] = bf_hi(a.x) * sc; q[8 * c4 + 2] = bf_lo(a.y) * sc; q[8 * c4 + 3] = bf_hi(a.y) * sc;
          q[8 * c4 + 4] = bf_lo(a.z) * sc; q[8 * c4 + 5] = bf_hi(a.z) * sc; q[8 * c4 + 6] = bf_lo(a.w) * sc; q[8 * c4 + 7] = bf_hi(a.w) * sc; } }
#pragma unroll
    for (int i = 0; i < 32; ++i) acc[i] = 0.f;
    float mrun = -1e30f, l = 0.f;
#pragma unroll 1
    for (int key = 0; key < NMEM; ++key) {
        const LAS bf16* kp = Ks + key * 136 + part * 32; float s = 0.f;
#pragma unroll
        for (int c4 = 0; c4 < 4; ++c4) { const v4u a = *(const LAS v4u*)(kp + 8 * c4);
            s += q[8 * c4 + 0] * bf_lo(a.x) + q[8 * c4 + 1] * bf_hi(a.x) + q[8 * c4 + 2] * bf_lo(a.y) + q[8 * c4 + 3] * bf_hi(a.y)
               + q[8 * c4 + 4] * bf_lo(a.z) + q[8 * c4 + 5] * bf_hi(a.z) + q[8 * c4 + 6] * bf_lo(a.w) + q[8 * c4 + 7] * bf_hi(a.w); }
        s += __shfl_xor(s, 1); s += __shfl_xor(s, 2);
        const float mn = fmaxf(mrun, s), alpha = __builtin_amdgcn_exp2f(mrun - mn), p = __builtin_amdgcn_exp2f(s - mn);
        mrun = mn; l = l * alpha + p;
        const LAS bf16* vp = Vs + key * 136 + part * 32;
#pragma unroll
        for (int c4 = 0; c4 < 4; ++c4) { const v4u a = *(const LAS v4u*)(vp + 8 * c4);
            acc[8 * c4 + 0] = acc[8 * c4 + 0] * alpha + p * bf_lo(a.x); acc[8 * c4 + 1] = acc[8 * c4 + 1] * alpha + p * bf_hi(a.x);
            acc[8 * c4 + 2] = acc[8 * c4 + 2] * alpha + p * bf_lo(a.y); acc[8 * c4 + 3] = acc[8 * c4 + 3] * alpha + p * bf_hi(a.y);
            acc[8 * c4 + 4] = acc[8 * c4 + 4] * alpha + p * bf_lo(a.z); acc[8 * c4 + 5] = acc[8 * c4 + 5] * alpha + p * bf_hi(a.z);
            acc[8 * c4 + 6] = acc[8 * c4 + 6] * alpha + p * bf_lo(a.w); acc[8 * c4 + 7] = acc[8 * c4 + 7] * alpha + p * bf_hi(a.w); }
    }
    const float inv = 1.f / l;
    bf16* op = (bf16*)(F.ws + WS_O2) + grow * 512 + h * 128 + part * 32;
#pragma unroll
    for (int c4 = 0; c4 < 4; ++c4) { v4u o; o.x = pk2(acc[8 * c4 + 0] * inv, acc[8 * c4 + 1] * inv); o.y = pk2(acc[8 * c4 + 2] * inv, acc[8 * c4 + 3] * inv);
        o.z = pk2(acc[8 * c4 + 4] * inv, acc[8 * c4 + 5] * inv); o.w = pk2(acc[8 * c4 + 6] * inv, acc[8 * c4 + 7] * inv); *(GAS v4u*)(op + 8 * c4) = o; }
    __syncthreads();
}

__device__ __forceinline__ float rlane(float x, int L) { int r = __builtin_amdgcn_readlane(__builtin_bit_cast(int, x), L); asm volatile("" : "+s"(r)); return __builtin_bit_cast(float, r); }
__device__ __forceinline__ void phase_router(Frame& F, const In& in, const float* H2) {
    LAS float* wl = (LAS float*)F.lds;
    for (int i = F.tid; i < 1024 * 32 / 4; i += NTHREADS) ((LAS f32x4*)wl)[i] = ((const GAS f32x4*)in.router_w)[i];
    __syncthreads();
    const int gw = F.vcu * NWAVES + F.wave, NGW = F.G * NWAVES, lane = F.lane, e = lane & 31;
    int* topi = (int*)(F.ws + WS_TOPI); float* topw = (float*)(F.ws + WS_TOPW); float* rstd3 = (float*)(F.ws + WS_RSTD3);
    unsigned* cnt = (unsigned*)(F.ws + WS_CTL + CTL_CNT);
    const float rb = in.router_b[e];
    for (int t = gw; t < T; t += NGW) {
        const GAS f32x4* xr = (const GAS f32x4*)(H2 + (size_t)t * D) + lane; const GAS f32x4* gr = (const GAS f32x4*)in.norm_moe + lane;
        f32x4 v[4]; float s = 0.f;
#pragma unroll
        for (int j = 0; j < 4; ++j) { v[j] = xr[64 * j]; s += (v[j].x * v[j].x + v[j].y * v[j].y) + (v[j].z * v[j].z + v[j].w * v[j].w); }
        const float rstd = 1.f / sqrtf(wave_sum(s) * (1.f / D) + EPS);
        if (lane == 0) rstd3[t] = rstd;
#pragma unroll
        for (int j = 0; j < 4; ++j) { const f32x4 g = gr[64 * j]; v[j] = v[j] * g * rstd; }
        float a0 = 0.f, a1 = 0.f, a2 = 0.f, a3 = 0.f;
#pragma unroll
        for (int j = 0; j < 4; ++j) {
#pragma unroll 4
            for (int L = 0; L < 64; ++L) {
                const LAS float* wp = wl + (size_t)(4 * (64 * j + L)) * 32 + e;
                a0 += rlane(v[j].x, L) * wp[0];
                a1 += rlane(v[j].y, L) * wp[32];
                a2 += rlane(v[j].z, L) * wp[64];
                a3 += rlane(v[j].w, L) * wp[96];
            }
        }
        float val = (a0 + a1) + (a2 + a3) + rb; const int idx = e;
        float tv0 = 0.f, tv1 = 0.f, tv2 = 0.f, tv3 = 0.f; int ti0 = 0, ti1 = 0, ti2 = 0, ti3 = 0;
#pragma unroll
        for (int k = 0; k < 4; ++k) {
            float bv = val; int bi = idx;
#pragma unroll
            for (int off = 1; off < 32; off <<= 1) { const float ov = __shfl_xor(bv, off); const int oi = __shfl_xor(bi, off); if (ov > bv || (ov == bv && oi < bi)) { bv = ov; bi = oi; } }
            if (k == 0) { tv0 = bv; ti0 = bi; } else if (k == 1) { tv1 = bv; ti1 = bi; } else if (k == 2) { tv2 = bv; ti2 = bi; } else { tv3 = bv; ti3 = bi; }
            if (idx == bi) val = -INFINITY;
        }
        const float e1 = __expf(tv1 - tv0), e2 = __expf(tv2 - tv0), e3 = __expf(tv3 - tv0), inv = 1.f / (1.f + e1 + e2 + e3);
        if (lane < 4) {
            const int ei = lane == 0 ? ti0 : (lane == 1 ? ti1 : (lane == 2 ? ti2 : ti3));
            const float wv = (lane == 0 ? 1.f : (lane == 1 ? e1 : (lane == 2 ? e2 : e3))) * inv;
            topi[t * 4 + lane] = ei; topw[t * 4 + lane] = wv;
            __hip_atomic_fetch_add(cnt + ei, 1u, __ATOMIC_RELAXED, __HIP_MEMORY_SCOPE_AGENT);
        }
    }
    __syncthreads();
}

__device__ __forceinline__ void build_tpre(Frame& F) {
    volatile LAS int* tpre = (volatile LAS int*)(F.lds + TBL_OFF);
    const unsigned* cnt = (const unsigned*)(F.ws + WS_CTL + CTL_CNT);
    if (F.tid == 0) { int acc = 0;
        for (int e = 0; e < NEXP; ++e) { tpre[e] = acc; const unsigned c = __hip_atomic_load(cnt + e, __ATOMIC_RELAXED, __HIP_MEMORY_SCOPE_AGENT); tpre[64 + e] = (int)c; acc += (int)((c + 255u) >> 8); }
        tpre[32] = acc; }
    __syncthreads();
}

__device__ __forceinline__ void phase_scatter(Frame& F, const In& in, const float* H2) {
    build_tpre(F);
    volatile LAS int* tpre = (volatile LAS int*)(F.lds + TBL_OFF);
    const int gw = F.vcu * NWAVES + F.wave, NGW = F.G * NWAVES, lane = F.lane;
    const int* topi = (const int*)(F.ws + WS_TOPI); const float* rstd3 = (const float*)(F.ws + WS_RSTD3);
    unsigned* fill = (unsigned*)(F.ws + WS_CTL + CTL_FILL); int* rowslot = (int*)(F.ws + WS_ROWSLOT); bf16* XS = (bf16*)(F.ws + WS_XS);
    if ((int)blockIdx.x < NEXP) { const int e = blockIdx.x; for (int R = tpre[e] * 256 + tpre[64 + e] + F.tid; R < tpre[e + 1] * 256; R += NTHREADS) rowslot[R] = -1; }
    for (int t = gw; t < T; t += NGW) {
        const GAS f32x4* xr = (const GAS f32x4*)(H2 + (size_t)t * D) + lane; const GAS f32x4* gr = (const GAS f32x4*)in.norm_moe + lane;
        const float rstd = rstd3[t];
        u64 o[4];
#pragma unroll
        for (int j = 0; j < 4; ++j) { const f32x4 v = xr[64 * j], g = gr[64 * j]; o[j] = (u64)pk2(v.x * rstd * g.x, v.y * rstd * g.y) | ((u64)pk2(v.z * rstd * g.z, v.w * rstd * g.w) << 32); }
#pragma unroll
        for (int k = 0; k < 4; ++k) {
            const int e = __builtin_amdgcn_readfirstlane(topi[t * 4 + k]);
            unsigned pos = 0; if (lane == 0) pos = __hip_atomic_fetch_add(fill + e, 1u, __ATOMIC_RELAXED, __HIP_MEMORY_SCOPE_AGENT);
            pos = __builtin_amdgcn_readfirstlane(pos);
            const int R = tpre[e] * 256 + (int)pos;
            GAS u64* dst = (GAS u64*)(XS + (size_t)R * D) + lane;
#pragma unroll
            for (int j = 0; j < 4; ++j) dst[64 * j] = o[j];
            if (lane == 0) rowslot[R] = t * 4 + k;
        }
    }
}

__device__ __forceinline__ void phase_final(Frame& F, const In& in, const float* H2, float* OUT) {
    const int gw = F.vcu * NWAVES + F.wave, NGW = F.G * NWAVES, lane = F.lane;
    const bf16* Y = (const bf16*)(F.ws + WS_Y);
    for (int t = gw; t < T; t += NGW) {
        const GAS f32x4* xr = (const GAS f32x4*)(H2 + (size_t)t * D) + lane; const GAS f32x4* gr = (const GAS f32x4*)in.norm_final + lane;
        f32x4 v[4]; float s = 0.f;
#pragma unroll
        for (int j = 0; j < 4; ++j) v[j] = xr[64 * j];
#pragma unroll
        for (int k = 0; k < 4; ++k) { const GAS u64* yr = (const GAS u64*)(Y + (size_t)(t * 4 + k) * D) + lane;
#pragma unroll
            for (int j = 0; j < 4; ++j) { const u64 w = yr[64 * j]; const unsigned lo = (unsigned)w, hi = (unsigned)(w >> 32); v[j].x += bf_lo(lo); v[j].y += bf_hi(lo); v[j].z += bf_lo(hi); v[j].w += bf_hi(hi); } }
#pragma unroll
        for (int j = 0; j < 4; ++j) s += (v[j].x * v[j].x + v[j].y * v[j].y) + (v[j].z * v[j].z + v[j].w * v[j].w);
        const float rstd = 1.f / sqrtf(wave_sum(s) * (1.f / D) + EPS);
        GAS f32x4* orow = (GAS f32x4*)(OUT + (size_t)t * D) + lane;
#pragma unroll
        for (int j = 0; j < 4; ++j) orow[64 * j] = v[j] * gr[64 * j] * rstd;
    }
}
struct Args { const float* in[25]; float* out; unsigned char* ws; int ph_lo, ph_hi; };
#ifndef PG8_SP2
#define PG8_SP2 true
#endif
#ifndef PG8_ALIGN
#define PG8_ALIGN true
#endif
__global__ void __launch_bounds__(NTHREADS, 2) mega_fwd(Args args) {
    extern __shared__ __attribute__((aligned(16))) unsigned char lds[];
    Frame F;
    F.lds = (LAS unsigned char*)lds; F.MISC = (volatile LAS unsigned*)(F.lds + MISC_OFF);
    F.tid = threadIdx.x; F.lane = F.tid & 63; F.wave = __builtin_amdgcn_readfirstlane(F.tid >> 6);
    F.G = gridDim.x; { const int bx = blockIdx.x; F.vcu = (F.G % 8 == 0) ? (bx % 8) * (F.G / 8) + bx / 8 : bx; }
    F.ws = args.ws; F.ctl = (gu32*)(args.ws + WS_CTL);
    In in;
    in.x = args.in[0]; in.mem = args.in[1]; in.norm_mix = args.in[2]; in.w_in = args.in[3]; in.conv_w = args.in[4]; in.w_ba = args.in[5]; in.w_bc = args.in[6];
    in.w_gate = args.in[7]; in.b_gate = args.in[8]; in.w_out = args.in[9]; in.norm_cross = args.in[10]; in.norm_mem = args.in[11]; in.w_cq = args.in[12];
    in.w_ckv = args.in[13]; in.w_co = args.in[14]; in.norm_moe = args.in[15]; in.router_w = args.in[16]; in.router_b = args.in[17]; in.w_eg = args.in[18];
    in.b_eg = args.in[19]; in.w_eu = args.in[20]; in.b_eu = args.in[21]; in.w_ed = args.in[22]; in.b_ed = args.in[23]; in.norm_final = args.in[24];
    unsigned char* ws = args.ws;
    for (int u = F.tid; u < 64; u += NTHREADS) ((LAS unsigned*)(F.lds + MISC_OFF))[u] = 0u;
    __syncthreads();
    XcdBarrier bar; bar.bar = (unsigned*)(F.ctl + CW_BAR); bar.x = 0; bar.st = nullptr;
    if (N_LAUNCHES == 1) bar = xcd_barrier_post((unsigned*)(F.ctl + CW_BAR), F.MISC + 8);
    const int lo = args.ph_lo, hi = args.ph_hi;
#define IN(k) (lo <= (k) && (k) < hi)
#define SEAM(k) do { if (IN(k) && IN((k) + 1)) xcd_barrier(bar); } while (0)
    typedef pg8::bf16_t b16;

    if (IN(0)) { phase_prologue(F, in); } SEAM(0);

    if (IN(1)) {
        pg8::Gemm g{(const b16*)(ws + WS_U1), (const b16*)(ws + WS_W1T), T, NPROJ, D}; pg8::StaticOrder S; S.init(T, NPROJ, F.G, (int)blockIdx.x);
        pg8::EpiProj E{(b16*)(ws + WS_PROJ), in.b_gate};
        pg8::gemm_phase<pg8::EpiProj, pg8::StaticOrder, PG8_ALIGN, PG8_SP2>(F.lds, g, S, E);
    } SEAM(1);

    if (IN(2)) { for (int u = blockIdx.x; u < NBATCH * 3 * 8 * 32; u += F.G) dil_attn_unit_mfma(F, u); } SEAM(2);

    if (IN(3)) { phase_combine_conv(F, in); } SEAM(3);

    if (IN(4)) {
        { pg8::Gemm g{(const b16*)(ws + WS_YA), (const b16*)(ws + WS_WBA), T, D, 512}; pg8::StaticOrder S; S.init(T, D, F.G, (int)blockIdx.x);
          pg8::EpiMix<false> E{(b16*)(ws + WS_MIX), (const b16*)(ws + WS_PROJ)};
          pg8::gemm_phase<pg8::EpiMix<false>, pg8::StaticOrder, PG8_ALIGN, PG8_SP2>(F.lds, g, S, E); }
        { pg8::Gemm g{(const b16*)(ws + WS_YC), (const b16*)(ws + WS_WBC), T, D, D}; pg8::StaticOrder S; S.init(T, D, F.G, (int)blockIdx.x);
          pg8::EpiMix<true> E{(b16*)(ws + WS_MIX), (const b16*)(ws + WS_PROJ)};
          pg8::gemm_phase<pg8::EpiMix<true>, pg8::StaticOrder, PG8_ALIGN, PG8_SP2>(F.lds, g, S, E); }
    } SEAM(4);

    if (IN(5)) {
        { pg8::Gemm g{(const b16*)(ws + WS_MIX), (const b16*)(ws + WS_WO), T, D, D}; pg8::StaticOrder S; S.init(T, D, F.G, (int)blockIdx.x);
          pg8::EpiH1 E{in.x, (float*)(ws + WS_H1), (b16*)(ws + WS_H1B), (float*)(ws + WS_CTL + CTL_SS2)};
          pg8::gemm_phase<pg8::EpiH1, pg8::StaticOrder, PG8_ALIGN, PG8_SP2>(F.lds, g, S, E); }
        phase_expert_convert(F, in);
    } SEAM(5);

    if (IN(6)) {
        { pg8::Gemm g{(const b16*)(ws + WS_H1B), (const b16*)(ws + WS_WCQ), T, 512, D}; pg8::StaticOrder S; S.init(T, 512, F.G, (int)blockIdx.x);
          pg8::EpiQ2 E{(b16*)(ws + WS_Q2), (const float*)(ws + WS_CTL + CTL_SS2)};
          pg8::gemm_phase<pg8::EpiQ2, pg8::StaticOrder, PG8_ALIGN, PG8_SP2>(F.lds, g, S, E); }
        { pg8::Gemm g{(const b16*)(ws + WS_MN), (const b16*)(ws + WS_WCKV), NBATCH * NMEM, D, D}; pg8::StaticOrder S; S.init(NBATCH * NMEM, D, F.G, ((int)blockIdx.x + F.G - 128) % F.G);
          pg8::EpiPlain E{(b16*)(ws + WS_KV), D};
          pg8::gemm_phase<pg8::EpiPlain, pg8::StaticOrder, PG8_ALIGN, PG8_SP2>(F.lds, g, S, E); }
    } SEAM(6);

    if (IN(7)) { for (int u = blockIdx.x; u < NBATCH * 4 * 32; u += F.G) cross_attn_unit(F, u); } SEAM(7);

    if (IN(8)) {
        pg8::Gemm g{(const b16*)(ws + WS_O2), (const b16*)(ws + WS_WCO), T, D, 512}; pg8::StaticOrder S; S.init(T, D, F.G, (int)blockIdx.x);
        pg8::EpiH2 E{(const float*)(ws + WS_H1), args.out};
        pg8::gemm_phase<pg8::EpiH2, pg8::StaticOrder, PG8_ALIGN, PG8_SP2>(F.lds, g, S, E);
    } SEAM(8);

    if (IN(9)) { phase_router(F, in, args.out); } SEAM(9);

    if (IN(10)) { phase_scatter(F, in, args.out); } SEAM(10);

    if (IN(11)) {
        build_tpre(F);
        pg8::Gemm g{(const b16*)(ws + WS_XS), (const b16*)(ws + WS_EXPGU), XS_ROWS, NEXP * 2048, D};
        MoeOrder S{(const volatile LAS int*)(F.lds + TBL_OFF), 8, F.G, (int)blockIdx.x};
        pg8::EpiHdn E{(b16*)(ws + WS_HDN), in.b_eg, in.b_eu};
        pg8::gemm_phase<pg8::EpiHdn, MoeOrder, PG8_ALIGN, PG8_SP2>(F.lds, g, S, E);
    } SEAM(11);

    if (IN(12)) {
        build_tpre(F);
        pg8::Gemm g{(const b16*)(ws + WS_HDN), (const b16*)(ws + WS_EXPD), XS_ROWS, NEXP * 1024, D};
        MoeOrder S{(const volatile LAS int*)(F.lds + TBL_OFF), 4, F.G, (int)blockIdx.x};
        pg8::EpiY E{(b16*)(ws + WS_Y), in.b_ed, (const int*)(ws + WS_ROWSLOT), (const float*)(ws + WS_TOPW)};
        pg8::gemm_phase<pg8::EpiY, MoeOrder, PG8_ALIGN, PG8_SP2>(F.lds, g, S, E);
    } SEAM(12);

    if (IN(13)) { phase_final(F, in, args.out, args.out); }
#undef IN
#undef SEAM
}

extern "C" void kernel_launch(void* const* d_in, const int* in_sizes, int n_in, void* d_out, int out_size, void* d_ws, size_t ws_size, hipStream_t stream) {
    static int grid = 0;
    if (grid == 0) {
        if (n_in != 25 || in_sizes[0] != T * D || out_size != T * D || ws_size < WS_END) {
            fprintf(stderr, "kernel_launch: built for 25 inputs, x/out of %d floats, >= %zu bytes of workspace; got n_in %d, in0 %d, out %d, ws %zu; nothing launched\n", T * D, (size_t)WS_END, n_in, n_in > 0 ? in_sizes[0] : -1, out_size, ws_size);
            grid = -1; return; }
        int dev = 0, cus = 0, per_cu = 0;
        if (hipGetDevice(&dev) != hipSuccess || hipDeviceGetAttribute(&cus, hipDeviceAttributeMultiprocessorCount, dev) != hipSuccess) { fprintf(stderr, "kernel_launch: device query failed\n"); grid = -1; return; }
        if (hipFuncSetAttribute((const void*)mega_fwd, hipFuncAttributeMaxDynamicSharedMemorySize, LDS_BYTES) != hipSuccess) { fprintf(stderr, "kernel_launch: hipFuncSetAttribute(%d B LDS) failed\n", LDS_BYTES); grid = -1; return; }
        if (hipOccupancyMaxActiveBlocksPerMultiprocessor(&per_cu, (const void*)mega_fwd, NTHREADS, LDS_BYTES) != hipSuccess || per_cu < 1) { fprintf(stderr, "kernel_launch: occupancy query says %d workgroups per CU\n", per_cu); per_cu = 1; }
        (void)hipGetLastError();
        grid = cus;
    }
    if (grid < 0) return;
    (void)hipMemsetAsync((char*)d_ws + WS_CTL, 0, CTL_ZERO_BYTES, stream);
    Args a{};
    for (int i = 0; i < 25; ++i) a.in[i] = (const float*)d_in[i];
    a.out = (float*)d_out; a.ws = (unsigned char*)d_ws;
    if (N_LAUNCHES == 1) {
        a.ph_lo = 0; a.ph_hi = N_PHASES;
        void* kargs[] = {&a};
        hipError_t e = hipLaunchCooperativeKernel((const void*)mega_fwd, dim3(grid), dim3(NTHREADS), kargs, LDS_BYTES, stream);
        if (e != hipSuccess) fprintf(stderr, "kernel_launch: cooperative launch failed: %s (grid %d)\n", hipGetErrorString(e), grid);
    } else {
        for (int p = 0; p < N_PHASES; ++p) { a.ph_lo = p; a.ph_hi = p + 1; hipLaunchKernelGGL(mega_fwd, dim3(grid), dim3(NTHREADS), LDS_BYTES, stream, a);
        }
    }
}
```

```cpp
#include <hip/hip_runtime.h>
#include <cstdio>
#include <cstdint>
namespace pg8 {
#define PG8_LAS __attribute__((address_space(3)))
typedef unsigned short bf16_t;
typedef short bf16x8 __attribute__((ext_vector_type(8)));
typedef float f32x4 __attribute__((ext_vector_type(4)));
typedef unsigned u32x4 __attribute__((ext_vector_type(4)));
constexpr int BM = 256, BK = 64, HALF = 128, HTB = HALF * BK * 2  , STAGE_BYTES = 8 * HTB, NXCD = 8, WGM = 8;

__host__ __device__ __forceinline__ int lds_byte(int r, int c) { const int st = (r >> 4) * 2 + (c >> 5), rr = r & 15, cc = c & 31, ob = rr * 64 + cc * 2; return st * 1024 + (ob ^ (((ob >> 9) & 1) << 5)); }
__host__ __device__ __forceinline__ void stage_rc(int b, int& R, int& C) { const int st = b / 1024, sb = b % 1024, swz = sb ^ (((sb >> 9) & 1) << 5); R = (st >> 1) * 16 + swz / 64; C = (st & 1) * 32 + (swz % 64) / 2; }
__host__ __device__ __forceinline__ int perm32(int rho) { const int n = rho >> 4, i = rho & 15; return 8 * (i >> 2) + 4 * n + (i & 3); }

struct Unit { int pm, pn; };
struct Gemm { const bf16_t* A; const bf16_t* Bt; int M, N, K; };

struct StaticOrder {
    int nM, nN, nwg, G, c;
    __host__ __device__ void init(int M, int N, int G_, int c_) { nM = M / BM; nN = N / BM; nwg = nM * nN; G = G_; c = c_; }
    __host__ __device__ bool next(int i, Unit& u) const {
        const long L = (long)i * G + c; if (L >= nwg) return false;
        int wgid = (int)L; { const int q = nwg / NXCD, r = nwg % NXCD, xcd = wgid % NXCD, off = wgid / NXCD; wgid = (xcd < r ? xcd * (q + 1) : r * (q + 1) + (xcd - r) * q) + off; }
        const int nig = WGM * nN, gid = wgid / nig, fm = gid * WGM, gsz = (nM - fm) < WGM ? (nM - fm) : WGM;
        u.pm = fm + ((wgid % nig) % gsz); u.pn = (wgid % nig) / gsz; return true;
    }
    __device__ __forceinline__ void a_ready(const Unit&) const {}
    __device__ __forceinline__ void done(const Unit&) const {}
};

__device__ __forceinline__ unsigned cvt_pk_bf16(float lo, float hi) { unsigned r; asm volatile("v_cvt_pk_bf16_f32 %0, %1, %2" : "=v"(r) : "v"(lo), "v"(hi)); return r; }
__device__ __forceinline__ float bflo(unsigned w) { return __builtin_bit_cast(float, w << 16); }
__device__ __forceinline__ float bfhi(unsigned w) { return __builtin_bit_cast(float, w & 0xffff0000u); }
__device__ __forceinline__ void unpack8(const u32x4 w, f32x4& a, f32x4& b) { a = (f32x4){bflo(w.x), bfhi(w.x), bflo(w.y), bfhi(w.y)}; b = (f32x4){bflo(w.z), bfhi(w.z), bflo(w.w), bfhi(w.w)}; }
__device__ __forceinline__ u32x4 pack8(const f32x4 a, const f32x4 b) { u32x4 w; w.x = cvt_pk_bf16(a[0], a[1]); w.y = cvt_pk_bf16(a[2], a[3]); w.z = cvt_pk_bf16(b[0], b[1]); w.w = cvt_pk_bf16(b[2], b[3]); return w; }
__device__ __forceinline__ float sigmoidf_fast(float x) { return __builtin_amdgcn_rcpf(1.0f + __builtin_amdgcn_exp2f(-1.4426950408889634f * x)); }
__device__ __forceinline__ f32x4 sig4(f32x4 v) { return (f32x4){sigmoidf_fast(v[0]), sigmoidf_fast(v[1]), sigmoidf_fast(v[2]), sigmoidf_fast(v[3])}; }

#define EPI_ROWS_BEGIN _Pragma("unroll") for (int ai = 0; ai < 2; ++ai) _Pragma("unroll") for (int m = 0; m < 4; ++m) { const int rowl = ai * HALF + wr * 64 + m * 16 + fr;
#define EPI_COLS_BEGIN _Pragma("unroll") for (int bj = 0; bj < 2; ++bj) { const int coll = bj * HALF + wc * 32 + 8 * fq; f32x4 v0 = acc[ai][bj][m][0], v1 = acc[ai][bj][m][1];
#define EPI_END }

struct EpiProj {
    static constexpr bool PERM = true, AFTER_DRAIN = false;
    bf16_t* O; const float* bgate;
    __device__ __forceinline__ void operator()(const f32x4 (&acc)[2][2][4][2], const Unit& u, int wr, int wc, int fr, int fq) const {
        const int row0 = u.pm * BM, col0 = u.pn * BM; const bool gate = col0 >= 7680;
        EPI_ROWS_BEGIN EPI_COLS_BEGIN
            const int row = row0 + rowl, col = col0 + coll;
            if (gate) { const f32x4 b0 = *(const f32x4*)(bgate + (col - 7680)), b1 = *(const f32x4*)(bgate + (col - 7680) + 4); v0 = sig4(v0 + b0); v1 = sig4(v1 + b1); }
            *(u32x4*)(O + (size_t)row * 9728 + col) = pack8(v0, v1);
        EPI_END EPI_END
    }
};
struct EpiPlain {
    static constexpr bool PERM = true, AFTER_DRAIN = false;
    bf16_t* O; int ldc;
    __device__ __forceinline__ void operator()(const f32x4 (&acc)[2][2][4][2], const Unit& u, int wr, int wc, int fr, int fq) const {
        const int row0 = u.pm * BM, col0 = u.pn * BM;
        EPI_ROWS_BEGIN EPI_COLS_BEGIN
            *(u32x4*)(O + (size_t)(row0 + rowl) * ldc + col0 + coll) = pack8(v0, v1);
        EPI_END EPI_END
    }
};
template <bool SECOND> struct EpiMix {
    static constexpr bool PERM = true, AFTER_DRAIN = false;
    bf16_t* MIX; const bf16_t* PROJ;
    __device__ __forceinline__ void operator()(const f32x4 (&acc)[2][2][4][2], const Unit& u, int wr, int wc, int fr, int fq) const {
        const int row0 = u.pm * BM, col0 = u.pn * BM;
        EPI_ROWS_BEGIN EPI_COLS_BEGIN
            const int row = row0 + rowl, col = col0 + coll;
            f32x4 g0, g1; unpack8(*(const u32x4*)(PROJ + (size_t)row * 9728 + (SECOND ? 8704 : 7680) + col), g0, g1);
            v0 = v0 * g0; v1 = v1 * g1;
            if (SECOND) { f32x4 t0, t1; unpack8(*(const u32x4*)(MIX + (size_t)row * 1024 + col), t0, t1); v0 = v0 + t0; v1 = v1 + t1; }
            *(u32x4*)(MIX + (size_t)row * 1024 + col) = pack8(v0, v1);
        EPI_END EPI_END
    }
};
struct EpiH1 {
    static constexpr bool PERM = true, AFTER_DRAIN = false;
    const float* X; float* H1; bf16_t* H1B; float* ss;
    __device__ __forceinline__ void operator()(const f32x4 (&acc)[2][2][4][2], const Unit& u, int wr, int wc, int fr, int fq) const {
        const int row0 = u.pm * BM, col0 = u.pn * BM;
        EPI_ROWS_BEGIN
            float s = 0.f; const int row = row0 + rowl;
            EPI_COLS_BEGIN
                const int col = col0 + coll; const size_t o = (size_t)row * 1024 + col;
                v0 = v0 + *(const f32x4*)(X + o); v1 = v1 + *(const f32x4*)(X + o + 4);
                *(f32x4*)(H1 + o) = v0; *(f32x4*)(H1 + o + 4) = v1; *(u32x4*)(H1B + o) = pack8(v0, v1);
                s += (v0[0] * v0[0] + v0[1] * v0[1]) + (v0[2] * v0[2] + v0[3] * v0[3]) + (v1[0] * v1[0] + v1[1] * v1[1]) + (v1[2] * v1[2] + v1[3] * v1[3]);
            EPI_END
            s += __shfl_xor(s, 16); s += __shfl_xor(s, 32);
            if (fq == 0) atomicAdd(ss + row, s);
        EPI_END
    }
};
struct EpiQ2 {
    static constexpr bool PERM = true, AFTER_DRAIN = false;
    bf16_t* Q2; const float* ss;
    __device__ __forceinline__ void operator()(const f32x4 (&acc)[2][2][4][2], const Unit& u, int wr, int wc, int fr, int fq) const {
        const int row0 = u.pm * BM, col0 = u.pn * BM;
        EPI_ROWS_BEGIN
            const int row = row0 + rowl; const float rs = __builtin_amdgcn_rsqf(__hip_atomic_load(ss + row, __ATOMIC_RELAXED, __HIP_MEMORY_SCOPE_AGENT) * (1.f / 1024.f) + 1e-6f);
            EPI_COLS_BEGIN
                *(u32x4*)(Q2 + (size_t)row * 512 + col0 + coll) = pack8(v0 * rs, v1 * rs);
            EPI_END
        EPI_END
    }
};
struct EpiH2 {
    static constexpr bool PERM = true, AFTER_DRAIN = false;
    const float* H1; float* OUT;
    __device__ __forceinline__ void operator()(const f32x4 (&acc)[2][2][4][2], const Unit& u, int wr, int wc, int fr, int fq) const {
        const int row0 = u.pm * BM, col0 = u.pn * BM;
        EPI_ROWS_BEGIN EPI_COLS_BEGIN
            const size_t o = (size_t)(row0 + rowl) * 1024 + col0 + coll;
            *(f32x4*)(OUT + o) = v0 + *(const f32x4*)(H1 + o); *(f32x4*)(OUT + o + 4) = v1 + *(const f32x4*)(H1 + o + 4);
        EPI_END EPI_END
    }
};
struct EpiHdn {
    static constexpr bool PERM = true, AFTER_DRAIN = false;
    bf16_t* HDN; const float* bg; const float* bu;
    __device__ __forceinline__ void operator()(const f32x4 (&acc)[2][2][4][2], const Unit& u, int wr, int wc, int fr, int fq) const {
        const int row0 = u.pm * BM, e = u.pn >> 3, hc = (u.pn & 7) * 128 + wc * 32 + 8 * fq;
        const float* pg = bg + e * 1024 + hc; const float* pu = bu + e * 1024 + hc;
        const f32x4 bg0 = *(const f32x4*)pg, bg1 = *(const f32x4*)(pg + 4), bu0 = *(const f32x4*)pu, bu1 = *(const f32x4*)(pu + 4);
        EPI_ROWS_BEGIN
            f32x4 g0 = acc[ai][0][m][0] + bg0, g1 = acc[ai][0][m][1] + bg1, l0 = acc[ai][1][m][0] + bu0, l1 = acc[ai][1][m][1] + bu1, h0, h1;
#pragma unroll
            for (int j = 0; j < 4; ++j) {
                const float ga = fminf(g0[j], 7.f), gb = fminf(g1[j], 7.f), la = fminf(fmaxf(l0[j], -7.f), 7.f), lb = fminf(fmaxf(l1[j], -7.f), 7.f);
                h0[j] = ga * sigmoidf_fast(1.702f * ga) * (la + 1.f); h1[j] = gb * sigmoidf_fast(1.702f * gb) * (lb + 1.f); }
            *(u32x4*)(HDN + (size_t)(row0 + rowl) * 1024 + hc) = pack8(h0, h1);
        EPI_END
    }
};
struct EpiY {
    static constexpr bool PERM = true, AFTER_DRAIN = false;
    bf16_t* Y; const float* bd; const int* rowslot; const float* topw;
    __device__ __forceinline__ void operator()(const f32x4 (&acc)[2][2][4][2], const Unit& u, int wr, int wc, int fr, int fq) const {
        const int row0 = u.pm * BM, e = u.pn >> 2, col0 = (u.pn & 3) * BM;
        EPI_ROWS_BEGIN
            const int slot = rowslot[row0 + rowl];
            if (slot >= 0) { const float w = topw[slot];
                EPI_COLS_BEGIN
                    const int col = col0 + coll; const float* pb = bd + e * 1024 + col;
                    v0 = (v0 + *(const f32x4*)pb) * w; v1 = (v1 + *(const f32x4*)(pb + 4)) * w;
                    *(u32x4*)(Y + (size_t)slot * 1024 + col) = pack8(v0, v1);
                EPI_END }
        EPI_END
    }
};
template <class Epi, class Sched, bool ALIGN_EPI = false, bool SP2 = false>
__device__ __forceinline__ void gemm_phase(PG8_LAS unsigned char* lds, const Gemm g, const Sched& S, const Epi& E) {
    const int tid = threadIdx.x, wid = __builtin_amdgcn_readfirstlane(tid >> 6), lane = tid & 63, wr = wid >> 2, wc = wid & 3, fr = lane & 15, fq = lane >> 4;
    const int K = g.K, nt = K / BK;
    unsigned voffA[2], voffB[2];
#pragma unroll
    for (int i = 0; i < 2; ++i) { int R, C; stage_rc(tid * 16 + i * 8192, R, C); const int Rb = Epi::PERM ? ((R & ~31) + perm32(R & 31)) : R;
        voffA[i] = (unsigned)(R * K + C) * 2u; voffB[i] = (unsigned)(Rb * K + C) * 2u; }
    const size_t kstep = (size_t)(BK * 2);
    const size_t hstep = (size_t)HALF * K * 2;
    const size_t tstep = 2 * hstep;
    const unsigned ldsw = (unsigned)wid * 1024u;
    const int aoff = lds_byte(wr * 64 + fr, fq * 8), boff = lds_byte(wc * 32 + fr, fq * 8);
#define PG8_SA(b, h) (((b) * 2 + (h)) * HTB)
#define PG8_SB(b, h) ((4 + (b) * 2 + (h)) * HTB)
#define PG8_STAGE(bufoff, gbase, voff) do { _Pragma("unroll") for (int _i = 0; _i < 2; ++_i) \
        __builtin_amdgcn_global_load_lds((const unsigned*)((const char*)(gbase) + (voff)[_i]), (PG8_LAS unsigned*)(lds + (bufoff) + ldsw + _i * 8192), 16, 0, 0); } while (0)
#define PG8_LDA(dst, b, h) do { _Pragma("unroll") for (int m = 0; m < 4; ++m) _Pragma("unroll") for (int k = 0; k < 2; ++k) dst[m][k] = *(const PG8_LAS bf16x8*)(lds + PG8_SA(b, h) + aoff + m * 2048 + k * 1024); } while (0)
#define PG8_LDB(dst, b, h) do { _Pragma("unroll") for (int n = 0; n < 2; ++n) _Pragma("unroll") for (int k = 0; k < 2; ++k) dst[n][k] = *(const PG8_LAS bf16x8*)(lds + PG8_SB(b, h) + boff + n * 2048 + k * 1024); } while (0)
#define PG8_MMA(ai, bj, At, Bt) do { __builtin_amdgcn_s_setprio(1); _Pragma("unroll") for (int m = 0; m < 4; ++m) _Pragma("unroll") for (int n = 0; n < 2; ++n) _Pragma("unroll") for (int k = 0; k < 2; ++k) \
        acc[ai][bj][m][n] = __builtin_amdgcn_mfma_f32_16x16x32_bf16(Bt[n][k], At[m][k], acc[ai][bj][m][n], 0, 0, 0); __builtin_amdgcn_s_setprio(0); } while (0)
#define PG8_WAIT_V(n) asm volatile("s_waitcnt vmcnt(" #n ")" ::: "memory")
#define PG8_WAIT_L(n) asm volatile("s_waitcnt lgkmcnt(" #n ")" ::: "memory")
#define PG8_BAR __builtin_amdgcn_s_barrier()
#define PG8_SCHED __builtin_amdgcn_sched_barrier(0)
    Unit cur, nxt; int ui = 0;
    if (!S.next(0, cur)) return;
    f32x4 acc[2][2][4][2];
#pragma unroll
    for (int a = 0; a < 2; ++a)
#pragma unroll
        for (int b = 0; b < 2; ++b)
#pragma unroll
            for (int m = 0; m < 4; ++m)
#pragma unroll
                for (int n = 0; n < 2; ++n) acc[a][b][m][n] = (f32x4){0.f, 0.f, 0.f, 0.f};
    bf16x8 At[4][2], B0[2][2], B1[2][2];
    const char* cA = (const char*)g.A + (size_t)cur.pm * tstep; const char* cB = (const char*)g.Bt + (size_t)cur.pn * tstep;
    S.a_ready(cur);
    if constexpr (SP2) {
        PG8_STAGE(PG8_SB(0, 0), cB, voffB); PG8_STAGE(PG8_SB(0, 1), cB + hstep, voffB); PG8_STAGE(PG8_SA(0, 0), cA, voffA); PG8_STAGE(PG8_SA(0, 1), cA + hstep, voffA);
        if (wr == 1) PG8_BAR;
        PG8_WAIT_V(2); PG8_BAR;
        PG8_STAGE(PG8_SB(1, 0), cB + kstep, voffB); PG8_STAGE(PG8_SA(1, 0), cA + kstep, voffA); PG8_STAGE(PG8_SB(1, 1), cB + hstep + kstep, voffB);
        PG8_WAIT_V(6); PG8_BAR;
    } else {
        PG8_STAGE(PG8_SB(0, 0), cB, voffB); PG8_STAGE(PG8_SA(0, 0), cA, voffA); PG8_STAGE(PG8_SB(0, 1), cB + hstep, voffB); PG8_STAGE(PG8_SA(0, 1), cA + hstep, voffA);
        if (wr == 1) PG8_BAR;
        PG8_WAIT_V(4); PG8_BAR;
        PG8_STAGE(PG8_SB(1, 0), cB + kstep, voffB); PG8_STAGE(PG8_SA(1, 0), cA + kstep, voffA); PG8_STAGE(PG8_SB(1, 1), cB + hstep + kstep, voffB);
        PG8_WAIT_V(6); PG8_BAR;
    }
    for (;;) {
        const bool has_next = S.next(ui + 1, nxt);
        const char* nA = has_next ? (const char*)g.A + (size_t)nxt.pm * tstep : cA; const char* nB = has_next ? (const char*)g.Bt + (size_t)nxt.pn * tstep : cB;
        for (int t = 0; t < nt; t += 2) {
            const bool last = (t == nt - 2);
            const char* a1 = cA + (size_t)(t + 1) * kstep;
            const char* a2 = last ? nA : cA + (size_t)(t + 2) * kstep; const char* b2 = last ? nB : cB + (size_t)(t + 2) * kstep;
            const char* a3 = a2 + kstep; const char* b3 = b2 + kstep;
            if (last && has_next) S.a_ready(nxt);
            if constexpr (SP2) {
            PG8_LDB(B0, 0, 0); PG8_LDB(B1, 0, 1); PG8_SCHED; PG8_LDA(At, 0, 0); PG8_STAGE(PG8_SA(1, 1), a1 + hstep, voffA);
            PG8_WAIT_V(8); PG8_WAIT_L(0); PG8_BAR; PG8_MMA(0, 0, At, B0); PG8_MMA(0, 1, At, B1); PG8_BAR; PG8_SCHED;
            PG8_LDA(At, 0, 1); PG8_STAGE(PG8_SB(0, 0), b2, voffB); PG8_STAGE(PG8_SB(0, 1), b2 + hstep, voffB); PG8_STAGE(PG8_SA(0, 0), a2, voffA);
            PG8_WAIT_V(8); PG8_WAIT_L(0); PG8_BAR; PG8_MMA(1, 0, At, B0); PG8_MMA(1, 1, At, B1); PG8_BAR; PG8_SCHED;
            PG8_LDB(B0, 1, 0); PG8_LDB(B1, 1, 1); PG8_SCHED; PG8_LDA(At, 1, 0); PG8_STAGE(PG8_SA(0, 1), a2 + hstep, voffA);
            PG8_WAIT_V(8); PG8_WAIT_L(0); PG8_BAR; PG8_MMA(0, 0, At, B0); PG8_MMA(0, 1, At, B1); PG8_BAR; PG8_SCHED;
            PG8_LDA(At, 1, 1); PG8_STAGE(PG8_SB(1, 0), b3, voffB); PG8_STAGE(PG8_SB(1, 1), b3 + hstep, voffB); PG8_STAGE(PG8_SA(1, 0), a3, voffA);
            PG8_WAIT_V(8); PG8_WAIT_L(0); PG8_BAR; PG8_MMA(1, 0, At, B0); PG8_MMA(1, 1, At, B1); PG8_BAR; PG8_SCHED;
            } else {
            PG8_LDB(B0, 0, 0); PG8_SCHED; PG8_LDA(At, 0, 0); PG8_STAGE(PG8_SA(1, 1), a1 + hstep, voffA);
            PG8_WAIT_L(8); PG8_BAR; PG8_WAIT_L(0); PG8_MMA(0, 0, At, B0); PG8_BAR; PG8_SCHED;
            PG8_LDB(B1, 0, 1); PG8_STAGE(PG8_SB(0, 0), b2, voffB);
            PG8_BAR; PG8_WAIT_L(0); PG8_MMA(0, 1, At, B1); PG8_BAR;
            PG8_LDA(At, 0, 1); PG8_STAGE(PG8_SA(0, 0), a2, voffA);
            PG8_BAR; PG8_WAIT_L(0); PG8_MMA(1, 0, At, B0); PG8_BAR; PG8_SCHED;
            PG8_STAGE(PG8_SB(0, 1), b2 + hstep, voffB);
            PG8_WAIT_V(6); PG8_BAR; PG8_MMA(1, 1, At, B1); PG8_BAR;
            PG8_LDB(B0, 1, 0); PG8_SCHED; PG8_LDA(At, 1, 0); PG8_STAGE(PG8_SA(0, 1), a2 + hstep, voffA);
            PG8_WAIT_L(8); PG8_BAR; PG8_WAIT_L(0); PG8_MMA(0, 0, At, B0); PG8_BAR; PG8_SCHED;
            PG8_LDB(B1, 1, 1); PG8_STAGE(PG8_SB(1, 0), b3, voffB);
            PG8_BAR; PG8_WAIT_L(0); PG8_MMA(0, 1, At, B1); PG8_BAR;
            PG8_LDA(At, 1, 1); PG8_STAGE(PG8_SA(1, 0), a3, voffA);
            PG8_BAR; PG8_WAIT_L(0); PG8_MMA(1, 0, At, B0); PG8_BAR; PG8_SCHED;
            PG8_STAGE(PG8_SB(1, 1), b3 + hstep, voffB);
            PG8_WAIT_V(6); PG8_BAR; PG8_MMA(1, 1, At, B1); PG8_BAR;
            }
        }
        if constexpr (ALIGN_EPI) { if (wr == 0) PG8_BAR; }
        if constexpr (!Epi::AFTER_DRAIN) { E(acc, cur, wr, wc, fr, fq); S.done(cur); }
        if (!has_next) break;
#pragma unroll
        for (int a = 0; a < 2; ++a)
#pragma unroll
            for (int b = 0; b < 2; ++b)
#pragma unroll
                for (int m = 0; m < 4; ++m)
#pragma unroll
                    for (int n = 0; n < 2; ++n) acc[a][b][m][n] = (f32x4){0.f, 0.f, 0.f, 0.f};
        cur = nxt; cA = nA; cB = nB; ++ui;
        if constexpr (ALIGN_EPI) { if (wr == 1) PG8_BAR; }
    }
    PG8_WAIT_V(0);
    if constexpr (!ALIGN_EPI) { if (wr == 0) PG8_BAR; }
    PG8_BAR;
    if constexpr (Epi::AFTER_DRAIN) { E.fused(acc, cur, wr, wc, fr, fq, lds, wid, lane); S.done(cur); }
#undef PG8_SA
#undef PG8_SB
#undef PG8_STAGE
#undef PG8_LDA
#undef PG8_LDB
#undef PG8_MMA
#undef PG8_WAIT_V
#undef PG8_WAIT_L
#undef PG8_BAR
#undef PG8_SCHED
}
}
#define GAS __attribute__((address_space(1)))
#define LAS __attribute__((address_space(3)))
typedef unsigned short bf16;
typedef unsigned v4u __attribute__((ext_vector_type(4)));
typedef float f32x4 __attribute__((ext_vector_type(4)));
typedef short bf16x8 __attribute__((ext_vector_type(8)));
typedef GAS unsigned gu32;
typedef GAS unsigned long long gu64;
#define RLX_AGENT __ATOMIC_RELAXED, __HIP_MEMORY_SCOPE_AGENT
#define LDS_WAIT() asm volatile("s_waitcnt lgkmcnt(0)" ::: "memory")
#define VM_WAIT() asm volatile("s_waitcnt vmcnt(0)" ::: "memory")
__device__ __forceinline__ unsigned long long rt() { return __builtin_amdgcn_s_memrealtime(); }
__device__ __forceinline__ unsigned f2bf(float f) { unsigned u = __builtin_bit_cast(unsigned, f); return (u + 0x7fffu + ((u >> 16) & 1u)) >> 16; }
__device__ __forceinline__ unsigned pk2(float lo, float hi) { return f2bf(lo) | (f2bf(hi) << 16); }

#define XB_TMO      128
#define XB_XCNT(j)  (256  + 64 * (j))
#define XB_XSUB(j)  (1280 + 64 * (j))
#define XB_XGEN(j)  (2304 + 64 * (j))
#define XB_TOP      3328
#define XB_TOPGEN   3392
#define XCD_BAR_WORDS 3456
#define XB_SPIN_CAP (1u << 18)

__device__ __forceinline__ unsigned xb_ld(unsigned* p)              { return __hip_atomic_load(p, __ATOMIC_RELAXED, __HIP_MEMORY_SCOPE_AGENT); }
__device__ __forceinline__ unsigned xb_add(unsigned* p, unsigned v) { return __hip_atomic_fetch_add(p, v, __ATOMIC_RELAXED, __HIP_MEMORY_SCOPE_AGENT); }
__device__ __forceinline__ unsigned xb_xcc_id() { return (unsigned)__builtin_amdgcn_s_getreg((3 << 11) | 20) & 0xFu; }
#define XB_SPIN(cond, bar) do { unsigned _sp = 0; while (cond) { __builtin_amdgcn_s_sleep(1); \
    if ((++_sp & 255u) == 0u) { if (xb_ld(&(bar)[XB_TMO])) break; if (_sp > XB_SPIN_CAP) { atomicAdd(&(bar)[XB_TMO], 1u); break; } } } } while (0)

struct XcdBarrier {
    unsigned* bar; unsigned x;
    volatile LAS unsigned* st;
};

__device__ __forceinline__ XcdBarrier xcd_barrier_post(unsigned* bar, volatile LAS unsigned* st) {
    XcdBarrier b; b.bar = bar; b.x = xb_xcc_id(); b.st = st;
    if (threadIdx.x == 0) (void)xb_add(&bar[XB_XCNT(b.x)], 1u);
    return b;
}
__device__ __forceinline__ void xcd_barrier_complete(unsigned* bar, unsigned x, unsigned& nloc, unsigned& nx) {
    const unsigned G = gridDim.x * gridDim.y * gridDim.z;
    unsigned sum, cnt, mine, sp = 0u;
    for (;;) {
        sum = 0u; cnt = 0u; mine = 0u;
#pragma unroll
        for (unsigned j = 0; j < 16; ++j) { const unsigned c = xb_ld(&bar[XB_XCNT(j)]); sum += c; cnt += (c > 0u) ? 1u : 0u; mine = (j == x) ? c : mine; }
        if (sum == G) break;
        __builtin_amdgcn_s_sleep(1);
        if ((++sp & 255u) == 0u) { if (xb_ld(&bar[XB_TMO])) break; if (sp > XB_SPIN_CAP) { atomicAdd(&bar[XB_TMO], 1u); break; } }
    }
    nloc = mine > 0u ? mine : 1u; nx = cnt > 0u ? cnt : 1u;
}

__device__ __forceinline__ void xcd_barrier(const XcdBarrier& b) {
    asm volatile("s_waitcnt vmcnt(0)" ::: "memory");
    __syncthreads();
    if (threadIdx.x == 0) {
        unsigned* bar = b.bar;
        __builtin_amdgcn_s_waitcnt(0);
        unsigned nloc = b.st[0], nx = b.st[1];
        if (nloc == 0u) { xcd_barrier_complete(bar, b.x, nloc, nx); b.st[0] = nloc; b.st[1] = nx; }
        const unsigned old = xb_add(&bar[XB_XSUB(b.x)], 1u);
        const unsigned gen = old / nloc;
        if (old + 1u == (gen + 1u) * nloc) {
            __builtin_amdgcn_fence(__ATOMIC_RELEASE, "agent");
            asm volatile("s_waitcnt vmcnt(0)" ::: "memory");
            const unsigned og = xb_add(&bar[XB_TOP], 1u);
            const unsigned tg = og / nx;
            if (og + 1u == (tg + 1u) * nx) xb_add(&bar[XB_TOPGEN], 1u);
            else XB_SPIN(xb_ld(&bar[XB_TOPGEN]) == tg, bar);
            __builtin_amdgcn_fence(__ATOMIC_ACQUIRE, "agent");
            xb_add(&bar[XB_XGEN(b.x)], 1u);
            asm volatile("s_waitcnt vmcnt(0)" ::: "memory");
        } else {
            XB_SPIN(xb_ld(&bar[XB_XGEN(b.x)]) == gen, bar);
            __builtin_amdgcn_fence(__ATOMIC_ACQUIRE, "agent");
            asm volatile("s_waitcnt vmcnt(0)" ::: "memory");
        }
    }
    __syncthreads();
}
constexpr int NWAVES = 8, NTHREADS = 512;
constexpr int T = 16384, D = 1024, SEQ = 4096, NBATCH = 4, NMEM = 256, NEXP = 32, TOPK = 4;
constexpr int NPROJ = 9728;
constexpr int XS_ROWS = T * TOPK + NEXP * 256;
constexpr float EPS = 1e-6f, LOG2E = 1.4426950408889634f, LN2 = 0.6931471805599453f;
#ifndef MK_N_LAUNCHES
#define MK_N_LAUNCHES 1
#endif
constexpr int N_PHASES = 14;
constexpr int N_LAUNCHES = MK_N_LAUNCHES;

constexpr size_t MiB = 1u << 20;
constexpr size_t WS_CTL = 0, CTL_ZERO_BYTES = 1 * MiB;
constexpr size_t CTL_SS2 = 256 * 1024, CTL_CNT = 384 * 1024, CTL_FILL = 384 * 1024 + 256;
constexpr size_t WS_WCQ = 1 * MiB, WS_WCO = 2 * MiB, WS_WO = 3 * MiB, WS_KV = 5 * MiB;
constexpr size_t WS_TOPI = 7 * MiB, WS_TOPW = WS_TOPI + 256 * 1024, WS_RSTD3 = WS_TOPW + 256 * 1024, WS_ROWSLOT = WS_RSTD3 + 64 * 1024;
constexpr size_t WS_EXPGU = 8 * MiB, WS_EXPD = 136 * MiB;
constexpr size_t WS_PROJ = 8 * MiB, WS_U1 = 312 * MiB, WS_W1T = 344 * MiB, WS_OG = 312 * MiB, WS_LSE = 360 * MiB;
constexpr size_t WS_WBA = 363 * MiB, WS_WBC = 364 * MiB, WS_MN = 366 * MiB, WS_YA = 368 * MiB, WS_YC = 384 * MiB, WS_MIX = 416 * MiB, WS_WCKV = 448 * MiB;
constexpr size_t WS_H1 = 200 * MiB, WS_H1B = 264 * MiB, WS_Q2 = 296 * MiB, WS_O2 = 312 * MiB;
constexpr size_t WS_XS = 200 * MiB, WS_HDN = 344 * MiB, WS_Y = 200 * MiB, WS_END = 488 * MiB;
static_assert(WS_ROWSLOT + (size_t)XS_ROWS * 4 <= WS_EXPGU, "misc region");
static_assert(WS_XS + (size_t)XS_ROWS * D * 2 <= WS_HDN && WS_HDN + (size_t)XS_ROWS * D * 2 <= WS_END, "moe rows");
constexpr int CW_TMO = 0, CW_CODE = 1, CW_BAR = 4096;

constexpr int LDS_BYTES = 163840;
constexpr int TBL_OFF = 163840 - 2048;
constexpr int MISC_OFF = 163840 - 256;

struct Frame {
    LAS unsigned char* lds;
    volatile LAS unsigned* MISC;
    gu32* ctl;
    unsigned char* ws;
    int tid, lane, wave, vcu, G;
};
__device__ __forceinline__ float wave_sum(float v) {
#pragma unroll
    for (int o = 1; o < 64; o <<= 1) v += __shfl_xor(v, o);
    return v;
}
typedef unsigned long long u64;
__device__ __forceinline__ float bf_lo(unsigned w) { return __builtin_bit_cast(float, w << 16); }
__device__ __forceinline__ float bf_hi(unsigned w) { return __builtin_bit_cast(float, w & 0xffff0000u); }

__device__ __forceinline__ void transpose_item(const float* W, int K, int N, bf16* WT, int drow, int k0, int n0, const float* gain, LAS float* scr, int lane) {
#pragma unroll 8
    for (int i = 0; i < 32; ++i) { const int kk = 2 * i + (lane >> 5); float w = W[(size_t)(k0 + kk) * N + n0 + (lane & 31)]; if (gain) w *= gain[k0 + kk]; scr[kk * 33 + (lane & 31)] = w; }
    LDS_WAIT(); asm volatile("" ::: "memory");
    const int c = lane & 7;
#pragma unroll
    for (int j = 0; j < 4; ++j) { const int n = (lane >> 3) + 8 * j; const LAS float* s = scr + (8 * c) * 33 + n;
        v4u o; o.x = pk2(s[0 * 33], s[1 * 33]); o.y = pk2(s[2 * 33], s[3 * 33]); o.z = pk2(s[4 * 33], s[5 * 33]); o.w = pk2(s[6 * 33], s[7 * 33]);
        *(GAS v4u*)(WT + (size_t)(drow + n) * K + k0 + 8 * c) = o; }
    LDS_WAIT(); asm volatile("" ::: "memory");
}
__device__ __forceinline__ bool transpose_mat(int& r, const float* W, int K, int N, bf16* WT, int drow0, const float* gain, LAS float* scr, int lane) {
    const int nblk = N / 32, items = (K / 64) * nblk;
    if (r < items) { const int kb = r / nblk, nb = r % nblk; transpose_item(W, K, N, WT, drow0 + 32 * nb, 64 * kb, 32 * nb, gain, scr, lane); return true; }
    r -= items; return false;
}
__device__ __forceinline__ void rms_row_to_bf16(const float* xrow, const float* gain, bf16* orow, int lane) {
    const GAS f32x4* xr = (const GAS f32x4*)xrow + lane; const GAS f32x4* gr = (const GAS f32x4*)gain + lane;
    f32x4 v[4]; float s = 0.f;
#pragma unroll
    for (int j = 0; j < 4; ++j) { v[j] = xr[64 * j]; s += (v[j].x * v[j].x + v[j].y * v[j].y) + (v[j].z * v[j].z + v[j].w * v[j].w); }
    const float rstd = 1.f / sqrtf(wave_sum(s) * (1.f / D) + EPS);
    GAS u64* o8 = (GAS u64*)orow + lane;
#pragma unroll
    for (int j = 0; j < 4; ++j) { const f32x4 g = gr[64 * j]; o8[64 * j] = (u64)pk2(v[j].x * rstd * g.x, v[j].y * rstd * g.y) | ((u64)pk2(v[j].z * rstd * g.z, v[j].w * rstd * g.w) << 32); }
}

__device__ __forceinline__ int xcd_remap(int wgid, int nwg) { const int q = nwg / 8, r = nwg % 8, xcd = wgid % 8, off = wgid / 8; return (xcd < r ? xcd * (q + 1) : r * (q + 1) + (xcd - r) * q) + off; }
struct MoeOrder {
    const volatile LAS int* tpre; int npn, G, c;
    __device__ __forceinline__ bool next(int i, pg8::Unit& u) const {
        const int total = tpre[32] * npn; const long L = (long)i * G + c; if (L >= total) return false;
        const int U = xcd_remap((int)L, total);
        int e = 0;
#pragma unroll 1
        for (int k = 1; k < 32; ++k) if (tpre[k] * npn <= U) e = k;
        const int t0 = tpre[e], nt = tpre[e + 1] - t0, Ul = U - t0 * npn;
        u.pm = t0 + Ul % nt; u.pn = e * npn + Ul / nt; return true;
    }
    __device__ __forceinline__ void a_ready(const pg8::Unit&) const {}
    __device__ __forceinline__ void done(const pg8::Unit&) const {}
};
struct In {
    const float *x, *mem, *norm_mix, *w_in, *conv_w, *w_ba, *w_bc, *w_gate, *b_gate, *w_out, *norm_cross, *norm_mem, *w_cq, *w_ckv, *w_co, *norm_moe,
                *router_w, *router_b, *w_eg, *b_eg, *w_eu, *b_eu, *w_ed, *b_ed, *norm_final;
};

__device__ __forceinline__ void phase_prologue(Frame& F, const In& in) {
    LAS float* scr = (LAS float*)(F.lds + F.wave * 16384);
    const int gw = F.vcu * NWAVES + F.wave, NGW = F.G * NWAVES;
    unsigned char* ws = F.ws;
    constexpr int NITEMS = 16 * 240 + 16 * 64 + 8 * 32 + 16 * 32 + 16 * 32 + 16 * 16 + 16 * 32 + 8 * 32;
    for (int it = gw; it < NITEMS; it += NGW) {
        int r = it;
        if (transpose_mat(r, in.w_in, 1024, 7680, (bf16*)(ws + WS_W1T), 0, nullptr, scr, F.lane)) continue;
        if (transpose_mat(r, in.w_gate, 1024, 2048, (bf16*)(ws + WS_W1T), 7680, nullptr, scr, F.lane)) continue;
        if (transpose_mat(r, in.w_ba, 512, 1024, (bf16*)(ws + WS_WBA), 0, nullptr, scr, F.lane)) continue;
        if (transpose_mat(r, in.w_bc, 1024, 1024, (bf16*)(ws + WS_WBC), 0, nullptr, scr, F.lane)) continue;
        if (transpose_mat(r, in.w_out, 1024, 1024, (bf16*)(ws + WS_WO), 0, nullptr, scr, F.lane)) continue;
        if (transpose_mat(r, in.w_cq, 1024, 512, (bf16*)(ws + WS_WCQ), 0, in.norm_cross, scr, F.lane)) continue;
        if (transpose_mat(r, in.w_ckv, 1024, 1024, (bf16*)(ws + WS_WCKV), 0, nullptr, scr, F.lane)) continue;
        transpose_mat(r, in.w_co, 512, 1024, (bf16*)(ws + WS_WCO), 0, nullptr, scr, F.lane);
    }
    for (int m = gw; m < T; m += NGW) rms_row_to_bf16(in.x + (size_t)m * D, in.norm_mix, (bf16*)(ws + WS_U1) + (size_t)m * D, F.lane);
    for (int m = gw; m < NBATCH * NMEM; m += NGW) rms_row_to_bf16(in.mem + (size_t)m * D, in.norm_mem, (bf16*)(ws + WS_MN) + (size_t)m * D, F.lane);
}

__device__ __forceinline__ void phase_expert_convert(Frame& F, const In& in) {
    LAS float* scr = (LAS float*)(F.lds + F.wave * 16384);
    const int gw = F.vcu * NWAVES + F.wave, NGW = F.G * NWAVES;
    constexpr int PER = 16 * 32, NITEMS = NEXP * 3 * PER;
    for (int it = gw; it < NITEMS; it += NGW) {
        const int mtx = it / PER, r = it % PER, e = mtx / 3, which = mtx % 3, kb = r / 32, nb = r % 32, n0 = 32 * nb;
        if (which == 0)      transpose_item(in.w_eg + (size_t)e * D * D, D, D, (bf16*)(F.ws + WS_EXPGU) + (size_t)e * 2048 * D, (n0 >> 7) * 256 + (n0 & 127), 64 * kb, n0, nullptr, scr, F.lane);
        else if (which == 1) transpose_item(in.w_eu + (size_t)e * D * D, D, D, (bf16*)(F.ws + WS_EXPGU) + (size_t)e * 2048 * D, (n0 >> 7) * 256 + 128 + (n0 & 127), 64 * kb, n0, nullptr, scr, F.lane);
        else                 transpose_item(in.w_ed + (size_t)e * D * D, D, D, (bf16*)(F.ws + WS_EXPD) + (size_t)e * D * D, n0, 64 * kb, n0, nullptr, scr, F.lane);
    }
}

__device__ __forceinline__ void dil_attn_unit(Frame& F, int unit) {
    const int rn = unit & 31, bgh = unit >> 5, h = bgh & 7, bg = bgh >> 3, g = bg % 3, b = bg / 3;
    const int dil = g == 0 ? 1 : (g == 1 ? 4 : 16), nper = 32 / dil, r = rn / nper, n = rn % nper;
    const bf16* PROJ = (const bf16*)(F.ws + WS_PROJ);
    LAS bf16* Ks = (LAS bf16*)F.lds; LAS bf16* Vs = Ks + 256 * 72;
    const int tid = F.tid;
#pragma unroll
    for (int it = 0; it < 4; ++it) {
        const int row = (tid >> 3) + 64 * it, ch = tid & 7, j = 128 * (n - 1) + row;
        v4u kv = (v4u){0u, 0u, 0u, 0u}, vv = kv;
        if (j >= 0) { const size_t grow = (size_t)b * SEQ + (size_t)j * dil + r; const bf16* p = PROJ + grow * NPROJ + g * 1536 + h * 64 + ch * 8; kv = *(const GAS v4u*)(p + 512); vv = *(const GAS v4u*)(p + 1024); }
        *(LAS v4u*)(Ks + row * 72 + ch * 8) = kv; *(LAS v4u*)(Vs + row * 72 + ch * 8) = vv;
    }
    __syncthreads();
    const int ql = tid >> 2, part = tid & 3;
    const size_t growq = (size_t)b * SEQ + (size_t)(128 * n + ql) * dil + r;
    float q[16], acc[16];
    { const bf16* p = PROJ + growq * NPROJ + g * 1536 + h * 64 + part * 16; const v4u a = *(const GAS v4u*)p, c = *(const GAS v4u*)(p + 8);
      const float sc = 0.125f * LOG2E;
      q[0] = bf_lo(a.x) * sc; q[1] = bf_hi(a.x) * sc; q[2] = bf_lo(a.y) * sc; q[3] = bf_hi(a.y) * sc; q[4] = bf_lo(a.z) * sc; q[5] = bf_hi(a.z) * sc; q[6] = bf_lo(a.w) * sc; q[7] = bf_hi(a.w) * sc;
      q[8] = bf_lo(c.x) * sc; q[9] = bf_hi(c.x) * sc; q[10] = bf_lo(c.y) * sc; q[11] = bf_hi(c.y) * sc; q[12] = bf_lo(c.z) * sc; q[13] = bf_hi(c.z) * sc; q[14] = bf_lo(c.w) * sc; q[15] = bf_hi(c.w) * sc; }
#pragma unroll
    for (int i = 0; i < 16; ++i) acc[i] = 0.f;
    float mrun = -1e30f, l = 0.f;
    const float slope2 = exp2f(-(float)(h + 1)) * (float)dil * LOG2E;
    const int jbase = 128 * (n - 1) + ql;
#pragma unroll 1
    for (int kk = 0; kk <= 128; ++kk) {
        const int kl = ql + kk; const bool valid = (jbase + kk) >= 0;
        const LAS bf16* kp = Ks + kl * 72 + part * 16; const v4u a = *(const LAS v4u*)kp, c = *(const LAS v4u*)(kp + 8);
        float s = q[0] * bf_lo(a.x) + q[1] * bf_hi(a.x) + q[2] * bf_lo(a.y) + q[3] * bf_hi(a.y) + q[4] * bf_lo(a.z) + q[5] * bf_hi(a.z) + q[6] * bf_lo(a.w) + q[7] * bf_hi(a.w)
                + q[8] * bf_lo(c.x) + q[9] * bf_hi(c.x) + q[10] * bf_lo(c.y) + q[11] * bf_hi(c.y) + q[12] * bf_lo(c.z) + q[13] * bf_hi(c.z) + q[14] * bf_lo(c.w) + q[15] * bf_hi(c.w);
        s += __shfl_xor(s, 1); s += __shfl_xor(s, 2);
        s -= slope2 * (float)(128 - kk);
        const float mn = valid ? fmaxf(mrun, s) : mrun;
        const float alpha = __builtin_amdgcn_exp2f(mrun - mn), p = valid ? __builtin_amdgcn_exp2f(s - mn) : 0.f;
        mrun = mn; l = l * alpha + p;
        const LAS bf16* vp = Vs + kl * 72 + part * 16; const v4u va = *(const LAS v4u*)vp, vc = *(const LAS v4u*)(vp + 8);
        acc[0] = acc[0] * alpha + p * bf_lo(va.x); acc[1] = acc[1] * alpha + p * bf_hi(va.x); acc[2] = acc[2] * alpha + p * bf_lo(va.y); acc[3] = acc[3] * alpha + p * bf_hi(va.y);
        acc[4] = acc[4] * alpha + p * bf_lo(va.z); acc[5] = acc[5] * alpha + p * bf_hi(va.z); acc[6] = acc[6] * alpha + p * bf_lo(va.w); acc[7] = acc[7] * alpha + p * bf_hi(va.w);
        acc[8] = acc[8] * alpha + p * bf_lo(vc.x); acc[9] = acc[9] * alpha + p * bf_hi(vc.x); acc[10] = acc[10] * alpha + p * bf_lo(vc.y); acc[11] = acc[11] * alpha + p * bf_hi(vc.y);
        acc[12] = acc[12] * alpha + p * bf_lo(vc.z); acc[13] = acc[13] * alpha + p * bf_hi(vc.z); acc[14] = acc[14] * alpha + p * bf_lo(vc.w); acc[15] = acc[15] * alpha + p * bf_hi(vc.w);
    }
    const float inv = 1.f / l;
    bf16* og = (bf16*)(F.ws + WS_OG) + ((size_t)g * T + growq) * 512 + h * 64 + part * 16;
    v4u o0, o1;
    o0.x = pk2(acc[0] * inv, acc[1] * inv); o0.y = pk2(acc[2] * inv, acc[3] * inv); o0.z = pk2(acc[4] * inv, acc[5] * inv); o0.w = pk2(acc[6] * inv, acc[7] * inv);
    o1.x = pk2(acc[8] * inv, acc[9] * inv); o1.y = pk2(acc[10] * inv, acc[11] * inv); o1.z = pk2(acc[12] * inv, acc[13] * inv); o1.w = pk2(acc[14] * inv, acc[15] * inv);
    *(GAS v4u*)og = o0; *(GAS v4u*)(og + 8) = o1;
    if (part == 0) ((float*)(F.ws + WS_LSE))[((size_t)g * T + growq) * 8 + h] = (mrun + __builtin_amdgcn_logf(l)) * LN2;
    __syncthreads();
}


typedef short s16x4v __attribute__((ext_vector_type(4)));
typedef short bf16x8v __attribute__((ext_vector_type(8)));
__device__ __forceinline__ s16x4v lds_tr16(const LAS bf16* p) { return __builtin_bit_cast(s16x4v, __builtin_amdgcn_ds_read_tr16_b64_v4i16((LAS s16x4v*)p)); }
__device__ __forceinline__ void dil_attn_unit_mfma(Frame& F, int unit) {
    const int rn = unit & 31, bgh = unit >> 5, h = bgh & 7, bg = bgh >> 3, g = bg % 3, b = bg / 3;
    const int dil = g == 0 ? 1 : (g == 1 ? 4 : 16), nper = 32 / dil, r = rn / nper, n = rn % nper;
    const bf16* PROJ = (const bf16*)(F.ws + WS_PROJ);
    LAS bf16* Ks = (LAS bf16*)F.lds; LAS bf16* Vs = Ks + 256 * 72;
    const int tid = F.tid, lane = F.lane, w = F.wave, qi = lane & 15, G = lane >> 4;
#pragma unroll
    for (int it = 0; it < 4; ++it) {
        const int row = (tid >> 3) + 64 * it, ch = tid & 7, j = 128 * (n - 1) + row;
        v4u kv = (v4u){0u, 0u, 0u, 0u}, vv = kv;
        if (j >= 0) { const size_t grow = (size_t)b * SEQ + (size_t)j * dil + r; const bf16* p = PROJ + grow * NPROJ + g * 1536 + h * 64 + ch * 8; kv = *(const GAS v4u*)(p + 512); vv = *(const GAS v4u*)(p + 1024); }
        *(LAS v4u*)(Ks + row * 72 + ch * 8) = kv; *(LAS v4u*)(Vs + row * 72 + ch * 8) = vv;
    }
    if (tid < 128) *(LAS v4u*)(Vs + (256 + (tid >> 3)) * 72 + (tid & 7) * 8) = (v4u){0u, 0u, 0u, 0u};
    const int ql = 16 * w + qi;
    const size_t growq = (size_t)b * SEQ + (size_t)(128 * n + ql) * dil + r;
    const bf16* qp = PROJ + growq * NPROJ + g * 1536 + h * 64 + 8 * G;
    const bf16x8v q0 = *(const GAS bf16x8v*)qp, q1 = *(const GAS bf16x8v*)(qp + 32);
    __syncthreads();
    pg8::f32x4 st[9];
#pragma unroll
    for (int t = 0; t < 9; ++t) {
        const LAS bf16* kp = Ks + (16 * (w + t) + qi) * 72 + 8 * G;
        const bf16x8v k0 = *(const LAS bf16x8v*)kp, k1 = *(const LAS bf16x8v*)(kp + 32);
        pg8::f32x4 a = (pg8::f32x4){0.f, 0.f, 0.f, 0.f};
        a = __builtin_amdgcn_mfma_f32_16x16x32_bf16(k0, q0, a, 0, 0, 0);
        a = __builtin_amdgcn_mfma_f32_16x16x32_bf16(k1, q1, a, 0, 0, 0);
        st[t] = a;
    }
    const float slope2 = exp2f(-(float)(h + 1)) * (float)dil * LOG2E, sc = 0.125f * LOG2E;
    const int jq = 128 * (n - 1);
    float mx = -1e30f;
#pragma unroll
    for (int t = 0; t < 9; ++t)
#pragma unroll
        for (int i = 0; i < 4; ++i) {
            const int kl = 16 * (w + t) + 4 * G + i, dk = kl - ql;
            const bool ok = dk >= 0 && dk <= 128 && (jq + kl) >= 0;
            const float sv = ok ? st[t][i] * sc - slope2 * (float)(128 - dk) : -1e30f;
            st[t][i] = sv; mx = fmaxf(mx, sv);
        }
    mx = fmaxf(mx, __shfl_xor(mx, 16)); mx = fmaxf(mx, __shfl_xor(mx, 32));
    float l = 0.f;
#pragma unroll
    for (int t = 0; t < 9; ++t)
#pragma unroll
        for (int i = 0; i < 4; ++i) { const float pv = st[t][i] > -1e29f ? __builtin_amdgcn_exp2f(st[t][i] - mx) : 0.f; st[t][i] = pv; l += pv; }
    l += __shfl_xor(l, 16); l += __shfl_xor(l, 32);
    pg8::f32x4 o[4];
#pragma unroll
    for (int dm = 0; dm < 4; ++dm) o[dm] = (pg8::f32x4){0.f, 0.f, 0.f, 0.f};
#pragma unroll
    for (int s5 = 0; s5 < 5; ++s5) {
        const pg8::f32x4 pa = st[2 * s5], pb = (2 * s5 + 1 < 9) ? st[2 * s5 + 1] : (pg8::f32x4){0.f, 0.f, 0.f, 0.f};
        bf16x8v pf;
        { const unsigned w0 = pk2(pa[0], pa[1]), w1 = pk2(pa[2], pa[3]), w2 = pk2(pb[0], pb[1]), w3 = pk2(pb[2], pb[3]);
          pf = __builtin_bit_cast(bf16x8v, (v4u){w0, w1, w2, w3}); }
        const LAS bf16* vbase = Vs + (16 * (w + 2 * s5) + 4 * G + (qi >> 2)) * 72 + 4 * (qi & 3);
#pragma unroll
        for (int dm = 0; dm < 4; ++dm) {
            const s16x4v lo = lds_tr16(vbase + 16 * dm), hi = lds_tr16(vbase + 16 * 72 + 16 * dm);
            const bf16x8v vf = (bf16x8v){lo[0], lo[1], lo[2], lo[3], hi[0], hi[1], hi[2], hi[3]};
            o[dm] = __builtin_amdgcn_mfma_f32_16x16x32_bf16(vf, pf, o[dm], 0, 0, 0);
        }
    }
    const float inv = 1.f / l;
    bf16* og = (bf16*)(F.ws + WS_OG) + ((size_t)g * T + growq) * 512 + h * 64 + 4 * G;
#pragma unroll
    for (int dm = 0; dm < 4; ++dm) *(GAS u64*)(og + 16 * dm) = (u64)pk2(o[dm][0] * inv, o[dm][1] * inv) | ((u64)pk2(o[dm][2] * inv, o[dm][3] * inv) << 32);
    if (G == 0) ((float*)(F.ws + WS_LSE))[((size_t)g * T + growq) * 8 + h] = (mx + __builtin_amdgcn_logf(l)) * LN2;
    __syncthreads();
}

__device__ __forceinline__ void phase_combine_conv(Frame& F, const In& in) {
    const int gw = F.vcu * NWAVES + F.wave, NGW = F.G * NWAVES, lane = F.lane;
    const bf16* PROJ = (const bf16*)(F.ws + WS_PROJ); const bf16* OG = (const bf16*)(F.ws + WS_OG); const float* LSE = (const float*)(F.ws + WS_LSE);
    for (int t = gw; t < T; t += NGW) {
        { const int head = lane >> 3;
          const float l0 = LSE[((size_t)0 * T + t) * 8 + head], l1 = LSE[((size_t)1 * T + t) * 8 + head], l2 = LSE[((size_t)2 * T + t) * 8 + head];
          const float mx = fmaxf(l0, fmaxf(l1, l2)); float w0 = __expf(l0 - mx), w1 = __expf(l1 - mx), w2 = __expf(l2 - mx); const float inv = 1.f / (w0 + w1 + w2); w0 *= inv; w1 *= inv; w2 *= inv;
          const v4u a = *(const GAS v4u*)(OG + ((size_t)0 * T + t) * 512 + 8 * lane), b = *(const GAS v4u*)(OG + ((size_t)1 * T + t) * 512 + 8 * lane), c = *(const GAS v4u*)(OG + ((size_t)2 * T + t) * 512 + 8 * lane);
          v4u o;
          o.x = pk2(w0 * bf_lo(a.x) + w1 * bf_lo(b.x) + w2 * bf_lo(c.x), w0 * bf_hi(a.x) + w1 * bf_hi(b.x) + w2 * bf_hi(c.x));
          o.y = pk2(w0 * bf_lo(a.y) + w1 * bf_lo(b.y) + w2 * bf_lo(c.y), w0 * bf_hi(a.y) + w1 * bf_hi(b.y) + w2 * bf_hi(c.y));
          o.z = pk2(w0 * bf_lo(a.z) + w1 * bf_lo(b.z) + w2 * bf_lo(c.z), w0 * bf_hi(a.z) + w1 * bf_hi(b.z) + w2 * bf_hi(c.z));
          o.w = pk2(w0 * bf_lo(a.w) + w1 * bf_lo(b.w) + w2 * bf_lo(c.w), w0 * bf_hi(a.w) + w1 * bf_hi(b.w) + w2 * bf_hi(c.w));
          *(GAS v4u*)((bf16*)(F.ws + WS_YA) + (size_t)t * 512 + 8 * lane) = o; }
        const int pos = t & (SEQ - 1);
#pragma unroll
        for (int half = 0; half < 2; ++half) {
            const int c = 8 * lane + 512 * half;
            float z[3][8];
#pragma unroll
            for (int dd = 0; dd < 3; ++dd) {
                const int back = 2 - dd;
                if (pos - back >= 0) { const bf16* p = PROJ + (size_t)(t - back) * NPROJ + 4608 + c; const v4u gc = *(const GAS v4u*)(p + 1024), xc = *(const GAS v4u*)(p + 2048);
                    z[dd][0] = bf_lo(gc.x) * bf_lo(xc.x); z[dd][1] = bf_hi(gc.x) * bf_hi(xc.x); z[dd][2] = bf_lo(gc.y) * bf_lo(xc.y); z[dd][3] = bf_hi(gc.y) * bf_hi(xc.y);
                    z[dd][4] = bf_lo(gc.z) * bf_lo(xc.z); z[dd][5] = bf_hi(gc.z) * bf_hi(xc.z); z[dd][6] = bf_lo(gc.w) * bf_lo(xc.w); z[dd][7] = bf_hi(gc.w) * bf_hi(xc.w); }
                else {
#pragma unroll
                    for (int i = 0; i < 8; ++i) z[dd][i] = 0.f; }
            }
            const v4u gb = *(const GAS v4u*)(PROJ + (size_t)t * NPROJ + 4608 + c);
            float y[8];
#pragma unroll
            for (int i = 0; i < 8; ++i) y[i] = in.conv_w[c + i] * z[0][i] + in.conv_w[1024 + c + i] * z[1][i] + in.conv_w[2048 + c + i] * z[2][i];
            v4u o; o.x = pk2(bf_lo(gb.x) * y[0], bf_hi(gb.x) * y[1]); o.y = pk2(bf_lo(gb.y) * y[2], bf_hi(gb.y) * y[3]); o.z = pk2(bf_lo(gb.z) * y[4], bf_hi(gb.z) * y[5]); o.w = pk2(bf_lo(gb.w) * y[6], bf_hi(gb.w) * y[7]);
            *(GAS v4u*)((bf16*)(F.ws + WS_YC) + (size_t)t * 1024 + c) = o;
        }
    }
}

__device__ __forceinline__ void cross_attn_unit(Frame& F, int unit) {
    const int qc = unit & 31, bh = unit >> 5, h = bh & 3, b = bh >> 2, tid = F.tid;
    const bf16* KV = (const bf16*)(F.ws + WS_KV); const bf16* Q2 = (const bf16*)(F.ws + WS_Q2);
    LAS bf16* Ks = (LAS bf16*)F.lds; LAS bf16* Vs = Ks + 256 * 136;
#pragma unroll
    for (int it = 0; it < 8; ++it) {
        const int row = (tid >> 4) + 32 * it, ch = tid & 15; const bf16* p = KV + (size_t)(b * NMEM + row) * 1024 + h * 128 + ch * 8;
        *(LAS v4u*)(Ks + row * 136 + ch * 8) = *(const GAS v4u*)p; *(LAS v4u*)(Vs + row * 136 + ch * 8) = *(const GAS v4u*)(p + 512);
    }
    __syncthreads();
    const int ql = tid >> 2, part = tid & 3; const size_t grow = (size_t)b * SEQ + 128 * qc + ql;
    float q[32], acc[32];
    { const bf16* p = Q2 + grow * 512 + h * 128 + part * 32; const float sc = 0.08838834764831845f * LOG2E;
#pragma unroll
      for (int c4 = 0; c4 < 4; ++c4) { const v4u a = *(const GAS v4u*)(p + 8 * c4);
          q[8 * c4 + 0] = bf_lo(a.x) * sc; q[8 * c4 + 1] = bf_hi(a.x) * sc; q[8 * c4 + 2] = bf_lo(a.y) * sc; q[8 * c4 + 3] = bf_hi(a.y) * sc;
          q[8 * c4 + 4] = bf_lo(a.z) * sc; q[8 * c4 + 5] = bf_hi(a.z) * sc; q[8 * c4 + 6] = bf_lo(a.w) * sc; q[8 * c4 + 7] = bf_hi(a.w) * sc; } }
#pragma unroll
    for (int i = 0; i < 32; ++i) acc[i] = 0.f;
    float mrun = -1e30f, l = 0.f;
#pragma unroll 1
    for (int key = 0; key < NMEM; ++key) {
        const LAS bf16* kp = Ks + key * 136 + part * 32; float s = 0.f;
#pragma unroll
        for (int c4 = 0; c4 < 4; ++c4) { const v4u a = *(const LAS v4u*)(kp + 8 * c4);
            s += q[8 * c4 + 0] * bf_lo(a.x) + q[8 * c4 + 1] * bf_hi(a.x) + q[8 * c4 + 2] * bf_lo(a.y) + q[8 * c4 + 3] * bf_hi(a.y)
               + q[8 * c4 + 4] * bf_lo(a.z) + q[8 * c4 + 5] * bf_hi(a.z) + q[8 * c4 + 6] * bf_lo(a.w) + q[8 * c4 + 7] * bf_hi(a.w); }
        s += __shfl_xor(s, 1); s += __shfl_xor(s, 2);
        const float mn = fmaxf(mrun, s), alpha = __builtin_amdgcn_exp2f(mrun - mn), p = __builtin_amdgcn_exp2f(s - mn);
        mrun = mn; l = l * alpha + p;
        const LAS bf16* vp = Vs + key * 136 + part * 32;
#pragma unroll
        for (int c4 = 0; c4 < 4; ++c4) { const v4u a = *(const LAS v4u*)(vp + 8 * c4);
            acc[8 * c4 + 0] = acc[8 * c4 + 0] * alpha + p * bf_lo(a.x); acc[8 * c4 + 1] = acc[8 * c4 + 1] * alpha + p * bf_hi(a.x);
            acc[8 * c4 + 2] = acc[8 * c4 + 2] * alpha + p * bf_lo(a.y); acc[8 * c4 + 3] = acc[8 * c4 + 3] * alpha + p * bf_hi(a.y);
            acc[8 * c4 + 4] = acc[8 * c4 + 4] * alpha + p * bf_lo(a.z); acc[8 * c4 + 5] = acc[8 * c4 + 5] * alpha + p * bf_hi(a.z);
            acc[8 * c4 + 6] = acc[8 * c4 + 6] * alpha + p * bf_lo(a.w); acc[8 * c4 + 7] = acc[8 * c4 + 7] * alpha + p * bf_hi(a.w); }
    }
    const float inv = 1.f / l;
    bf16* op = (bf16*)(F.ws + WS_O2) + grow * 512 + h * 128 + part * 32;
#pragma unroll
    for (int c4 = 0; c4 < 4; ++c4) { v4u o; o.x = pk2(acc[8 * c4 + 0] * inv, acc[8 * c4 + 1] * inv); o.y = pk2(acc[8 * c4 + 2] * inv, acc[8 * c4 + 3] * inv);
        o.z = pk2(acc[8 * c4 + 4] * inv, acc[8 * c4 + 5] * inv); o.w = pk2(acc[8 * c4 + 6] * inv, acc[8 * c4 + 7] * inv); *(GAS v4u*)(op + 8 * c4) = o; }
    __syncthreads();
}

__device__ __forceinline__ float rlane(float x, int L) { int r = __builtin_amdgcn_readlane(__builtin_bit_cast(int, x), L); asm volatile("" : "+s"(r)); return __builtin_bit_cast(float, r); }

__device__ __forceinline__ void cross_attn_unit_mfma(Frame& F, int unit) {
    const int qc = unit & 31, bh = unit >> 5, h = bh & 3, b = bh >> 2, tid = F.tid, lane = F.lane, w = F.wave, qi = lane & 15, G = lane >> 4;
    const bf16* KV = (const bf16*)(F.ws + WS_KV); const bf16* Q2 = (const bf16*)(F.ws + WS_Q2);
    LAS bf16* Ks = (LAS bf16*)F.lds; LAS bf16* Vs = Ks + 256 * 136;
#pragma unroll
    for (int it = 0; it < 8; ++it) {
        const int row = (tid >> 4) + 32 * it, ch = tid & 15; const bf16* p = KV + (size_t)(b * NMEM + row) * 1024 + h * 128 + ch * 8;
        *(LAS v4u*)(Ks + row * 136 + ch * 8) = *(const GAS v4u*)p; *(LAS v4u*)(Vs + row * 136 + ch * 8) = *(const GAS v4u*)(p + 512);
    }
    const size_t grow = (size_t)b * SEQ + 128 * qc + 16 * w + qi;
    bf16x8v q[4];
#pragma unroll
    for (int ks = 0; ks < 4; ++ks) q[ks] = *(const GAS bf16x8v*)(Q2 + grow * 512 + h * 128 + 32 * ks + 8 * G);
    __syncthreads();
    pg8::f32x4 st[16];
#pragma unroll
    for (int t = 0; t < 16; ++t) {
        const LAS bf16* kp = Ks + (16 * t + qi) * 136 + 8 * G;
        pg8::f32x4 a = (pg8::f32x4){0.f, 0.f, 0.f, 0.f};
#pragma unroll
        for (int ks = 0; ks < 4; ++ks) a = __builtin_amdgcn_mfma_f32_16x16x32_bf16(*(const LAS bf16x8v*)(kp + 32 * ks), q[ks], a, 0, 0, 0);
        st[t] = a;
    }
    const float sc = 0.08838834764831845f * LOG2E;
    float mx = -1e30f;
#pragma unroll
    for (int t = 0; t < 16; ++t)
#pragma unroll
        for (int i = 0; i < 4; ++i) { st[t][i] *= sc; mx = fmaxf(mx, st[t][i]); }
    mx = fmaxf(mx, __shfl_xor(mx, 16)); mx = fmaxf(mx, __shfl_xor(mx, 32));
    float l = 0.f;
#pragma unroll
    for (int t = 0; t < 16; ++t)
#pragma unroll
        for (int i = 0; i < 4; ++i) { const float pv = __builtin_amdgcn_exp2f(st[t][i] - mx); st[t][i] = pv; l += pv; }
    l += __shfl_xor(l, 16); l += __shfl_xor(l, 32);
    pg8::f32x4 o[8];
#pragma unroll
    for (int dm = 0; dm < 8; ++dm) o[dm] = (pg8::f32x4){0.f, 0.f, 0.f, 0.f};
#pragma unroll
    for (int s8 = 0; s8 < 8; ++s8) {
        const pg8::f32x4 pa = st[2 * s8], pb = st[2 * s8 + 1];
        const bf16x8v pf = __builtin_bit_cast(bf16x8v, (v4u){pk2(pa[0], pa[1]), pk2(pa[2], pa[3]), pk2(pb[0], pb[1]), pk2(pb[2], pb[3])});
        const LAS bf16* vbase = Vs + (32 * s8 + 4 * G + (qi >> 2)) * 136 + 4 * (qi & 3);
#pragma unroll
        for (int dm = 0; dm < 8; ++dm) {
            const s16x4v lo = lds_tr16(vbase + 16 * dm), hi = lds_tr16(vbase + 16 * 136 + 16 * dm);
            const bf16x8v vf = (bf16x8v){lo[0], lo[1], lo[2], lo[3], hi[0], hi[1], hi[2], hi[3]};
            o[dm] = __builtin_amdgcn_mfma_f32_16x16x32_bf16(vf, pf, o[dm], 0, 0, 0);
        }
    }
    const float inv = 1.f / l;
    bf16* op = (bf16*)(F.ws + WS_O2) + grow * 512 + h * 128 + 4 * G;
#pragma unroll
    for (int dm = 0; dm < 8; ++dm) *(GAS u64*)(op + 16 * dm) = (u64)pk2(o[dm][0] * inv, o[dm][1] * inv) | ((u64)pk2(o[dm][2] * inv, o[dm][3] * inv) << 32);
    __syncthreads();
}

__device__ __forceinline__ void phase_router(Frame& F, const In& in, const float* H2) {
    LAS float* wl = (LAS float*)F.lds;
    for (int i = F.tid; i < 1024 * 32 / 4; i += NTHREADS) ((LAS f32x4*)wl)[i] = ((const GAS f32x4*)in.router_w)[i];
    __syncthreads();
    const int gw = F.vcu * NWAVES + F.wave, NGW = F.G * NWAVES, lane = F.lane, e = lane & 31;
    int* topi = (int*)(F.ws + WS_TOPI); float* topw = (float*)(F.ws + WS_TOPW); float* rstd3 = (float*)(F.ws + WS_RSTD3);
    unsigned* cnt = (unsigned*)(F.ws + WS_CTL + CTL_CNT);
    const float rb = in.router_b[e];
    for (int t = gw; t < T; t += NGW) {
        const GAS f32x4* xr = (const GAS f32x4*)(H2 + (size_t)t * D) + lane; const GAS f32x4* gr = (const GAS f32x4*)in.norm_moe + lane;
        f32x4 v[4]; float s = 0.f;
#pragma unroll
        for (int j = 0; j < 4; ++j) { v[j] = xr[64 * j]; s += (v[j].x * v[j].x + v[j].y * v[j].y) + (v[j].z * v[j].z + v[j].w * v[j].w); }
        const float rstd = 1.f / sqrtf(wave_sum(s) * (1.f / D) + EPS);
        if (lane == 0) rstd3[t] = rstd;
#pragma unroll
        for (int j = 0; j < 4; ++j) { const f32x4 g = gr[64 * j]; v[j] = v[j] * g * rstd; }
        float a0 = 0.f, a1 = 0.f, a2 = 0.f, a3 = 0.f;
#pragma unroll
        for (int j = 0; j < 4; ++j) {
#pragma unroll 4
            for (int L = 0; L < 64; ++L) {
                const LAS float* wp = wl + (size_t)(4 * (64 * j + L)) * 32 + e;
                a0 += rlane(v[j].x, L) * wp[0];
                a1 += rlane(v[j].y, L) * wp[32];
                a2 += rlane(v[j].z, L) * wp[64];
                a3 += rlane(v[j].w, L) * wp[96];
            }
        }
        float val = (a0 + a1) + (a2 + a3) + rb; const int idx = e;
        float tv0 = 0.f, tv1 = 0.f, tv2 = 0.f, tv3 = 0.f; int ti0 = 0, ti1 = 0, ti2 = 0, ti3 = 0;
#pragma unroll
        for (int k = 0; k < 4; ++k) {
            float bv = val; int bi = idx;
#pragma unroll
            for (int off = 1; off < 32; off <<= 1) { const float ov = __shfl_xor(bv, off); const int oi = __shfl_xor(bi, off); if (ov > bv || (ov == bv && oi < bi)) { bv = ov; bi = oi; } }
            if (k == 0) { tv0 = bv; ti0 = bi; } else if (k == 1) { tv1 = bv; ti1 = bi; } else if (k == 2) { tv2 = bv; ti2 = bi; } else { tv3 = bv; ti3 = bi; }
            if (idx == bi) val = -INFINITY;
        }
        const float e1 = __expf(tv1 - tv0), e2 = __expf(tv2 - tv0), e3 = __expf(tv3 - tv0), inv = 1.f / (1.f + e1 + e2 + e3);
        if (lane < 4) {
            const int ei = lane == 0 ? ti0 : (lane == 1 ? ti1 : (lane == 2 ? ti2 : ti3));
            const float wv = (lane == 0 ? 1.f : (lane == 1 ? e1 : (lane == 2 ? e2 : e3))) * inv;
            topi[t * 4 + lane] = ei; topw[t * 4 + lane] = wv;
            __hip_atomic_fetch_add(cnt + ei, 1u, __ATOMIC_RELAXED, __HIP_MEMORY_SCOPE_AGENT);
        }
    }
    __syncthreads();
}

__device__ __forceinline__ void build_tpre(Frame& F) {
    volatile LAS int* tpre = (volatile LAS int*)(F.lds + TBL_OFF);
    const unsigned* cnt = (const unsigned*)(F.ws + WS_CTL + CTL_CNT);
    if (F.tid == 0) { int acc = 0;
        for (int e = 0; e < NEXP; ++e) { tpre[e] = acc; const unsigned c = __hip_atomic_load(cnt + e, __ATOMIC_RELAXED, __HIP_MEMORY_SCOPE_AGENT); tpre[64 + e] = (int)c; acc += (int)((c + 255u) >> 8); }
        tpre[32] = acc; }
    __syncthreads();
}

__device__ __forceinline__ void phase_scatter(Frame& F, const In& in, const float* H2) {
    build_tpre(F);
    volatile LAS int* tpre = (volatile LAS int*)(F.lds + TBL_OFF);
    const int gw = F.vcu * NWAVES + F.wave, NGW = F.G * NWAVES, lane = F.lane;
    const int* topi = (const int*)(F.ws + WS_TOPI); const float* rstd3 = (const float*)(F.ws + WS_RSTD3);
    unsigned* fill = (unsigned*)(F.ws + WS_CTL + CTL_FILL); int* rowslot = (int*)(F.ws + WS_ROWSLOT); bf16* XS = (bf16*)(F.ws + WS_XS);
    if ((int)blockIdx.x < NEXP) { const int e = blockIdx.x; for (int R = tpre[e] * 256 + tpre[64 + e] + F.tid; R < tpre[e + 1] * 256; R += NTHREADS) rowslot[R] = -1; }
    for (int t = gw; t < T; t += NGW) {
        const GAS f32x4* xr = (const GAS f32x4*)(H2 + (size_t)t * D) + lane; const GAS f32x4* gr = (const GAS f32x4*)in.norm_moe + lane;
        const float rstd = rstd3[t];
        u64 o[4];
#pragma unroll
        for (int j = 0; j < 4; ++j) { const f32x4 v = xr[64 * j], g = gr[64 * j]; o[j] = (u64)pk2(v.x * rstd * g.x, v.y * rstd * g.y) | ((u64)pk2(v.z * rstd * g.z, v.w * rstd * g.w) << 32); }
#pragma unroll
        for (int k = 0; k < 4; ++k) {
            const int e = __builtin_amdgcn_readfirstlane(topi[t * 4 + k]);
            unsigned pos = 0; if (lane == 0) pos = __hip_atomic_fetch_add(fill + e, 1u, __ATOMIC_RELAXED, __HIP_MEMORY_SCOPE_AGENT);
            pos = __builtin_amdgcn_readfirstlane(pos);
            const int R = tpre[e] * 256 + (int)pos;
            GAS u64* dst = (GAS u64*)(XS + (size_t)R * D) + lane;
#pragma unroll
            for (int j = 0; j < 4; ++j) dst[64 * j] = o[j];
            if (lane == 0) rowslot[R] = t * 4 + k;
        }
    }
}

__device__ __forceinline__ void phase_final(Frame& F, const In& in, const float* H2, float* OUT) {
    const int gw = F.vcu * NWAVES + F.wave, NGW = F.G * NWAVES, lane = F.lane;
    const bf16* Y = (const bf16*)(F.ws + WS_Y);
    for (int t = gw; t < T; t += NGW) {
        const GAS f32x4* xr = (const GAS f32x4*)(H2 + (size_t)t * D) + lane; const GAS f32x4* gr = (const GAS f32x4*)in.norm_final + lane;
        f32x4 v[4]; float s = 0.f;
#pragma unroll
        for (int j = 0; j < 4; ++j) v[j] = xr[64 * j];
#pragma unroll
        for (int k = 0; k < 4; ++k) { const GAS u64* yr = (const GAS u64*)(Y + (size_t)(t * 4 + k) * D) + lane;
#pragma unroll
            for (int j = 0; j < 4; ++j) { const u64 w = yr[64 * j]; const unsigned lo = (unsigned)w, hi = (unsigned)(w >> 32); v[j].x += bf_lo(lo); v[j].y += bf_hi(lo); v[j].z += bf_lo(hi); v[j].w += bf_hi(hi); } }
#pragma unroll
        for (int j = 0; j < 4; ++j) s += (v[j].x * v[j].x + v[j].y * v[j].y) + (v[j].z * v[j].z + v[j].w * v[j].w);
        const float rstd = 1.f / sqrtf(wave_sum(s) * (1.f / D) + EPS);
        GAS f32x4* orow = (GAS f32x4*)(OUT + (size_t)t * D) + lane;
#pragma unroll
        for (int j = 0; j < 4; ++j) orow[64 * j] = v[j] * gr[64 * j] * rstd;
    }
}
struct Args { const float* in[25]; float* out; unsigned char* ws; int ph_lo, ph_hi; };
#ifndef PG8_SP2
#define PG8_SP2 true
#endif
#ifndef PG8_ALIGN
#define PG8_ALIGN true
#endif
__global__ void __launch_bounds__(NTHREADS, 2) mega_fwd(Args args) {
    extern __shared__ __attribute__((aligned(16))) unsigned char lds[];
    Frame F;
    F.lds = (LAS unsigned char*)lds; F.MISC = (volatile LAS unsigned*)(F.lds + MISC_OFF);
    F.tid = threadIdx.x; F.lane = F.tid & 63; F.wave = __builtin_amdgcn_readfirstlane(F.tid >> 6);
    F.G = gridDim.x; { const int bx = blockIdx.x; F.vcu = (F.G % 8 == 0) ? (bx % 8) * (F.G / 8) + bx / 8 : bx; }
    F.ws = args.ws; F.ctl = (gu32*)(args.ws + WS_CTL);
    In in;
    in.x = args.in[0]; in.mem = args.in[1]; in.norm_mix = args.in[2]; in.w_in = args.in[3]; in.conv_w = args.in[4]; in.w_ba = args.in[5]; in.w_bc = args.in[6];
    in.w_gate = args.in[7]; in.b_gate = args.in[8]; in.w_out = args.in[9]; in.norm_cross = args.in[10]; in.norm_mem = args.in[11]; in.w_cq = args.in[12];
    in.w_ckv = args.in[13]; in.w_co = args.in[14]; in.norm_moe = args.in[15]; in.router_w = args.in[16]; in.router_b = args.in[17]; in.w_eg = args.in[18];
    in.b_eg = args.in[19]; in.w_eu = args.in[20]; in.b_eu = args.in[21]; in.w_ed = args.in[22]; in.b_ed = args.in[23]; in.norm_final = args.in[24];
    unsigned char* ws = args.ws;
    for (int u = F.tid; u < 64; u += NTHREADS) ((LAS unsigned*)(F.lds + MISC_OFF))[u] = 0u;
    __syncthreads();
    XcdBarrier bar; bar.bar = (unsigned*)(F.ctl + CW_BAR); bar.x = 0; bar.st = nullptr;
    if (N_LAUNCHES == 1) bar = xcd_barrier_post((unsigned*)(F.ctl + CW_BAR), F.MISC + 8);
    const int lo = args.ph_lo, hi = args.ph_hi;
#define IN(k) (lo <= (k) && (k) < hi)
#define SEAM(k) do { if (IN(k) && IN((k) + 1)) xcd_barrier(bar); } while (0)
    typedef pg8::bf16_t b16;

    if (IN(0)) { phase_prologue(F, in); } SEAM(0);

    if (IN(1)) {
        pg8::Gemm g{(const b16*)(ws + WS_U1), (const b16*)(ws + WS_W1T), T, NPROJ, D}; pg8::StaticOrder S; S.init(T, NPROJ, F.G, (int)blockIdx.x);
        pg8::EpiProj E{(b16*)(ws + WS_PROJ), in.b_gate};
        pg8::gemm_phase<pg8::EpiProj, pg8::StaticOrder, PG8_ALIGN, PG8_SP2>(F.lds, g, S, E);
    } SEAM(1);

    if (IN(2)) { for (int u = blockIdx.x; u < NBATCH * 3 * 8 * 32; u += F.G) dil_attn_unit_mfma(F, u); } SEAM(2);

    if (IN(3)) { phase_combine_conv(F, in); } SEAM(3);

    if (IN(4)) {
        { pg8::Gemm g{(const b16*)(ws + WS_YA), (const b16*)(ws + WS_WBA), T, D, 512}; pg8::StaticOrder S; S.init(T, D, F.G, (int)blockIdx.x);
          pg8::EpiMix<false> E{(b16*)(ws + WS_MIX), (const b16*)(ws + WS_PROJ)};
          pg8::gemm_phase<pg8::EpiMix<false>, pg8::StaticOrder, PG8_ALIGN, PG8_SP2>(F.lds, g, S, E); }
        { pg8::Gemm g{(const b16*)(ws + WS_YC), (const b16*)(ws + WS_WBC), T, D, D}; pg8::StaticOrder S; S.init(T, D, F.G, (int)blockIdx.x);
          pg8::EpiMix<true> E{(b16*)(ws + WS_MIX), (const b16*)(ws + WS_PROJ)};
          pg8::gemm_phase<pg8::EpiMix<true>, pg8::StaticOrder, PG8_ALIGN, PG8_SP2>(F.lds, g, S, E); }
    } SEAM(4);

    if (IN(5)) {
        { pg8::Gemm g{(const b16*)(ws + WS_MIX), (const b16*)(ws + WS_WO), T, D, D}; pg8::StaticOrder S; S.init(T, D, F.G, (int)blockIdx.x);
          pg8::EpiH1 E{in.x, (float*)(ws + WS_H1), (b16*)(ws + WS_H1B), (float*)(ws + WS_CTL + CTL_SS2)};
          pg8::gemm_phase<pg8::EpiH1, pg8::StaticOrder, PG8_ALIGN, PG8_SP2>(F.lds, g, S, E); }
        phase_expert_convert(F, in);
    } SEAM(5);

    if (IN(6)) {
        { pg8::Gemm g{(const b16*)(ws + WS_H1B), (const b16*)(ws + WS_WCQ), T, 512, D}; pg8::StaticOrder S; S.init(T, 512, F.G, (int)blockIdx.x);
          pg8::EpiQ2 E{(b16*)(ws + WS_Q2), (const float*)(ws + WS_CTL + CTL_SS2)};
          pg8::gemm_phase<pg8::EpiQ2, pg8::StaticOrder, PG8_ALIGN, PG8_SP2>(F.lds, g, S, E); }
        { pg8::Gemm g{(const b16*)(ws + WS_MN), (const b16*)(ws + WS_WCKV), NBATCH * NMEM, D, D}; pg8::StaticOrder S; S.init(NBATCH * NMEM, D, F.G, ((int)blockIdx.x + F.G - 128) % F.G);
          pg8::EpiPlain E{(b16*)(ws + WS_KV), D};
          pg8::gemm_phase<pg8::EpiPlain, pg8::StaticOrder, PG8_ALIGN, PG8_SP2>(F.lds, g, S, E); }
    } SEAM(6);

    if (IN(7)) { for (int u = blockIdx.x; u < NBATCH * 4 * 32; u += F.G) cross_attn_unit_mfma(F, u); } SEAM(7);

    if (IN(8)) {
        pg8::Gemm g{(const b16*)(ws + WS_O2), (const b16*)(ws + WS_WCO), T, D, 512}; pg8::StaticOrder S; S.init(T, D, F.G, (int)blockIdx.x);
        pg8::EpiH2 E{(const float*)(ws + WS_H1), args.out};
        pg8::gemm_phase<pg8::EpiH2, pg8::StaticOrder, PG8_ALIGN, PG8_SP2>(F.lds, g, S, E);
    } SEAM(8);

    if (IN(9)) { phase_router(F, in, args.out); } SEAM(9);

    if (IN(10)) { phase_scatter(F, in, args.out); } SEAM(10);

    if (IN(11)) {
        build_tpre(F);
        pg8::Gemm g{(const b16*)(ws + WS_XS), (const b16*)(ws + WS_EXPGU), XS_ROWS, NEXP * 2048, D};
        MoeOrder S{(const volatile LAS int*)(F.lds + TBL_OFF), 8, F.G, (int)blockIdx.x};
        pg8::EpiHdn E{(b16*)(ws + WS_HDN), in.b_eg, in.b_eu};
        pg8::gemm_phase<pg8::EpiHdn, MoeOrder, PG8_ALIGN, PG8_SP2>(F.lds, g, S, E);
    } SEAM(11);

    if (IN(12)) {
        build_tpre(F);
        pg8::Gemm g{(const b16*)(ws + WS_HDN), (const b16*)(ws + WS_EXPD), XS_ROWS, NEXP * 1024, D};
        MoeOrder S{(const volatile LAS int*)(F.lds + TBL_OFF), 4, F.G, (int)blockIdx.x};
        pg8::EpiY E{(b16*)(ws + WS_Y), in.b_ed, (const int*)(ws + WS_ROWSLOT), (const float*)(ws + WS_TOPW)};
        pg8::gemm_phase<pg8::EpiY, MoeOrder, PG8_ALIGN, PG8_SP2>(F.lds, g, S, E);
    } SEAM(12);

    if (IN(13)) { phase_final(F, in, args.out, args.out); }
#undef IN
#undef SEAM
}

extern "C" void kernel_launch(void* const* d_in, const int* in_sizes, int n_in, void* d_out, int out_size, void* d_ws, size_t ws_size, hipStream_t stream) {
    static int grid = 0;
    if (grid == 0) {
        if (n_in != 25 || in_sizes[0] != T * D || out_size != T * D || ws_size < WS_END) {
            fprintf(stderr, "kernel_launch: built for 25 inputs, x/out of %d floats, >= %zu bytes of workspace; got n_in %d, in0 %d, out %d, ws %zu; nothing launched\n", T * D, (size_t)WS_END, n_in, n_in > 0 ? in_sizes[0] : -1, out_size, ws_size);
            grid = -1; return; }
        int dev = 0, cus = 0, per_cu = 0;
        if (hipGetDevice(&dev) != hipSuccess || hipDeviceGetAttribute(&cus, hipDeviceAttributeMultiprocessorCount, dev) != hipSuccess) { fprintf(stderr, "kernel_launch: device query failed\n"); grid = -1; return; }
        if (hipFuncSetAttribute((const void*)mega_fwd, hipFuncAttributeMaxDynamicSharedMemorySize, LDS_BYTES) != hipSuccess) { fprintf(stderr, "kernel_launch: hipFuncSetAttribute(%d B LDS) failed\n", LDS_BYTES); grid = -1; return; }
        if (hipOccupancyMaxActiveBlocksPerMultiprocessor(&per_cu, (const void*)mega_fwd, NTHREADS, LDS_BYTES) != hipSuccess || per_cu < 1) { fprintf(stderr, "kernel_launch: occupancy query says %d workgroups per CU\n", per_cu); per_cu = 1; }
        (void)hipGetLastError();
        grid = cus;
    }
    if (grid < 0) return;
    (void)hipMemsetAsync((char*)d_ws + WS_CTL, 0, CTL_ZERO_BYTES, stream);
    Args a{};
    for (int i = 0; i < 25; ++i) a.in[i] = (const float*)d_in[i];
    a.out = (float*)d_out; a.ws = (unsigned char*)d_ws;
    if (N_LAUNCHES == 1) {
        a.ph_lo = 0; a.ph_hi = N_PHASES;
        void* kargs[] = {&a};
        hipError_t e = hipLaunchCooperativeKernel((const void*)mega_fwd, dim3(grid), dim3(NTHREADS), kargs, LDS_BYTES, stream);
        if (e != hipSuccess) fprintf(stderr, "kernel_launch: cooperative launch failed: %s (grid %d)\n", hipGetErrorString(e), grid);
    } else {
        for (int p = 0; p < N_PHASES; ++p) { a.ph_lo = p; a.ph_hi = p + 1; hipLaunchKernelGGL(mega_fwd, dim3(grid), dim3(NTHREADS), LDS_BYTES, stream, a);
        }
    }
}
```

```cpp
#include <hip/hip_runtime.h>
#include <cstdio>
#include <cstdint>
namespace pg8 {
#define PG8_LAS __attribute__((address_space(3)))
typedef unsigned short bf16_t;
typedef short bf16x8 __attribute__((ext_vector_type(8)));
typedef float f32x4 __attribute__((ext_vector_type(4)));
typedef unsigned u32x4 __attribute__((ext_vector_type(4)));
constexpr int BM = 256, BK = 64, HALF = 128, HTB = HALF * BK * 2  , STAGE_BYTES = 8 * HTB, NXCD = 8, WGM = 8;

__host__ __device__ __forceinline__ int lds_byte(int r, int c) { const int st = (r >> 4) * 2 + (c >> 5), rr = r & 15, cc = c & 31, ob = rr * 64 + cc * 2; return st * 1024 + (ob ^ (((ob >> 9) & 1) << 5)); }
__host__ __device__ __forceinline__ void stage_rc(int b, int& R, int& C) { const int st = b / 1024, sb = b % 1024, swz = sb ^ (((sb >> 9) & 1) << 5); R = (st >> 1) * 16 + swz / 64; C = (st & 1) * 32 + (swz % 64) / 2; }
__host__ __device__ __forceinline__ int perm32(int rho) { const int n = rho >> 4, i = rho & 15; return 8 * (i >> 2) + 4 * n + (i & 3); }

struct Unit { int pm, pn; };
struct Gemm { const bf16_t* A; const bf16_t* Bt; int M, N, K; };

struct StaticOrder {
    int nM, nN, nwg, G, c;
    __host__ __device__ void init(int M, int N, int G_, int c_) { nM = M / BM; nN = N / BM; nwg = nM * nN; G = G_; c = c_; }
    __host__ __device__ bool next(int i, Unit& u) const {
        const long L = (long)i * G + c; if (L >= nwg) return false;
        int wgid = (int)L; { const int q = nwg / NXCD, r = nwg % NXCD, xcd = wgid % NXCD, off = wgid / NXCD; wgid = (xcd < r ? xcd * (q + 1) : r * (q + 1) + (xcd - r) * q) + off; }
        const int nig = WGM * nN, gid = wgid / nig, fm = gid * WGM, gsz = (nM - fm) < WGM ? (nM - fm) : WGM;
        u.pm = fm + ((wgid % nig) % gsz); u.pn = (wgid % nig) / gsz; return true;
    }
    __device__ __forceinline__ void a_ready(const Unit&) const {}
    __device__ __forceinline__ void done(const Unit&) const {}
};

__device__ __forceinline__ unsigned cvt_pk_bf16(float lo, float hi) { unsigned r; asm volatile("v_cvt_pk_bf16_f32 %0, %1, %2" : "=v"(r) : "v"(lo), "v"(hi)); return r; }
__device__ __forceinline__ float bflo(unsigned w) { return __builtin_bit_cast(float, w << 16); }
__device__ __forceinline__ float bfhi(unsigned w) { return __builtin_bit_cast(float, w & 0xffff0000u); }
__device__ __forceinline__ void unpack8(const u32x4 w, f32x4& a, f32x4& b) { a = (f32x4){bflo(w.x), bfhi(w.x), bflo(w.y), bfhi(w.y)}; b = (f32x4){bflo(w.z), bfhi(w.z), bflo(w.w), bfhi(w.w)}; }
__device__ __forceinline__ u32x4 pack8(const f32x4 a, const f32x4 b) { u32x4 w; w.x = cvt_pk_bf16(a[0], a[1]); w.y = cvt_pk_bf16(a[2], a[3]); w.z = cvt_pk_bf16(b[0], b[1]); w.w = cvt_pk_bf16(b[2], b[3]); return w; }
__device__ __forceinline__ float sigmoidf_fast(float x) { return __builtin_amdgcn_rcpf(1.0f + __builtin_amdgcn_exp2f(-1.4426950408889634f * x)); }
__device__ __forceinline__ f32x4 sig4(f32x4 v) { return (f32x4){sigmoidf_fast(v[0]), sigmoidf_fast(v[1]), sigmoidf_fast(v[2]), sigmoidf_fast(v[3])}; }

#define EPI_ROWS_BEGIN _Pragma("unroll") for (int ai = 0; ai < 2; ++ai) _Pragma("unroll") for (int m = 0; m < 4; ++m) { const int rowl = ai * HALF + wr * 64 + m * 16 + fr;
#define EPI_COLS_BEGIN _Pragma("unroll") for (int bj = 0; bj < 2; ++bj) { const int coll = bj * HALF + wc * 32 + 8 * fq; f32x4 v0 = acc[ai][bj][m][0], v1 = acc[ai][bj][m][1];
#define EPI_END }

struct EpiProj {
    static constexpr bool PERM = true, AFTER_DRAIN = false;
    bf16_t* O; const float* bgate;
    __device__ __forceinline__ void operator()(const f32x4 (&acc)[2][2][4][2], const Unit& u, int wr, int wc, int fr, int fq) const {
        const int row0 = u.pm * BM, col0 = u.pn * BM; const bool gate = col0 >= 7680;
        EPI_ROWS_BEGIN EPI_COLS_BEGIN
            const int row = row0 + rowl, col = col0 + coll;
            if (gate) { const f32x4 b0 = *(const f32x4*)(bgate + (col - 7680)), b1 = *(const f32x4*)(bgate + (col - 7680) + 4); v0 = sig4(v0 + b0); v1 = sig4(v1 + b1); }
            *(u32x4*)(O + (size_t)row * 9728 + col) = pack8(v0, v1);
        EPI_END EPI_END
    }
};
struct EpiPlain {
    static constexpr bool PERM = true, AFTER_DRAIN = false;
    bf16_t* O; int ldc;
    __device__ __forceinline__ void operator()(const f32x4 (&acc)[2][2][4][2], const Unit& u, int wr, int wc, int fr, int fq) const {
        const int row0 = u.pm * BM, col0 = u.pn * BM;
        EPI_ROWS_BEGIN EPI_COLS_BEGIN
            *(u32x4*)(O + (size_t)(row0 + rowl) * ldc + col0 + coll) = pack8(v0, v1);
        EPI_END EPI_END
    }
};
template <bool SECOND> struct EpiMix {
    static constexpr bool PERM = true, AFTER_DRAIN = false;
    bf16_t* MIX; const bf16_t* PROJ;
    __device__ __forceinline__ void operator()(const f32x4 (&acc)[2][2][4][2], const Unit& u, int wr, int wc, int fr, int fq) const {
        const int row0 = u.pm * BM, col0 = u.pn * BM;
        EPI_ROWS_BEGIN EPI_COLS_BEGIN
            const int row = row0 + rowl, col = col0 + coll;
            f32x4 g0, g1; unpack8(*(const u32x4*)(PROJ + (size_t)row * 9728 + (SECOND ? 8704 : 7680) + col), g0, g1);
            v0 = v0 * g0; v1 = v1 * g1;
            if (SECOND) { f32x4 t0, t1; unpack8(*(const u32x4*)(MIX + (size_t)row * 1024 + col), t0, t1); v0 = v0 + t0; v1 = v1 + t1; }
            *(u32x4*)(MIX + (size_t)row * 1024 + col) = pack8(v0, v1);
        EPI_END EPI_END
    }
};
struct EpiH1 {
    static constexpr bool PERM = true, AFTER_DRAIN = false;
    const float* X; float* H1; bf16_t* H1B; float* ss;
    __device__ __forceinline__ void operator()(const f32x4 (&acc)[2][2][4][2], const Unit& u, int wr, int wc, int fr, int fq) const {
        const int row0 = u.pm * BM, col0 = u.pn * BM;
        EPI_ROWS_BEGIN
            float s = 0.f; const int row = row0 + rowl;
            EPI_COLS_BEGIN
                const int col = col0 + coll; const size_t o = (size_t)row * 1024 + col;
                v0 = v0 + *(const f32x4*)(X + o); v1 = v1 + *(const f32x4*)(X + o + 4);
                *(f32x4*)(H1 + o) = v0; *(f32x4*)(H1 + o + 4) = v1; *(u32x4*)(H1B + o) = pack8(v0, v1);
                s += (v0[0] * v0[0] + v0[1] * v0[1]) + (v0[2] * v0[2] + v0[3] * v0[3]) + (v1[0] * v1[0] + v1[1] * v1[1]) + (v1[2] * v1[2] + v1[3] * v1[3]);
            EPI_END
            s += __shfl_xor(s, 16); s += __shfl_xor(s, 32);
            if (fq == 0) atomicAdd(ss + row, s);
        EPI_END
    }
};
struct EpiQ2 {
    static constexpr bool PERM = true, AFTER_DRAIN = false;
    bf16_t* Q2; const float* ss;
    __device__ __forceinline__ void operator()(const f32x4 (&acc)[2][2][4][2], const Unit& u, int wr, int wc, int fr, int fq) const {
        const int row0 = u.pm * BM, col0 = u.pn * BM;
        EPI_ROWS_BEGIN
            const int row = row0 + rowl; const float rs = __builtin_amdgcn_rsqf(__hip_atomic_load(ss + row, __ATOMIC_RELAXED, __HIP_MEMORY_SCOPE_AGENT) * (1.f / 1024.f) + 1e-6f);
            EPI_COLS_BEGIN
                *(u32x4*)(Q2 + (size_t)row * 512 + col0 + coll) = pack8(v0 * rs, v1 * rs);
            EPI_END
        EPI_END
    }
};
struct EpiH2 {
    static constexpr bool PERM = true, AFTER_DRAIN = false;
    const float* H1; float* OUT;
    __device__ __forceinline__ void operator()(const f32x4 (&acc)[2][2][4][2], const Unit& u, int wr, int wc, int fr, int fq) const {
        const int row0 = u.pm * BM, col0 = u.pn * BM;
        EPI_ROWS_BEGIN EPI_COLS_BEGIN
            const size_t o = (size_t)(row0 + rowl) * 1024 + col0 + coll;
            *(f32x4*)(OUT + o) = v0 + *(const f32x4*)(H1 + o); *(f32x4*)(OUT + o + 4) = v1 + *(const f32x4*)(H1 + o + 4);
        EPI_END EPI_END
    }
};
struct EpiHdn {
    static constexpr bool PERM = true, AFTER_DRAIN = false;
    bf16_t* HDN; const float* bg; const float* bu;
    __device__ __forceinline__ void operator()(const f32x4 (&acc)[2][2][4][2], const Unit& u, int wr, int wc, int fr, int fq) const {
        const int row0 = u.pm * BM, e = u.pn >> 3, hc = (u.pn & 7) * 128 + wc * 32 + 8 * fq;
        const float* pg = bg + e * 1024 + hc; const float* pu = bu + e * 1024 + hc;
        const f32x4 bg0 = *(const f32x4*)pg, bg1 = *(const f32x4*)(pg + 4), bu0 = *(const f32x4*)pu, bu1 = *(const f32x4*)(pu + 4);
        EPI_ROWS_BEGIN
            f32x4 g0 = acc[ai][0][m][0] + bg0, g1 = acc[ai][0][m][1] + bg1, l0 = acc[ai][1][m][0] + bu0, l1 = acc[ai][1][m][1] + bu1, h0, h1;
#pragma unroll
            for (int j = 0; j < 4; ++j) {
                const float ga = fminf(g0[j], 7.f), gb = fminf(g1[j], 7.f), la = fminf(fmaxf(l0[j], -7.f), 7.f), lb = fminf(fmaxf(l1[j], -7.f), 7.f);
                h0[j] = ga * sigmoidf_fast(1.702f * ga) * (la + 1.f); h1[j] = gb * sigmoidf_fast(1.702f * gb) * (lb + 1.f); }
            *(u32x4*)(HDN + (size_t)(row0 + rowl) * 1024 + hc) = pack8(h0, h1);
        EPI_END
    }
};
struct EpiY {
    static constexpr bool PERM = true, AFTER_DRAIN = false;
    bf16_t* Y; const float* bd; const int* rowslot; const float* topw;
    __device__ __forceinline__ void operator()(const f32x4 (&acc)[2][2][4][2], const Unit& u, int wr, int wc, int fr, int fq) const {
        const int row0 = u.pm * BM, e = u.pn >> 2, col0 = (u.pn & 3) * BM;
        EPI_ROWS_BEGIN
            const int slot = rowslot[row0 + rowl];
            if (slot >= 0) { const float w = topw[slot];
                EPI_COLS_BEGIN
                    const int col = col0 + coll; const float* pb = bd + e * 1024 + col;
                    v0 = (v0 + *(const f32x4*)pb) * w; v1 = (v1 + *(const f32x4*)(pb + 4)) * w;
                    *(u32x4*)(Y + (size_t)slot * 1024 + col) = pack8(v0, v1);
                EPI_END }
        EPI_END
    }
};
template <class Epi, class Sched, bool ALIGN_EPI = false, bool SP2 = false>
__device__ __forceinline__ void gemm_phase(PG8_LAS unsigned char* lds, const Gemm g, const Sched& S, const Epi& E) {
    const int tid = threadIdx.x, wid = __builtin_amdgcn_readfirstlane(tid >> 6), lane = tid & 63, wr = wid >> 2, wc = wid & 3, fr = lane & 15, fq = lane >> 4;
    const int K = g.K, nt = K / BK;
    unsigned voffA[2], voffB[2];
#pragma unroll
    for (int i = 0; i < 2; ++i) { int R, C; stage_rc(tid * 16 + i * 8192, R, C); const int Rb = Epi::PERM ? ((R & ~31) + perm32(R & 31)) : R;
        voffA[i] = (unsigned)(R * K + C) * 2u; voffB[i] = (unsigned)(Rb * K + C) * 2u; }
    const size_t kstep = (size_t)(BK * 2);
    const size_t hstep = (size_t)HALF * K * 2;
    const size_t tstep = 2 * hstep;
    const unsigned ldsw = (unsigned)wid * 1024u;
    const int aoff = lds_byte(wr * 64 + fr, fq * 8), boff = lds_byte(wc * 32 + fr, fq * 8);
#define PG8_SA(b, h) (((b) * 2 + (h)) * HTB)
#define PG8_SB(b, h) ((4 + (b) * 2 + (h)) * HTB)
#define PG8_STAGE(bufoff, gbase, voff) do { _Pragma("unroll") for (int _i = 0; _i < 2; ++_i) \
        __builtin_amdgcn_global_load_lds((const unsigned*)((const char*)(gbase) + (voff)[_i]), (PG8_LAS unsigned*)(lds + (bufoff) + ldsw + _i * 8192), 16, 0, 0); } while (0)
#define PG8_LDA(dst, b, h) do { _Pragma("unroll") for (int m = 0; m < 4; ++m) _Pragma("unroll") for (int k = 0; k < 2; ++k) dst[m][k] = *(const PG8_LAS bf16x8*)(lds + PG8_SA(b, h) + aoff + m * 2048 + k * 1024); } while (0)
#define PG8_LDB(dst, b, h) do { _Pragma("unroll") for (int n = 0; n < 2; ++n) _Pragma("unroll") for (int k = 0; k < 2; ++k) dst[n][k] = *(const PG8_LAS bf16x8*)(lds + PG8_SB(b, h) + boff + n * 2048 + k * 1024); } while (0)
#define PG8_MMA(ai, bj, At, Bt) do { __builtin_amdgcn_s_setprio(1); _Pragma("unroll") for (int m = 0; m < 4; ++m) _Pragma("unroll") for (int n = 0; n < 2; ++n) _Pragma("unroll") for (int k = 0; k < 2; ++k) \
        acc[ai][bj][m][n] = __builtin_amdgcn_mfma_f32_16x16x32_bf16(Bt[n][k], At[m][k], acc[ai][bj][m][n], 0, 0, 0); __builtin_amdgcn_s_setprio(0); } while (0)
#define PG8_WAIT_V(n) asm volatile("s_waitcnt vmcnt(" #n ")" ::: "memory")
#define PG8_WAIT_L(n) asm volatile("s_waitcnt lgkmcnt(" #n ")" ::: "memory")
#define PG8_BAR __builtin_amdgcn_s_barrier()
#define PG8_SCHED __builtin_amdgcn_sched_barrier(0)
    Unit cur, nxt; int ui = 0;
    if (!S.next(0, cur)) return;
    f32x4 acc[2][2][4][2];
#pragma unroll
    for (int a = 0; a < 2; ++a)
#pragma unroll
        for (int b = 0; b < 2; ++b)
#pragma unroll
            for (int m = 0; m < 4; ++m)
#pragma unroll
                for (int n = 0; n < 2; ++n) acc[a][b][m][n] = (f32x4){0.f, 0.f, 0.f, 0.f};
    bf16x8 At[4][2], B0[2][2], B1[2][2];
    const char* cA = (const char*)g.A + (size_t)cur.pm * tstep; const char* cB = (const char*)g.Bt + (size_t)cur.pn * tstep;
    S.a_ready(cur);
    if constexpr (SP2) {
        PG8_STAGE(PG8_SB(0, 0), cB, voffB); PG8_STAGE(PG8_SB(0, 1), cB + hstep, voffB); PG8_STAGE(PG8_SA(0, 0), cA, voffA); PG8_STAGE(PG8_SA(0, 1), cA + hstep, voffA);
        if (wr == 1) PG8_BAR;
        PG8_WAIT_V(2); PG8_BAR;
        PG8_STAGE(PG8_SB(1, 0), cB + kstep, voffB); PG8_STAGE(PG8_SA(1, 0), cA + kstep, voffA); PG8_STAGE(PG8_SB(1, 1), cB + hstep + kstep, voffB);
        PG8_WAIT_V(6); PG8_BAR;
    } else {
        PG8_STAGE(PG8_SB(0, 0), cB, voffB); PG8_STAGE(PG8_SA(0, 0), cA, voffA); PG8_STAGE(PG8_SB(0, 1), cB + hstep, voffB); PG8_STAGE(PG8_SA(0, 1), cA + hstep, voffA);
        if (wr == 1) PG8_BAR;
        PG8_WAIT_V(4); PG8_BAR;
        PG8_STAGE(PG8_SB(1, 0), cB + kstep, voffB); PG8_STAGE(PG8_SA(1, 0), cA + kstep, voffA); PG8_STAGE(PG8_SB(1, 1), cB + hstep + kstep, voffB);
        PG8_WAIT_V(6); PG8_BAR;
    }
    for (;;) {
        const bool has_next = S.next(ui + 1, nxt);
        const char* nA = has_next ? (const char*)g.A + (size_t)nxt.pm * tstep : cA; const char* nB = has_next ? (const char*)g.Bt + (size_t)nxt.pn * tstep : cB;
        for (int t = 0; t < nt; t += 2) {
            const bool last = (t == nt - 2);
            const char* a1 = cA + (size_t)(t + 1) * kstep;
            const char* a2 = last ? nA : cA + (size_t)(t + 2) * kstep; const char* b2 = last ? nB : cB + (size_t)(t + 2) * kstep;
            const char* a3 = a2 + kstep; const char* b3 = b2 + kstep;
            if (last && has_next) S.a_ready(nxt);
            if constexpr (SP2) {
            PG8_LDB(B0, 0, 0); PG8_LDB(B1, 0, 1); PG8_SCHED; PG8_LDA(At, 0, 0); PG8_STAGE(PG8_SA(1, 1), a1 + hstep, voffA);
            PG8_WAIT_V(8); PG8_WAIT_L(0); PG8_BAR; PG8_MMA(0, 0, At, B0); PG8_MMA(0, 1, At, B1); PG8_BAR; PG8_SCHED;
            PG8_LDA(At, 0, 1); PG8_STAGE(PG8_SB(0, 0), b2, voffB); PG8_STAGE(PG8_SB(0, 1), b2 + hstep, voffB); PG8_STAGE(PG8_SA(0, 0), a2, voffA);
            PG8_WAIT_V(8); PG8_WAIT_L(0); PG8_BAR; PG8_MMA(1, 0, At, B0); PG8_MMA(1, 1, At, B1); PG8_BAR; PG8_SCHED;
            PG8_LDB(B0, 1, 0); PG8_LDB(B1, 1, 1); PG8_SCHED; PG8_LDA(At, 1, 0); PG8_STAGE(PG8_SA(0, 1), a2 + hstep, voffA);
            PG8_WAIT_V(8); PG8_WAIT_L(0); PG8_BAR; PG8_MMA(0, 0, At, B0); PG8_MMA(0, 1, At, B1); PG8_BAR; PG8_SCHED;
            PG8_LDA(At, 1, 1); PG8_STAGE(PG8_SB(1, 0), b3, voffB); PG8_STAGE(PG8_SB(1, 1), b3 + hstep, voffB); PG8_STAGE(PG8_SA(1, 0), a3, voffA);
            PG8_WAIT_V(8); PG8_WAIT_L(0); PG8_BAR; PG8_MMA(1, 0, At, B0); PG8_MMA(1, 1, At, B1); PG8_BAR; PG8_SCHED;
            } else {
            PG8_LDB(B0, 0, 0); PG8_SCHED; PG8_LDA(At, 0, 0); PG8_STAGE(PG8_SA(1, 1), a1 + hstep, voffA);
            PG8_WAIT_L(8); PG8_BAR; PG8_WAIT_L(0); PG8_MMA(0, 0, At, B0); PG8_BAR; PG8_SCHED;
            PG8_LDB(B1, 0, 1); PG8_STAGE(PG8_SB(0, 0), b2, voffB);
            PG8_BAR; PG8_WAIT_L(0); PG8_MMA(0, 1, At, B1); PG8_BAR;
            PG8_LDA(At, 0, 1); PG8_STAGE(PG8_SA(0, 0), a2, voffA);
            PG8_BAR; PG8_WAIT_L(0); PG8_MMA(1, 0, At, B0); PG8_BAR; PG8_SCHED;
            PG8_STAGE(PG8_SB(0, 1), b2 + hstep, voffB);
            PG8_WAIT_V(6); PG8_BAR; PG8_MMA(1, 1, At, B1); PG8_BAR;
            PG8_LDB(B0, 1, 0); PG8_SCHED; PG8_LDA(At, 1, 0); PG8_STAGE(PG8_SA(0, 1), a2 + hstep, voffA);
            PG8_WAIT_L(8); PG8_BAR; PG8_WAIT_L(0); PG8_MMA(0, 0, At, B0); PG8_BAR; PG8_SCHED;
            PG8_LDB(B1, 1, 1); PG8_STAGE(PG8_SB(1, 0), b3, voffB);
            PG8_BAR; PG8_WAIT_L(0); PG8_MMA(0, 1, At, B1); PG8_BAR;
            PG8_LDA(At, 1, 1); PG8_STAGE(PG8_SA(1, 0), a3, voffA);
            PG8_BAR; PG8_WAIT_L(0); PG8_MMA(1, 0, At, B0); PG8_BAR; PG8_SCHED;
            PG8_STAGE(PG8_SB(1, 1), b3 + hstep, voffB);
            PG8_WAIT_V(6); PG8_BAR; PG8_MMA(1, 1, At, B1); PG8_BAR;
            }
        }
        if constexpr (ALIGN_EPI) { if (wr == 0) PG8_BAR; }
        if constexpr (!Epi::AFTER_DRAIN) { E(acc, cur, wr, wc, fr, fq); S.done(cur); }
        if (!has_next) break;
#pragma unroll
        for (int a = 0; a < 2; ++a)
#pragma unroll
            for (int b = 0; b < 2; ++b)
#pragma unroll
                for (int m = 0; m < 4; ++m)
#pragma unroll
                    for (int n = 0; n < 2; ++n) acc[a][b][m][n] = (f32x4){0.f, 0.f, 0.f, 0.f};
        cur = nxt; cA = nA; cB = nB; ++ui;
        if constexpr (ALIGN_EPI) { if (wr == 1) PG8_BAR; }
    }
    PG8_WAIT_V(0);
    if constexpr (!ALIGN_EPI) { if (wr == 0) PG8_BAR; }
    PG8_BAR;
    if constexpr (Epi::AFTER_DRAIN) { E.fused(acc, cur, wr, wc, fr, fq, lds, wid, lane); S.done(cur); }
#undef PG8_SA
#undef PG8_SB
#undef PG8_STAGE
#undef PG8_LDA
#undef PG8_LDB
#undef PG8_MMA
#undef PG8_WAIT_V
#undef PG8_WAIT_L
#undef PG8_BAR
#undef PG8_SCHED
}
}
namespace pg8 {
template <class Epi, class Sched>
__device__ __forceinline__ void gemm_phase_gather(PG8_LAS unsigned char* lds, const Gemm g, const Sched& S, const Epi& E, const PG8_LAS int* rowbuf) {
    const int tid = threadIdx.x, wid = __builtin_amdgcn_readfirstlane(tid >> 6), lane = tid & 63, wr = wid >> 2, wc = wid & 3, fr = lane & 15, fq = lane >> 4;
    const int K = g.K, nt = K / BK;
    unsigned colA[2], voffB[2]; int rowA[2];
#pragma unroll
    for (int i = 0; i < 2; ++i) { int R, C; stage_rc(tid * 16 + i * 8192, R, C); const int Rb = Epi::PERM ? ((R & ~31) + perm32(R & 31)) : R;
        rowA[i] = R; colA[i] = (unsigned)C * 2u; voffB[i] = (unsigned)(Rb * K + C) * 2u; }
    const size_t kstep = (size_t)(BK * 2), hstep = (size_t)HALF * K * 2, tstep = 2 * hstep;
    const unsigned rowbytes = (unsigned)K * 2u;
    const unsigned ldsw = (unsigned)wid * 1024u;
    const int aoff = lds_byte(wr * 64 + fr, fq * 8), boff = lds_byte(wc * 32 + fr, fq * 8);
#define PG8_SA(b, h) (((b) * 2 + (h)) * HTB)
#define PG8_SB(b, h) ((4 + (b) * 2 + (h)) * HTB)
#define PG8_STAGE(bufoff, gbase, voff) do { _Pragma("unroll") for (int _i = 0; _i < 2; ++_i) \
        __builtin_amdgcn_global_load_lds((const unsigned*)((const char*)(gbase) + (voff)[_i]), (PG8_LAS unsigned*)(lds + (bufoff) + ldsw + _i * 8192), 16, 0, 0); } while (0)
#define PG8_LDA(dst, b, h) do { _Pragma("unroll") for (int m = 0; m < 4; ++m) _Pragma("unroll") for (int k = 0; k < 2; ++k) dst[m][k] = *(const PG8_LAS bf16x8*)(lds + PG8_SA(b, h) + aoff + m * 2048 + k * 1024); } while (0)
#define PG8_LDB(dst, b, h) do { _Pragma("unroll") for (int n = 0; n < 2; ++n) _Pragma("unroll") for (int k = 0; k < 2; ++k) dst[n][k] = *(const PG8_LAS bf16x8*)(lds + PG8_SB(b, h) + boff + n * 2048 + k * 1024); } while (0)
#define PG8_MMA(ai, bj, At, Bt) do { __builtin_amdgcn_s_setprio(1); _Pragma("unroll") for (int m = 0; m < 4; ++m) _Pragma("unroll") for (int n = 0; n < 2; ++n) _Pragma("unroll") for (int k = 0; k < 2; ++k) \
        acc[ai][bj][m][n] = __builtin_amdgcn_mfma_f32_16x16x32_bf16(Bt[n][k], At[m][k], acc[ai][bj][m][n], 0, 0, 0); __builtin_amdgcn_s_setprio(0); } while (0)
#define PG8_WAIT_V(n) asm volatile("s_waitcnt vmcnt(" #n ")" ::: "memory")
#define PG8_WAIT_L(n) asm volatile("s_waitcnt lgkmcnt(" #n ")" ::: "memory")
#define PG8_BAR __builtin_amdgcn_s_barrier()
#define PG8_SCHED __builtin_amdgcn_sched_barrier(0)
#define PG8_ROWS(dst, u_) do { _Pragma("unroll") for (int h_ = 0; h_ < 2; ++h_) _Pragma("unroll") for (int i_ = 0; i_ < 2; ++i_) dst[h_][i_] = (unsigned)rowbuf[256 * (u_) + 128 * h_ + rowA[i_]] * rowbytes + colA[i_]; } while (0)
    Unit cur, nxt; int ui = 0;
    if (!S.next(0, cur)) return;
    f32x4 acc[2][2][4][2];
#pragma unroll
    for (int a = 0; a < 2; ++a)
#pragma unroll
        for (int b = 0; b < 2; ++b)
#pragma unroll
            for (int m = 0; m < 4; ++m)
#pragma unroll
                for (int n = 0; n < 2; ++n) acc[a][b][m][n] = (f32x4){0.f, 0.f, 0.f, 0.f};
    bf16x8 At[4][2], B0[2][2], B1[2][2];
    const char* Ab = (const char*)g.A; const char* cB = (const char*)g.Bt + (size_t)cur.pn * tstep;
    unsigned ca[2][2], na[2][2];
    PG8_ROWS(ca, 0);
    PG8_STAGE(PG8_SB(0, 0), cB, voffB); PG8_STAGE(PG8_SB(0, 1), cB + hstep, voffB); PG8_STAGE(PG8_SA(0, 0), Ab, ca[0]); PG8_STAGE(PG8_SA(0, 1), Ab, ca[1]);
    if (wr == 1) PG8_BAR;
    PG8_WAIT_V(2); PG8_BAR;
    PG8_STAGE(PG8_SB(1, 0), cB + kstep, voffB); PG8_STAGE(PG8_SA(1, 0), Ab + kstep, ca[0]); PG8_STAGE(PG8_SB(1, 1), cB + hstep + kstep, voffB);
    PG8_WAIT_V(6); PG8_BAR;
    for (;;) {
        const bool has_next = S.next(ui + 1, nxt);
        const char* nB = has_next ? (const char*)g.Bt + (size_t)nxt.pn * tstep : cB;
        if (has_next) { PG8_ROWS(na, ui + 1); } else {
#pragma unroll
            for (int h_ = 0; h_ < 2; ++h_)
#pragma unroll
                for (int i_ = 0; i_ < 2; ++i_) na[h_][i_] = ca[h_][i_]; }
        for (int t = 0; t < nt; t += 2) {
            const bool last = (t == nt - 2);
            const char* a1 = Ab + (size_t)(t + 1) * kstep;
            const char* a2 = last ? Ab : Ab + (size_t)(t + 2) * kstep; const char* b2 = last ? nB : cB + (size_t)(t + 2) * kstep;
            const char* a3 = a2 + kstep; const char* b3 = b2 + kstep;
            unsigned o2[2][2];
#pragma unroll
            for (int h_ = 0; h_ < 2; ++h_)
#pragma unroll
                for (int i_ = 0; i_ < 2; ++i_) o2[h_][i_] = last ? na[h_][i_] : ca[h_][i_];
            PG8_LDB(B0, 0, 0); PG8_LDB(B1, 0, 1); PG8_SCHED; PG8_LDA(At, 0, 0); PG8_STAGE(PG8_SA(1, 1), a1, ca[1]);
            PG8_WAIT_V(8); PG8_WAIT_L(0); PG8_BAR; PG8_MMA(0, 0, At, B0); PG8_MMA(0, 1, At, B1); PG8_BAR; PG8_SCHED;
            PG8_LDA(At, 0, 1); PG8_STAGE(PG8_SB(0, 0), b2, voffB); PG8_STAGE(PG8_SB(0, 1), b2 + hstep, voffB); PG8_STAGE(PG8_SA(0, 0), a2, o2[0]);
            PG8_WAIT_V(8); PG8_WAIT_L(0); PG8_BAR; PG8_MMA(1, 0, At, B0); PG8_MMA(1, 1, At, B1); PG8_BAR; PG8_SCHED;
            PG8_LDB(B0, 1, 0); PG8_LDB(B1, 1, 1); PG8_SCHED; PG8_LDA(At, 1, 0); PG8_STAGE(PG8_SA(0, 1), a2, o2[1]);
            PG8_WAIT_V(8); PG8_WAIT_L(0); PG8_BAR; PG8_MMA(0, 0, At, B0); PG8_MMA(0, 1, At, B1); PG8_BAR; PG8_SCHED;
            PG8_LDA(At, 1, 1); PG8_STAGE(PG8_SB(1, 0), b3, voffB); PG8_STAGE(PG8_SB(1, 1), b3 + hstep, voffB); PG8_STAGE(PG8_SA(1, 0), a3, o2[0]);
            PG8_WAIT_V(8); PG8_WAIT_L(0); PG8_BAR; PG8_MMA(1, 0, At, B0); PG8_MMA(1, 1, At, B1); PG8_BAR; PG8_SCHED;
        }
        if (wr == 0) PG8_BAR;
        E(acc, cur, wr, wc, fr, fq); S.done(cur);
        if (!has_next) break;
#pragma unroll
        for (int a = 0; a < 2; ++a)
#pragma unroll
            for (int b = 0; b < 2; ++b)
#pragma unroll
                for (int m = 0; m < 4; ++m)
#pragma unroll
                    for (int n = 0; n < 2; ++n) acc[a][b][m][n] = (f32x4){0.f, 0.f, 0.f, 0.f};
        cur = nxt; cB = nB; ++ui;
#pragma unroll
        for (int h_ = 0; h_ < 2; ++h_)
#pragma unroll
            for (int i_ = 0; i_ < 2; ++i_) ca[h_][i_] = na[h_][i_];
        if (wr == 1) PG8_BAR;
    }
    PG8_WAIT_V(0);
    PG8_BAR;
#undef PG8_ROWS
#undef PG8_SA
#undef PG8_SB
#undef PG8_STAGE
#undef PG8_LDA
#undef PG8_LDB
#undef PG8_MMA
#undef PG8_WAIT_V
#undef PG8_WAIT_L
#undef PG8_BAR
#undef PG8_SCHED
}
}
#define GAS __attribute__((address_space(1)))
#define LAS __attribute__((address_space(3)))
typedef unsigned short bf16;
typedef unsigned v4u __attribute__((ext_vector_type(4)));
typedef float f32x4 __attribute__((ext_vector_type(4)));
typedef short bf16x8 __attribute__((ext_vector_type(8)));
typedef GAS unsigned gu32;
typedef GAS unsigned long long gu64;
#define RLX_AGENT __ATOMIC_RELAXED, __HIP_MEMORY_SCOPE_AGENT
#define LDS_WAIT() asm volatile("s_waitcnt lgkmcnt(0)" ::: "memory")
#define VM_WAIT() asm volatile("s_waitcnt vmcnt(0)" ::: "memory")
__device__ __forceinline__ unsigned long long rt() { return __builtin_amdgcn_s_memrealtime(); }
__device__ __forceinline__ unsigned f2bf(float f) { unsigned u = __builtin_bit_cast(unsigned, f); return (u + 0x7fffu + ((u >> 16) & 1u)) >> 16; }
__device__ __forceinline__ unsigned pk2(float lo, float hi) { return f2bf(lo) | (f2bf(hi) << 16); }

#define XB_TMO      128
#define XB_XCNT(j)  (256  + 64 * (j))
#define XB_XSUB(j)  (1280 + 64 * (j))
#define XB_XGEN(j)  (2304 + 64 * (j))
#define XB_TOP      3328
#define XB_TOPGEN   3392
#define XCD_BAR_WORDS 3456
#define XB_SPIN_CAP (1u << 18)

__device__ __forceinline__ unsigned xb_ld(unsigned* p)              { return __hip_atomic_load(p, __ATOMIC_RELAXED, __HIP_MEMORY_SCOPE_AGENT); }
__device__ __forceinline__ unsigned xb_add(unsigned* p, unsigned v) { return __hip_atomic_fetch_add(p, v, __ATOMIC_RELAXED, __HIP_MEMORY_SCOPE_AGENT); }
__device__ __forceinline__ unsigned xb_xcc_id() { return (unsigned)__builtin_amdgcn_s_getreg((3 << 11) | 20) & 0xFu; }
#define XB_SPIN(cond, bar) do { unsigned _sp = 0; while (cond) { __builtin_amdgcn_s_sleep(1); \
    if ((++_sp & 255u) == 0u) { if (xb_ld(&(bar)[XB_TMO])) break; if (_sp > XB_SPIN_CAP) { atomicAdd(&(bar)[XB_TMO], 1u); break; } } } } while (0)

struct XcdBarrier {
    unsigned* bar; unsigned x;
    volatile LAS unsigned* st;
};

__device__ __forceinline__ XcdBarrier xcd_barrier_post(unsigned* bar, volatile LAS unsigned* st) {
    XcdBarrier b; b.bar = bar; b.x = xb_xcc_id(); b.st = st;
    if (threadIdx.x == 0) (void)xb_add(&bar[XB_XCNT(b.x)], 1u);
    return b;
}
__device__ __forceinline__ void xcd_barrier_complete(unsigned* bar, unsigned x, unsigned& nloc, unsigned& nx) {
    const unsigned G = gridDim.x * gridDim.y * gridDim.z;
    unsigned sum, cnt, mine, sp = 0u;
    for (;;) {
        sum = 0u; cnt = 0u; mine = 0u;
#pragma unroll
        for (unsigned j = 0; j < 16; ++j) { const unsigned c = xb_ld(&bar[XB_XCNT(j)]); sum += c; cnt += (c > 0u) ? 1u : 0u; mine = (j == x) ? c : mine; }
        if (sum == G) break;
        __builtin_amdgcn_s_sleep(1);
        if ((++sp & 255u) == 0u) { if (xb_ld(&bar[XB_TMO])) break; if (sp > XB_SPIN_CAP) { atomicAdd(&bar[XB_TMO], 1u); break; } }
    }
    nloc = mine > 0u ? mine : 1u; nx = cnt > 0u ? cnt : 1u;
}

__device__ __forceinline__ void xcd_barrier(const XcdBarrier& b) {
    asm volatile("s_waitcnt vmcnt(0)" ::: "memory");
    __syncthreads();
    if (threadIdx.x == 0) {
        unsigned* bar = b.bar;
        __builtin_amdgcn_s_waitcnt(0);
        unsigned nloc = b.st[0], nx = b.st[1];
        if (nloc == 0u) { xcd_barrier_complete(bar, b.x, nloc, nx); b.st[0] = nloc; b.st[1] = nx; }
        const unsigned old = xb_add(&bar[XB_XSUB(b.x)], 1u);
        const unsigned gen = old / nloc;
        if (old + 1u == (gen + 1u) * nloc) {
            __builtin_amdgcn_fence(__ATOMIC_RELEASE, "agent");
            asm volatile("s_waitcnt vmcnt(0)" ::: "memory");
            const unsigned og = xb_add(&bar[XB_TOP], 1u);
            const unsigned tg = og / nx;
            if (og + 1u == (tg + 1u) * nx) xb_add(&bar[XB_TOPGEN], 1u);
            else XB_SPIN(xb_ld(&bar[XB_TOPGEN]) == tg, bar);
            __builtin_amdgcn_fence(__ATOMIC_ACQUIRE, "agent");
            xb_add(&bar[XB_XGEN(b.x)], 1u);
            asm volatile("s_waitcnt vmcnt(0)" ::: "memory");
        } else {
            XB_SPIN(xb_ld(&bar[XB_XGEN(b.x)]) == gen, bar);
            __builtin_amdgcn_fence(__ATOMIC_ACQUIRE, "agent");
            asm volatile("s_waitcnt vmcnt(0)" ::: "memory");
        }
    }
    __syncthreads();
}
constexpr int NWAVES = 8, NTHREADS = 512;
constexpr int T = 16384, D = 1024, SEQ = 4096, NBATCH = 4, NMEM = 256, NEXP = 32, TOPK = 4;
constexpr int NPROJ = 9728;
constexpr int XS_ROWS = T * TOPK + NEXP * 256;
constexpr float EPS = 1e-6f, LOG2E = 1.4426950408889634f, LN2 = 0.6931471805599453f;
#ifndef MK_N_LAUNCHES
#define MK_N_LAUNCHES 1
#endif
constexpr int N_PHASES = 14;
constexpr int N_LAUNCHES = MK_N_LAUNCHES;

constexpr size_t MiB = 1u << 20;
constexpr size_t WS_CTL = 0, CTL_ZERO_BYTES = 1 * MiB;
constexpr size_t CTL_SS2 = 256 * 1024, CTL_CNT = 384 * 1024, CTL_ROWTOK = 640 * 1024;
constexpr size_t WS_WCQ = 1 * MiB, WS_WCO = 2 * MiB, WS_WO = 3 * MiB, WS_KV = 5 * MiB;
constexpr size_t WS_TOPI = 7 * MiB, WS_TOPW = WS_TOPI + 256 * 1024, WS_RSTD3 = WS_TOPW + 256 * 1024, WS_ROWSLOT = WS_RSTD3 + 64 * 1024;
constexpr size_t WS_EXPGU = 8 * MiB, WS_EXPD = 136 * MiB;
constexpr size_t WS_PROJ = 8 * MiB, WS_U1 = 312 * MiB, WS_W1T = 344 * MiB, WS_OG = 312 * MiB, WS_LSE = 360 * MiB;
constexpr size_t WS_WBA = 363 * MiB, WS_WBC = 364 * MiB, WS_MN = 366 * MiB, WS_YA = 368 * MiB, WS_YC = 384 * MiB, WS_MIX = 416 * MiB, WS_WCKV = 448 * MiB;
constexpr size_t WS_H1 = 200 * MiB, WS_H1B = 264 * MiB, WS_Q2 = 296 * MiB, WS_O2 = 312 * MiB;
constexpr size_t WS_U3 = 200 * MiB, WS_HDN = 344 * MiB, WS_Y = 200 * MiB, WS_END = 488 * MiB;
constexpr size_t WS_HIST = WS_ROWSLOT + 288 * 1024;
static_assert(WS_ROWSLOT + (size_t)XS_ROWS * 4 <= WS_HIST && WS_HIST + 256 * 32 * 4 <= WS_EXPGU && CTL_ROWTOK + (size_t)XS_ROWS * 4 <= CTL_ZERO_BYTES, "misc region");
static_assert(WS_U3 + (size_t)T * D * 2 <= WS_HDN && WS_HDN + (size_t)XS_ROWS * D * 2 <= WS_END, "moe rows");
constexpr int CW_TMO = 0, CW_CODE = 1, CW_BAR = 4096;

constexpr int LDS_BYTES = 163840;
constexpr int TBL_OFF = 163840 - 2048;
constexpr int ROWBUF_OFF = 131072, ROWBUF_UNITS = 24;
constexpr int MISC_OFF = 163840 - 256;

struct Frame {
    LAS unsigned char* lds;
    volatile LAS unsigned* MISC;
    gu32* ctl;
    unsigned char* ws;
    int tid, lane, wave, vcu, G;
};
__device__ __forceinline__ float wave_sum(float v) {
#pragma unroll
    for (int o = 1; o < 64; o <<= 1) v += __shfl_xor(v, o);
    return v;
}
typedef unsigned long long u64;
__device__ __forceinline__ float bf_lo(unsigned w) { return __builtin_bit_cast(float, w << 16); }
__device__ __forceinline__ float bf_hi(unsigned w) { return __builtin_bit_cast(float, w & 0xffff0000u); }

__device__ __forceinline__ void transpose_item(const float* W, int K, int N, bf16* WT, int drow, int k0, int n0, const float* gain, LAS float* scr, int lane) {
#pragma unroll 8
    for (int i = 0; i < 32; ++i) { const int kk = 2 * i + (lane >> 5); float w = W[(size_t)(k0 + kk) * N + n0 + (lane & 31)]; if (gain) w *= gain[k0 + kk]; scr[kk * 33 + (lane & 31)] = w; }
    LDS_WAIT(); asm volatile("" ::: "memory");
    const int c = lane & 7;
#pragma unroll
    for (int j = 0; j < 4; ++j) { const int n = (lane >> 3) + 8 * j; const LAS float* s = scr + (8 * c) * 33 + n;
        v4u o; o.x = pk2(s[0 * 33], s[1 * 33]); o.y = pk2(s[2 * 33], s[3 * 33]); o.z = pk2(s[4 * 33], s[5 * 33]); o.w = pk2(s[6 * 33], s[7 * 33]);
        *(GAS v4u*)(WT + (size_t)(drow + n) * K + k0 + 8 * c) = o; }
    LDS_WAIT(); asm volatile("" ::: "memory");
}
__device__ __forceinline__ bool transpose_mat(int& r, const float* W, int K, int N, bf16* WT, int drow0, const float* gain, LAS float* scr, int lane) {
    const int nblk = N / 32, items = (K / 64) * nblk;
    if (r < items) { const int kb = r / nblk, nb = r % nblk; transpose_item(W, K, N, WT, drow0 + 32 * nb, 64 * kb, 32 * nb, gain, scr, lane); return true; }
    r -= items; return false;
}
__device__ __forceinline__ void rms_row_to_bf16(const float* xrow, const float* gain, bf16* orow, int lane) {
    const GAS f32x4* xr = (const GAS f32x4*)xrow + lane; const GAS f32x4* gr = (const GAS f32x4*)gain + lane;
    f32x4 v[4]; float s = 0.f;
#pragma unroll
    for (int j = 0; j < 4; ++j) { v[j] = xr[64 * j]; s += (v[j].x * v[j].x + v[j].y * v[j].y) + (v[j].z * v[j].z + v[j].w * v[j].w); }
    const float rstd = 1.f / sqrtf(wave_sum(s) * (1.f / D) + EPS);
    GAS u64* o8 = (GAS u64*)orow + lane;
#pragma unroll
    for (int j = 0; j < 4; ++j) { const f32x4 g = gr[64 * j]; o8[64 * j] = (u64)pk2(v[j].x * rstd * g.x, v[j].y * rstd * g.y) | ((u64)pk2(v[j].z * rstd * g.z, v[j].w * rstd * g.w) << 32); }
}

__device__ __forceinline__ int xcd_remap(int wgid, int nwg) { const int q = nwg / 8, r = nwg % 8, xcd = wgid % 8, off = wgid / 8; return (xcd < r ? xcd * (q + 1) : r * (q + 1) + (xcd - r) * q) + off; }
struct MoeOrder {
    const volatile LAS int* tpre; int npn, G, c;
    __device__ __forceinline__ bool next(int i, pg8::Unit& u) const {
        const int total = tpre[32] * npn; const long L = (long)i * G + c; if (L >= total) return false;
        const int U = xcd_remap((int)L, total);
        int e = 0;
#pragma unroll 1
        for (int k = 1; k < 32; ++k) if (tpre[k] * npn <= U) e = k;
        const int t0 = tpre[e], nt = tpre[e + 1] - t0, Ul = U - t0 * npn;
        u.pm = t0 + Ul % nt; u.pn = e * npn + Ul / nt; return true;
    }
    __device__ __forceinline__ void a_ready(const pg8::Unit&) const {}
    __device__ __forceinline__ void done(const pg8::Unit&) const {}
};
struct In {
    const float *x, *mem, *norm_mix, *w_in, *conv_w, *w_ba, *w_bc, *w_gate, *b_gate, *w_out, *norm_cross, *norm_mem, *w_cq, *w_ckv, *w_co, *norm_moe,
                *router_w, *router_b, *w_eg, *b_eg, *w_eu, *b_eu, *w_ed, *b_ed, *norm_final;
};

__device__ __forceinline__ void phase_prologue(Frame& F, const In& in) {
    LAS float* scr = (LAS float*)(F.lds + F.wave * 16384);
    const int gw = F.vcu * NWAVES + F.wave, NGW = F.G * NWAVES;
    unsigned char* ws = F.ws;
    constexpr int NITEMS = 16 * 240 + 16 * 64 + 8 * 32 + 16 * 32 + 16 * 32 + 16 * 16 + 16 * 32 + 8 * 32;
    for (int it = gw; it < NITEMS; it += NGW) {
        int r = it;
        if (transpose_mat(r, in.w_in, 1024, 7680, (bf16*)(ws + WS_W1T), 0, nullptr, scr, F.lane)) continue;
        if (transpose_mat(r, in.w_gate, 1024, 2048, (bf16*)(ws + WS_W1T), 7680, nullptr, scr, F.lane)) continue;
        if (transpose_mat(r, in.w_ba, 512, 1024, (bf16*)(ws + WS_WBA), 0, nullptr, scr, F.lane)) continue;
        if (transpose_mat(r, in.w_bc, 1024, 1024, (bf16*)(ws + WS_WBC), 0, nullptr, scr, F.lane)) continue;
        if (transpose_mat(r, in.w_out, 1024, 1024, (bf16*)(ws + WS_WO), 0, nullptr, scr, F.lane)) continue;
        if (transpose_mat(r, in.w_cq, 1024, 512, (bf16*)(ws + WS_WCQ), 0, in.norm_cross, scr, F.lane)) continue;
        if (transpose_mat(r, in.w_ckv, 1024, 1024, (bf16*)(ws + WS_WCKV), 0, nullptr, scr, F.lane)) continue;
        transpose_mat(r, in.w_co, 512, 1024, (bf16*)(ws + WS_WCO), 0, nullptr, scr, F.lane);
    }
    for (int m = gw; m < T; m += NGW) rms_row_to_bf16(in.x + (size_t)m * D, in.norm_mix, (bf16*)(ws + WS_U1) + (size_t)m * D, F.lane);
    for (int m = gw; m < NBATCH * NMEM; m += NGW) rms_row_to_bf16(in.mem + (size_t)m * D, in.norm_mem, (bf16*)(ws + WS_MN) + (size_t)m * D, F.lane);
}

__device__ __forceinline__ void phase_expert_convert(Frame& F, const In& in) {
    LAS float* scr = (LAS float*)(F.lds + F.wave * 16384);
    const int gw = F.vcu * NWAVES + F.wave, NGW = F.G * NWAVES;
    constexpr int PER = 16 * 32, NITEMS = NEXP * 3 * PER;
    for (int it = gw; it < NITEMS; it += NGW) {
        const int mtx = it / PER, r = it % PER, e = mtx / 3, which = mtx % 3, kb = r / 32, nb = r % 32, n0 = 32 * nb;
        if (which == 0)      transpose_item(in.w_eg + (size_t)e * D * D, D, D, (bf16*)(F.ws + WS_EXPGU) + (size_t)e * 2048 * D, (n0 >> 7) * 256 + (n0 & 127), 64 * kb, n0, nullptr, scr, F.lane);
        else if (which == 1) transpose_item(in.w_eu + (size_t)e * D * D, D, D, (bf16*)(F.ws + WS_EXPGU) + (size_t)e * 2048 * D, (n0 >> 7) * 256 + 128 + (n0 & 127), 64 * kb, n0, nullptr, scr, F.lane);
        else                 transpose_item(in.w_ed + (size_t)e * D * D, D, D, (bf16*)(F.ws + WS_EXPD) + (size_t)e * D * D, n0, 64 * kb, n0, nullptr, scr, F.lane);
    }
}


typedef short s16x4v __attribute__((ext_vector_type(4)));
typedef short bf16x8v __attribute__((ext_vector_type(8)));
__device__ __forceinline__ s16x4v lds_tr16(const LAS bf16* p) { return __builtin_bit_cast(s16x4v, __builtin_amdgcn_ds_read_tr16_b64_v4i16((LAS s16x4v*)p)); }
__device__ __forceinline__ void dil_attn_unit_mfma(Frame& F, int unit) {
    const int rn = unit & 31, bgh = unit >> 5, h = bgh & 7, bg = bgh >> 3, g = bg % 3, b = bg / 3;
    const int dil = g == 0 ? 1 : (g == 1 ? 4 : 16), nper = 32 / dil, r = rn / nper, n = rn % nper;
    const bf16* PROJ = (const bf16*)(F.ws + WS_PROJ);
    LAS bf16* Ks = (LAS bf16*)F.lds; LAS bf16* Vs = Ks + 256 * 72;
    const int tid = F.tid, lane = F.lane, w = F.wave, qi = lane & 15, G = lane >> 4;
#pragma unroll
    for (int it = 0; it < 4; ++it) {
        const int row = (tid >> 3) + 64 * it, ch = tid & 7, j = 128 * (n - 1) + row;
        v4u kv = (v4u){0u, 0u, 0u, 0u}, vv = kv;
        if (j >= 0) { const size_t grow = (size_t)b * SEQ + (size_t)j * dil + r; const bf16* p = PROJ + grow * NPROJ + g * 1536 + h * 64 + ch * 8; kv = *(const GAS v4u*)(p + 512); vv = *(const GAS v4u*)(p + 1024); }
        *(LAS v4u*)(Ks + row * 72 + ch * 8) = kv; *(LAS v4u*)(Vs + row * 72 + ch * 8) = vv;
    }
    if (tid < 128) *(LAS v4u*)(Vs + (256 + (tid >> 3)) * 72 + (tid & 7) * 8) = (v4u){0u, 0u, 0u, 0u};
    const int ql = 16 * w + qi;
    const size_t growq = (size_t)b * SEQ + (size_t)(128 * n + ql) * dil + r;
    const bf16* qp = PROJ + growq * NPROJ + g * 1536 + h * 64 + 8 * G;
    const bf16x8v q0 = *(const GAS bf16x8v*)qp, q1 = *(const GAS bf16x8v*)(qp + 32);
    __syncthreads();
    pg8::f32x4 st[9];
#pragma unroll
    for (int t = 0; t < 9; ++t) {
        const LAS bf16* kp = Ks + (16 * (w + t) + qi) * 72 + 8 * G;
        const bf16x8v k0 = *(const LAS bf16x8v*)kp, k1 = *(const LAS bf16x8v*)(kp + 32);
        pg8::f32x4 a = (pg8::f32x4){0.f, 0.f, 0.f, 0.f};
        a = __builtin_amdgcn_mfma_f32_16x16x32_bf16(k0, q0, a, 0, 0, 0);
        a = __builtin_amdgcn_mfma_f32_16x16x32_bf16(k1, q1, a, 0, 0, 0);
        st[t] = a;
    }
    const float slope2 = exp2f(-(float)(h + 1)) * (float)dil * LOG2E, sc = 0.125f * LOG2E;
    const int jq = 128 * (n - 1);
    float mx = -1e30f;
#pragma unroll
    for (int t = 0; t < 9; ++t)
#pragma unroll
        for (int i = 0; i < 4; ++i) {
            const int kl = 16 * (w + t) + 4 * G + i, dk = kl - ql;
            const bool ok = dk >= 0 && dk <= 128 && (jq + kl) >= 0;
            const float sv = ok ? st[t][i] * sc - slope2 * (float)(128 - dk) : -1e30f;
            st[t][i] = sv; mx = fmaxf(mx, sv);
        }
    mx = fmaxf(mx, __shfl_xor(mx, 16)); mx = fmaxf(mx, __shfl_xor(mx, 32));
    float l = 0.f;
#pragma unroll
    for (int t = 0; t < 9; ++t)
#pragma unroll
        for (int i = 0; i < 4; ++i) { const float pv = st[t][i] > -1e29f ? __builtin_amdgcn_exp2f(st[t][i] - mx) : 0.f; st[t][i] = pv; l += pv; }
    l += __shfl_xor(l, 16); l += __shfl_xor(l, 32);
    pg8::f32x4 o[4];
#pragma unroll
    for (int dm = 0; dm < 4; ++dm) o[dm] = (pg8::f32x4){0.f, 0.f, 0.f, 0.f};
#pragma unroll
    for (int s5 = 0; s5 < 5; ++s5) {
        const pg8::f32x4 pa = st[2 * s5], pb = (2 * s5 + 1 < 9) ? st[2 * s5 + 1] : (pg8::f32x4){0.f, 0.f, 0.f, 0.f};
        bf16x8v pf;
        { const unsigned w0 = pk2(pa[0], pa[1]), w1 = pk2(pa[2], pa[3]), w2 = pk2(pb[0], pb[1]), w3 = pk2(pb[2], pb[3]);
          pf = __builtin_bit_cast(bf16x8v, (v4u){w0, w1, w2, w3}); }
        const LAS bf16* vbase = Vs + (16 * (w + 2 * s5) + 4 * G + (qi >> 2)) * 72 + 4 * (qi & 3);
#pragma unroll
        for (int dm = 0; dm < 4; ++dm) {
            const s16x4v lo = lds_tr16(vbase + 16 * dm), hi = lds_tr16(vbase + 16 * 72 + 16 * dm);
            const bf16x8v vf = (bf16x8v){lo[0], lo[1], lo[2], lo[3], hi[0], hi[1], hi[2], hi[3]};
            o[dm] = __builtin_amdgcn_mfma_f32_16x16x32_bf16(vf, pf, o[dm], 0, 0, 0);
        }
    }
    const float inv = 1.f / l;
    bf16* og = (bf16*)(F.ws + WS_OG) + ((size_t)g * T + growq) * 512 + h * 64 + 4 * G;
#pragma unroll
    for (int dm = 0; dm < 4; ++dm) *(GAS u64*)(og + 16 * dm) = (u64)pk2(o[dm][0] * inv, o[dm][1] * inv) | ((u64)pk2(o[dm][2] * inv, o[dm][3] * inv) << 32);
    if (G == 0) ((float*)(F.ws + WS_LSE))[((size_t)g * T + growq) * 8 + h] = (mx + __builtin_amdgcn_logf(l)) * LN2;
    __syncthreads();
}

__device__ __forceinline__ void phase_combine_conv(Frame& F, const In& in) {
    const int gw = F.vcu * NWAVES + F.wave, NGW = F.G * NWAVES, lane = F.lane;
    const bf16* PROJ = (const bf16*)(F.ws + WS_PROJ); const bf16* OG = (const bf16*)(F.ws + WS_OG); const float* LSE = (const float*)(F.ws + WS_LSE);
    for (int t = gw; t < T; t += NGW) {
        { const int head = lane >> 3;
          const float l0 = LSE[((size_t)0 * T + t) * 8 + head], l1 = LSE[((size_t)1 * T + t) * 8 + head], l2 = LSE[((size_t)2 * T + t) * 8 + head];
          const float mx = fmaxf(l0, fmaxf(l1, l2)); float w0 = __expf(l0 - mx), w1 = __expf(l1 - mx), w2 = __expf(l2 - mx); const float inv = 1.f / (w0 + w1 + w2); w0 *= inv; w1 *= inv; w2 *= inv;
          const v4u a = *(const GAS v4u*)(OG + ((size_t)0 * T + t) * 512 + 8 * lane), b = *(const GAS v4u*)(OG + ((size_t)1 * T + t) * 512 + 8 * lane), c = *(const GAS v4u*)(OG + ((size_t)2 * T + t) * 512 + 8 * lane);
          v4u o;
          o.x = pk2(w0 * bf_lo(a.x) + w1 * bf_lo(b.x) + w2 * bf_lo(c.x), w0 * bf_hi(a.x) + w1 * bf_hi(b.x) + w2 * bf_hi(c.x));
          o.y = pk2(w0 * bf_lo(a.y) + w1 * bf_lo(b.y) + w2 * bf_lo(c.y), w0 * bf_hi(a.y) + w1 * bf_hi(b.y) + w2 * bf_hi(c.y));
          o.z = pk2(w0 * bf_lo(a.z) + w1 * bf_lo(b.z) + w2 * bf_lo(c.z), w0 * bf_hi(a.z) + w1 * bf_hi(b.z) + w2 * bf_hi(c.z));
          o.w = pk2(w0 * bf_lo(a.w) + w1 * bf_lo(b.w) + w2 * bf_lo(c.w), w0 * bf_hi(a.w) + w1 * bf_hi(b.w) + w2 * bf_hi(c.w));
          *(GAS v4u*)((bf16*)(F.ws + WS_YA) + (size_t)t * 512 + 8 * lane) = o; }
        const int pos = t & (SEQ - 1);
#pragma unroll
        for (int half = 0; half < 2; ++half) {
            const int c = 8 * lane + 512 * half;
            float z[3][8];
#pragma unroll
            for (int dd = 0; dd < 3; ++dd) {
                const int back = 2 - dd;
                if (pos - back >= 0) { const bf16* p = PROJ + (size_t)(t - back) * NPROJ + 4608 + c; const v4u gc = *(const GAS v4u*)(p + 1024), xc = *(const GAS v4u*)(p + 2048);
                    z[dd][0] = bf_lo(gc.x) * bf_lo(xc.x); z[dd][1] = bf_hi(gc.x) * bf_hi(xc.x); z[dd][2] = bf_lo(gc.y) * bf_lo(xc.y); z[dd][3] = bf_hi(gc.y) * bf_hi(xc.y);
                    z[dd][4] = bf_lo(gc.z) * bf_lo(xc.z); z[dd][5] = bf_hi(gc.z) * bf_hi(xc.z); z[dd][6] = bf_lo(gc.w) * bf_lo(xc.w); z[dd][7] = bf_hi(gc.w) * bf_hi(xc.w); }
                else {
#pragma unroll
                    for (int i = 0; i < 8; ++i) z[dd][i] = 0.f; }
            }
            const v4u gb = *(const GAS v4u*)(PROJ + (size_t)t * NPROJ + 4608 + c);
            float y[8];
#pragma unroll
            for (int i = 0; i < 8; ++i) y[i] = in.conv_w[c + i] * z[0][i] + in.conv_w[1024 + c + i] * z[1][i] + in.conv_w[2048 + c + i] * z[2][i];
            v4u o; o.x = pk2(bf_lo(gb.x) * y[0], bf_hi(gb.x) * y[1]); o.y = pk2(bf_lo(gb.y) * y[2], bf_hi(gb.y) * y[3]); o.z = pk2(bf_lo(gb.z) * y[4], bf_hi(gb.z) * y[5]); o.w = pk2(bf_lo(gb.w) * y[6], bf_hi(gb.w) * y[7]);
            *(GAS v4u*)((bf16*)(F.ws + WS_YC) + (size_t)t * 1024 + c) = o;
        }
    }
}


__device__ __forceinline__ void cross_attn_unit_mfma(Frame& F, int unit) {
    const int qc = unit & 31, bh = unit >> 5, h = bh & 3, b = bh >> 2, tid = F.tid, lane = F.lane, w = F.wave, qi = lane & 15, G = lane >> 4;
    const bf16* KV = (const bf16*)(F.ws + WS_KV); const bf16* Q2 = (const bf16*)(F.ws + WS_Q2);
    LAS bf16* Ks = (LAS bf16*)F.lds; LAS bf16* Vs = Ks + 256 * 136;
#pragma unroll
    for (int it = 0; it < 8; ++it) {
        const int row = (tid >> 4) + 32 * it, ch = tid & 15; const bf16* p = KV + (size_t)(b * NMEM + row) * 1024 + h * 128 + ch * 8;
        *(LAS v4u*)(Ks + row * 136 + ch * 8) = *(const GAS v4u*)p; *(LAS v4u*)(Vs + row * 136 + ch * 8) = *(const GAS v4u*)(p + 512);
    }
    const size_t grow = (size_t)b * SEQ + 128 * qc + 16 * w + qi;
    bf16x8v q[4];
#pragma unroll
    for (int ks = 0; ks < 4; ++ks) q[ks] = *(const GAS bf16x8v*)(Q2 + grow * 512 + h * 128 + 32 * ks + 8 * G);
    __syncthreads();
    pg8::f32x4 st[16];
#pragma unroll
    for (int t = 0; t < 16; ++t) {
        const LAS bf16* kp = Ks + (16 * t + qi) * 136 + 8 * G;
        pg8::f32x4 a = (pg8::f32x4){0.f, 0.f, 0.f, 0.f};
#pragma unroll
        for (int ks = 0; ks < 4; ++ks) a = __builtin_amdgcn_mfma_f32_16x16x32_bf16(*(const LAS bf16x8v*)(kp + 32 * ks), q[ks], a, 0, 0, 0);
        st[t] = a;
    }
    const float sc = 0.08838834764831845f * LOG2E;
    float mx = -1e30f;
#pragma unroll
    for (int t = 0; t < 16; ++t)
#pragma unroll
        for (int i = 0; i < 4; ++i) { st[t][i] *= sc; mx = fmaxf(mx, st[t][i]); }
    mx = fmaxf(mx, __shfl_xor(mx, 16)); mx = fmaxf(mx, __shfl_xor(mx, 32));
    float l = 0.f;
#pragma unroll
    for (int t = 0; t < 16; ++t)
#pragma unroll
        for (int i = 0; i < 4; ++i) { const float pv = __builtin_amdgcn_exp2f(st[t][i] - mx); st[t][i] = pv; l += pv; }
    l += __shfl_xor(l, 16); l += __shfl_xor(l, 32);
    pg8::f32x4 o[8];
#pragma unroll
    for (int dm = 0; dm < 8; ++dm) o[dm] = (pg8::f32x4){0.f, 0.f, 0.f, 0.f};
#pragma unroll
    for (int s8 = 0; s8 < 8; ++s8) {
        const pg8::f32x4 pa = st[2 * s8], pb = st[2 * s8 + 1];
        const bf16x8v pf = __builtin_bit_cast(bf16x8v, (v4u){pk2(pa[0], pa[1]), pk2(pa[2], pa[3]), pk2(pb[0], pb[1]), pk2(pb[2], pb[3])});
        const LAS bf16* vbase = Vs + (32 * s8 + 4 * G + (qi >> 2)) * 136 + 4 * (qi & 3);
#pragma unroll
        for (int dm = 0; dm < 8; ++dm) {
            const s16x4v lo = lds_tr16(vbase + 16 * dm), hi = lds_tr16(vbase + 16 * 136 + 16 * dm);
            const bf16x8v vf = (bf16x8v){lo[0], lo[1], lo[2], lo[3], hi[0], hi[1], hi[2], hi[3]};
            o[dm] = __builtin_amdgcn_mfma_f32_16x16x32_bf16(vf, pf, o[dm], 0, 0, 0);
        }
    }
    const float inv = 1.f / l;
    bf16* op = (bf16*)(F.ws + WS_O2) + grow * 512 + h * 128 + 4 * G;
#pragma unroll
    for (int dm = 0; dm < 8; ++dm) *(GAS u64*)(op + 16 * dm) = (u64)pk2(o[dm][0] * inv, o[dm][1] * inv) | ((u64)pk2(o[dm][2] * inv, o[dm][3] * inv) << 32);
    __syncthreads();
}

__device__ __forceinline__ float rlane(float x, int L) { int r = __builtin_amdgcn_readlane(__builtin_bit_cast(int, x), L); asm volatile("" : "+s"(r)); return __builtin_bit_cast(float, r); }
__device__ __forceinline__ void phase_router(Frame& F, const In& in, const float* H2) {
    LAS float* wl = (LAS float*)F.lds; volatile LAS int* hist = (volatile LAS int*)(F.lds + TBL_OFF + 1024);
    for (int i = F.tid; i < 1024 * 32 / 4; i += NTHREADS) ((LAS f32x4*)wl)[i] = ((const GAS f32x4*)in.router_w)[i];
    if (F.tid < 32) hist[F.tid] = 0;
    __syncthreads();
    const int lane = F.lane, e = lane & 31, tpb = (T + F.G - 1) / F.G, t0 = F.vcu * tpb, t1 = (t0 + tpb < T) ? t0 + tpb : T;
    int* topi = (int*)(F.ws + WS_TOPI); float* topw = (float*)(F.ws + WS_TOPW); bf16* U3 = (bf16*)(F.ws + WS_U3);
    const float rb = in.router_b[e];
    for (int t = t0 + F.wave; t < t1; t += NWAVES) {
        const GAS f32x4* xr = (const GAS f32x4*)(H2 + (size_t)t * D) + lane; const GAS f32x4* gr = (const GAS f32x4*)in.norm_moe + lane;
        f32x4 v[4]; float s = 0.f;
#pragma unroll
        for (int j = 0; j < 4; ++j) { v[j] = xr[64 * j]; s += (v[j].x * v[j].x + v[j].y * v[j].y) + (v[j].z * v[j].z + v[j].w * v[j].w); }
        const float rstd = 1.f / sqrtf(wave_sum(s) * (1.f / D) + EPS);
        GAS u64* u3r = (GAS u64*)(U3 + (size_t)t * D) + lane;
#pragma unroll
        for (int j = 0; j < 4; ++j) { const f32x4 g = gr[64 * j]; v[j] = v[j] * g * rstd; u3r[64 * j] = (u64)pk2(v[j].x, v[j].y) | ((u64)pk2(v[j].z, v[j].w) << 32); }
        float a0 = 0.f, a1 = 0.f, a2 = 0.f, a3 = 0.f;
#pragma unroll
        for (int j = 0; j < 4; ++j) {
#pragma unroll 4
            for (int L = 0; L < 64; ++L) {
                const LAS float* wp = wl + (size_t)(4 * (64 * j + L)) * 32 + e;
                a0 += rlane(v[j].x, L) * wp[0];
                a1 += rlane(v[j].y, L) * wp[32];
                a2 += rlane(v[j].z, L) * wp[64];
                a3 += rlane(v[j].w, L) * wp[96];
            }
        }
        float val = (a0 + a1) + (a2 + a3) + rb; const int idx = e;
        float tv0 = 0.f, tv1 = 0.f, tv2 = 0.f, tv3 = 0.f; int ti0 = 0, ti1 = 0, ti2 = 0, ti3 = 0;
#pragma unroll
        for (int k = 0; k < 4; ++k) {
            float bv = val; int bi = idx;
#pragma unroll
            for (int off = 1; off < 32; off <<= 1) { const float ov = __shfl_xor(bv, off); const int oi = __shfl_xor(bi, off); if (ov > bv || (ov == bv && oi < bi)) { bv = ov; bi = oi; } }
            if (k == 0) { tv0 = bv; ti0 = bi; } else if (k == 1) { tv1 = bv; ti1 = bi; } else if (k == 2) { tv2 = bv; ti2 = bi; } else { tv3 = bv; ti3 = bi; }
            if (idx == bi) val = -INFINITY;
        }
        const float e1 = __expf(tv1 - tv0), e2 = __expf(tv2 - tv0), e3 = __expf(tv3 - tv0), inv = 1.f / (1.f + e1 + e2 + e3);
        if (lane < 4) {
            const int ei = lane == 0 ? ti0 : (lane == 1 ? ti1 : (lane == 2 ? ti2 : ti3));
            const float wv = (lane == 0 ? 1.f : (lane == 1 ? e1 : (lane == 2 ? e2 : e3))) * inv;
            topi[t * 4 + lane] = ei; topw[t * 4 + lane] = wv;
            __hip_atomic_fetch_add((LAS int*)(F.lds + TBL_OFF + 1024) + ei, 1, __ATOMIC_RELAXED, __HIP_MEMORY_SCOPE_WORKGROUP);
        }
    }
    __syncthreads();
    if (F.tid < 32) ((int*)(F.ws + WS_HIST))[F.vcu * 32 + F.tid] = hist[F.tid];
    __syncthreads();
}

__device__ __forceinline__ void phase_assign(Frame& F) {
    volatile LAS int* tb = (volatile LAS int*)(F.lds + TBL_OFF);
    LAS int* part = (LAS int*)F.lds;
    const int* HIST = (const int*)(F.ws + WS_HIST); const int tid = F.tid, e = tid & 31, pt = tid >> 5;
    { int tot = 0, bef = 0; for (int b = pt; b < F.G; b += 16) { const int h = HIST[b * 32 + e]; tot += h; bef += (b < F.vcu) ? h : 0; } part[pt * 64 + e] = tot; part[pt * 64 + 32 + e] = bef; }
    __syncthreads();
    if (tid < 32) { int tot = 0, bef = 0; for (int q = 0; q < 16; ++q) { tot += part[q * 64 + tid]; bef += part[q * 64 + 32 + tid]; } tb[64 + tid] = tot; tb[128 + tid] = bef; tb[160 + tid] = 0; }
    __syncthreads();
    if (tid == 0) { int acc = 0; for (int k = 0; k < NEXP; ++k) { tb[k] = acc; acc += (tb[64 + k] + 255) >> 8; } tb[32] = acc; }
    __syncthreads();
    if (tid < 32) { tb[128 + tid] += tb[tid] * 256; if (F.vcu == 0) ((unsigned*)(F.ws + WS_CTL + CTL_CNT))[tid] = (unsigned)tb[64 + tid]; }
    __syncthreads();
    int* rowtok = (int*)(F.ws + WS_CTL + CTL_ROWTOK); int* rowslot = (int*)(F.ws + WS_ROWSLOT); const int* topi = (const int*)(F.ws + WS_TOPI);
    if (F.vcu < NEXP) { const int x = F.vcu; for (int R = tb[x] * 256 + tb[64 + x] + tid; R < tb[x + 1] * 256; R += NTHREADS) rowslot[R] = -1; }
    const int tpb = (T + F.G - 1) / F.G, t0 = F.vcu * tpb, t1 = (t0 + tpb < T) ? t0 + tpb : T;
    for (int a = t0 * 4 + tid; a < t1 * 4; a += NTHREADS) {
        const int x = topi[a];
        const int rank = __hip_atomic_fetch_add((LAS int*)(F.lds + TBL_OFF) + 160 + x, 1, __ATOMIC_RELAXED, __HIP_MEMORY_SCOPE_WORKGROUP);
        const int R = tb[128 + x] + rank; rowtok[R] = a >> 2; rowslot[R] = a;
    }
    __syncthreads();
}

__device__ __forceinline__ void build_tpre(Frame& F) {
    volatile LAS int* tpre = (volatile LAS int*)(F.lds + TBL_OFF);
    const unsigned* cnt = (const unsigned*)(F.ws + WS_CTL + CTL_CNT);
    if (F.tid == 0) { int acc = 0;
        for (int e = 0; e < NEXP; ++e) { tpre[e] = acc; const unsigned c = __hip_atomic_load(cnt + e, __ATOMIC_RELAXED, __HIP_MEMORY_SCOPE_AGENT); tpre[64 + e] = (int)c; acc += (int)((c + 255u) >> 8); }
        tpre[32] = acc; }
    __syncthreads();
}

__device__ __forceinline__ void phase_final(Frame& F, const In& in, const float* H2, float* OUT) {
    const int gw = F.vcu * NWAVES + F.wave, NGW = F.G * NWAVES, lane = F.lane;
    const bf16* Y = (const bf16*)(F.ws + WS_Y);
    for (int t = gw; t < T; t += NGW) {
        const GAS f32x4* xr = (const GAS f32x4*)(H2 + (size_t)t * D) + lane; const GAS f32x4* gr = (const GAS f32x4*)in.norm_final + lane;
        f32x4 v[4]; float s = 0.f;
#pragma unroll
        for (int j = 0; j < 4; ++j) v[j] = xr[64 * j];
#pragma unroll
        for (int k = 0; k < 4; ++k) { const GAS u64* yr = (const GAS u64*)(Y + (size_t)(t * 4 + k) * D) + lane;
#pragma unroll
            for (int j = 0; j < 4; ++j) { const u64 w = yr[64 * j]; const unsigned lo = (unsigned)w, hi = (unsigned)(w >> 32); v[j].x += bf_lo(lo); v[j].y += bf_hi(lo); v[j].z += bf_lo(hi); v[j].w += bf_hi(hi); } }
#pragma unroll
        for (int j = 0; j < 4; ++j) s += (v[j].x * v[j].x + v[j].y * v[j].y) + (v[j].z * v[j].z + v[j].w * v[j].w);
        const float rstd = 1.f / sqrtf(wave_sum(s) * (1.f / D) + EPS);
        GAS f32x4* orow = (GAS f32x4*)(OUT + (size_t)t * D) + lane;
#pragma unroll
        for (int j = 0; j < 4; ++j) orow[64 * j] = v[j] * gr[64 * j] * rstd;
    }
}
struct Args { const float* in[25]; float* out; unsigned char* ws; int ph_lo, ph_hi; };
#ifndef PG8_SP2
#define PG8_SP2 true
#endif
#ifndef PG8_ALIGN
#define PG8_ALIGN true
#endif
__global__ void __launch_bounds__(NTHREADS, 2) mega_fwd(Args args) {
    extern __shared__ __attribute__((aligned(16))) unsigned char lds[];
    Frame F;
    F.lds = (LAS unsigned char*)lds; F.MISC = (volatile LAS unsigned*)(F.lds + MISC_OFF);
    F.tid = threadIdx.x; F.lane = F.tid & 63; F.wave = __builtin_amdgcn_readfirstlane(F.tid >> 6);
    F.G = gridDim.x; { const int bx = blockIdx.x; F.vcu = (F.G % 8 == 0) ? (bx % 8) * (F.G / 8) + bx / 8 : bx; }
    F.ws = args.ws; F.ctl = (gu32*)(args.ws + WS_CTL);
    In in;
    in.x = args.in[0]; in.mem = args.in[1]; in.norm_mix = args.in[2]; in.w_in = args.in[3]; in.conv_w = args.in[4]; in.w_ba = args.in[5]; in.w_bc = args.in[6];
    in.w_gate = args.in[7]; in.b_gate = args.in[8]; in.w_out = args.in[9]; in.norm_cross = args.in[10]; in.norm_mem = args.in[11]; in.w_cq = args.in[12];
    in.w_ckv = args.in[13]; in.w_co = args.in[14]; in.norm_moe = args.in[15]; in.router_w = args.in[16]; in.router_b = args.in[17]; in.w_eg = args.in[18];
    in.b_eg = args.in[19]; in.w_eu = args.in[20]; in.b_eu = args.in[21]; in.w_ed = args.in[22]; in.b_ed = args.in[23]; in.norm_final = args.in[24];
    unsigned char* ws = args.ws;
    for (int u = F.tid; u < 64; u += NTHREADS) ((LAS unsigned*)(F.lds + MISC_OFF))[u] = 0u;
    __syncthreads();
    XcdBarrier bar; bar.bar = (unsigned*)(F.ctl + CW_BAR); bar.x = 0; bar.st = nullptr;
    if (N_LAUNCHES == 1) bar = xcd_barrier_post((unsigned*)(F.ctl + CW_BAR), F.MISC + 8);
    const int lo = args.ph_lo, hi = args.ph_hi;
#define IN(k) (lo <= (k) && (k) < hi)
#define SEAM(k) do { if (IN(k) && IN((k) + 1)) xcd_barrier(bar); } while (0)
    typedef pg8::bf16_t b16;

    if (IN(0)) { phase_prologue(F, in); } SEAM(0);

    if (IN(1)) {
        pg8::Gemm g{(const b16*)(ws + WS_U1), (const b16*)(ws + WS_W1T), T, NPROJ, D}; pg8::StaticOrder S; S.init(T, NPROJ, F.G, (int)blockIdx.x);
        pg8::EpiProj E{(b16*)(ws + WS_PROJ), in.b_gate};
        pg8::gemm_phase<pg8::EpiProj, pg8::StaticOrder, PG8_ALIGN, PG8_SP2>(F.lds, g, S, E);
    } SEAM(1);

    if (IN(2)) { for (int u = blockIdx.x; u < NBATCH * 3 * 8 * 32; u += F.G) dil_attn_unit_mfma(F, u); } SEAM(2);

    if (IN(3)) { phase_combine_conv(F, in); } SEAM(3);

    if (IN(4)) {
        { pg8::Gemm g{(const b16*)(ws + WS_YA), (const b16*)(ws + WS_WBA), T, D, 512}; pg8::StaticOrder S; S.init(T, D, F.G, (int)blockIdx.x);
          pg8::EpiMix<false> E{(b16*)(ws + WS_MIX), (const b16*)(ws + WS_PROJ)};
          pg8::gemm_phase<pg8::EpiMix<false>, pg8::StaticOrder, PG8_ALIGN, PG8_SP2>(F.lds, g, S, E); }
        { pg8::Gemm g{(const b16*)(ws + WS_YC), (const b16*)(ws + WS_WBC), T, D, D}; pg8::StaticOrder S; S.init(T, D, F.G, (int)blockIdx.x);
          pg8::EpiMix<true> E{(b16*)(ws + WS_MIX), (const b16*)(ws + WS_PROJ)};
          pg8::gemm_phase<pg8::EpiMix<true>, pg8::StaticOrder, PG8_ALIGN, PG8_SP2>(F.lds, g, S, E); }
    } SEAM(4);

    if (IN(5)) {
        { pg8::Gemm g{(const b16*)(ws + WS_MIX), (const b16*)(ws + WS_WO), T, D, D}; pg8::StaticOrder S; S.init(T, D, F.G, (int)blockIdx.x);
          pg8::EpiH1 E{in.x, (float*)(ws + WS_H1), (b16*)(ws + WS_H1B), (float*)(ws + WS_CTL + CTL_SS2)};
          pg8::gemm_phase<pg8::EpiH1, pg8::StaticOrder, PG8_ALIGN, PG8_SP2>(F.lds, g, S, E); }
        phase_expert_convert(F, in);
    } SEAM(5);

    if (IN(6)) {
        { pg8::Gemm g{(const b16*)(ws + WS_H1B), (const b16*)(ws + WS_WCQ), T, 512, D}; pg8::StaticOrder S; S.init(T, 512, F.G, (int)blockIdx.x);
          pg8::EpiQ2 E{(b16*)(ws + WS_Q2), (const float*)(ws + WS_CTL + CTL_SS2)};
          pg8::gemm_phase<pg8::EpiQ2, pg8::StaticOrder, PG8_ALIGN, PG8_SP2>(F.lds, g, S, E); }
        { pg8::Gemm g{(const b16*)(ws + WS_MN), (const b16*)(ws + WS_WCKV), NBATCH * NMEM, D, D}; pg8::StaticOrder S; S.init(NBATCH * NMEM, D, F.G, ((int)blockIdx.x + F.G - 128) % F.G);
          pg8::EpiPlain E{(b16*)(ws + WS_KV), D};
          pg8::gemm_phase<pg8::EpiPlain, pg8::StaticOrder, PG8_ALIGN, PG8_SP2>(F.lds, g, S, E); }
    } SEAM(6);

    if (IN(7)) { for (int u = blockIdx.x; u < NBATCH * 4 * 32; u += F.G) cross_attn_unit_mfma(F, u); } SEAM(7);

    if (IN(8)) {
        pg8::Gemm g{(const b16*)(ws + WS_O2), (const b16*)(ws + WS_WCO), T, D, 512}; pg8::StaticOrder S; S.init(T, D, F.G, (int)blockIdx.x);
        pg8::EpiH2 E{(const float*)(ws + WS_H1), args.out};
        pg8::gemm_phase<pg8::EpiH2, pg8::StaticOrder, PG8_ALIGN, PG8_SP2>(F.lds, g, S, E);
    } SEAM(8);

    if (IN(9)) { phase_router(F, in, args.out); } SEAM(9);

    if (IN(10)) { phase_assign(F); } SEAM(10);

    if (IN(11)) {
        build_tpre(F);
        pg8::Gemm g{(const b16*)(ws + WS_U3), (const b16*)(ws + WS_EXPGU), T, NEXP * 2048, D};
        MoeOrder S{(const volatile LAS int*)(F.lds + TBL_OFF), 8, F.G, (int)blockIdx.x};
        LAS int* rowbuf = (LAS int*)(F.lds + ROWBUF_OFF); const int* rowtok = (const int*)(ws + WS_CTL + CTL_ROWTOK);
        { pg8::Unit uu; for (int i = 0; i < ROWBUF_UNITS && S.next(i, uu); ++i) if (F.tid < 256) rowbuf[256 * i + F.tid] = rowtok[uu.pm * 256 + F.tid]; }
        __syncthreads();
        pg8::EpiHdn E{(b16*)(ws + WS_HDN), in.b_eg, in.b_eu};
        pg8::gemm_phase_gather<pg8::EpiHdn, MoeOrder>(F.lds, g, S, E, (const LAS int*)rowbuf);
    } SEAM(11);

    if (IN(12)) {
        build_tpre(F);
        pg8::Gemm g{(const b16*)(ws + WS_HDN), (const b16*)(ws + WS_EXPD), XS_ROWS, NEXP * 1024, D};
        MoeOrder S{(const volatile LAS int*)(F.lds + TBL_OFF), 4, F.G, (int)blockIdx.x};
        pg8::EpiY E{(b16*)(ws + WS_Y), in.b_ed, (const int*)(ws + WS_ROWSLOT), (const float*)(ws + WS_TOPW)};
        pg8::gemm_phase<pg8::EpiY, MoeOrder, PG8_ALIGN, PG8_SP2>(F.lds, g, S, E);
    } SEAM(12);

    if (IN(13)) { phase_final(F, in, args.out, args.out); }
#undef IN
#undef SEAM
}

extern "C" void kernel_launch(void* const* d_in, const int* in_sizes, int n_in, void* d_out, int out_size, void* d_ws, size_t ws_size, hipStream_t stream) {
    static int grid = 0;
    if (grid == 0) {
        if (n_in != 25 || in_sizes[0] != T * D || out_size != T * D || ws_size < WS_END) {
            fprintf(stderr, "kernel_launch: built for 25 inputs, x/out of %d floats, >= %zu bytes of workspace; got n_in %d, in0 %d, out %d, ws %zu; nothing launched\n", T * D, (size_t)WS_END, n_in, n_in > 0 ? in_sizes[0] : -1, out_size, ws_size);
            grid = -1; return; }
        int dev = 0, cus = 0, per_cu = 0;
        if (hipGetDevice(&dev) != hipSuccess || hipDeviceGetAttribute(&cus, hipDeviceAttributeMultiprocessorCount, dev) != hipSuccess) { fprintf(stderr, "kernel_launch: device query failed\n"); grid = -1; return; }
        if (hipFuncSetAttribute((const void*)mega_fwd, hipFuncAttributeMaxDynamicSharedMemorySize, LDS_BYTES) != hipSuccess) { fprintf(stderr, "kernel_launch: hipFuncSetAttribute(%d B LDS) failed\n", LDS_BYTES); grid = -1; return; }
        if (hipOccupancyMaxActiveBlocksPerMultiprocessor(&per_cu, (const void*)mega_fwd, NTHREADS, LDS_BYTES) != hipSuccess || per_cu < 1) { fprintf(stderr, "kernel_launch: occupancy query says %d workgroups per CU\n", per_cu); per_cu = 1; }
        (void)hipGetLastError();
        grid = cus < 256 ? cus : 256;
    }
    if (grid < 0) return;
    (void)hipMemsetAsync((char*)d_ws + WS_CTL, 0, CTL_ZERO_BYTES, stream);
    Args a{};
    for (int i = 0; i < 25; ++i) a.in[i] = (const float*)d_in[i];
    a.out = (float*)d_out; a.ws = (unsigned char*)d_ws;
    if (N_LAUNCHES == 1) {
        a.ph_lo = 0; a.ph_hi = N_PHASES;
        void* kargs[] = {&a};
        hipError_t e = hipLaunchCooperativeKernel((const void*)mega_fwd, dim3(grid), dim3(NTHREADS), kargs, LDS_BYTES, stream);
        if (e != hipSuccess) fprintf(stderr, "kernel_launch: cooperative launch failed: %s (grid %d)\n", hipGetErrorString(e), grid);
    } else {
        for (int p = 0; p < N_PHASES; ++p) { a.ph_lo = p; a.ph_hi = p + 1; hipLaunchKernelGGL(mega_fwd, dim3(grid), dim3(NTHREADS), LDS_BYTES, stream, a);
        }
    }
}
```

```cpp
#include <hip/hip_runtime.h>
#include <cstdio>
#include <cstdint>
namespace pg8 {
#define PG8_LAS __attribute__((address_space(3)))
typedef unsigned short bf16_t;
typedef short bf16x8 __attribute__((ext_vector_type(8)));
typedef float f32x4 __attribute__((ext_vector_type(4)));
typedef unsigned u32x4 __attribute__((ext_vector_type(4)));
constexpr int BM = 256, BK = 64, HALF = 128, HTB = HALF * BK * 2  , STAGE_BYTES = 8 * HTB, NXCD = 8, WGM = 8;

__host__ __device__ __forceinline__ int lds_byte(int r, int c) { const int st = (r >> 4) * 2 + (c >> 5), rr = r & 15, cc = c & 31, ob = rr * 64 + cc * 2; return st * 1024 + (ob ^ (((ob >> 9) & 1) << 5)); }
__host__ __device__ __forceinline__ void stage_rc(int b, int& R, int& C) { const int st = b / 1024, sb = b % 1024, swz = sb ^ (((sb >> 9) & 1) << 5); R = (st >> 1) * 16 + swz / 64; C = (st & 1) * 32 + (swz % 64) / 2; }
__host__ __device__ __forceinline__ int perm32(int rho) { const int n = rho >> 4, i = rho & 15; return 8 * (i >> 2) + 4 * n + (i & 3); }

struct Unit { int pm, pn; };
struct Gemm { const bf16_t* A; const bf16_t* Bt; int M, N, K; };

struct StaticOrder {
    int nM, nN, nwg, G, c;
    __host__ __device__ void init(int M, int N, int G_, int c_) { nM = M / BM; nN = N / BM; nwg = nM * nN; G = G_; c = c_; }
    __host__ __device__ bool next(int i, Unit& u) const {
        const long L = (long)i * G + c; if (L >= nwg) return false;
        int wgid = (int)L; { const int q = nwg / NXCD, r = nwg % NXCD, xcd = wgid % NXCD, off = wgid / NXCD; wgid = (xcd < r ? xcd * (q + 1) : r * (q + 1) + (xcd - r) * q) + off; }
        const int nig = WGM * nN, gid = wgid / nig, fm = gid * WGM, gsz = (nM - fm) < WGM ? (nM - fm) : WGM;
        u.pm = fm + ((wgid % nig) % gsz); u.pn = (wgid % nig) / gsz; return true;
    }
    __device__ __forceinline__ void a_ready(const Unit&) const {}
    __device__ __forceinline__ void done(const Unit&) const {}
};

__device__ __forceinline__ unsigned cvt_pk_bf16(float lo, float hi) { unsigned r; asm volatile("v_cvt_pk_bf16_f32 %0, %1, %2" : "=v"(r) : "v"(lo), "v"(hi)); return r; }
__device__ __forceinline__ float bflo(unsigned w) { return __builtin_bit_cast(float, w << 16); }
__device__ __forceinline__ float bfhi(unsigned w) { return __builtin_bit_cast(float, w & 0xffff0000u); }
__device__ __forceinline__ void unpack8(const u32x4 w, f32x4& a, f32x4& b) { a = (f32x4){bflo(w.x), bfhi(w.x), bflo(w.y), bfhi(w.y)}; b = (f32x4){bflo(w.z), bfhi(w.z), bflo(w.w), bfhi(w.w)}; }
__device__ __forceinline__ u32x4 pack8(const f32x4 a, const f32x4 b) { u32x4 w; w.x = cvt_pk_bf16(a[0], a[1]); w.y = cvt_pk_bf16(a[2], a[3]); w.z = cvt_pk_bf16(b[0], b[1]); w.w = cvt_pk_bf16(b[2], b[3]); return w; }
__device__ __forceinline__ float sigmoidf_fast(float x) { return __builtin_amdgcn_rcpf(1.0f + __builtin_amdgcn_exp2f(-1.4426950408889634f * x)); }
__device__ __forceinline__ f32x4 sig4(f32x4 v) { return (f32x4){sigmoidf_fast(v[0]), sigmoidf_fast(v[1]), sigmoidf_fast(v[2]), sigmoidf_fast(v[3])}; }

#define EPI_ROWS_BEGIN _Pragma("unroll") for (int ai = 0; ai < 2; ++ai) _Pragma("unroll") for (int m = 0; m < 4; ++m) { const int rowl = ai * HALF + wr * 64 + m * 16 + fr;
#define EPI_COLS_BEGIN _Pragma("unroll") for (int bj = 0; bj < 2; ++bj) { const int coll = bj * HALF + wc * 32 + 8 * fq; f32x4 v0 = acc[ai][bj][m][0], v1 = acc[ai][bj][m][1];
#define EPI_END }

struct EpiProj {
    static constexpr bool PERM = true, AFTER_DRAIN = false;
    bf16_t* O; const float* bgate;
    __device__ __forceinline__ void operator()(const f32x4 (&acc)[2][2][4][2], const Unit& u, int wr, int wc, int fr, int fq) const {
        const int row0 = u.pm * BM, col0 = u.pn * BM; const bool gate = col0 >= 7680;
        EPI_ROWS_BEGIN EPI_COLS_BEGIN
            const int row = row0 + rowl, col = col0 + coll;
            if (gate) { const f32x4 b0 = *(const f32x4*)(bgate + (col - 7680)), b1 = *(const f32x4*)(bgate + (col - 7680) + 4); v0 = sig4(v0 + b0); v1 = sig4(v1 + b1); }
            *(u32x4*)(O + (size_t)row * 9728 + col) = pack8(v0, v1);
        EPI_END EPI_END
    }
};
struct EpiPlain {
    static constexpr bool PERM = true, AFTER_DRAIN = false;
    bf16_t* O; int ldc;
    __device__ __forceinline__ void operator()(const f32x4 (&acc)[2][2][4][2], const Unit& u, int wr, int wc, int fr, int fq) const {
        const int row0 = u.pm * BM, col0 = u.pn * BM;
        EPI_ROWS_BEGIN EPI_COLS_BEGIN
            *(u32x4*)(O + (size_t)(row0 + rowl) * ldc + col0 + coll) = pack8(v0, v1);
        EPI_END EPI_END
    }
};
template <bool SECOND> struct EpiMix {
    static constexpr bool PERM = true, AFTER_DRAIN = false;
    bf16_t* MIX; const bf16_t* PROJ;
    __device__ __forceinline__ void operator()(const f32x4 (&acc)[2][2][4][2], const Unit& u, int wr, int wc, int fr, int fq) const {
        const int row0 = u.pm * BM, col0 = u.pn * BM;
        EPI_ROWS_BEGIN EPI_COLS_BEGIN
            const int row = row0 + rowl, col = col0 + coll;
            f32x4 g0, g1; unpack8(*(const u32x4*)(PROJ + (size_t)row * 9728 + (SECOND ? 8704 : 7680) + col), g0, g1);
            v0 = v0 * g0; v1 = v1 * g1;
            if (SECOND) { f32x4 t0, t1; unpack8(*(const u32x4*)(MIX + (size_t)row * 1024 + col), t0, t1); v0 = v0 + t0; v1 = v1 + t1; }
            *(u32x4*)(MIX + (size_t)row * 1024 + col) = pack8(v0, v1);
        EPI_END EPI_END
    }
};
struct EpiH1 {
    static constexpr bool PERM = true, AFTER_DRAIN = false;
    const float* X; float* H1; bf16_t* H1B; float* ss;
    __device__ __forceinline__ void operator()(const f32x4 (&acc)[2][2][4][2], const Unit& u, int wr, int wc, int fr, int fq) const {
        const int row0 = u.pm * BM, col0 = u.pn * BM;
        EPI_ROWS_BEGIN
            float s = 0.f; const int row = row0 + rowl;
            EPI_COLS_BEGIN
                const int col = col0 + coll; const size_t o = (size_t)row * 1024 + col;
                v0 = v0 + *(const f32x4*)(X + o); v1 = v1 + *(const f32x4*)(X + o + 4);
                *(f32x4*)(H1 + o) = v0; *(f32x4*)(H1 + o + 4) = v1; *(u32x4*)(H1B + o) = pack8(v0, v1);
                s += (v0[0] * v0[0] + v0[1] * v0[1]) + (v0[2] * v0[2] + v0[3] * v0[3]) + (v1[0] * v1[0] + v1[1] * v1[1]) + (v1[2] * v1[2] + v1[3] * v1[3]);
            EPI_END
            s += __shfl_xor(s, 16); s += __shfl_xor(s, 32);
            if (fq == 0) atomicAdd(ss + row, s);
        EPI_END
    }
};
struct EpiQ2 {
    static constexpr bool PERM = true, AFTER_DRAIN = false;
    bf16_t* Q2; const float* ss;
    __device__ __forceinline__ void operator()(const f32x4 (&acc)[2][2][4][2], const Unit& u, int wr, int wc, int fr, int fq) const {
        const int row0 = u.pm * BM, col0 = u.pn * BM;
        EPI_ROWS_BEGIN
            const int row = row0 + rowl; const float rs = __builtin_amdgcn_rsqf(__hip_atomic_load(ss + row, __ATOMIC_RELAXED, __HIP_MEMORY_SCOPE_AGENT) * (1.f / 1024.f) + 1e-6f);
            EPI_COLS_BEGIN
                *(u32x4*)(Q2 + (size_t)row * 512 + col0 + coll) = pack8(v0 * rs, v1 * rs);
            EPI_END
        EPI_END
    }
};
struct EpiH2 {
    static constexpr bool PERM = true, AFTER_DRAIN = false;
    const float* H1; float* OUT;
    __device__ __forceinline__ void operator()(const f32x4 (&acc)[2][2][4][2], const Unit& u, int wr, int wc, int fr, int fq) const {
        const int row0 = u.pm * BM, col0 = u.pn * BM;
        EPI_ROWS_BEGIN EPI_COLS_BEGIN
            const size_t o = (size_t)(row0 + rowl) * 1024 + col0 + coll;
            *(f32x4*)(OUT + o) = v0 + *(const f32x4*)(H1 + o); *(f32x4*)(OUT + o + 4) = v1 + *(const f32x4*)(H1 + o + 4);
        EPI_END EPI_END
    }
};
struct EpiHdn {
    static constexpr bool PERM = true, AFTER_DRAIN = false;
    bf16_t* HDN; const float* bg; const float* bu;
    __device__ __forceinline__ void operator()(const f32x4 (&acc)[2][2][4][2], const Unit& u, int wr, int wc, int fr, int fq) const {
        const int row0 = u.pm * BM, e = u.pn >> 3, hc = (u.pn & 7) * 128 + wc * 32 + 8 * fq;
        const float* pg = bg + e * 1024 + hc; const float* pu = bu + e * 1024 + hc;
        const f32x4 bg0 = *(const f32x4*)pg, bg1 = *(const f32x4*)(pg + 4), bu0 = *(const f32x4*)pu, bu1 = *(const f32x4*)(pu + 4);
        EPI_ROWS_BEGIN
            f32x4 g0 = acc[ai][0][m][0] + bg0, g1 = acc[ai][0][m][1] + bg1, l0 = acc[ai][1][m][0] + bu0, l1 = acc[ai][1][m][1] + bu1, h0, h1;
#pragma unroll
            for (int j = 0; j < 4; ++j) {
                const float ga = fminf(g0[j], 7.f), gb = fminf(g1[j], 7.f), la = fminf(fmaxf(l0[j], -7.f), 7.f), lb = fminf(fmaxf(l1[j], -7.f), 7.f);
                h0[j] = ga * sigmoidf_fast(1.702f * ga) * (la + 1.f); h1[j] = gb * sigmoidf_fast(1.702f * gb) * (lb + 1.f); }
            *(u32x4*)(HDN + (size_t)(row0 + rowl) * 1024 + hc) = pack8(h0, h1);
        EPI_END
    }
};
struct EpiY {
    static constexpr bool PERM = true, AFTER_DRAIN = false;
    bf16_t* Y; const float* bd; const int* rowslot; const float* topw;
    __device__ __forceinline__ void operator()(const f32x4 (&acc)[2][2][4][2], const Unit& u, int wr, int wc, int fr, int fq) const {
        const int row0 = u.pm * BM, e = u.pn >> 2, col0 = (u.pn & 3) * BM;
        EPI_ROWS_BEGIN
            const int slot = rowslot[row0 + rowl];
            if (slot >= 0) { const float w = topw[slot];
                EPI_COLS_BEGIN
                    const int col = col0 + coll; const float* pb = bd + e * 1024 + col;
                    v0 = (v0 + *(const f32x4*)pb) * w; v1 = (v1 + *(const f32x4*)(pb + 4)) * w;
                    *(u32x4*)(Y + (size_t)slot * 1024 + col) = pack8(v0, v1);
                EPI_END }
        EPI_END
    }
};
template <class Epi, class Sched, bool ALIGN_EPI = false, bool SP2 = false>
__device__ __forceinline__ void gemm_phase(PG8_LAS unsigned char* lds, const Gemm g, const Sched& S, const Epi& E) {
    const int tid = threadIdx.x, wid = __builtin_amdgcn_readfirstlane(tid >> 6), lane = tid & 63, wr = wid >> 2, wc = wid & 3, fr = lane & 15, fq = lane >> 4;
    const int K = g.K, nt = K / BK;
    unsigned voffA[2], voffB[2];
#pragma unroll
    for (int i = 0; i < 2; ++i) { int R, C; stage_rc(tid * 16 + i * 8192, R, C); const int Rb = Epi::PERM ? ((R & ~31) + perm32(R & 31)) : R;
        voffA[i] = (unsigned)(R * K + C) * 2u; voffB[i] = (unsigned)(Rb * K + C) * 2u; }
    const size_t kstep = (size_t)(BK * 2);
    const size_t hstep = (size_t)HALF * K * 2;
    const size_t tstep = 2 * hstep;
    const unsigned ldsw = (unsigned)wid * 1024u;
    const int aoff = lds_byte(wr * 64 + fr, fq * 8), boff = lds_byte(wc * 32 + fr, fq * 8);
#define PG8_SA(b, h) (((b) * 2 + (h)) * HTB)
#define PG8_SB(b, h) ((4 + (b) * 2 + (h)) * HTB)
#define PG8_STAGE(bufoff, gbase, voff) do { _Pragma("unroll") for (int _i = 0; _i < 2; ++_i) \
        __builtin_amdgcn_global_load_lds((const unsigned*)((const char*)(gbase) + (voff)[_i]), (PG8_LAS unsigned*)(lds + (bufoff) + ldsw + _i * 8192), 16, 0, 0); } while (0)
#define PG8_LDA(dst, b, h) do { _Pragma("unroll") for (int m = 0; m < 4; ++m) _Pragma("unroll") for (int k = 0; k < 2; ++k) dst[m][k] = *(const PG8_LAS bf16x8*)(lds + PG8_SA(b, h) + aoff + m * 2048 + k * 1024); } while (0)
#define PG8_LDB(dst, b, h) do { _Pragma("unroll") for (int n = 0; n < 2; ++n) _Pragma("unroll") for (int k = 0; k < 2; ++k) dst[n][k] = *(const PG8_LAS bf16x8*)(lds + PG8_SB(b, h) + boff + n * 2048 + k * 1024); } while (0)
#define PG8_MMA(ai, bj, At, Bt) do { __builtin_amdgcn_s_setprio(1); _Pragma("unroll") for (int m = 0; m < 4; ++m) _Pragma("unroll") for (int n = 0; n < 2; ++n) _Pragma("unroll") for (int k = 0; k < 2; ++k) \
        acc[ai][bj][m][n] = __builtin_amdgcn_mfma_f32_16x16x32_bf16(Bt[n][k], At[m][k], acc[ai][bj][m][n], 0, 0, 0); __builtin_amdgcn_s_setprio(0); } while (0)
#define PG8_WAIT_V(n) asm volatile("s_waitcnt vmcnt(" #n ")" ::: "memory")
#define PG8_WAIT_L(n) asm volatile("s_waitcnt lgkmcnt(" #n ")" ::: "memory")
#define PG8_BAR __builtin_amdgcn_s_barrier()
#define PG8_SCHED __builtin_amdgcn_sched_barrier(0)
    Unit cur, nxt; int ui = 0;
    if (!S.next(0, cur)) return;
    f32x4 acc[2][2][4][2];
#pragma unroll
    for (int a = 0; a < 2; ++a)
#pragma unroll
        for (int b = 0; b < 2; ++b)
#pragma unroll
            for (int m = 0; m < 4; ++m)
#pragma unroll
                for (int n = 0; n < 2; ++n) acc[a][b][m][n] = (f32x4){0.f, 0.f, 0.f, 0.f};
    bf16x8 At[4][2], B0[2][2], B1[2][2];
    const char* cA = (const char*)g.A + (size_t)cur.pm * tstep; const char* cB = (const char*)g.Bt + (size_t)cur.pn * tstep;
    S.a_ready(cur);
    if constexpr (SP2) {
        PG8_STAGE(PG8_SB(0, 0), cB, voffB); PG8_STAGE(PG8_SB(0, 1), cB + hstep, voffB); PG8_STAGE(PG8_SA(0, 0), cA, voffA); PG8_STAGE(PG8_SA(0, 1), cA + hstep, voffA);
        if (wr == 1) PG8_BAR;
        PG8_WAIT_V(2); PG8_BAR;
        PG8_STAGE(PG8_SB(1, 0), cB + kstep, voffB); PG8_STAGE(PG8_SA(1, 0), cA + kstep, voffA); PG8_STAGE(PG8_SB(1, 1), cB + hstep + kstep, voffB);
        PG8_WAIT_V(6); PG8_BAR;
    } else {
        PG8_STAGE(PG8_SB(0, 0), cB, voffB); PG8_STAGE(PG8_SA(0, 0), cA, voffA); PG8_STAGE(PG8_SB(0, 1), cB + hstep, voffB); PG8_STAGE(PG8_SA(0, 1), cA + hstep, voffA);
        if (wr == 1) PG8_BAR;
        PG8_WAIT_V(4); PG8_BAR;
        PG8_STAGE(PG8_SB(1, 0), cB + kstep, voffB); PG8_STAGE(PG8_SA(1, 0), cA + kstep, voffA); PG8_STAGE(PG8_SB(1, 1), cB + hstep + kstep, voffB);
        PG8_WAIT_V(6); PG8_BAR;
    }
    for (;;) {
        const bool has_next = S.next(ui + 1, nxt);
        const char* nA = has_next ? (const char*)g.A + (size_t)nxt.pm * tstep : cA; const char* nB = has_next ? (const char*)g.Bt + (size_t)nxt.pn * tstep : cB;
        for (int t = 0; t < nt; t += 2) {
            const bool last = (t == nt - 2);
            const char* a1 = cA + (size_t)(t + 1) * kstep;
            const char* a2 = last ? nA : cA + (size_t)(t + 2) * kstep; const char* b2 = last ? nB : cB + (size_t)(t + 2) * kstep;
            const char* a3 = a2 + kstep; const char* b3 = b2 + kstep;
            if (last && has_next) S.a_ready(nxt);
            if constexpr (SP2) {
            PG8_LDB(B0, 0, 0); PG8_LDB(B1, 0, 1); PG8_SCHED; PG8_LDA(At, 0, 0); PG8_STAGE(PG8_SA(1, 1), a1 + hstep, voffA);
            PG8_WAIT_V(8); PG8_WAIT_L(0); PG8_BAR; PG8_MMA(0, 0, At, B0); PG8_MMA(0, 1, At, B1); PG8_BAR; PG8_SCHED;
            PG8_LDA(At, 0, 1); PG8_STAGE(PG8_SB(0, 0), b2, voffB); PG8_STAGE(PG8_SB(0, 1), b2 + hstep, voffB); PG8_STAGE(PG8_SA(0, 0), a2, voffA);
            PG8_WAIT_V(8); PG8_WAIT_L(0); PG8_BAR; PG8_MMA(1, 0, At, B0); PG8_MMA(1, 1, At, B1); PG8_BAR; PG8_SCHED;
            PG8_LDB(B0, 1, 0); PG8_LDB(B1, 1, 1); PG8_SCHED; PG8_LDA(At, 1, 0); PG8_STAGE(PG8_SA(0, 1), a2 + hstep, voffA);
            PG8_WAIT_V(8); PG8_WAIT_L(0); PG8_BAR; PG8_MMA(0, 0, At, B0); PG8_MMA(0, 1, At, B1); PG8_BAR; PG8_SCHED;
            PG8_LDA(At, 1, 1); PG8_STAGE(PG8_SB(1, 0), b3, voffB); PG8_STAGE(PG8_SB(1, 1), b3 + hstep, voffB); PG8_STAGE(PG8_SA(1, 0), a3, voffA);
            PG8_WAIT_V(8); PG8_WAIT_L(0); PG8_BAR; PG8_MMA(1, 0, At, B0); PG8_MMA(1, 1, At, B1); PG8_BAR; PG8_SCHED;
            } else {
            PG8_LDB(B0, 0, 0); PG8_SCHED; PG8_LDA(At, 0, 0); PG8_STAGE(PG8_SA(1, 1), a1 + hstep, voffA);
            PG8_WAIT_L(8); PG8_BAR; PG8_WAIT_L(0); PG8_MMA(0, 0, At, B0); PG8_BAR; PG8_SCHED;
            PG8_LDB(B1, 0, 1); PG8_STAGE(PG8_SB(0, 0), b2, voffB);
            PG8_BAR; PG8_WAIT_L(0); PG8_MMA(0, 1, At, B1); PG8_BAR;
            PG8_LDA(At, 0, 1); PG8_STAGE(PG8_SA(0, 0), a2, voffA);
            PG8_BAR; PG8_WAIT_L(0); PG8_MMA(1, 0, At, B0); PG8_BAR; PG8_SCHED;
            PG8_STAGE(PG8_SB(0, 1), b2 + hstep, voffB);
            PG8_WAIT_V(6); PG8_BAR; PG8_MMA(1, 1, At, B1); PG8_BAR;
            PG8_LDB(B0, 1, 0); PG8_SCHED; PG8_LDA(At, 1, 0); PG8_STAGE(PG8_SA(0, 1), a2 + hstep, voffA);
            PG8_WAIT_L(8); PG8_BAR; PG8_WAIT_L(0); PG8_MMA(0, 0, At, B0); PG8_BAR; PG8_SCHED;
            PG8_LDB(B1, 1, 1); PG8_STAGE(PG8_SB(1, 0), b3, voffB);
            PG8_BAR; PG8_WAIT_L(0); PG8_MMA(0, 1, At, B1); PG8_BAR;
            PG8_LDA(At, 1, 1); PG8_STAGE(PG8_SA(1, 0), a3, voffA);
            PG8_BAR; PG8_WAIT_L(0); PG8_MMA(1, 0, At, B0); PG8_BAR; PG8_SCHED;
            PG8_STAGE(PG8_SB(1, 1), b3 + hstep, voffB);
            PG8_WAIT_V(6); PG8_BAR; PG8_MMA(1, 1, At, B1); PG8_BAR;
            }
        }
        if constexpr (ALIGN_EPI) { if (wr == 0) PG8_BAR; }
        if constexpr (!Epi::AFTER_DRAIN) { E(acc, cur, wr, wc, fr, fq); S.done(cur); }
        if (!has_next) break;
#pragma unroll
        for (int a = 0; a < 2; ++a)
#pragma unroll
            for (int b = 0; b < 2; ++b)
#pragma unroll
                for (int m = 0; m < 4; ++m)
#pragma unroll
                    for (int n = 0; n < 2; ++n) acc[a][b][m][n] = (f32x4){0.f, 0.f, 0.f, 0.f};
        cur = nxt; cA = nA; cB = nB; ++ui;
        if constexpr (ALIGN_EPI) { if (wr == 1) PG8_BAR; }
    }
    PG8_WAIT_V(0);
    if constexpr (!ALIGN_EPI) { if (wr == 0) PG8_BAR; }
    PG8_BAR;
    if constexpr (Epi::AFTER_DRAIN) { E.fused(acc, cur, wr, wc, fr, fq, lds, wid, lane); S.done(cur); }
#undef PG8_SA
#undef PG8_SB
#undef PG8_STAGE
#undef PG8_LDA
#undef PG8_LDB
#undef PG8_MMA
#undef PG8_WAIT_V
#undef PG8_WAIT_L
#undef PG8_BAR
#undef PG8_SCHED
}
}
namespace pg8 {
template <class Epi, class Sched>
__device__ __forceinline__ void gemm_phase_gather(PG8_LAS unsigned char* lds, const Gemm g, const Sched& S, const Epi& E, const PG8_LAS int* rowbuf) {
    const int tid = threadIdx.x, wid = __builtin_amdgcn_readfirstlane(tid >> 6), lane = tid & 63, wr = wid >> 2, wc = wid & 3, fr = lane & 15, fq = lane >> 4;
    const int K = g.K, nt = K / BK;
    unsigned colA[2], voffB[2]; int rowA[2];
#pragma unroll
    for (int i = 0; i < 2; ++i) { int R, C; stage_rc(tid * 16 + i * 8192, R, C); const int Rb = Epi::PERM ? ((R & ~31) + perm32(R & 31)) : R;
        rowA[i] = R; colA[i] = (unsigned)C * 2u; voffB[i] = (unsigned)(Rb * K + C) * 2u; }
    const size_t kstep = (size_t)(BK * 2), hstep = (size_t)HALF * K * 2, tstep = 2 * hstep;
    const unsigned rowbytes = (unsigned)K * 2u;
    const unsigned ldsw = (unsigned)wid * 1024u;
    const int aoff = lds_byte(wr * 64 + fr, fq * 8), boff = lds_byte(wc * 32 + fr, fq * 8);
#define PG8_SA(b, h) (((b) * 2 + (h)) * HTB)
#define PG8_SB(b, h) ((4 + (b) * 2 + (h)) * HTB)
#define PG8_STAGE(bufoff, gbase, voff) do { _Pragma("unroll") for (int _i = 0; _i < 2; ++_i) \
        __builtin_amdgcn_global_load_lds((const unsigned*)((const char*)(gbase) + (voff)[_i]), (PG8_LAS unsigned*)(lds + (bufoff) + ldsw + _i * 8192), 16, 0, 0); } while (0)
#define PG8_LDA(dst, b, h) do { _Pragma("unroll") for (int m = 0; m < 4; ++m) _Pragma("unroll") for (int k = 0; k < 2; ++k) dst[m][k] = *(const PG8_LAS bf16x8*)(lds + PG8_SA(b, h) + aoff + m * 2048 + k * 1024); } while (0)
#define PG8_LDB(dst, b, h) do { _Pragma("unroll") for (int n = 0; n < 2; ++n) _Pragma("unroll") for (int k = 0; k < 2; ++k) dst[n][k] = *(const PG8_LAS bf16x8*)(lds + PG8_SB(b, h) + boff + n * 2048 + k * 1024); } while (0)
#define PG8_MMA(ai, bj, At, Bt) do { __builtin_amdgcn_s_setprio(1); _Pragma("unroll") for (int m = 0; m < 4; ++m) _Pragma("unroll") for (int n = 0; n < 2; ++n) _Pragma("unroll") for (int k = 0; k < 2; ++k) \
        acc[ai][bj][m][n] = __builtin_amdgcn_mfma_f32_16x16x32_bf16(Bt[n][k], At[m][k], acc[ai][bj][m][n], 0, 0, 0); __builtin_amdgcn_s_setprio(0); } while (0)
#define PG8_WAIT_V(n) asm volatile("s_waitcnt vmcnt(" #n ")" ::: "memory")
#define PG8_WAIT_L(n) asm volatile("s_waitcnt lgkmcnt(" #n ")" ::: "memory")
#define PG8_BAR __builtin_amdgcn_s_barrier()
#define PG8_SCHED __builtin_amdgcn_sched_barrier(0)
#define PG8_ROWS(dst, u_) do { _Pragma("unroll") for (int h_ = 0; h_ < 2; ++h_) _Pragma("unroll") for (int i_ = 0; i_ < 2; ++i_) dst[h_][i_] = (unsigned)rowbuf[256 * (u_) + 128 * h_ + rowA[i_]] * rowbytes + colA[i_]; } while (0)
    Unit cur, nxt; int ui = 0;
    if (!S.next(0, cur)) return;
    f32x4 acc[2][2][4][2];
#pragma unroll
    for (int a = 0; a < 2; ++a)
#pragma unroll
        for (int b = 0; b < 2; ++b)
#pragma unroll
            for (int m = 0; m < 4; ++m)
#pragma unroll
                for (int n = 0; n < 2; ++n) acc[a][b][m][n] = (f32x4){0.f, 0.f, 0.f, 0.f};
    bf16x8 At[4][2], B0[2][2], B1[2][2];
    const char* Ab = (const char*)g.A; const char* cB = (const char*)g.Bt + (size_t)cur.pn * tstep;
    unsigned ca[2][2], na[2][2];
    PG8_ROWS(ca, 0);
    PG8_STAGE(PG8_SB(0, 0), cB, voffB); PG8_STAGE(PG8_SB(0, 1), cB + hstep, voffB); PG8_STAGE(PG8_SA(0, 0), Ab, ca[0]); PG8_STAGE(PG8_SA(0, 1), Ab, ca[1]);
    if (wr == 1) PG8_BAR;
    PG8_WAIT_V(2); PG8_BAR;
    PG8_STAGE(PG8_SB(1, 0), cB + kstep, voffB); PG8_STAGE(PG8_SA(1, 0), Ab + kstep, ca[0]); PG8_STAGE(PG8_SB(1, 1), cB + hstep + kstep, voffB);
    PG8_WAIT_V(6); PG8_BAR;
    for (;;) {
        const bool has_next = S.next(ui + 1, nxt);
        const char* nB = has_next ? (const char*)g.Bt + (size_t)nxt.pn * tstep : cB;
        if (has_next) { PG8_ROWS(na, ui + 1); } else {
#pragma unroll
            for (int h_ = 0; h_ < 2; ++h_)
#pragma unroll
                for (int i_ = 0; i_ < 2; ++i_) na[h_][i_] = ca[h_][i_]; }
        for (int t = 0; t < nt; t += 2) {
            const bool last = (t == nt - 2);
            const char* a1 = Ab + (size_t)(t + 1) * kstep;
            const char* a2 = last ? Ab : Ab + (size_t)(t + 2) * kstep; const char* b2 = last ? nB : cB + (size_t)(t + 2) * kstep;
            const char* a3 = a2 + kstep; const char* b3 = b2 + kstep;
            unsigned o2[2][2];
#pragma unroll
            for (int h_ = 0; h_ < 2; ++h_)
#pragma unroll
                for (int i_ = 0; i_ < 2; ++i_) o2[h_][i_] = last ? na[h_][i_] : ca[h_][i_];
            PG8_LDB(B0, 0, 0); PG8_LDB(B1, 0, 1); PG8_SCHED; PG8_LDA(At, 0, 0); PG8_STAGE(PG8_SA(1, 1), a1, ca[1]);
            PG8_WAIT_V(8); PG8_WAIT_L(0); PG8_BAR; PG8_MMA(0, 0, At, B0); PG8_MMA(0, 1, At, B1); PG8_BAR; PG8_SCHED;
            PG8_LDA(At, 0, 1); PG8_STAGE(PG8_SB(0, 0), b2, voffB); PG8_STAGE(PG8_SB(0, 1), b2 + hstep, voffB); PG8_STAGE(PG8_SA(0, 0), a2, o2[0]);
            PG8_WAIT_V(8); PG8_WAIT_L(0); PG8_BAR; PG8_MMA(1, 0, At, B0); PG8_MMA(1, 1, At, B1); PG8_BAR; PG8_SCHED;
            PG8_LDB(B0, 1, 0); PG8_LDB(B1, 1, 1); PG8_SCHED; PG8_LDA(At, 1, 0); PG8_STAGE(PG8_SA(0, 1), a2, o2[1]);
            PG8_WAIT_V(8); PG8_WAIT_L(0); PG8_BAR; PG8_MMA(0, 0, At, B0); PG8_MMA(0, 1, At, B1); PG8_BAR; PG8_SCHED;
            PG8_LDA(At, 1, 1); PG8_STAGE(PG8_SB(1, 0), b3, voffB); PG8_STAGE(PG8_SB(1, 1), b3 + hstep, voffB); PG8_STAGE(PG8_SA(1, 0), a3, o2[0]);
            PG8_WAIT_V(8); PG8_WAIT_L(0); PG8_BAR; PG8_MMA(1, 0, At, B0); PG8_MMA(1, 1, At, B1); PG8_BAR; PG8_SCHED;
        }
        if (wr == 0) PG8_BAR;
        E(acc, cur, wr, wc, fr, fq); S.done(cur);
        if (!has_next) break;
#pragma unroll
        for (int a = 0; a < 2; ++a)
#pragma unroll
            for (int b = 0; b < 2; ++b)
#pragma unroll
                for (int m = 0; m < 4; ++m)
#pragma unroll
                    for (int n = 0; n < 2; ++n) acc[a][b][m][n] = (f32x4){0.f, 0.f, 0.f, 0.f};
        cur = nxt; cB = nB; ++ui;
#pragma unroll
        for (int h_ = 0; h_ < 2; ++h_)
#pragma unroll
            for (int i_ = 0; i_ < 2; ++i_) ca[h_][i_] = na[h_][i_];
        if (wr == 1) PG8_BAR;
    }
    PG8_WAIT_V(0);
    PG8_BAR;
#undef PG8_ROWS
#undef PG8_SA
#undef PG8_SB
#undef PG8_STAGE
#undef PG8_LDA
#undef PG8_LDB
#undef PG8_MMA
#undef PG8_WAIT_V
#undef PG8_WAIT_L
#undef PG8_BAR
#undef PG8_SCHED
}
}
#define GAS __attribute__((address_space(1)))
#define LAS __attribute__((address_space(3)))
typedef unsigned short bf16;
typedef unsigned v4u __attribute__((ext_vector_type(4)));
typedef float f32x4 __attribute__((ext_vector_type(4)));
typedef short bf16x8 __attribute__((ext_vector_type(8)));
typedef GAS unsigned gu32;
typedef GAS unsigned long long gu64;
#define RLX_AGENT __ATOMIC_RELAXED, __HIP_MEMORY_SCOPE_AGENT
#define LDS_WAIT() asm volatile("s_waitcnt lgkmcnt(0)" ::: "memory")
#define VM_WAIT() asm volatile("s_waitcnt vmcnt(0)" ::: "memory")
__device__ __forceinline__ unsigned long long rt() { return __builtin_amdgcn_s_memrealtime(); }
__device__ __forceinline__ unsigned f2bf(float f) { unsigned u = __builtin_bit_cast(unsigned, f); return (u + 0x7fffu + ((u >> 16) & 1u)) >> 16; }
__device__ __forceinline__ unsigned pk2(float lo, float hi) { return f2bf(lo) | (f2bf(hi) << 16); }

#define XB_TMO      128
#define XB_XCNT(j)  (256  + 64 * (j))
#define XB_XSUB(j)  (1280 + 64 * (j))
#define XB_XGEN(j)  (2304 + 64 * (j))
#define XB_TOP      3328
#define XB_TOPGEN   3392
#define XCD_BAR_WORDS 3456
#define XB_SPIN_CAP (1u << 18)

__device__ __forceinline__ unsigned xb_ld(unsigned* p)              { return __hip_atomic_load(p, __ATOMIC_RELAXED, __HIP_MEMORY_SCOPE_AGENT); }
__device__ __forceinline__ unsigned xb_add(unsigned* p, unsigned v) { return __hip_atomic_fetch_add(p, v, __ATOMIC_RELAXED, __HIP_MEMORY_SCOPE_AGENT); }
__device__ __forceinline__ unsigned xb_xcc_id() { return (unsigned)__builtin_amdgcn_s_getreg((3 << 11) | 20) & 0xFu; }
#define XB_SPIN(cond, bar) do { unsigned _sp = 0; while (cond) { __builtin_amdgcn_s_sleep(1); \
    if ((++_sp & 255u) == 0u) { if (xb_ld(&(bar)[XB_TMO])) break; if (_sp > XB_SPIN_CAP) { atomicAdd(&(bar)[XB_TMO], 1u); break; } } } } while (0)

struct XcdBarrier {
    unsigned* bar; unsigned x;
    volatile LAS unsigned* st;
};

__device__ __forceinline__ XcdBarrier xcd_barrier_post(unsigned* bar, volatile LAS unsigned* st) {
    XcdBarrier b; b.bar = bar; b.x = xb_xcc_id(); b.st = st;
    if (threadIdx.x == 0) (void)xb_add(&bar[XB_XCNT(b.x)], 1u);
    return b;
}
__device__ __forceinline__ void xcd_barrier_complete(unsigned* bar, unsigned x, unsigned& nloc, unsigned& nx) {
    const unsigned G = gridDim.x * gridDim.y * gridDim.z;
    unsigned sum, cnt, mine, sp = 0u;
    for (;;) {
        sum = 0u; cnt = 0u; mine = 0u;
#pragma unroll
        for (unsigned j = 0; j < 16; ++j) { const unsigned c = xb_ld(&bar[XB_XCNT(j)]); sum += c; cnt += (c > 0u) ? 1u : 0u; mine = (j == x) ? c : mine; }
        if (sum == G) break;
        __builtin_amdgcn_s_sleep(1);
        if ((++sp & 255u) == 0u) { if (xb_ld(&bar[XB_TMO])) break; if (sp > XB_SPIN_CAP) { atomicAdd(&bar[XB_TMO], 1u); break; } }
    }
    nloc = mine > 0u ? mine : 1u; nx = cnt > 0u ? cnt : 1u;
}

__device__ __forceinline__ void xcd_barrier(const XcdBarrier& b) {
    asm volatile("s_waitcnt vmcnt(0)" ::: "memory");
    __syncthreads();
    if (threadIdx.x == 0) {
        unsigned* bar = b.bar;
        __builtin_amdgcn_s_waitcnt(0);
        unsigned nloc = b.st[0], nx = b.st[1];
        if (nloc == 0u) { xcd_barrier_complete(bar, b.x, nloc, nx); b.st[0] = nloc; b.st[1] = nx; }
        const unsigned old = xb_add(&bar[XB_XSUB(b.x)], 1u);
        const unsigned gen = old / nloc;
        if (old + 1u == (gen + 1u) * nloc) {
            __builtin_amdgcn_fence(__ATOMIC_RELEASE, "agent");
            asm volatile("s_waitcnt vmcnt(0)" ::: "memory");
            const unsigned og = xb_add(&bar[XB_TOP], 1u);
            const unsigned tg = og / nx;
            if (og + 1u == (tg + 1u) * nx) xb_add(&bar[XB_TOPGEN], 1u);
            else XB_SPIN(xb_ld(&bar[XB_TOPGEN]) == tg, bar);
            __builtin_amdgcn_fence(__ATOMIC_ACQUIRE, "agent");
            xb_add(&bar[XB_XGEN(b.x)], 1u);
            asm volatile("s_waitcnt vmcnt(0)" ::: "memory");
        } else {
            XB_SPIN(xb_ld(&bar[XB_XGEN(b.x)]) == gen, bar);
            __builtin_amdgcn_fence(__ATOMIC_ACQUIRE, "agent");
            asm volatile("s_waitcnt vmcnt(0)" ::: "memory");
        }
    }
    __syncthreads();
}
constexpr int NWAVES = 8, NTHREADS = 512;
constexpr int T = 16384, D = 1024, SEQ = 4096, NBATCH = 4, NMEM = 256, NEXP = 32, TOPK = 4;
constexpr int NPROJ = 9728;
constexpr int XS_ROWS = T * TOPK + NEXP * 256;
constexpr float EPS = 1e-6f, LOG2E = 1.4426950408889634f, LN2 = 0.6931471805599453f;
#ifndef MK_N_LAUNCHES
#define MK_N_LAUNCHES 1
#endif
constexpr int N_PHASES = 14;
constexpr int N_LAUNCHES = MK_N_LAUNCHES;

constexpr size_t MiB = 1u << 20;
constexpr size_t WS_CTL = 0, CTL_ZERO_BYTES = 1 * MiB;
constexpr size_t CTL_SS2 = 256 * 1024, CTL_CNT = 384 * 1024, CTL_ROWTOK = 640 * 1024;
constexpr size_t WS_WCQ = 1 * MiB, WS_WCO = 2 * MiB, WS_WO = 3 * MiB, WS_KV = 5 * MiB;
constexpr size_t WS_TOPI = 7 * MiB, WS_TOPW = WS_TOPI + 256 * 1024, WS_RSTD3 = WS_TOPW + 256 * 1024, WS_ROWSLOT = WS_RSTD3 + 64 * 1024;
constexpr size_t WS_EXPGU = 8 * MiB, WS_EXPD = 136 * MiB;
constexpr size_t WS_PROJ = 8 * MiB, WS_U1 = 312 * MiB, WS_W1T = 344 * MiB, WS_OG = 312 * MiB, WS_LSE = 360 * MiB;
constexpr size_t WS_WBA = 363 * MiB, WS_WBC = 364 * MiB, WS_MN = 366 * MiB, WS_YA = 368 * MiB, WS_YC = 384 * MiB, WS_MIX = 416 * MiB, WS_WCKV = 448 * MiB;
constexpr size_t WS_H1 = 200 * MiB, WS_H1B = 264 * MiB, WS_Q2 = 296 * MiB, WS_O2 = 312 * MiB;
constexpr size_t WS_U3 = 200 * MiB, WS_HDN = 344 * MiB, WS_Y = 200 * MiB, WS_END = 488 * MiB;
constexpr size_t WS_HIST = WS_ROWSLOT + 288 * 1024;
static_assert(WS_ROWSLOT + (size_t)XS_ROWS * 4 <= WS_HIST && WS_HIST + 256 * 32 * 4 <= WS_EXPGU && CTL_ROWTOK + (size_t)XS_ROWS * 4 <= CTL_ZERO_BYTES, "misc region");
static_assert(WS_U3 + (size_t)T * D * 2 <= WS_HDN && WS_HDN + (size_t)XS_ROWS * D * 2 <= WS_END, "moe rows");
constexpr int CW_TMO = 0, CW_CODE = 1, CW_BAR = 4096;

constexpr int LDS_BYTES = 163840;
constexpr int TBL_OFF = 163840 - 2048;
constexpr int ROWBUF_OFF = 131072, ROWBUF_UNITS = 24;
constexpr int MISC_OFF = 163840 - 256;

struct Frame {
    LAS unsigned char* lds;
    volatile LAS unsigned* MISC;
    gu32* ctl;
    unsigned char* ws;
    int tid, lane, wave, vcu, G;
};
__device__ __forceinline__ float wave_sum(float v) {
#pragma unroll
    for (int o = 1; o < 64; o <<= 1) v += __shfl_xor(v, o);
    return v;
}
typedef unsigned long long u64;
__device__ __forceinline__ float bf_lo(unsigned w) { return __builtin_bit_cast(float, w << 16); }
__device__ __forceinline__ float bf_hi(unsigned w) { return __builtin_bit_cast(float, w & 0xffff0000u); }

__device__ __forceinline__ void transpose_item(const float* W, int K, int N, bf16* WT, int drow, int k0, int n0, const float* gain, LAS float* scr, int lane) {
#pragma unroll 8
    for (int i = 0; i < 32; ++i) { const int kk = 2 * i + (lane >> 5); float w = W[(size_t)(k0 + kk) * N + n0 + (lane & 31)]; if (gain) w *= gain[k0 + kk]; scr[kk * 33 + (lane & 31)] = w; }
    LDS_WAIT(); asm volatile("" ::: "memory");
    const int c = lane & 7;
#pragma unroll
    for (int j = 0; j < 4; ++j) { const int n = (lane >> 3) + 8 * j; const LAS float* s = scr + (8 * c) * 33 + n;
        v4u o; o.x = pk2(s[0 * 33], s[1 * 33]); o.y = pk2(s[2 * 33], s[3 * 33]); o.z = pk2(s[4 * 33], s[5 * 33]); o.w = pk2(s[6 * 33], s[7 * 33]);
        *(GAS v4u*)(WT + (size_t)(drow + n) * K + k0 + 8 * c) = o; }
    LDS_WAIT(); asm volatile("" ::: "memory");
}
__device__ __forceinline__ bool transpose_mat(int& r, const float* W, int K, int N, bf16* WT, int drow0, const float* gain, LAS float* scr, int lane) {
    const int nblk = N / 32, items = (K / 64) * nblk;
    if (r < items) { const int kb = r / nblk, nb = r % nblk; transpose_item(W, K, N, WT, drow0 + 32 * nb, 64 * kb, 32 * nb, gain, scr, lane); return true; }
    r -= items; return false;
}
__device__ __forceinline__ void rms_row_to_bf16(const float* xrow, const float* gain, bf16* orow, int lane) {
    const GAS f32x4* xr = (const GAS f32x4*)xrow + lane; const GAS f32x4* gr = (const GAS f32x4*)gain + lane;
    f32x4 v[4]; float s = 0.f;
#pragma unroll
    for (int j = 0; j < 4; ++j) { v[j] = xr[64 * j]; s += (v[j].x * v[j].x + v[j].y * v[j].y) + (v[j].z * v[j].z + v[j].w * v[j].w); }
    const float rstd = 1.f / sqrtf(wave_sum(s) * (1.f / D) + EPS);
    GAS u64* o8 = (GAS u64*)orow + lane;
#pragma unroll
    for (int j = 0; j < 4; ++j) { const f32x4 g = gr[64 * j]; o8[64 * j] = (u64)pk2(v[j].x * rstd * g.x, v[j].y * rstd * g.y) | ((u64)pk2(v[j].z * rstd * g.z, v[j].w * rstd * g.w) << 32); }
}

__device__ __forceinline__ int xcd_remap(int wgid, int nwg) { const int q = nwg / 8, r = nwg % 8, xcd = wgid % 8, off = wgid / 8; return (xcd < r ? xcd * (q + 1) : r * (q + 1) + (xcd - r) * q) + off; }
struct MoeOrder {
    const volatile LAS int* tpre; int npn, G, c;
    __device__ __forceinline__ bool next(int i, pg8::Unit& u) const {
        const int total = tpre[32] * npn; const long L = (long)i * G + c; if (L >= total) return false;
        const int U = xcd_remap((int)L, total);
        int e = 0;
#pragma unroll 1
        for (int k = 1; k < 32; ++k) if (tpre[k] * npn <= U) e = k;
        const int t0 = tpre[e], nt = tpre[e + 1] - t0, Ul = U - t0 * npn;
        u.pm = t0 + Ul % nt; u.pn = e * npn + Ul / nt; return true;
    }
    __device__ __forceinline__ void a_ready(const pg8::Unit&) const {}
    __device__ __forceinline__ void done(const pg8::Unit&) const {}
};
struct In {
    const float *x, *mem, *norm_mix, *w_in, *conv_w, *w_ba, *w_bc, *w_gate, *b_gate, *w_out, *norm_cross, *norm_mem, *w_cq, *w_ckv, *w_co, *norm_moe,
                *router_w, *router_b, *w_eg, *b_eg, *w_eu, *b_eu, *w_ed, *b_ed, *norm_final;
};

__device__ __forceinline__ void phase_prologue(Frame& F, const In& in) {
    LAS float* scr = (LAS float*)(F.lds + F.wave * 16384);
    const int gw = F.vcu * NWAVES + F.wave, NGW = F.G * NWAVES;
    unsigned char* ws = F.ws;
    constexpr int NITEMS = 16 * 240 + 16 * 64 + 8 * 32 + 16 * 32 + 16 * 32 + 16 * 16 + 16 * 32 + 8 * 32;
    for (int it = gw; it < NITEMS; it += NGW) {
        int r = it;
        if (transpose_mat(r, in.w_in, 1024, 7680, (bf16*)(ws + WS_W1T), 0, nullptr, scr, F.lane)) continue;
        if (transpose_mat(r, in.w_gate, 1024, 2048, (bf16*)(ws + WS_W1T), 7680, nullptr, scr, F.lane)) continue;
        if (transpose_mat(r, in.w_ba, 512, 1024, (bf16*)(ws + WS_WBA), 0, nullptr, scr, F.lane)) continue;
        if (transpose_mat(r, in.w_bc, 1024, 1024, (bf16*)(ws + WS_WBC), 0, nullptr, scr, F.lane)) continue;
        if (transpose_mat(r, in.w_out, 1024, 1024, (bf16*)(ws + WS_WO), 0, nullptr, scr, F.lane)) continue;
        if (transpose_mat(r, in.w_cq, 1024, 512, (bf16*)(ws + WS_WCQ), 0, in.norm_cross, scr, F.lane)) continue;
        if (transpose_mat(r, in.w_ckv, 1024, 1024, (bf16*)(ws + WS_WCKV), 0, nullptr, scr, F.lane)) continue;
        transpose_mat(r, in.w_co, 512, 1024, (bf16*)(ws + WS_WCO), 0, nullptr, scr, F.lane);
    }
    for (int m = gw; m < T; m += NGW) rms_row_to_bf16(in.x + (size_t)m * D, in.norm_mix, (bf16*)(ws + WS_U1) + (size_t)m * D, F.lane);
    for (int m = gw; m < NBATCH * NMEM; m += NGW) rms_row_to_bf16(in.mem + (size_t)m * D, in.norm_mem, (bf16*)(ws + WS_MN) + (size_t)m * D, F.lane);
}

__device__ __forceinline__ void phase_expert_convert(Frame& F, const In& in) {
    LAS float* scr = (LAS float*)(F.lds + F.wave * 16384);
    const int gw = F.vcu * NWAVES + F.wave, NGW = F.G * NWAVES;
    constexpr int PER = 16 * 32, NITEMS = NEXP * 3 * PER;
    for (int it = gw; it < NITEMS; it += NGW) {
        const int mtx = it / PER, r = it % PER, e = mtx / 3, which = mtx % 3, kb = r / 32, nb = r % 32, n0 = 32 * nb;
        if (which == 0)      transpose_item(in.w_eg + (size_t)e * D * D, D, D, (bf16*)(F.ws + WS_EXPGU) + (size_t)e * 2048 * D, (n0 >> 7) * 256 + (n0 & 127), 64 * kb, n0, nullptr, scr, F.lane);
        else if (which == 1) transpose_item(in.w_eu + (size_t)e * D * D, D, D, (bf16*)(F.ws + WS_EXPGU) + (size_t)e * 2048 * D, (n0 >> 7) * 256 + 128 + (n0 & 127), 64 * kb, n0, nullptr, scr, F.lane);
        else                 transpose_item(in.w_ed + (size_t)e * D * D, D, D, (bf16*)(F.ws + WS_EXPD) + (size_t)e * D * D, n0, 64 * kb, n0, nullptr, scr, F.lane);
    }
}


typedef short s16x4v __attribute__((ext_vector_type(4)));
typedef short bf16x8v __attribute__((ext_vector_type(8)));
__device__ __forceinline__ s16x4v lds_tr16(const LAS bf16* p) { return __builtin_bit_cast(s16x4v, __builtin_amdgcn_ds_read_tr16_b64_v4i16((LAS s16x4v*)p)); }
__device__ __forceinline__ void dil_attn_unit_mfma(Frame& F, int unit) {
    const int rn = unit & 31, bgh = unit >> 5, h = bgh & 7, bg = bgh >> 3, g = bg % 3, b = bg / 3;
    const int dil = g == 0 ? 1 : (g == 1 ? 4 : 16), nper = 32 / dil, r = rn / nper, n = rn % nper;
    const bf16* PROJ = (const bf16*)(F.ws + WS_PROJ);
    LAS bf16* Ks = (LAS bf16*)F.lds; LAS bf16* Vs = Ks + 256 * 72;
    const int tid = F.tid, lane = F.lane, w = F.wave, qi = lane & 15, G = lane >> 4;
#pragma unroll
    for (int it = 0; it < 4; ++it) {
        const int row = (tid >> 3) + 64 * it, ch = tid & 7, j = 128 * (n - 1) + row;
        v4u kv = (v4u){0u, 0u, 0u, 0u}, vv = kv;
        if (j >= 0) { const size_t grow = (size_t)b * SEQ + (size_t)j * dil + r; const bf16* p = PROJ + grow * NPROJ + g * 1536 + h * 64 + ch * 8; kv = *(const GAS v4u*)(p + 512); vv = *(const GAS v4u*)(p + 1024); }
        *(LAS v4u*)(Ks + row * 72 + ch * 8) = kv; *(LAS v4u*)(Vs + row * 72 + ch * 8) = vv;
    }
    if (tid < 128) *(LAS v4u*)(Vs + (256 + (tid >> 3)) * 72 + (tid & 7) * 8) = (v4u){0u, 0u, 0u, 0u};
    const int ql = 16 * w + qi;
    const size_t growq = (size_t)b * SEQ + (size_t)(128 * n + ql) * dil + r;
    const bf16* qp = PROJ + growq * NPROJ + g * 1536 + h * 64 + 8 * G;
    const bf16x8v q0 = *(const GAS bf16x8v*)qp, q1 = *(const GAS bf16x8v*)(qp + 32);
    __syncthreads();
    pg8::f32x4 st[9];
#pragma unroll
    for (int t = 0; t < 9; ++t) {
        const LAS bf16* kp = Ks + (16 * (w + t) + qi) * 72 + 8 * G;
        const bf16x8v k0 = *(const LAS bf16x8v*)kp, k1 = *(const LAS bf16x8v*)(kp + 32);
        pg8::f32x4 a = (pg8::f32x4){0.f, 0.f, 0.f, 0.f};
        a = __builtin_amdgcn_mfma_f32_16x16x32_bf16(k0, q0, a, 0, 0, 0);
        a = __builtin_amdgcn_mfma_f32_16x16x32_bf16(k1, q1, a, 0, 0, 0);
        st[t] = a;
    }
    const float slope2 = exp2f(-(float)(h + 1)) * (float)dil * LOG2E, sc = 0.125f * LOG2E;
    const int jq = 128 * (n - 1);
    float mx = -1e30f;
#pragma unroll
    for (int t = 0; t < 9; ++t)
#pragma unroll
        for (int i = 0; i < 4; ++i) {
            const int kl = 16 * (w + t) + 4 * G + i, dk = kl - ql;
            const bool ok = dk >= 0 && dk <= 128 && (jq + kl) >= 0;
            const float sv = ok ? st[t][i] * sc - slope2 * (float)(128 - dk) : -1e30f;
            st[t][i] = sv; mx = fmaxf(mx, sv);
        }
    mx = fmaxf(mx, __shfl_xor(mx, 16)); mx = fmaxf(mx, __shfl_xor(mx, 32));
    float l = 0.f;
#pragma unroll
    for (int t = 0; t < 9; ++t)
#pragma unroll
        for (int i = 0; i < 4; ++i) { const float pv = st[t][i] > -1e29f ? __builtin_amdgcn_exp2f(st[t][i] - mx) : 0.f; st[t][i] = pv; l += pv; }
    l += __shfl_xor(l, 16); l += __shfl_xor(l, 32);
    pg8::f32x4 o[4];
#pragma unroll
    for (int dm = 0; dm < 4; ++dm) o[dm] = (pg8::f32x4){0.f, 0.f, 0.f, 0.f};
#pragma unroll
    for (int s5 = 0; s5 < 5; ++s5) {
        const pg8::f32x4 pa = st[2 * s5], pb = (2 * s5 + 1 < 9) ? st[2 * s5 + 1] : (pg8::f32x4){0.f, 0.f, 0.f, 0.f};
        bf16x8v pf;
        { const unsigned w0 = pk2(pa[0], pa[1]), w1 = pk2(pa[2], pa[3]), w2 = pk2(pb[0], pb[1]), w3 = pk2(pb[2], pb[3]);
          pf = __builtin_bit_cast(bf16x8v, (v4u){w0, w1, w2, w3}); }
        const LAS bf16* vbase = Vs + (16 * (w + 2 * s5) + 4 * G + (qi >> 2)) * 72 + 4 * (qi & 3);
#pragma unroll
        for (int dm = 0; dm < 4; ++dm) {
            const s16x4v lo = lds_tr16(vbase + 16 * dm), hi = lds_tr16(vbase + 16 * 72 + 16 * dm);
            const bf16x8v vf = (bf16x8v){lo[0], lo[1], lo[2], lo[3], hi[0], hi[1], hi[2], hi[3]};
            o[dm] = __builtin_amdgcn_mfma_f32_16x16x32_bf16(vf, pf, o[dm], 0, 0, 0);
        }
    }
    const float inv = 1.f / l;
    bf16* og = (bf16*)(F.ws + WS_OG) + ((size_t)g * T + growq) * 512 + h * 64 + 4 * G;
#pragma unroll
    for (int dm = 0; dm < 4; ++dm) *(GAS u64*)(og + 16 * dm) = (u64)pk2(o[dm][0] * inv, o[dm][1] * inv) | ((u64)pk2(o[dm][2] * inv, o[dm][3] * inv) << 32);
    if (G == 0) ((float*)(F.ws + WS_LSE))[((size_t)g * T + growq) * 8 + h] = (mx + __builtin_amdgcn_logf(l)) * LN2;
    __syncthreads();
}

__device__ __forceinline__ void phase_combine_conv(Frame& F, const In& in) {
    const int gw = F.vcu * NWAVES + F.wave, NGW = F.G * NWAVES, lane = F.lane;
    const bf16* PROJ = (const bf16*)(F.ws + WS_PROJ); const bf16* OG = (const bf16*)(F.ws + WS_OG); const float* LSE = (const float*)(F.ws + WS_LSE);
    for (int t = gw; t < T; t += NGW) {
        { const int head = lane >> 3;
          const float l0 = LSE[((size_t)0 * T + t) * 8 + head], l1 = LSE[((size_t)1 * T + t) * 8 + head], l2 = LSE[((size_t)2 * T + t) * 8 + head];
          const float mx = fmaxf(l0, fmaxf(l1, l2)); float w0 = __expf(l0 - mx), w1 = __expf(l1 - mx), w2 = __expf(l2 - mx); const float inv = 1.f / (w0 + w1 + w2); w0 *= inv; w1 *= inv; w2 *= inv;
          const v4u a = *(const GAS v4u*)(OG + ((size_t)0 * T + t) * 512 + 8 * lane), b = *(const GAS v4u*)(OG + ((size_t)1 * T + t) * 512 + 8 * lane), c = *(const GAS v4u*)(OG + ((size_t)2 * T + t) * 512 + 8 * lane);
          v4u o;
          o.x = pk2(w0 * bf_lo(a.x) + w1 * bf_lo(b.x) + w2 * bf_lo(c.x), w0 * bf_hi(a.x) + w1 * bf_hi(b.x) + w2 * bf_hi(c.x));
          o.y = pk2(w0 * bf_lo(a.y) + w1 * bf_lo(b.y) + w2 * bf_lo(c.y), w0 * bf_hi(a.y) + w1 * bf_hi(b.y) + w2 * bf_hi(c.y));
          o.z = pk2(w0 * bf_lo(a.z) + w1 * bf_lo(b.z) + w2 * bf_lo(c.z), w0 * bf_hi(a.z) + w1 * bf_hi(b.z) + w2 * bf_hi(c.z));
          o.w = pk2(w0 * bf_lo(a.w) + w1 * bf_lo(b.w) + w2 * bf_lo(c.w), w0 * bf_hi(a.w) + w1 * bf_hi(b.w) + w2 * bf_hi(c.w));
          *(GAS v4u*)((bf16*)(F.ws + WS_YA) + (size_t)t * 512 + 8 * lane) = o; }
        const int pos = t & (SEQ - 1);
#pragma unroll
        for (int half = 0; half < 2; ++half) {
            const int c = 8 * lane + 512 * half;
            float z[3][8];
#pragma unroll
            for (int dd = 0; dd < 3; ++dd) {
                const int back = 2 - dd;
                if (pos - back >= 0) { const bf16* p = PROJ + (size_t)(t - back) * NPROJ + 4608 + c; const v4u gc = *(const GAS v4u*)(p + 1024), xc = *(const GAS v4u*)(p + 2048);
                    z[dd][0] = bf_lo(gc.x) * bf_lo(xc.x); z[dd][1] = bf_hi(gc.x) * bf_hi(xc.x); z[dd][2] = bf_lo(gc.y) * bf_lo(xc.y); z[dd][3] = bf_hi(gc.y) * bf_hi(xc.y);
                    z[dd][4] = bf_lo(gc.z) * bf_lo(xc.z); z[dd][5] = bf_hi(gc.z) * bf_hi(xc.z); z[dd][6] = bf_lo(gc.w) * bf_lo(xc.w); z[dd][7] = bf_hi(gc.w) * bf_hi(xc.w); }
                else {
#pragma unroll
                    for (int i = 0; i < 8; ++i) z[dd][i] = 0.f; }
            }
            const v4u gb = *(const GAS v4u*)(PROJ + (size_t)t * NPROJ + 4608 + c);
            float y[8];
#pragma unroll
            for (int i = 0; i < 8; ++i) y[i] = in.conv_w[c + i] * z[0][i] + in.conv_w[1024 + c + i] * z[1][i] + in.conv_w[2048 + c + i] * z[2][i];
            v4u o; o.x = pk2(bf_lo(gb.x) * y[0], bf_hi(gb.x) * y[1]); o.y = pk2(bf_lo(gb.y) * y[2], bf_hi(gb.y) * y[3]); o.z = pk2(bf_lo(gb.z) * y[4], bf_hi(gb.z) * y[5]); o.w = pk2(bf_lo(gb.w) * y[6], bf_hi(gb.w) * y[7]);
            *(GAS v4u*)((bf16*)(F.ws + WS_YC) + (size_t)t * 1024 + c) = o;
        }
    }
}


__device__ __forceinline__ void cross_attn_unit_mfma(Frame& F, int unit) {
    const int qc = unit & 31, bh = unit >> 5, h = bh & 3, b = bh >> 2, tid = F.tid, lane = F.lane, w = F.wave, qi = lane & 15, G = lane >> 4;
    const bf16* KV = (const bf16*)(F.ws + WS_KV); const bf16* Q2 = (const bf16*)(F.ws + WS_Q2);
    LAS bf16* Ks = (LAS bf16*)F.lds; LAS bf16* Vs = Ks + 256 * 136;
#pragma unroll
    for (int it = 0; it < 8; ++it) {
        const int row = (tid >> 4) + 32 * it, ch = tid & 15; const bf16* p = KV + (size_t)(b * NMEM + row) * 1024 + h * 128 + ch * 8;
        *(LAS v4u*)(Ks + row * 136 + ch * 8) = *(const GAS v4u*)p; *(LAS v4u*)(Vs + row * 136 + ch * 8) = *(const GAS v4u*)(p + 512);
    }
    const size_t grow = (size_t)b * SEQ + 128 * qc + 16 * w + qi;
    bf16x8v q[4];
#pragma unroll
    for (int ks = 0; ks < 4; ++ks) q[ks] = *(const GAS bf16x8v*)(Q2 + grow * 512 + h * 128 + 32 * ks + 8 * G);
    __syncthreads();
    pg8::f32x4 st[16];
#pragma unroll
    for (int t = 0; t < 16; ++t) {
        const LAS bf16* kp = Ks + (16 * t + qi) * 136 + 8 * G;
        pg8::f32x4 a = (pg8::f32x4){0.f, 0.f, 0.f, 0.f};
#pragma unroll
        for (int ks = 0; ks < 4; ++ks) a = __builtin_amdgcn_mfma_f32_16x16x32_bf16(*(const LAS bf16x8v*)(kp + 32 * ks), q[ks], a, 0, 0, 0);
        st[t] = a;
    }
    const float sc = 0.08838834764831845f * LOG2E;
    float mx = -1e30f;
#pragma unroll
    for (int t = 0; t < 16; ++t)
#pragma unroll
        for (int i = 0; i < 4; ++i) { st[t][i] *= sc; mx = fmaxf(mx, st[t][i]); }
    mx = fmaxf(mx, __shfl_xor(mx, 16)); mx = fmaxf(mx, __shfl_xor(mx, 32));
    float l = 0.f;
#pragma unroll
    for (int t = 0; t < 16; ++t)
#pragma unroll
        for (int i = 0; i < 4; ++i) { const float pv = __builtin_amdgcn_exp2f(st[t][i] - mx); st[t][i] = pv; l += pv; }
    l += __shfl_xor(l, 16); l += __shfl_xor(l, 32);
    pg8::f32x4 o[8];
#pragma unroll
    for (int dm = 0; dm < 8; ++dm) o[dm] = (pg8::f32x4){0.f, 0.f, 0.f, 0.f};
#pragma unroll
    for (int s8 = 0; s8 < 8; ++s8) {
        const pg8::f32x4 pa = st[2 * s8], pb = st[2 * s8 + 1];
        const bf16x8v pf = __builtin_bit_cast(bf16x8v, (v4u){pk2(pa[0], pa[1]), pk2(pa[2], pa[3]), pk2(pb[0], pb[1]), pk2(pb[2], pb[3])});
        const LAS bf16* vbase = Vs + (32 * s8 + 4 * G + (qi >> 2)) * 136 + 4 * (qi & 3);
#pragma unroll
        for (int dm = 0; dm < 8; ++dm) {
            const s16x4v lo = lds_tr16(vbase + 16 * dm), hi = lds_tr16(vbase + 16 * 136 + 16 * dm);
            const bf16x8v vf = (bf16x8v){lo[0], lo[1], lo[2], lo[3], hi[0], hi[1], hi[2], hi[3]};
            o[dm] = __builtin_amdgcn_mfma_f32_16x16x32_bf16(vf, pf, o[dm], 0, 0, 0);
        }
    }
    const float inv = 1.f / l;
    bf16* op = (bf16*)(F.ws + WS_O2) + grow * 512 + h * 128 + 4 * G;
#pragma unroll
    for (int dm = 0; dm < 8; ++dm) *(GAS u64*)(op + 16 * dm) = (u64)pk2(o[dm][0] * inv, o[dm][1] * inv) | ((u64)pk2(o[dm][2] * inv, o[dm][3] * inv) << 32);
    __syncthreads();
}

__device__ __forceinline__ void phase_router(Frame& F, const In& in, const float* H2) {
    LAS float* wl = (LAS float*)F.lds; LAS float* part = (LAS float*)(F.lds + 131072); LAS float* ssq = part + 2 * 64 * 32; LAS float* rsl = ssq + 128;
    volatile LAS int* hist = (volatile LAS int*)(F.lds + TBL_OFF + 1024);
    const int tid = F.tid, lane = F.lane, w = F.wave;
    for (int i = tid; i < 1024 * 8; i += NTHREADS) { const int k = i >> 3, c4 = i & 7; const f32x4 v = ((const GAS f32x4*)in.router_w)[i] * in.norm_moe[k];
        *(LAS f32x4*)(wl + k * 32 + ((4 * c4 + 16 * ((k >> 7) & 1)) & 31)) = v; }
    if (tid < 32) hist[tid] = 0;
    __syncthreads();
    int* topi = (int*)(F.ws + WS_TOPI); float* topw = (float*)(F.ws + WS_TOPW); bf16* U3 = (bf16*)(F.ws + WS_U3);
    for (int ch = F.vcu; ch < T / 64; ch += F.G) {
    const int t0 = ch * 64;
    {
        const int tg = w & 3, kh = w >> 2, ti = lane & 15, kq = lane >> 4, kbase = kh * 512 + kq * 128;
        const GAS f32x4* xr = (const GAS f32x4*)(H2 + (size_t)(t0 + 16 * tg + ti) * D + kbase);
        const LAS float* wb = wl + kbase * 32 + ((ti + 16 * (kq & 1)) & 31);
        const LAS float* wb2 = wl + kbase * 32 + ((ti + 16 + 16 * (kq & 1)) & 31);
        f32x4 c0 = (f32x4){0.f, 0.f, 0.f, 0.f}, c1 = c0; float sq = 0.f;
#pragma unroll 2
        for (int c8 = 0; c8 < 4; ++c8) {
            f32x4 x[8];
#pragma unroll
            for (int q = 0; q < 8; ++q) x[q] = xr[8 * c8 + q];
#pragma unroll
            for (int q = 0; q < 8; ++q) {
                const int kk = 4 * (8 * c8 + q);
                c0 = __builtin_amdgcn_mfma_f32_16x16x4f32(x[q].x, wb[(kk + 0) * 32], c0, 0, 0, 0); c1 = __builtin_amdgcn_mfma_f32_16x16x4f32(x[q].x, wb2[(kk + 0) * 32], c1, 0, 0, 0);
                c0 = __builtin_amdgcn_mfma_f32_16x16x4f32(x[q].y, wb[(kk + 1) * 32], c0, 0, 0, 0); c1 = __builtin_amdgcn_mfma_f32_16x16x4f32(x[q].y, wb2[(kk + 1) * 32], c1, 0, 0, 0);
                c0 = __builtin_amdgcn_mfma_f32_16x16x4f32(x[q].z, wb[(kk + 2) * 32], c0, 0, 0, 0); c1 = __builtin_amdgcn_mfma_f32_16x16x4f32(x[q].z, wb2[(kk + 2) * 32], c1, 0, 0, 0);
                c0 = __builtin_amdgcn_mfma_f32_16x16x4f32(x[q].w, wb[(kk + 3) * 32], c0, 0, 0, 0); c1 = __builtin_amdgcn_mfma_f32_16x16x4f32(x[q].w, wb2[(kk + 3) * 32], c1, 0, 0, 0);
                sq += (x[q].x * x[q].x + x[q].y * x[q].y) + (x[q].z * x[q].z + x[q].w * x[q].w);
            }
        }
        sq += __shfl_xor(sq, 16); sq += __shfl_xor(sq, 32);
        if (kq == 0) ssq[kh * 64 + 16 * tg + ti] = sq;
#pragma unroll
        for (int r = 0; r < 4; ++r) { LAS float* pp = part + (kh * 64 + 16 * tg + 4 * kq + r) * 32 + ti; pp[0] = c0[r]; pp[16] = c1[r]; }
    }
    __syncthreads();
    if (tid < 64) {
        const int t = t0 + tid; const float rstd = 1.f / sqrtf((ssq[tid] + ssq[64 + tid]) * (1.f / D) + EPS); rsl[tid] = rstd;
        LAS float* lg = part + tid * 32;
        for (int e = 0; e < 32; ++e) lg[e] = (lg[e] + lg[64 * 32 + e]) * rstd + in.router_b[e];
        float tv[4]; int tix[4];
#pragma unroll
        for (int k = 0; k < 4; ++k) { float bv = -INFINITY; int bi = 0; for (int e = 0; e < 32; ++e) { const float v = lg[e]; if (v > bv) { bv = v; bi = e; } } tv[k] = bv; tix[k] = bi; lg[bi] = -INFINITY; }
        const float e1 = __expf(tv[1] - tv[0]), e2 = __expf(tv[2] - tv[0]), e3 = __expf(tv[3] - tv[0]), inv = 1.f / (1.f + e1 + e2 + e3);
        topi[t * 4 + 0] = tix[0]; topi[t * 4 + 1] = tix[1]; topi[t * 4 + 2] = tix[2]; topi[t * 4 + 3] = tix[3];
        topw[t * 4 + 0] = inv; topw[t * 4 + 1] = e1 * inv; topw[t * 4 + 2] = e2 * inv; topw[t * 4 + 3] = e3 * inv;
#pragma unroll
        for (int k = 0; k < 4; ++k) __hip_atomic_fetch_add((LAS int*)(F.lds + TBL_OFF + 1024) + tix[k], 1, __ATOMIC_RELAXED, __HIP_MEMORY_SCOPE_WORKGROUP);
    }
    __syncthreads();
    for (int tl = w; tl < 64; tl += NWAVES) {
        const int t = t0 + tl; const float rstd = rsl[tl];
        const GAS f32x4* xr = (const GAS f32x4*)(H2 + (size_t)t * D) + lane; const GAS f32x4* gr = (const GAS f32x4*)in.norm_moe + lane; GAS u64* u3r = (GAS u64*)(U3 + (size_t)t * D) + lane;
#pragma unroll
        for (int j = 0; j < 4; ++j) { const f32x4 v = xr[64 * j] * gr[64 * j] * rstd; u3r[64 * j] = (u64)pk2(v.x, v.y) | ((u64)pk2(v.z, v.w) << 32); }
    }
    __syncthreads();
    }
    if (tid < 32) ((int*)(F.ws + WS_HIST))[F.vcu * 32 + tid] = hist[tid];
    __syncthreads();
}

__device__ __forceinline__ void phase_assign(Frame& F) {
    volatile LAS int* tb = (volatile LAS int*)(F.lds + TBL_OFF);
    LAS int* part = (LAS int*)F.lds;
    const int* HIST = (const int*)(F.ws + WS_HIST); const int tid = F.tid, e = tid & 31, pt = tid >> 5;
    { int tot = 0, bef = 0; for (int b = pt; b < F.G; b += 16) { const int h = HIST[b * 32 + e]; tot += h; bef += (b < F.vcu) ? h : 0; } part[pt * 64 + e] = tot; part[pt * 64 + 32 + e] = bef; }
    __syncthreads();
    if (tid < 32) { int tot = 0, bef = 0; for (int q = 0; q < 16; ++q) { tot += part[q * 64 + tid]; bef += part[q * 64 + 32 + tid]; } tb[64 + tid] = tot; tb[128 + tid] = bef; tb[160 + tid] = 0; }
    __syncthreads();
    if (tid == 0) { int acc = 0; for (int k = 0; k < NEXP; ++k) { tb[k] = acc; acc += (tb[64 + k] + 255) >> 8; } tb[32] = acc; }
    __syncthreads();
    if (tid < 32) { tb[128 + tid] += tb[tid] * 256; if (F.vcu == 0) ((unsigned*)(F.ws + WS_CTL + CTL_CNT))[tid] = (unsigned)tb[64 + tid]; }
    __syncthreads();
    int* rowtok = (int*)(F.ws + WS_CTL + CTL_ROWTOK); int* rowslot = (int*)(F.ws + WS_ROWSLOT); const int* topi = (const int*)(F.ws + WS_TOPI);
    if (F.vcu < NEXP) { const int x = F.vcu; for (int R = tb[x] * 256 + tb[64 + x] + tid; R < tb[x + 1] * 256; R += NTHREADS) rowslot[R] = -1; }
    for (int ch = F.vcu; ch < T / 64; ch += F.G)
    for (int a = ch * 256 + tid; a < ch * 256 + 256; a += NTHREADS) {
        const int x = topi[a];
        const int rank = __hip_atomic_fetch_add((LAS int*)(F.lds + TBL_OFF) + 160 + x, 1, __ATOMIC_RELAXED, __HIP_MEMORY_SCOPE_WORKGROUP);
        const int R = tb[128 + x] + rank; rowtok[R] = a >> 2; rowslot[R] = a;
    }
    __syncthreads();
}

__device__ __forceinline__ void build_tpre(Frame& F) {
    volatile LAS int* tpre = (volatile LAS int*)(F.lds + TBL_OFF);
    const unsigned* cnt = (const unsigned*)(F.ws + WS_CTL + CTL_CNT);
    if (F.tid == 0) { int acc = 0;
        for (int e = 0; e < NEXP; ++e) { tpre[e] = acc; const unsigned c = __hip_atomic_load(cnt + e, __ATOMIC_RELAXED, __HIP_MEMORY_SCOPE_AGENT); tpre[64 + e] = (int)c; acc += (int)((c + 255u) >> 8); }
        tpre[32] = acc; }
    __syncthreads();
}

__device__ __forceinline__ void phase_final(Frame& F, const In& in, const float* H2, float* OUT) {
    const int gw = F.vcu * NWAVES + F.wave, NGW = F.G * NWAVES, lane = F.lane;
    const bf16* Y = (const bf16*)(F.ws + WS_Y);
    for (int t = gw; t < T; t += NGW) {
        const GAS f32x4* xr = (const GAS f32x4*)(H2 + (size_t)t * D) + lane; const GAS f32x4* gr = (const GAS f32x4*)in.norm_final + lane;
        f32x4 v[4]; float s = 0.f;
#pragma unroll
        for (int j = 0; j < 4; ++j) v[j] = xr[64 * j];
#pragma unroll
        for (int k = 0; k < 4; ++k) { const GAS u64* yr = (const GAS u64*)(Y + (size_t)(t * 4 + k) * D) + lane;
#pragma unroll
            for (int j = 0; j < 4; ++j) { const u64 w = yr[64 * j]; const unsigned lo = (unsigned)w, hi = (unsigned)(w >> 32); v[j].x += bf_lo(lo); v[j].y += bf_hi(lo); v[j].z += bf_lo(hi); v[j].w += bf_hi(hi); } }
#pragma unroll
        for (int j = 0; j < 4; ++j) s += (v[j].x * v[j].x + v[j].y * v[j].y) + (v[j].z * v[j].z + v[j].w * v[j].w);
        const float rstd = 1.f / sqrtf(wave_sum(s) * (1.f / D) + EPS);
        GAS f32x4* orow = (GAS f32x4*)(OUT + (size_t)t * D) + lane;
#pragma unroll
        for (int j = 0; j < 4; ++j) orow[64 * j] = v[j] * gr[64 * j] * rstd;
    }
}
struct Args { const float* in[25]; float* out; unsigned char* ws; int ph_lo, ph_hi; };
#ifndef PG8_SP2
#define PG8_SP2 true
#endif
#ifndef PG8_ALIGN
#define PG8_ALIGN true
#endif
__global__ void __launch_bounds__(NTHREADS, 2) mega_fwd(Args args) {
    extern __shared__ __attribute__((aligned(16))) unsigned char lds[];
    Frame F;
    F.lds = (LAS unsigned char*)lds; F.MISC = (volatile LAS unsigned*)(F.lds + MISC_OFF);
    F.tid = threadIdx.x; F.lane = F.tid & 63; F.wave = __builtin_amdgcn_readfirstlane(F.tid >> 6);
    F.G = gridDim.x; { const int bx = blockIdx.x; F.vcu = (F.G % 8 == 0) ? (bx % 8) * (F.G / 8) + bx / 8 : bx; }
    F.ws = args.ws; F.ctl = (gu32*)(args.ws + WS_CTL);
    In in;
    in.x = args.in[0]; in.mem = args.in[1]; in.norm_mix = args.in[2]; in.w_in = args.in[3]; in.conv_w = args.in[4]; in.w_ba = args.in[5]; in.w_bc = args.in[6];
    in.w_gate = args.in[7]; in.b_gate = args.in[8]; in.w_out = args.in[9]; in.norm_cross = args.in[10]; in.norm_mem = args.in[11]; in.w_cq = args.in[12];
    in.w_ckv = args.in[13]; in.w_co = args.in[14]; in.norm_moe = args.in[15]; in.router_w = args.in[16]; in.router_b = args.in[17]; in.w_eg = args.in[18];
    in.b_eg = args.in[19]; in.w_eu = args.in[20]; in.b_eu = args.in[21]; in.w_ed = args.in[22]; in.b_ed = args.in[23]; in.norm_final = args.in[24];
    unsigned char* ws = args.ws;
    for (int u = F.tid; u < 64; u += NTHREADS) ((LAS unsigned*)(F.lds + MISC_OFF))[u] = 0u;
    __syncthreads();
    XcdBarrier bar; bar.bar = (unsigned*)(F.ctl + CW_BAR); bar.x = 0; bar.st = nullptr;
    if (N_LAUNCHES == 1) bar = xcd_barrier_post((unsigned*)(F.ctl + CW_BAR), F.MISC + 8);
    const int lo = args.ph_lo, hi = args.ph_hi;
#define IN(k) (lo <= (k) && (k) < hi)
#define SEAM(k) do { if (IN(k) && IN((k) + 1)) xcd_barrier(bar); } while (0)
    typedef pg8::bf16_t b16;

    if (IN(0)) { phase_prologue(F, in); } SEAM(0);

    if (IN(1)) {
        pg8::Gemm g{(const b16*)(ws + WS_U1), (const b16*)(ws + WS_W1T), T, NPROJ, D}; pg8::StaticOrder S; S.init(T, NPROJ, F.G, (int)blockIdx.x);
        pg8::EpiProj E{(b16*)(ws + WS_PROJ), in.b_gate};
        pg8::gemm_phase<pg8::EpiProj, pg8::StaticOrder, PG8_ALIGN, PG8_SP2>(F.lds, g, S, E);
    } SEAM(1);

    if (IN(2)) { for (int u = blockIdx.x; u < NBATCH * 3 * 8 * 32; u += F.G) dil_attn_unit_mfma(F, u); } SEAM(2);

    if (IN(3)) { phase_combine_conv(F, in); } SEAM(3);

    if (IN(4)) {
        { pg8::Gemm g{(const b16*)(ws + WS_YA), (const b16*)(ws + WS_WBA), T, D, 512}; pg8::StaticOrder S; S.init(T, D, F.G, (int)blockIdx.x);
          pg8::EpiMix<false> E{(b16*)(ws + WS_MIX), (const b16*)(ws + WS_PROJ)};
          pg8::gemm_phase<pg8::EpiMix<false>, pg8::StaticOrder, PG8_ALIGN, PG8_SP2>(F.lds, g, S, E); }
        { pg8::Gemm g{(const b16*)(ws + WS_YC), (const b16*)(ws + WS_WBC), T, D, D}; pg8::StaticOrder S; S.init(T, D, F.G, (int)blockIdx.x);
          pg8::EpiMix<true> E{(b16*)(ws + WS_MIX), (const b16*)(ws + WS_PROJ)};
          pg8::gemm_phase<pg8::EpiMix<true>, pg8::StaticOrder, PG8_ALIGN, PG8_SP2>(F.lds, g, S, E); }
    } SEAM(4);

    if (IN(5)) {
        { pg8::Gemm g{(const b16*)(ws + WS_MIX), (const b16*)(ws + WS_WO), T, D, D}; pg8::StaticOrder S; S.init(T, D, F.G, (int)blockIdx.x);
          pg8::EpiH1 E{in.x, (float*)(ws + WS_H1), (b16*)(ws + WS_H1B), (float*)(ws + WS_CTL + CTL_SS2)};
          pg8::gemm_phase<pg8::EpiH1, pg8::StaticOrder, PG8_ALIGN, PG8_SP2>(F.lds, g, S, E); }
        phase_expert_convert(F, in);
    } SEAM(5);

    if (IN(6)) {
        { pg8::Gemm g{(const b16*)(ws + WS_H1B), (const b16*)(ws + WS_WCQ), T, 512, D}; pg8::StaticOrder S; S.init(T, 512, F.G, (int)blockIdx.x);
          pg8::EpiQ2 E{(b16*)(ws + WS_Q2), (const float*)(ws + WS_CTL + CTL_SS2)};
          pg8::gemm_phase<pg8::EpiQ2, pg8::StaticOrder, PG8_ALIGN, PG8_SP2>(F.lds, g, S, E); }
        { pg8::Gemm g{(const b16*)(ws + WS_MN), (const b16*)(ws + WS_WCKV), NBATCH * NMEM, D, D}; pg8::StaticOrder S; S.init(NBATCH * NMEM, D, F.G, ((int)blockIdx.x + F.G - 128) % F.G);
          pg8::EpiPlain E{(b16*)(ws + WS_KV), D};
          pg8::gemm_phase<pg8::EpiPlain, pg8::StaticOrder, PG8_ALIGN, PG8_SP2>(F.lds, g, S, E); }
    } SEAM(6);

    if (IN(7)) { for (int u = blockIdx.x; u < NBATCH * 4 * 32; u += F.G) cross_attn_unit_mfma(F, u); } SEAM(7);

    if (IN(8)) {
        pg8::Gemm g{(const b16*)(ws + WS_O2), (const b16*)(ws + WS_WCO), T, D, 512}; pg8::StaticOrder S; S.init(T, D, F.G, (int)blockIdx.x);
        pg8::EpiH2 E{(const float*)(ws + WS_H1), args.out};
        pg8::gemm_phase<pg8::EpiH2, pg8::StaticOrder, PG8_ALIGN, PG8_SP2>(F.lds, g, S, E);
    } SEAM(8);

    if (IN(9)) { phase_router(F, in, args.out); } SEAM(9);

    if (IN(10)) { phase_assign(F); } SEAM(10);

    if (IN(11)) {
        build_tpre(F);
        pg8::Gemm g{(const b16*)(ws + WS_U3), (const b16*)(ws + WS_EXPGU), T, NEXP * 2048, D};
        MoeOrder S{(const volatile LAS int*)(F.lds + TBL_OFF), 8, F.G, (int)blockIdx.x};
        LAS int* rowbuf = (LAS int*)(F.lds + ROWBUF_OFF); const int* rowtok = (const int*)(ws + WS_CTL + CTL_ROWTOK);
        { pg8::Unit uu; for (int i = 0; i < ROWBUF_UNITS && S.next(i, uu); ++i) if (F.tid < 256) rowbuf[256 * i + F.tid] = rowtok[uu.pm * 256 + F.tid]; }
        __syncthreads();
        pg8::EpiHdn E{(b16*)(ws + WS_HDN), in.b_eg, in.b_eu};
        pg8::gemm_phase_gather<pg8::EpiHdn, MoeOrder>(F.lds, g, S, E, (const LAS int*)rowbuf);
    } SEAM(11);

    if (IN(12)) {
        build_tpre(F);
        pg8::Gemm g{(const b16*)(ws + WS_HDN), (const b16*)(ws + WS_EXPD), XS_ROWS, NEXP * 1024, D};
        MoeOrder S{(const volatile LAS int*)(F.lds + TBL_OFF), 4, F.G, (int)blockIdx.x};
        pg8::EpiY E{(b16*)(ws + WS_Y), in.b_ed, (const int*)(ws + WS_ROWSLOT), (const float*)(ws + WS_TOPW)};
        pg8::gemm_phase<pg8::EpiY, MoeOrder, PG8_ALIGN, PG8_SP2>(F.lds, g, S, E);
    } SEAM(12);

    if (IN(13)) { phase_final(F, in, args.out, args.out); }
#undef IN
#undef SEAM
}

extern "C" void kernel_launch(void* const* d_in, const int* in_sizes, int n_in, void* d_out, int out_size, void* d_ws, size_t ws_size, hipStream_t stream) {
    static int grid = 0;
    if (grid == 0) {
        if (n_in != 25 || in_sizes[0] != T * D || out_size != T * D || ws_size < WS_END) {
            fprintf(stderr, "kernel_launch: built for 25 inputs, x/out of %d floats, >= %zu bytes of workspace; got n_in %d, in0 %d, out %d, ws %zu; nothing launched\n", T * D, (size_t)WS_END, n_in, n_in > 0 ? in_sizes[0] : -1, out_size, ws_size);
            grid = -1; return; }
        int dev = 0, cus = 0, per_cu = 0;
        if (hipGetDevice(&dev) != hipSuccess || hipDeviceGetAttribute(&cus, hipDeviceAttributeMultiprocessorCount, dev) != hipSuccess) { fprintf(stderr, "kernel_launch: device query failed\n"); grid = -1; return; }
        if (hipFuncSetAttribute((const void*)mega_fwd, hipFuncAttributeMaxDynamicSharedMemorySize, LDS_BYTES) != hipSuccess) { fprintf(stderr, "kernel_launch: hipFuncSetAttribute(%d B LDS) failed\n", LDS_BYTES); grid = -1; return; }
        if (hipOccupancyMaxActiveBlocksPerMultiprocessor(&per_cu, (const void*)mega_fwd, NTHREADS, LDS_BYTES) != hipSuccess || per_cu < 1) { fprintf(stderr, "kernel_launch: occupancy query says %d workgroups per CU\n", per_cu); per_cu = 1; }
        (void)hipGetLastError();
        grid = cus < 256 ? cus : 256;
    }
    if (grid < 0) return;
    (void)hipMemsetAsync((char*)d_ws + WS_CTL, 0, CTL_ZERO_BYTES, stream);
    Args a{};
    for (int i = 0; i < 25; ++i) a.in[i] = (const float*)d_in[i];
    a.out = (float*)d_out; a.ws = (unsigned char*)d_ws;
    if (N_LAUNCHES == 1) {
        a.ph_lo = 0; a.ph_hi = N_PHASES;
        void* kargs[] = {&a};
        hipError_t e = hipLaunchCooperativeKernel((const void*)mega_fwd, dim3(grid), dim3(NTHREADS), kargs, LDS_BYTES, stream);
        if (e != hipSuccess) fprintf(stderr, "kernel_launch: cooperative launch failed: %s (grid %d)\n", hipGetErrorString(e), grid);
    } else {
        for (int p = 0; p < N_PHASES; ++p) { a.ph_lo = p; a.ph_hi = p + 1; hipLaunchKernelGGL(mega_fwd, dim3(grid), dim3(NTHREADS), LDS_BYTES, stream, a);
        }
    }
}
```

```cpp
#include <hip/hip_runtime.h>
#include <cstdio>
#include <cstdint>
namespace pg8 {
#define PG8_LAS __attribute__((address_space(3)))
typedef unsigned short bf16_t;
typedef short bf16x8 __attribute__((ext_vector_type(8)));
typedef float f32x4 __attribute__((ext_vector_type(4)));
typedef unsigned u32x4 __attribute__((ext_vector_type(4)));
constexpr int BM = 256, BK = 64, HALF = 128, HTB = HALF * BK * 2  , STAGE_BYTES = 8 * HTB, NXCD = 8, WGM = 8;

__host__ __device__ __forceinline__ int lds_byte(int r, int c) { const int st = (r >> 4) * 2 + (c >> 5), rr = r & 15, cc = c & 31, ob = rr * 64 + cc * 2; return st * 1024 + (ob ^ (((ob >> 9) & 1) << 5)); }
__host__ __device__ __forceinline__ void stage_rc(int b, int& R, int& C) { const int st = b / 1024, sb = b % 1024, swz = sb ^ (((sb >> 9) & 1) << 5); R = (st >> 1) * 16 + swz / 64; C = (st & 1) * 32 + (swz % 64) / 2; }
__host__ __device__ __forceinline__ int perm32(int rho) { const int n = rho >> 4, i = rho & 15; return 8 * (i >> 2) + 4 * n + (i & 3); }

struct Unit { int pm, pn; };
struct Gemm { const bf16_t* A; const bf16_t* Bt; int M, N, K; };

struct StaticOrder {
    int nM, nN, nwg, G, c;
    __host__ __device__ void init(int M, int N, int G_, int c_) { nM = M / BM; nN = N / BM; nwg = nM * nN; G = G_; c = c_; }
    __host__ __device__ bool next(int i, Unit& u) const {
        const long L = (long)i * G + c; if (L >= nwg) return false;
        int wgid = (int)L; { const int q = nwg / NXCD, r = nwg % NXCD, xcd = wgid % NXCD, off = wgid / NXCD; wgid = (xcd < r ? xcd * (q + 1) : r * (q + 1) + (xcd - r) * q) + off; }
        const int nig = WGM * nN, gid = wgid / nig, fm = gid * WGM, gsz = (nM - fm) < WGM ? (nM - fm) : WGM;
        u.pm = fm + ((wgid % nig) % gsz); u.pn = (wgid % nig) / gsz; return true;
    }
    __device__ __forceinline__ void a_ready(const Unit&) const {}
    __device__ __forceinline__ void done(const Unit&) const {}
};

__device__ __forceinline__ unsigned cvt_pk_bf16(float lo, float hi) { unsigned r; asm volatile("v_cvt_pk_bf16_f32 %0, %1, %2" : "=v"(r) : "v"(lo), "v"(hi)); return r; }
__device__ __forceinline__ float bflo(unsigned w) { return __builtin_bit_cast(float, w << 16); }
__device__ __forceinline__ float bfhi(unsigned w) { return __builtin_bit_cast(float, w & 0xffff0000u); }
__device__ __forceinline__ void unpack8(const u32x4 w, f32x4& a, f32x4& b) { a = (f32x4){bflo(w.x), bfhi(w.x), bflo(w.y), bfhi(w.y)}; b = (f32x4){bflo(w.z), bfhi(w.z), bflo(w.w), bfhi(w.w)}; }
__device__ __forceinline__ u32x4 pack8(const f32x4 a, const f32x4 b) { u32x4 w; w.x = cvt_pk_bf16(a[0], a[1]); w.y = cvt_pk_bf16(a[2], a[3]); w.z = cvt_pk_bf16(b[0], b[1]); w.w = cvt_pk_bf16(b[2], b[3]); return w; }
__device__ __forceinline__ float sigmoidf_fast(float x) { return __builtin_amdgcn_rcpf(1.0f + __builtin_amdgcn_exp2f(-1.4426950408889634f * x)); }
__device__ __forceinline__ f32x4 sig4(f32x4 v) { return (f32x4){sigmoidf_fast(v[0]), sigmoidf_fast(v[1]), sigmoidf_fast(v[2]), sigmoidf_fast(v[3])}; }

typedef int v8i32 __attribute__((ext_vector_type(8)));
typedef int v4i32 __attribute__((ext_vector_type(4)));
__device__ __forceinline__ void mfma_f8_inplace(f32x4& c, const v8i32& a, const v8i32& b, int scale) {
    asm volatile("s_nop 1\n\tv_mfma_scale_f32_16x16x128_f8f6f4 %0, %1, %2, %0, %3, %3 op_sel_hi:[0,0,0]" : "+v"(c) : "v"(a), "v"(b), "v"(scale)); }
template <bool F8> struct FragSel;
template <> struct FragSel<false> { struct A { bf16x8 f[4][2]; }; struct B { bf16x8 f[2][2]; }; };
template <> struct FragSel<true> { struct A { v8i32 f[4]; }; struct B { v8i32 f[2]; }; };
__device__ __forceinline__ unsigned pack4_fp8(const f32x4 v) { int w = 0; w = __builtin_amdgcn_cvt_pk_fp8_f32(v[0], v[1], w, false); w = __builtin_amdgcn_cvt_pk_fp8_f32(v[2], v[3], w, true); return (unsigned)w; }
constexpr float W8_SCALE = 32.f, W8_INV = 1.f / 32.f;
#define EPI_ROWS_BEGIN _Pragma("unroll") for (int ai = 0; ai < 2; ++ai) _Pragma("unroll") for (int m = 0; m < 4; ++m) { const int rowl = ai * HALF + wr * 64 + m * 16 + fr;
#define EPI_COLS_BEGIN _Pragma("unroll") for (int bj = 0; bj < 2; ++bj) { const int coll = bj * HALF + wc * 32 + 8 * fq; f32x4 v0 = acc[ai][bj][m][0], v1 = acc[ai][bj][m][1];
#define EPI_END }

struct EpiProj {
    static constexpr bool PERM = true, AFTER_DRAIN = false;
    bf16_t* O; const float* bgate;
    __device__ __forceinline__ void operator()(const f32x4 (&acc)[2][2][4][2], const Unit& u, int wr, int wc, int fr, int fq) const {
        const int row0 = u.pm * BM, col0 = u.pn * BM; const bool gate = col0 >= 7680;
        EPI_ROWS_BEGIN EPI_COLS_BEGIN
            const int row = row0 + rowl, col = col0 + coll;
            if (gate) { const f32x4 b0 = *(const f32x4*)(bgate + (col - 7680)), b1 = *(const f32x4*)(bgate + (col - 7680) + 4); v0 = sig4(v0 + b0); v1 = sig4(v1 + b1); }
            *(u32x4*)(O + (size_t)row * 9728 + col) = pack8(v0, v1);
        EPI_END EPI_END
    }
};
struct EpiPlain {
    static constexpr bool PERM = true, AFTER_DRAIN = false;
    bf16_t* O; int ldc;
    __device__ __forceinline__ void operator()(const f32x4 (&acc)[2][2][4][2], const Unit& u, int wr, int wc, int fr, int fq) const {
        const int row0 = u.pm * BM, col0 = u.pn * BM;
        EPI_ROWS_BEGIN EPI_COLS_BEGIN
            *(u32x4*)(O + (size_t)(row0 + rowl) * ldc + col0 + coll) = pack8(v0, v1);
        EPI_END EPI_END
    }
};
template <bool SECOND> struct EpiMix {
    static constexpr bool PERM = true, AFTER_DRAIN = false;
    bf16_t* MIX; const bf16_t* PROJ;
    __device__ __forceinline__ void operator()(const f32x4 (&acc)[2][2][4][2], const Unit& u, int wr, int wc, int fr, int fq) const {
        const int row0 = u.pm * BM, col0 = u.pn * BM;
        EPI_ROWS_BEGIN EPI_COLS_BEGIN
            const int row = row0 + rowl, col = col0 + coll;
            f32x4 g0, g1; unpack8(*(const u32x4*)(PROJ + (size_t)row * 9728 + (SECOND ? 8704 : 7680) + col), g0, g1);
            v0 = v0 * g0; v1 = v1 * g1;
            if (SECOND) { f32x4 t0, t1; unpack8(*(const u32x4*)(MIX + (size_t)row * 1024 + col), t0, t1); v0 = v0 + t0; v1 = v1 + t1; }
            *(u32x4*)(MIX + (size_t)row * 1024 + col) = pack8(v0, v1);
        EPI_END EPI_END
    }
};
struct EpiH1 {
    static constexpr bool PERM = true, AFTER_DRAIN = false;
    const float* X; float* H1; bf16_t* H1B; float* ss;
    __device__ __forceinline__ void operator()(const f32x4 (&acc)[2][2][4][2], const Unit& u, int wr, int wc, int fr, int fq) const {
        const int row0 = u.pm * BM, col0 = u.pn * BM;
        EPI_ROWS_BEGIN
            float s = 0.f; const int row = row0 + rowl;
            EPI_COLS_BEGIN
                const int col = col0 + coll; const size_t o = (size_t)row * 1024 + col;
                v0 = v0 + *(const f32x4*)(X + o); v1 = v1 + *(const f32x4*)(X + o + 4);
                *(f32x4*)(H1 + o) = v0; *(f32x4*)(H1 + o + 4) = v1; *(u32x4*)(H1B + o) = pack8(v0, v1);
                s += (v0[0] * v0[0] + v0[1] * v0[1]) + (v0[2] * v0[2] + v0[3] * v0[3]) + (v1[0] * v1[0] + v1[1] * v1[1]) + (v1[2] * v1[2] + v1[3] * v1[3]);
            EPI_END
            s += __shfl_xor(s, 16); s += __shfl_xor(s, 32);
            if (fq == 0) atomicAdd(ss + row, s);
        EPI_END
    }
};
struct EpiQ2 {
    static constexpr bool PERM = true, AFTER_DRAIN = false;
    bf16_t* Q2; const float* ss;
    __device__ __forceinline__ void operator()(const f32x4 (&acc)[2][2][4][2], const Unit& u, int wr, int wc, int fr, int fq) const {
        const int row0 = u.pm * BM, col0 = u.pn * BM;
        EPI_ROWS_BEGIN
            const int row = row0 + rowl; const float rs = __builtin_amdgcn_rsqf(__hip_atomic_load(ss + row, __ATOMIC_RELAXED, __HIP_MEMORY_SCOPE_AGENT) * (1.f / 1024.f) + 1e-6f);
            EPI_COLS_BEGIN
                *(u32x4*)(Q2 + (size_t)row * 512 + col0 + coll) = pack8(v0 * rs, v1 * rs);
            EPI_END
        EPI_END
    }
};
struct EpiH2 {
    static constexpr bool PERM = true, AFTER_DRAIN = false;
    const float* H1; float* OUT;
    __device__ __forceinline__ void operator()(const f32x4 (&acc)[2][2][4][2], const Unit& u, int wr, int wc, int fr, int fq) const {
        const int row0 = u.pm * BM, col0 = u.pn * BM;
        EPI_ROWS_BEGIN EPI_COLS_BEGIN
            const size_t o = (size_t)(row0 + rowl) * 1024 + col0 + coll;
            *(f32x4*)(OUT + o) = v0 + *(const f32x4*)(H1 + o); *(f32x4*)(OUT + o + 4) = v1 + *(const f32x4*)(H1 + o + 4);
        EPI_END EPI_END
    }
};
struct EpiHdn {
    static constexpr bool PERM = true, AFTER_DRAIN = false;
    bf16_t* HDN; const float* bg; const float* bu;
    __device__ __forceinline__ void operator()(const f32x4 (&acc)[2][2][4][2], const Unit& u, int wr, int wc, int fr, int fq) const {
        const int row0 = u.pm * BM, e = u.pn >> 3, hc = (u.pn & 7) * 128 + wc * 32 + 8 * fq;
        const float* pg = bg + e * 1024 + hc; const float* pu = bu + e * 1024 + hc;
        const f32x4 bg0 = *(const f32x4*)pg, bg1 = *(const f32x4*)(pg + 4), bu0 = *(const f32x4*)pu, bu1 = *(const f32x4*)(pu + 4);
        EPI_ROWS_BEGIN
            f32x4 g0 = acc[ai][0][m][0] + bg0, g1 = acc[ai][0][m][1] + bg1, l0 = acc[ai][1][m][0] + bu0, l1 = acc[ai][1][m][1] + bu1, h0, h1;
#pragma unroll
            for (int j = 0; j < 4; ++j) {
                const float ga = fminf(g0[j], 7.f), gb = fminf(g1[j], 7.f), la = fminf(fmaxf(l0[j], -7.f), 7.f), lb = fminf(fmaxf(l1[j], -7.f), 7.f);
                h0[j] = ga * sigmoidf_fast(1.702f * ga) * (la + 1.f); h1[j] = gb * sigmoidf_fast(1.702f * gb) * (lb + 1.f); }
            *(u32x4*)(HDN + (size_t)(row0 + rowl) * 1024 + hc) = pack8(h0, h1);
        EPI_END
    }
};
struct EpiHdnF8 {
    static constexpr bool PERM = true, AFTER_DRAIN = false;
    unsigned char* HDN; const float* bg; const float* bu;
    __device__ __forceinline__ void operator()(const f32x4 (&acc)[2][2][4][2], const Unit& u, int wr, int wc, int fr, int fq) const {
        const int row0 = u.pm * BM, e = u.pn >> 3, hc = (u.pn & 7) * 128 + wc * 32 + 8 * fq;
        const float* pg = bg + e * 1024 + hc; const float* pu = bu + e * 1024 + hc;
        const f32x4 bg0 = *(const f32x4*)pg, bg1 = *(const f32x4*)(pg + 4), bu0 = *(const f32x4*)pu, bu1 = *(const f32x4*)(pu + 4);
        EPI_ROWS_BEGIN
            f32x4 g0 = acc[ai][0][m][0] * W8_INV + bg0, g1 = acc[ai][0][m][1] * W8_INV + bg1, l0 = acc[ai][1][m][0] * W8_INV + bu0, l1 = acc[ai][1][m][1] * W8_INV + bu1, h0, h1;
#pragma unroll
            for (int j = 0; j < 4; ++j) {
                const float ga = fminf(g0[j], 7.f), gb = fminf(g1[j], 7.f), la = fminf(fmaxf(l0[j], -7.f), 7.f), lb = fminf(fmaxf(l1[j], -7.f), 7.f);
                h0[j] = ga * sigmoidf_fast(1.702f * ga) * (la + 1.f); h1[j] = gb * sigmoidf_fast(1.702f * gb) * (lb + 1.f); }
            *(unsigned long long*)(HDN + (size_t)(row0 + rowl) * 1024 + hc) = (unsigned long long)pack4_fp8(h0) | ((unsigned long long)pack4_fp8(h1) << 32);
        EPI_END
    }
};
struct EpiYF8 {
    static constexpr bool PERM = true, AFTER_DRAIN = false;
    bf16_t* Y; const float* bd; const int* rowslot; const float* topw;
    __device__ __forceinline__ void operator()(const f32x4 (&acc)[2][2][4][2], const Unit& u, int wr, int wc, int fr, int fq) const {
        const int row0 = u.pm * BM, e = u.pn >> 2, col0 = (u.pn & 3) * BM;
        EPI_ROWS_BEGIN
            const int slot = rowslot[row0 + rowl];
            if (slot >= 0) { const float w = topw[slot];
                EPI_COLS_BEGIN
                    const int col = col0 + coll; const float* pb = bd + e * 1024 + col;
                    v0 = (v0 * W8_INV + *(const f32x4*)pb) * w; v1 = (v1 * W8_INV + *(const f32x4*)(pb + 4)) * w;
                    *(u32x4*)(Y + (size_t)slot * 1024 + col) = pack8(v0, v1);
                EPI_END }
        EPI_END
    }
};
struct EpiY {
    static constexpr bool PERM = true, AFTER_DRAIN = false;
    bf16_t* Y; const float* bd; const int* rowslot; const float* topw;
    __device__ __forceinline__ void operator()(const f32x4 (&acc)[2][2][4][2], const Unit& u, int wr, int wc, int fr, int fq) const {
        const int row0 = u.pm * BM, e = u.pn >> 2, col0 = (u.pn & 3) * BM;
        EPI_ROWS_BEGIN
            const int slot = rowslot[row0 + rowl];
            if (slot >= 0) { const float w = topw[slot];
                EPI_COLS_BEGIN
                    const int col = col0 + coll; const float* pb = bd + e * 1024 + col;
                    v0 = (v0 + *(const f32x4*)pb) * w; v1 = (v1 + *(const f32x4*)(pb + 4)) * w;
                    *(u32x4*)(Y + (size_t)slot * 1024 + col) = pack8(v0, v1);
                EPI_END }
        EPI_END
    }
};
template <class Epi, class Sched, bool ALIGN_EPI = false, bool SP2 = false, bool F8 = false>
__device__ __forceinline__ void gemm_phase(PG8_LAS unsigned char* lds, const Gemm g, const Sched& S, const Epi& E) {
    const int tid = threadIdx.x, wid = __builtin_amdgcn_readfirstlane(tid >> 6), lane = tid & 63, wr = wid >> 2, wc = wid & 3, fr = lane & 15, fq = lane >> 4;
    const int K = g.K, nt = K / BK;
    unsigned voffA[2], voffB[2];
#pragma unroll
    for (int i = 0; i < 2; ++i) { int R, C; stage_rc(tid * 16 + i * 8192, R, C); const int Rb = Epi::PERM ? ((R & ~31) + perm32(R & 31)) : R;
        voffA[i] = (unsigned)(R * K + C) * 2u; voffB[i] = (unsigned)(Rb * K + C) * 2u; }
    const size_t kstep = (size_t)(BK * 2);
    const size_t hstep = (size_t)HALF * K * 2;
    const size_t tstep = 2 * hstep;
    const unsigned ldsw = (unsigned)wid * 1024u;
    const int aoff = F8 ? lds_byte(wr * 64 + fr, fq * 16) : lds_byte(wr * 64 + fr, fq * 8), boff = F8 ? lds_byte(wc * 32 + fr, fq * 16) : lds_byte(wc * 32 + fr, fq * 8);
#define PG8_SA(b, h) (((b) * 2 + (h)) * HTB)
#define PG8_SB(b, h) ((4 + (b) * 2 + (h)) * HTB)
#define PG8_STAGE(bufoff, gbase, voff) do { _Pragma("unroll") for (int _i = 0; _i < 2; ++_i) \
        __builtin_amdgcn_global_load_lds((const unsigned*)((const char*)(gbase) + (voff)[_i]), (PG8_LAS unsigned*)(lds + (bufoff) + ldsw + _i * 8192), 16, 0, 0); } while (0)
#define PG8_LDA(dst, b, h) do { _Pragma("unroll") for (int m = 0; m < 4; ++m) { if constexpr (F8) { const v4i32 lo_ = *(const PG8_LAS v4i32*)(lds + PG8_SA(b, h) + aoff + m * 2048), hi_ = *(const PG8_LAS v4i32*)(lds + PG8_SA(b, h) + aoff + m * 2048 + 16); \
        dst.f[m] = __builtin_shufflevector(lo_, hi_, 0, 1, 2, 3, 4, 5, 6, 7); } else { _Pragma("unroll") for (int k = 0; k < 2; ++k) dst.f[m][k] = *(const PG8_LAS bf16x8*)(lds + PG8_SA(b, h) + aoff + m * 2048 + k * 1024); } } } while (0)
#define PG8_LDB(dst, b, h) do { _Pragma("unroll") for (int n = 0; n < 2; ++n) { if constexpr (F8) { const v4i32 lo_ = *(const PG8_LAS v4i32*)(lds + PG8_SB(b, h) + boff + n * 2048), hi_ = *(const PG8_LAS v4i32*)(lds + PG8_SB(b, h) + boff + n * 2048 + 16); \
        dst.f[n] = __builtin_shufflevector(lo_, hi_, 0, 1, 2, 3, 4, 5, 6, 7); } else { _Pragma("unroll") for (int k = 0; k < 2; ++k) dst.f[n][k] = *(const PG8_LAS bf16x8*)(lds + PG8_SB(b, h) + boff + n * 2048 + k * 1024); } } } while (0)
#define PG8_MMA(ai, bj, At, Bt) do { __builtin_amdgcn_s_setprio(1); \
        if constexpr (F8) { _Pragma("unroll") for (int m = 0; m < 4; ++m) _Pragma("unroll") for (int n = 0; n < 2; ++n) \
            mfma_f8_inplace(acc[ai][bj][m][n], Bt.f[n], At.f[m], f8scale); } \
        else { _Pragma("unroll") for (int m = 0; m < 4; ++m) _Pragma("unroll") for (int n = 0; n < 2; ++n) _Pragma("unroll") for (int k = 0; k < 2; ++k) \
            acc[ai][bj][m][n] = __builtin_amdgcn_mfma_f32_16x16x32_bf16(Bt.f[n][k], At.f[m][k], acc[ai][bj][m][n], 0, 0, 0); } \
        __builtin_amdgcn_s_setprio(0); } while (0)
#define PG8_WAIT_V(n) asm volatile("s_waitcnt vmcnt(" #n ")" ::: "memory")
#define PG8_WAIT_L(n) asm volatile("s_waitcnt lgkmcnt(" #n ")" ::: "memory")
#define PG8_BAR __builtin_amdgcn_s_barrier()
#define PG8_SCHED __builtin_amdgcn_sched_barrier(0)
    int f8scale = 0x7F7F7F7F; asm volatile("" : "+v"(f8scale));
    Unit cur, nxt; int ui = 0;
    if (!S.next(0, cur)) return;
    f32x4 acc[2][2][4][2];
#pragma unroll
    for (int a = 0; a < 2; ++a)
#pragma unroll
        for (int b = 0; b < 2; ++b)
#pragma unroll
            for (int m = 0; m < 4; ++m)
#pragma unroll
                for (int n = 0; n < 2; ++n) acc[a][b][m][n] = (f32x4){0.f, 0.f, 0.f, 0.f};
    typename FragSel<F8>::A At; typename FragSel<F8>::B B0, B1;
    const char* cA = (const char*)g.A + (size_t)cur.pm * tstep; const char* cB = (const char*)g.Bt + (size_t)cur.pn * tstep;
    S.a_ready(cur);
    if constexpr (SP2) {
        PG8_STAGE(PG8_SB(0, 0), cB, voffB); PG8_STAGE(PG8_SB(0, 1), cB + hstep, voffB); PG8_STAGE(PG8_SA(0, 0), cA, voffA); PG8_STAGE(PG8_SA(0, 1), cA + hstep, voffA);
        if (wr == 1) PG8_BAR;
        PG8_WAIT_V(2); PG8_BAR;
        PG8_STAGE(PG8_SB(1, 0), cB + kstep, voffB); PG8_STAGE(PG8_SA(1, 0), cA + kstep, voffA); PG8_STAGE(PG8_SB(1, 1), cB + hstep + kstep, voffB);
        PG8_WAIT_V(6); PG8_BAR;
    } else {
        PG8_STAGE(PG8_SB(0, 0), cB, voffB); PG8_STAGE(PG8_SA(0, 0), cA, voffA); PG8_STAGE(PG8_SB(0, 1), cB + hstep, voffB); PG8_STAGE(PG8_SA(0, 1), cA + hstep, voffA);
        if (wr == 1) PG8_BAR;
        PG8_WAIT_V(4); PG8_BAR;
        PG8_STAGE(PG8_SB(1, 0), cB + kstep, voffB); PG8_STAGE(PG8_SA(1, 0), cA + kstep, voffA); PG8_STAGE(PG8_SB(1, 1), cB + hstep + kstep, voffB);
        PG8_WAIT_V(6); PG8_BAR;
    }
    for (;;) {
        const bool has_next = S.next(ui + 1, nxt);
        const char* nA = has_next ? (const char*)g.A + (size_t)nxt.pm * tstep : cA; const char* nB = has_next ? (const char*)g.Bt + (size_t)nxt.pn * tstep : cB;
#pragma unroll 1
        for (int t = 0; t < nt; t += 2) {
            const bool last = (t == nt - 2);
            const char* a1 = cA + (size_t)(t + 1) * kstep;
            const char* a2 = last ? nA : cA + (size_t)(t + 2) * kstep; const char* b2 = last ? nB : cB + (size_t)(t + 2) * kstep;
            const char* a3 = a2 + kstep; const char* b3 = b2 + kstep;
            if (last && has_next) S.a_ready(nxt);
            if constexpr (SP2) {
            PG8_LDB(B0, 0, 0); PG8_LDB(B1, 0, 1); PG8_SCHED; PG8_LDA(At, 0, 0); PG8_STAGE(PG8_SA(1, 1), a1 + hstep, voffA);
            PG8_WAIT_V(8); PG8_WAIT_L(0); PG8_BAR; PG8_MMA(0, 0, At, B0); PG8_MMA(0, 1, At, B1); PG8_BAR; PG8_SCHED;
            PG8_LDA(At, 0, 1); PG8_STAGE(PG8_SB(0, 0), b2, voffB); PG8_STAGE(PG8_SB(0, 1), b2 + hstep, voffB); PG8_STAGE(PG8_SA(0, 0), a2, voffA);
            PG8_WAIT_V(8); PG8_WAIT_L(0); PG8_BAR; PG8_MMA(1, 0, At, B0); PG8_MMA(1, 1, At, B1); PG8_BAR; PG8_SCHED;
            PG8_LDB(B0, 1, 0); PG8_LDB(B1, 1, 1); PG8_SCHED; PG8_LDA(At, 1, 0); PG8_STAGE(PG8_SA(0, 1), a2 + hstep, voffA);
            PG8_WAIT_V(8); PG8_WAIT_L(0); PG8_BAR; PG8_MMA(0, 0, At, B0); PG8_MMA(0, 1, At, B1); PG8_BAR; PG8_SCHED;
            PG8_LDA(At, 1, 1); PG8_STAGE(PG8_SB(1, 0), b3, voffB); PG8_STAGE(PG8_SB(1, 1), b3 + hstep, voffB); PG8_STAGE(PG8_SA(1, 0), a3, voffA);
            PG8_WAIT_V(8); PG8_WAIT_L(0); PG8_BAR; PG8_MMA(1, 0, At, B0); PG8_MMA(1, 1, At, B1); PG8_BAR; PG8_SCHED;
            } else {
            PG8_LDB(B0, 0, 0); PG8_SCHED; PG8_LDA(At, 0, 0); PG8_STAGE(PG8_SA(1, 1), a1 + hstep, voffA);
            PG8_WAIT_L(8); PG8_BAR; PG8_WAIT_L(0); PG8_MMA(0, 0, At, B0); PG8_BAR; PG8_SCHED;
            PG8_LDB(B1, 0, 1); PG8_STAGE(PG8_SB(0, 0), b2, voffB);
            PG8_BAR; PG8_WAIT_L(0); PG8_MMA(0, 1, At, B1); PG8_BAR;
            PG8_LDA(At, 0, 1); PG8_STAGE(PG8_SA(0, 0), a2, voffA);
            PG8_BAR; PG8_WAIT_L(0); PG8_MMA(1, 0, At, B0); PG8_BAR; PG8_SCHED;
            PG8_STAGE(PG8_SB(0, 1), b2 + hstep, voffB);
            PG8_WAIT_V(6); PG8_BAR; PG8_MMA(1, 1, At, B1); PG8_BAR;
            PG8_LDB(B0, 1, 0); PG8_SCHED; PG8_LDA(At, 1, 0); PG8_STAGE(PG8_SA(0, 1), a2 + hstep, voffA);
            PG8_WAIT_L(8); PG8_BAR; PG8_WAIT_L(0); PG8_MMA(0, 0, At, B0); PG8_BAR; PG8_SCHED;
            PG8_LDB(B1, 1, 1); PG8_STAGE(PG8_SB(1, 0), b3, voffB);
            PG8_BAR; PG8_WAIT_L(0); PG8_MMA(0, 1, At, B1); PG8_BAR;
            PG8_LDA(At, 1, 1); PG8_STAGE(PG8_SA(1, 0), a3, voffA);
            PG8_BAR; PG8_WAIT_L(0); PG8_MMA(1, 0, At, B0); PG8_BAR; PG8_SCHED;
            PG8_STAGE(PG8_SB(1, 1), b3 + hstep, voffB);
            PG8_WAIT_V(6); PG8_BAR; PG8_MMA(1, 1, At, B1); PG8_BAR;
            }
        }
        if constexpr (F8) asm volatile("s_nop 15\n\ts_nop 7" ::: "memory");
        if constexpr (ALIGN_EPI) { if (wr == 0) PG8_BAR; }
        if constexpr (!Epi::AFTER_DRAIN) { E(acc, cur, wr, wc, fr, fq); S.done(cur); }
        if (!has_next) break;
#pragma unroll
        for (int a = 0; a < 2; ++a)
#pragma unroll
            for (int b = 0; b < 2; ++b)
#pragma unroll
                for (int m = 0; m < 4; ++m)
#pragma unroll
                    for (int n = 0; n < 2; ++n) acc[a][b][m][n] = (f32x4){0.f, 0.f, 0.f, 0.f};
        cur = nxt; cA = nA; cB = nB; ++ui;
        if constexpr (ALIGN_EPI) { if (wr == 1) PG8_BAR; }
    }
    PG8_WAIT_V(0);
    if constexpr (!ALIGN_EPI) { if (wr == 0) PG8_BAR; }
    PG8_BAR;
    if constexpr (Epi::AFTER_DRAIN) { E.fused(acc, cur, wr, wc, fr, fq, lds, wid, lane); S.done(cur); }
#undef PG8_SA
#undef PG8_SB
#undef PG8_STAGE
#undef PG8_LDA
#undef PG8_LDB
#undef PG8_MMA
#undef PG8_WAIT_V
#undef PG8_WAIT_L
#undef PG8_BAR
#undef PG8_SCHED
}
}
namespace pg8 {
template <class Epi, class Sched, bool F8 = false>
__device__ __forceinline__ void gemm_phase_gather(PG8_LAS unsigned char* lds, const Gemm g, const Sched& S, const Epi& E, const PG8_LAS int* rowbuf) {
    const int tid = threadIdx.x, wid = __builtin_amdgcn_readfirstlane(tid >> 6), lane = tid & 63, wr = wid >> 2, wc = wid & 3, fr = lane & 15, fq = lane >> 4;
    const int K = g.K, nt = K / BK;
    unsigned colA[2], voffB[2]; int rowA[2];
#pragma unroll
    for (int i = 0; i < 2; ++i) { int R, C; stage_rc(tid * 16 + i * 8192, R, C); const int Rb = Epi::PERM ? ((R & ~31) + perm32(R & 31)) : R;
        rowA[i] = R; colA[i] = (unsigned)C * 2u; voffB[i] = (unsigned)(Rb * K + C) * 2u; }
    const size_t kstep = (size_t)(BK * 2), hstep = (size_t)HALF * K * 2, tstep = 2 * hstep;
    const unsigned rowbytes = (unsigned)K * 2u;
    const unsigned ldsw = (unsigned)wid * 1024u;
    const int aoff = F8 ? lds_byte(wr * 64 + fr, fq * 16) : lds_byte(wr * 64 + fr, fq * 8), boff = F8 ? lds_byte(wc * 32 + fr, fq * 16) : lds_byte(wc * 32 + fr, fq * 8);
#define PG8_SA(b, h) (((b) * 2 + (h)) * HTB)
#define PG8_SB(b, h) ((4 + (b) * 2 + (h)) * HTB)
#define PG8_STAGE(bufoff, gbase, voff) do { _Pragma("unroll") for (int _i = 0; _i < 2; ++_i) \
        __builtin_amdgcn_global_load_lds((const unsigned*)((const char*)(gbase) + (voff)[_i]), (PG8_LAS unsigned*)(lds + (bufoff) + ldsw + _i * 8192), 16, 0, 0); } while (0)
#define PG8_LDA(dst, b, h) do { _Pragma("unroll") for (int m = 0; m < 4; ++m) { if constexpr (F8) { const v4i32 lo_ = *(const PG8_LAS v4i32*)(lds + PG8_SA(b, h) + aoff + m * 2048), hi_ = *(const PG8_LAS v4i32*)(lds + PG8_SA(b, h) + aoff + m * 2048 + 16); \
        dst.f[m] = __builtin_shufflevector(lo_, hi_, 0, 1, 2, 3, 4, 5, 6, 7); } else { _Pragma("unroll") for (int k = 0; k < 2; ++k) dst.f[m][k] = *(const PG8_LAS bf16x8*)(lds + PG8_SA(b, h) + aoff + m * 2048 + k * 1024); } } } while (0)
#define PG8_LDB(dst, b, h) do { _Pragma("unroll") for (int n = 0; n < 2; ++n) { if constexpr (F8) { const v4i32 lo_ = *(const PG8_LAS v4i32*)(lds + PG8_SB(b, h) + boff + n * 2048), hi_ = *(const PG8_LAS v4i32*)(lds + PG8_SB(b, h) + boff + n * 2048 + 16); \
        dst.f[n] = __builtin_shufflevector(lo_, hi_, 0, 1, 2, 3, 4, 5, 6, 7); } else { _Pragma("unroll") for (int k = 0; k < 2; ++k) dst.f[n][k] = *(const PG8_LAS bf16x8*)(lds + PG8_SB(b, h) + boff + n * 2048 + k * 1024); } } } while (0)
#define PG8_MMA(ai, bj, At, Bt) do { __builtin_amdgcn_s_setprio(1); \
        if constexpr (F8) { _Pragma("unroll") for (int m = 0; m < 4; ++m) _Pragma("unroll") for (int n = 0; n < 2; ++n) \
            mfma_f8_inplace(acc[ai][bj][m][n], Bt.f[n], At.f[m], f8scale); } \
        else { _Pragma("unroll") for (int m = 0; m < 4; ++m) _Pragma("unroll") for (int n = 0; n < 2; ++n) _Pragma("unroll") for (int k = 0; k < 2; ++k) \
            acc[ai][bj][m][n] = __builtin_amdgcn_mfma_f32_16x16x32_bf16(Bt.f[n][k], At.f[m][k], acc[ai][bj][m][n], 0, 0, 0); } \
        __builtin_amdgcn_s_setprio(0); } while (0)
#define PG8_WAIT_V(n) asm volatile("s_waitcnt vmcnt(" #n ")" ::: "memory")
#define PG8_WAIT_L(n) asm volatile("s_waitcnt lgkmcnt(" #n ")" ::: "memory")
#define PG8_BAR __builtin_amdgcn_s_barrier()
#define PG8_SCHED __builtin_amdgcn_sched_barrier(0)
#define PG8_ROWS(dst, u_) do { _Pragma("unroll") for (int h_ = 0; h_ < 2; ++h_) _Pragma("unroll") for (int i_ = 0; i_ < 2; ++i_) dst[h_][i_] = (unsigned)rowbuf[256 * (u_) + 128 * h_ + rowA[i_]] * rowbytes + colA[i_]; } while (0)
    int f8scale = 0x7F7F7F7F; asm volatile("" : "+v"(f8scale));
    Unit cur, nxt; int ui = 0;
    if (!S.next(0, cur)) return;
    f32x4 acc[2][2][4][2];
#pragma unroll
    for (int a = 0; a < 2; ++a)
#pragma unroll
        for (int b = 0; b < 2; ++b)
#pragma unroll
            for (int m = 0; m < 4; ++m)
#pragma unroll
                for (int n = 0; n < 2; ++n) acc[a][b][m][n] = (f32x4){0.f, 0.f, 0.f, 0.f};
    typename FragSel<F8>::A At; typename FragSel<F8>::B B0, B1;
    const char* Ab = (const char*)g.A; const char* cB = (const char*)g.Bt + (size_t)cur.pn * tstep;
    unsigned ca[2][2], na[2][2];
    PG8_ROWS(ca, 0);
    PG8_STAGE(PG8_SB(0, 0), cB, voffB); PG8_STAGE(PG8_SB(0, 1), cB + hstep, voffB); PG8_STAGE(PG8_SA(0, 0), Ab, ca[0]); PG8_STAGE(PG8_SA(0, 1), Ab, ca[1]);
    if (wr == 1) PG8_BAR;
    PG8_WAIT_V(2); PG8_BAR;
    PG8_STAGE(PG8_SB(1, 0), cB + kstep, voffB); PG8_STAGE(PG8_SA(1, 0), Ab + kstep, ca[0]); PG8_STAGE(PG8_SB(1, 1), cB + hstep + kstep, voffB);
    PG8_WAIT_V(6); PG8_BAR;
    for (;;) {
        const bool has_next = S.next(ui + 1, nxt);
        const char* nB = has_next ? (const char*)g.Bt + (size_t)nxt.pn * tstep : cB;
        if (has_next) { PG8_ROWS(na, ui + 1); } else {
#pragma unroll
            for (int h_ = 0; h_ < 2; ++h_)
#pragma unroll
                for (int i_ = 0; i_ < 2; ++i_) na[h_][i_] = ca[h_][i_]; }
#pragma unroll 1
        for (int t = 0; t < nt; t += 2) {
            const bool last = (t == nt - 2);
            const char* a1 = Ab + (size_t)(t + 1) * kstep;
            const char* a2 = last ? Ab : Ab + (size_t)(t + 2) * kstep; const char* b2 = last ? nB : cB + (size_t)(t + 2) * kstep;
            const char* a3 = a2 + kstep; const char* b3 = b2 + kstep;
            unsigned o2[2][2];
#pragma unroll
            for (int h_ = 0; h_ < 2; ++h_)
#pragma unroll
                for (int i_ = 0; i_ < 2; ++i_) o2[h_][i_] = last ? na[h_][i_] : ca[h_][i_];
            PG8_LDB(B0, 0, 0); PG8_LDB(B1, 0, 1); PG8_SCHED; PG8_LDA(At, 0, 0); PG8_STAGE(PG8_SA(1, 1), a1, ca[1]);
            PG8_WAIT_V(8); PG8_WAIT_L(0); PG8_BAR; PG8_MMA(0, 0, At, B0); PG8_MMA(0, 1, At, B1); PG8_BAR; PG8_SCHED;
            PG8_LDA(At, 0, 1); PG8_STAGE(PG8_SB(0, 0), b2, voffB); PG8_STAGE(PG8_SB(0, 1), b2 + hstep, voffB); PG8_STAGE(PG8_SA(0, 0), a2, o2[0]);
            PG8_WAIT_V(8); PG8_WAIT_L(0); PG8_BAR; PG8_MMA(1, 0, At, B0); PG8_MMA(1, 1, At, B1); PG8_BAR; PG8_SCHED;
            PG8_LDB(B0, 1, 0); PG8_LDB(B1, 1, 1); PG8_SCHED; PG8_LDA(At, 1, 0); PG8_STAGE(PG8_SA(0, 1), a2, o2[1]);
            PG8_WAIT_V(8); PG8_WAIT_L(0); PG8_BAR; PG8_MMA(0, 0, At, B0); PG8_MMA(0, 1, At, B1); PG8_BAR; PG8_SCHED;
            PG8_LDA(At, 1, 1); PG8_STAGE(PG8_SB(1, 0), b3, voffB); PG8_STAGE(PG8_SB(1, 1), b3 + hstep, voffB); PG8_STAGE(PG8_SA(1, 0), a3, o2[0]);
            PG8_WAIT_V(8); PG8_WAIT_L(0); PG8_BAR; PG8_MMA(1, 0, At, B0); PG8_MMA(1, 1, At, B1); PG8_BAR; PG8_SCHED;
        }
        if constexpr (F8) asm volatile("s_nop 15\n\ts_nop 7" ::: "memory");
        if (wr == 0) PG8_BAR;
        E(acc, cur, wr, wc, fr, fq); S.done(cur);
        if (!has_next) break;
#pragma unroll
        for (int a = 0; a < 2; ++a)
#pragma unroll
            for (int b = 0; b < 2; ++b)
#pragma unroll
                for (int m = 0; m < 4; ++m)
#pragma unroll
                    for (int n = 0; n < 2; ++n) acc[a][b][m][n] = (f32x4){0.f, 0.f, 0.f, 0.f};
        cur = nxt; cB = nB; ++ui;
#pragma unroll
        for (int h_ = 0; h_ < 2; ++h_)
#pragma unroll
            for (int i_ = 0; i_ < 2; ++i_) ca[h_][i_] = na[h_][i_];
        if (wr == 1) PG8_BAR;
    }
    PG8_WAIT_V(0);
    PG8_BAR;
#undef PG8_ROWS
#undef PG8_SA
#undef PG8_SB
#undef PG8_STAGE
#undef PG8_LDA
#undef PG8_LDB
#undef PG8_MMA
#undef PG8_WAIT_V
#undef PG8_WAIT_L
#undef PG8_BAR
#undef PG8_SCHED
}
}
#define GAS __attribute__((address_space(1)))
#define LAS __attribute__((address_space(3)))
typedef unsigned short bf16;
typedef unsigned v4u __attribute__((ext_vector_type(4)));
typedef float f32x4 __attribute__((ext_vector_type(4)));
typedef short bf16x8 __attribute__((ext_vector_type(8)));
typedef GAS unsigned gu32;
typedef GAS unsigned long long gu64;
#define RLX_AGENT __ATOMIC_RELAXED, __HIP_MEMORY_SCOPE_AGENT
#define LDS_WAIT() asm volatile("s_waitcnt lgkmcnt(0)" ::: "memory")
#define VM_WAIT() asm volatile("s_waitcnt vmcnt(0)" ::: "memory")
__device__ __forceinline__ unsigned long long rt() { return __builtin_amdgcn_s_memrealtime(); }
__device__ __forceinline__ unsigned f2bf(float f) { unsigned u = __builtin_bit_cast(unsigned, f); return (u + 0x7fffu + ((u >> 16) & 1u)) >> 16; }
__device__ __forceinline__ unsigned pk2(float lo, float hi) { return f2bf(lo) | (f2bf(hi) << 16); }

#define XB_TMO      128
#define XB_XCNT(j)  (256  + 64 * (j))
#define XB_XSUB(j)  (1280 + 64 * (j))
#define XB_XGEN(j)  (2304 + 64 * (j))
#define XB_TOP      3328
#define XB_TOPGEN   3392
#define XCD_BAR_WORDS 3456
#define XB_SPIN_CAP (1u << 18)

__device__ __forceinline__ unsigned xb_ld(unsigned* p)              { return __hip_atomic_load(p, __ATOMIC_RELAXED, __HIP_MEMORY_SCOPE_AGENT); }
__device__ __forceinline__ unsigned xb_add(unsigned* p, unsigned v) { return __hip_atomic_fetch_add(p, v, __ATOMIC_RELAXED, __HIP_MEMORY_SCOPE_AGENT); }
__device__ __forceinline__ unsigned xb_xcc_id() { return (unsigned)__builtin_amdgcn_s_getreg((3 << 11) | 20) & 0xFu; }
#define XB_SPIN(cond, bar) do { unsigned _sp = 0; while (cond) { __builtin_amdgcn_s_sleep(1); \
    if ((++_sp & 255u) == 0u) { if (xb_ld(&(bar)[XB_TMO])) break; if (_sp > XB_SPIN_CAP) { atomicAdd(&(bar)[XB_TMO], 1u); break; } } } } while (0)

struct XcdBarrier {
    unsigned* bar; unsigned x;
    volatile LAS unsigned* st;
};

__device__ __forceinline__ XcdBarrier xcd_barrier_post(unsigned* bar, volatile LAS unsigned* st) {
    XcdBarrier b; b.bar = bar; b.x = xb_xcc_id(); b.st = st;
    if (threadIdx.x == 0) (void)xb_add(&bar[XB_XCNT(b.x)], 1u);
    return b;
}
__device__ __forceinline__ void xcd_barrier_complete(unsigned* bar, unsigned x, unsigned& nloc, unsigned& nx) {
    const unsigned G = gridDim.x * gridDim.y * gridDim.z;
    unsigned sum, cnt, mine, sp = 0u;
    for (;;) {
        sum = 0u; cnt = 0u; mine = 0u;
#pragma unroll
        for (unsigned j = 0; j < 16; ++j) { const unsigned c = xb_ld(&bar[XB_XCNT(j)]); sum += c; cnt += (c > 0u) ? 1u : 0u; mine = (j == x) ? c : mine; }
        if (sum == G) break;
        __builtin_amdgcn_s_sleep(1);
        if ((++sp & 255u) == 0u) { if (xb_ld(&bar[XB_TMO])) break; if (sp > XB_SPIN_CAP) { atomicAdd(&bar[XB_TMO], 1u); break; } }
    }
    nloc = mine > 0u ? mine : 1u; nx = cnt > 0u ? cnt : 1u;
}

__device__ __forceinline__ void xcd_barrier(const XcdBarrier& b) {
    asm volatile("s_waitcnt vmcnt(0)" ::: "memory");
    __syncthreads();
    if (threadIdx.x == 0) {
        unsigned* bar = b.bar;
        __builtin_amdgcn_s_waitcnt(0);
        unsigned nloc = b.st[0], nx = b.st[1];
        if (nloc == 0u) { xcd_barrier_complete(bar, b.x, nloc, nx); b.st[0] = nloc; b.st[1] = nx; }
        const unsigned old = xb_add(&bar[XB_XSUB(b.x)], 1u);
        const unsigned gen = old / nloc;
        if (old + 1u == (gen + 1u) * nloc) {
            __builtin_amdgcn_fence(__ATOMIC_RELEASE, "agent");
            asm volatile("s_waitcnt vmcnt(0)" ::: "memory");
            const unsigned og = xb_add(&bar[XB_TOP], 1u);
            const unsigned tg = og / nx;
            if (og + 1u == (tg + 1u) * nx) xb_add(&bar[XB_TOPGEN], 1u);
            else XB_SPIN(xb_ld(&bar[XB_TOPGEN]) == tg, bar);
            __builtin_amdgcn_fence(__ATOMIC_ACQUIRE, "agent");
            xb_add(&bar[XB_XGEN(b.x)], 1u);
            asm volatile("s_waitcnt vmcnt(0)" ::: "memory");
        } else {
            XB_SPIN(xb_ld(&bar[XB_XGEN(b.x)]) == gen, bar);
            __builtin_amdgcn_fence(__ATOMIC_ACQUIRE, "agent");
            asm volatile("s_waitcnt vmcnt(0)" ::: "memory");
        }
    }
    __syncthreads();
}
constexpr int NWAVES = 8, NTHREADS = 512;
constexpr int T = 16384, D = 1024, SEQ = 4096, NBATCH = 4, NMEM = 256, NEXP = 32, TOPK = 4;
constexpr int NPROJ = 9728;
constexpr int XS_ROWS = T * TOPK + NEXP * 256;
constexpr float EPS = 1e-6f, LOG2E = 1.4426950408889634f, LN2 = 0.6931471805599453f;
#ifndef MK_N_LAUNCHES
#define MK_N_LAUNCHES 1
#endif
constexpr int N_PHASES = 14;
constexpr int N_LAUNCHES = MK_N_LAUNCHES;

constexpr size_t MiB = 1u << 20;
constexpr size_t WS_CTL = 0, CTL_ZERO_BYTES = 1 * MiB;
constexpr size_t CTL_SS2 = 256 * 1024, CTL_CNT = 384 * 1024, CTL_ROWTOK = 640 * 1024;
constexpr size_t WS_WCQ = 1 * MiB, WS_WCO = 2 * MiB, WS_WO = 3 * MiB, WS_KV = 5 * MiB;
constexpr size_t WS_TOPI = 7 * MiB, WS_TOPW = WS_TOPI + 256 * 1024, WS_RSTD3 = WS_TOPW + 256 * 1024, WS_ROWSLOT = WS_RSTD3 + 64 * 1024;
constexpr size_t WS_EXPGU = 8 * MiB, WS_EXPD = 72 * MiB;
constexpr size_t WS_PROJ = 8 * MiB, WS_U1 = 312 * MiB, WS_W1T = 344 * MiB, WS_OG = 312 * MiB, WS_LSE = 360 * MiB;
constexpr size_t WS_WBA = 363 * MiB, WS_WBC = 364 * MiB, WS_MN = 366 * MiB, WS_YA = 368 * MiB, WS_YC = 384 * MiB, WS_MIX = 416 * MiB, WS_WCKV = 448 * MiB;
constexpr size_t WS_H1 = 200 * MiB, WS_H1B = 264 * MiB, WS_Q2 = 296 * MiB, WS_O2 = 312 * MiB;
constexpr size_t WS_U3 = 200 * MiB, WS_HDN = 344 * MiB, WS_Y = 200 * MiB, WS_END = 488 * MiB;
constexpr size_t WS_HIST = WS_ROWSLOT + 288 * 1024;
static_assert(WS_ROWSLOT + (size_t)XS_ROWS * 4 <= WS_HIST && WS_HIST + 256 * 32 * 4 <= WS_EXPGU && CTL_ROWTOK + (size_t)XS_ROWS * 4 <= CTL_ZERO_BYTES, "misc region");
static_assert(WS_U3 + (size_t)T * D <= WS_HDN && WS_HDN + (size_t)XS_ROWS * D * 2 <= WS_END, "moe rows");
constexpr int CW_TMO = 0, CW_CODE = 1, CW_BAR = 4096;

constexpr int LDS_BYTES = 163840;
constexpr int TBL_OFF = 163840 - 2048;
constexpr int ROWBUF_OFF = 131072, ROWBUF_UNITS = 24;
constexpr int MISC_OFF = 163840 - 256;

struct Frame {
    LAS unsigned char* lds;
    volatile LAS unsigned* MISC;
    gu32* ctl;
    unsigned char* ws;
    int tid, lane, wave, vcu, G;
};
__device__ __forceinline__ float wave_sum(float v) {
#pragma unroll
    for (int o = 1; o < 64; o <<= 1) v += __shfl_xor(v, o);
    return v;
}
typedef unsigned long long u64;
__device__ __forceinline__ float bf_lo(unsigned w) { return __builtin_bit_cast(float, w << 16); }
__device__ __forceinline__ float bf_hi(unsigned w) { return __builtin_bit_cast(float, w & 0xffff0000u); }

__device__ __forceinline__ void transpose_item(const float* W, int K, int N, bf16* WT, int drow, int k0, int n0, const float* gain, LAS float* scr, int lane) {
#pragma unroll 8
    for (int i = 0; i < 32; ++i) { const int kk = 2 * i + (lane >> 5); float w = W[(size_t)(k0 + kk) * N + n0 + (lane & 31)]; if (gain) w *= gain[k0 + kk]; scr[kk * 33 + (lane & 31)] = w; }
    LDS_WAIT(); asm volatile("" ::: "memory");
    const int c = lane & 7;
#pragma unroll
    for (int j = 0; j < 4; ++j) { const int n = (lane >> 3) + 8 * j; const LAS float* s = scr + (8 * c) * 33 + n;
        v4u o; o.x = pk2(s[0 * 33], s[1 * 33]); o.y = pk2(s[2 * 33], s[3 * 33]); o.z = pk2(s[4 * 33], s[5 * 33]); o.w = pk2(s[6 * 33], s[7 * 33]);
        *(GAS v4u*)(WT + (size_t)(drow + n) * K + k0 + 8 * c) = o; }
    LDS_WAIT(); asm volatile("" ::: "memory");
}
__device__ __forceinline__ void transpose_item_f8(const float* W, int K, int N, unsigned char* WT, int drow, int k0, int n0, float scale, LAS float* scr, int lane) {
#pragma unroll 8
    for (int i = 0; i < 32; ++i) { const int kk = 2 * i + (lane >> 5); scr[kk * 33 + (lane & 31)] = W[(size_t)(k0 + kk) * N + n0 + (lane & 31)] * scale; }
    LDS_WAIT(); asm volatile("" ::: "memory");
    const int n = lane >> 1;
#pragma unroll
    for (int j = 0; j < 2; ++j) { const int c = (lane & 1) + 2 * j; const LAS float* s = scr + (16 * c) * 33 + n; v4u o;
        { int w = 0; w = __builtin_amdgcn_cvt_pk_fp8_f32(s[0 * 33], s[1 * 33], w, false); w = __builtin_amdgcn_cvt_pk_fp8_f32(s[2 * 33], s[3 * 33], w, true); o.x = (unsigned)w; }
        { int w = 0; w = __builtin_amdgcn_cvt_pk_fp8_f32(s[4 * 33], s[5 * 33], w, false); w = __builtin_amdgcn_cvt_pk_fp8_f32(s[6 * 33], s[7 * 33], w, true); o.y = (unsigned)w; }
        { int w = 0; w = __builtin_amdgcn_cvt_pk_fp8_f32(s[8 * 33], s[9 * 33], w, false); w = __builtin_amdgcn_cvt_pk_fp8_f32(s[10 * 33], s[11 * 33], w, true); o.z = (unsigned)w; }
        { int w = 0; w = __builtin_amdgcn_cvt_pk_fp8_f32(s[12 * 33], s[13 * 33], w, false); w = __builtin_amdgcn_cvt_pk_fp8_f32(s[14 * 33], s[15 * 33], w, true); o.w = (unsigned)w; }
        *(GAS v4u*)(WT + (size_t)(drow + n) * K + k0 + 16 * c) = o; }
    LDS_WAIT(); asm volatile("" ::: "memory");
}
__device__ __forceinline__ bool transpose_mat(int& r, const float* W, int K, int N, bf16* WT, int drow0, const float* gain, LAS float* scr, int lane) {
    const int nblk = N / 32, items = (K / 64) * nblk;
    if (r < items) { const int kb = r / nblk, nb = r % nblk; transpose_item(W, K, N, WT, drow0 + 32 * nb, 64 * kb, 32 * nb, gain, scr, lane); return true; }
    r -= items; return false;
}
__device__ __forceinline__ void rms_row_to_bf16(const float* xrow, const float* gain, bf16* orow, int lane) {
    const GAS f32x4* xr = (const GAS f32x4*)xrow + lane; const GAS f32x4* gr = (const GAS f32x4*)gain + lane;
    f32x4 v[4]; float s = 0.f;
#pragma unroll
    for (int j = 0; j < 4; ++j) { v[j] = xr[64 * j]; s += (v[j].x * v[j].x + v[j].y * v[j].y) + (v[j].z * v[j].z + v[j].w * v[j].w); }
    const float rstd = 1.f / sqrtf(wave_sum(s) * (1.f / D) + EPS);
    GAS u64* o8 = (GAS u64*)orow + lane;
#pragma unroll
    for (int j = 0; j < 4; ++j) { const f32x4 g = gr[64 * j]; o8[64 * j] = (u64)pk2(v[j].x * rstd * g.x, v[j].y * rstd * g.y) | ((u64)pk2(v[j].z * rstd * g.z, v[j].w * rstd * g.w) << 32); }
}

__device__ __forceinline__ int xcd_remap(int wgid, int nwg) { const int q = nwg / 8, r = nwg % 8, xcd = wgid % 8, off = wgid / 8; return (xcd < r ? xcd * (q + 1) : r * (q + 1) + (xcd - r) * q) + off; }
struct MoeOrder {
    const volatile LAS int* tpre; int npn, G, c;
    __device__ __forceinline__ bool next(int i, pg8::Unit& u) const {
        const int total = __builtin_amdgcn_readfirstlane(tpre[32]) * npn; const long L = (long)i * G + c; if (L >= total) return false;
        const int U = xcd_remap((int)L, total);
        int e = 0;
#pragma unroll 1
        for (int k = 1; k < 32; ++k) if (__builtin_amdgcn_readfirstlane(tpre[k]) * npn <= U) e = k;
        const int t0 = __builtin_amdgcn_readfirstlane(tpre[e]), nt = __builtin_amdgcn_readfirstlane(tpre[e + 1]) - t0, Ul = U - t0 * npn;
        u.pm = t0 + Ul % nt; u.pn = e * npn + Ul / nt; return true;
    }
    __device__ __forceinline__ void a_ready(const pg8::Unit&) const {}
    __device__ __forceinline__ void done(const pg8::Unit&) const {}
};
struct In {
    const float *x, *mem, *norm_mix, *w_in, *conv_w, *w_ba, *w_bc, *w_gate, *b_gate, *w_out, *norm_cross, *norm_mem, *w_cq, *w_ckv, *w_co, *norm_moe,
                *router_w, *router_b, *w_eg, *b_eg, *w_eu, *b_eu, *w_ed, *b_ed, *norm_final;
};

__device__ __forceinline__ void phase_prologue(Frame& F, const In& in) {
    LAS float* scr = (LAS float*)(F.lds + F.wave * 16384);
    const int gw = F.vcu * NWAVES + F.wave, NGW = F.G * NWAVES;
    unsigned char* ws = F.ws;
    constexpr int NITEMS = 16 * 240 + 16 * 64 + 8 * 32 + 16 * 32 + 16 * 32 + 16 * 16 + 16 * 32 + 8 * 32;
    for (int it = gw; it < NITEMS; it += NGW) {
        int r = it;
        if (transpose_mat(r, in.w_in, 1024, 7680, (bf16*)(ws + WS_W1T), 0, nullptr, scr, F.lane)) continue;
        if (transpose_mat(r, in.w_gate, 1024, 2048, (bf16*)(ws + WS_W1T), 7680, nullptr, scr, F.lane)) continue;
        if (transpose_mat(r, in.w_ba, 512, 1024, (bf16*)(ws + WS_WBA), 0, nullptr, scr, F.lane)) continue;
        if (transpose_mat(r, in.w_bc, 1024, 1024, (bf16*)(ws + WS_WBC), 0, nullptr, scr, F.lane)) continue;
        if (transpose_mat(r, in.w_out, 1024, 1024, (bf16*)(ws + WS_WO), 0, nullptr, scr, F.lane)) continue;
        if (transpose_mat(r, in.w_cq, 1024, 512, (bf16*)(ws + WS_WCQ), 0, in.norm_cross, scr, F.lane)) continue;
        if (transpose_mat(r, in.w_ckv, 1024, 1024, (bf16*)(ws + WS_WCKV), 0, nullptr, scr, F.lane)) continue;
        transpose_mat(r, in.w_co, 512, 1024, (bf16*)(ws + WS_WCO), 0, nullptr, scr, F.lane);
    }
    for (int m = gw; m < T; m += NGW) rms_row_to_bf16(in.x + (size_t)m * D, in.norm_mix, (bf16*)(ws + WS_U1) + (size_t)m * D, F.lane);
    for (int m = gw; m < NBATCH * NMEM; m += NGW) rms_row_to_bf16(in.mem + (size_t)m * D, in.norm_mem, (bf16*)(ws + WS_MN) + (size_t)m * D, F.lane);
}

__device__ __forceinline__ void phase_expert_convert(Frame& F, const In& in) {
    LAS float* scr = (LAS float*)(F.lds + F.wave * 16384);
    const int gw = F.vcu * NWAVES + F.wave, NGW = F.G * NWAVES;
    constexpr int PER = 16 * 32, NITEMS = NEXP * 3 * PER;
    for (int it = gw; it < NITEMS; it += NGW) {
        const int mtx = it / PER, r = it % PER, e = mtx / 3, which = mtx % 3, kb = r / 32, nb = r % 32, n0 = 32 * nb;
        if (which == 0)      transpose_item_f8(in.w_eg + (size_t)e * D * D, D, D, F.ws + WS_EXPGU + (size_t)e * 2048 * D, (n0 >> 7) * 256 + (n0 & 127), 64 * kb, n0, pg8::W8_SCALE, scr, F.lane);
        else if (which == 1) transpose_item_f8(in.w_eu + (size_t)e * D * D, D, D, F.ws + WS_EXPGU + (size_t)e * 2048 * D, (n0 >> 7) * 256 + 128 + (n0 & 127), 64 * kb, n0, pg8::W8_SCALE, scr, F.lane);
        else                 transpose_item_f8(in.w_ed + (size_t)e * D * D, D, D, F.ws + WS_EXPD + (size_t)e * D * D, n0, 64 * kb, n0, pg8::W8_SCALE, scr, F.lane);
    }
}

typedef short s16x4v __attribute__((ext_vector_type(4)));
typedef short bf16x8v __attribute__((ext_vector_type(8)));
__device__ __forceinline__ s16x4v lds_tr16(const LAS bf16* p) { return __builtin_bit_cast(s16x4v, __builtin_amdgcn_ds_read_tr16_b64_v4i16((LAS s16x4v*)p)); }
__device__ __forceinline__ void dil_attn_unit_mfma(Frame& F, int unit) {
    const int rn = unit & 31, bgh = unit >> 5, h = bgh & 7, bg = bgh >> 3, g = bg % 3, b = bg / 3;
    const int dil = g == 0 ? 1 : (g == 1 ? 4 : 16), nper = 32 / dil, r = rn / nper, n = rn % nper;
    const bf16* PROJ = (const bf16*)(F.ws + WS_PROJ);
    LAS bf16* Ks = (LAS bf16*)F.lds; LAS bf16* Vs = Ks + 256 * 72;
    const int tid = F.tid, lane = F.lane, w = F.wave, qi = lane & 15, G = lane >> 4;
#pragma unroll
    for (int it = 0; it < 4; ++it) {
        const int row = (tid >> 3) + 64 * it, ch = tid & 7, j = 128 * (n - 1) + row;
        v4u kv = (v4u){0u, 0u, 0u, 0u}, vv = kv;
        if (j >= 0) { const size_t grow = (size_t)b * SEQ + (size_t)j * dil + r; const bf16* p = PROJ + grow * NPROJ + g * 1536 + h * 64 + ch * 8; kv = *(const GAS v4u*)(p + 512); vv = *(const GAS v4u*)(p + 1024); }
        *(LAS v4u*)(Ks + row * 72 + ch * 8) = kv; *(LAS v4u*)(Vs + row * 72 + ch * 8) = vv;
    }
    if (tid < 128) *(LAS v4u*)(Vs + (256 + (tid >> 3)) * 72 + (tid & 7) * 8) = (v4u){0u, 0u, 0u, 0u};
    const int ql = 16 * w + qi;
    const size_t growq = (size_t)b * SEQ + (size_t)(128 * n + ql) * dil + r;
    const bf16* qp = PROJ + growq * NPROJ + g * 1536 + h * 64 + 8 * G;
    const bf16x8v q0 = *(const GAS bf16x8v*)qp, q1 = *(const GAS bf16x8v*)(qp + 32);
    __syncthreads();
    pg8::f32x4 st[9];
#pragma unroll
    for (int t = 0; t < 9; ++t) {
        const LAS bf16* kp = Ks + (16 * (w + t) + qi) * 72 + 8 * G;
        const bf16x8v k0 = *(const LAS bf16x8v*)kp, k1 = *(const LAS bf16x8v*)(kp + 32);
        pg8::f32x4 a = (pg8::f32x4){0.f, 0.f, 0.f, 0.f};
        a = __builtin_amdgcn_mfma_f32_16x16x32_bf16(k0, q0, a, 0, 0, 0);
        a = __builtin_amdgcn_mfma_f32_16x16x32_bf16(k1, q1, a, 0, 0, 0);
        st[t] = a;
    }
    const float slope2 = exp2f(-(float)(h + 1)) * (float)dil * LOG2E, sc = 0.125f * LOG2E;
    const int jq = 128 * (n - 1);
    float mx = -1e30f;
#pragma unroll
    for (int t = 0; t < 9; ++t)
#pragma unroll
        for (int i = 0; i < 4; ++i) {
            const int kl = 16 * (w + t) + 4 * G + i, dk = kl - ql;
            const bool ok = dk >= 0 && dk <= 128 && (jq + kl) >= 0;
            const float sv = ok ? st[t][i] * sc - slope2 * (float)(128 - dk) : -1e30f;
            st[t][i] = sv; mx = fmaxf(mx, sv);
        }
    mx = fmaxf(mx, __shfl_xor(mx, 16)); mx = fmaxf(mx, __shfl_xor(mx, 32));
    float l = 0.f;
#pragma unroll
    for (int t = 0; t < 9; ++t)
#pragma unroll
        for (int i = 0; i < 4; ++i) { const float pv = st[t][i] > -1e29f ? __builtin_amdgcn_exp2f(st[t][i] - mx) : 0.f; st[t][i] = pv; l += pv; }
    l += __shfl_xor(l, 16); l += __shfl_xor(l, 32);
    pg8::f32x4 o[4];
#pragma unroll
    for (int dm = 0; dm < 4; ++dm) o[dm] = (pg8::f32x4){0.f, 0.f, 0.f, 0.f};
#pragma unroll
    for (int s5 = 0; s5 < 5; ++s5) {
        const pg8::f32x4 pa = st[2 * s5], pb = (2 * s5 + 1 < 9) ? st[2 * s5 + 1] : (pg8::f32x4){0.f, 0.f, 0.f, 0.f};
        bf16x8v pf;
        { const unsigned w0 = pk2(pa[0], pa[1]), w1 = pk2(pa[2], pa[3]), w2 = pk2(pb[0], pb[1]), w3 = pk2(pb[2], pb[3]);
          pf = __builtin_bit_cast(bf16x8v, (v4u){w0, w1, w2, w3}); }
        const LAS bf16* vbase = Vs + (16 * (w + 2 * s5) + 4 * G + (qi >> 2)) * 72 + 4 * (qi & 3);
#pragma unroll
        for (int dm = 0; dm < 4; ++dm) {
            const s16x4v lo = lds_tr16(vbase + 16 * dm), hi = lds_tr16(vbase + 16 * 72 + 16 * dm);
            const bf16x8v vf = (bf16x8v){lo[0], lo[1], lo[2], lo[3], hi[0], hi[1], hi[2], hi[3]};
            o[dm] = __builtin_amdgcn_mfma_f32_16x16x32_bf16(vf, pf, o[dm], 0, 0, 0);
        }
    }
    const float inv = 1.f / l;
    bf16* og = (bf16*)(F.ws + WS_OG) + ((size_t)g * T + growq) * 512 + h * 64 + 4 * G;
#pragma unroll
    for (int dm = 0; dm < 4; ++dm) *(GAS u64*)(og + 16 * dm) = (u64)pk2(o[dm][0] * inv, o[dm][1] * inv) | ((u64)pk2(o[dm][2] * inv, o[dm][3] * inv) << 32);
    if (G == 0) ((float*)(F.ws + WS_LSE))[((size_t)g * T + growq) * 8 + h] = (mx + __builtin_amdgcn_logf(l)) * LN2;
    __syncthreads();
}

__device__ __forceinline__ void phase_combine_conv(Frame& F, const In& in) {
    const int gw = F.vcu * NWAVES + F.wave, NGW = F.G * NWAVES, lane = F.lane;
    const bf16* PROJ = (const bf16*)(F.ws + WS_PROJ); const bf16* OG = (const bf16*)(F.ws + WS_OG); const float* LSE = (const float*)(F.ws + WS_LSE);
    for (int t = gw; t < T; t += NGW) {
        { const int head = lane >> 3;
          const float l0 = LSE[((size_t)0 * T + t) * 8 + head], l1 = LSE[((size_t)1 * T + t) * 8 + head], l2 = LSE[((size_t)2 * T + t) * 8 + head];
          const float mx = fmaxf(l0, fmaxf(l1, l2)); float w0 = __expf(l0 - mx), w1 = __expf(l1 - mx), w2 = __expf(l2 - mx); const float inv = 1.f / (w0 + w1 + w2); w0 *= inv; w1 *= inv; w2 *= inv;
          const v4u a = *(const GAS v4u*)(OG + ((size_t)0 * T + t) * 512 + 8 * lane), b = *(const GAS v4u*)(OG + ((size_t)1 * T + t) * 512 + 8 * lane), c = *(const GAS v4u*)(OG + ((size_t)2 * T + t) * 512 + 8 * lane);
          v4u o;
          o.x = pk2(w0 * bf_lo(a.x) + w1 * bf_lo(b.x) + w2 * bf_lo(c.x), w0 * bf_hi(a.x) + w1 * bf_hi(b.x) + w2 * bf_hi(c.x));
          o.y = pk2(w0 * bf_lo(a.y) + w1 * bf_lo(b.y) + w2 * bf_lo(c.y), w0 * bf_hi(a.y) + w1 * bf_hi(b.y) + w2 * bf_hi(c.y));
          o.z = pk2(w0 * bf_lo(a.z) + w1 * bf_lo(b.z) + w2 * bf_lo(c.z), w0 * bf_hi(a.z) + w1 * bf_hi(b.z) + w2 * bf_hi(c.z));
          o.w = pk2(w0 * bf_lo(a.w) + w1 * bf_lo(b.w) + w2 * bf_lo(c.w), w0 * bf_hi(a.w) + w1 * bf_hi(b.w) + w2 * bf_hi(c.w));
          *(GAS v4u*)((bf16*)(F.ws + WS_YA) + (size_t)t * 512 + 8 * lane) = o; }
        const int pos = t & (SEQ - 1);
#pragma unroll
        for (int half = 0; half < 2; ++half) {
            const int c = 8 * lane + 512 * half;
            float z[3][8];
#pragma unroll
            for (int dd = 0; dd < 3; ++dd) {
                const int back = 2 - dd;
                if (pos - back >= 0) { const bf16* p = PROJ + (size_t)(t - back) * NPROJ + 4608 + c; const v4u gc = *(const GAS v4u*)(p + 1024), xc = *(const GAS v4u*)(p + 2048);
                    z[dd][0] = bf_lo(gc.x) * bf_lo(xc.x); z[dd][1] = bf_hi(gc.x) * bf_hi(xc.x); z[dd][2] = bf_lo(gc.y) * bf_lo(xc.y); z[dd][3] = bf_hi(gc.y) * bf_hi(xc.y);
                    z[dd][4] = bf_lo(gc.z) * bf_lo(xc.z); z[dd][5] = bf_hi(gc.z) * bf_hi(xc.z); z[dd][6] = bf_lo(gc.w) * bf_lo(xc.w); z[dd][7] = bf_hi(gc.w) * bf_hi(xc.w); }
                else {
#pragma unroll
                    for (int i = 0; i < 8; ++i) z[dd][i] = 0.f; }
            }
            const v4u gb = *(const GAS v4u*)(PROJ + (size_t)t * NPROJ + 4608 + c);
            float y[8];
#pragma unroll
            for (int i = 0; i < 8; ++i) y[i] = in.conv_w[c + i] * z[0][i] + in.conv_w[1024 + c + i] * z[1][i] + in.conv_w[2048 + c + i] * z[2][i];
            v4u o; o.x = pk2(bf_lo(gb.x) * y[0], bf_hi(gb.x) * y[1]); o.y = pk2(bf_lo(gb.y) * y[2], bf_hi(gb.y) * y[3]); o.z = pk2(bf_lo(gb.z) * y[4], bf_hi(gb.z) * y[5]); o.w = pk2(bf_lo(gb.w) * y[6], bf_hi(gb.w) * y[7]);
            *(GAS v4u*)((bf16*)(F.ws + WS_YC) + (size_t)t * 1024 + c) = o;
        }
    }
}


__device__ __forceinline__ void cross_attn_unit_mfma(Frame& F, int unit) {
    const int qc = unit & 31, bh = unit >> 5, h = bh & 3, b = bh >> 2, tid = F.tid, lane = F.lane, w = F.wave, qi = lane & 15, G = lane >> 4;
    const bf16* KV = (const bf16*)(F.ws + WS_KV); const bf16* Q2 = (const bf16*)(F.ws + WS_Q2);
    LAS bf16* Ks = (LAS bf16*)F.lds; LAS bf16* Vs = Ks + 256 * 136;
#pragma unroll
    for (int it = 0; it < 8; ++it) {
        const int row = (tid >> 4) + 32 * it, ch = tid & 15; const bf16* p = KV + (size_t)(b * NMEM + row) * 1024 + h * 128 + ch * 8;
        *(LAS v4u*)(Ks + row * 136 + ch * 8) = *(const GAS v4u*)p; *(LAS v4u*)(Vs + row * 136 + ch * 8) = *(const GAS v4u*)(p + 512);
    }
    const size_t grow = (size_t)b * SEQ + 128 * qc + 16 * w + qi;
    bf16x8v q[4];
#pragma unroll
    for (int ks = 0; ks < 4; ++ks) q[ks] = *(const GAS bf16x8v*)(Q2 + grow * 512 + h * 128 + 32 * ks + 8 * G);
    __syncthreads();
    pg8::f32x4 st[16];
#pragma unroll
    for (int t = 0; t < 16; ++t) {
        const LAS bf16* kp = Ks + (16 * t + qi) * 136 + 8 * G;
        pg8::f32x4 a = (pg8::f32x4){0.f, 0.f, 0.f, 0.f};
#pragma unroll
        for (int ks = 0; ks < 4; ++ks) a = __builtin_amdgcn_mfma_f32_16x16x32_bf16(*(const LAS bf16x8v*)(kp + 32 * ks), q[ks], a, 0, 0, 0);
        st[t] = a;
    }
    const float sc = 0.08838834764831845f * LOG2E;
    float mx = -1e30f;
#pragma unroll
    for (int t = 0; t < 16; ++t)
#pragma unroll
        for (int i = 0; i < 4; ++i) { st[t][i] *= sc; mx = fmaxf(mx, st[t][i]); }
    mx = fmaxf(mx, __shfl_xor(mx, 16)); mx = fmaxf(mx, __shfl_xor(mx, 32));
    float l = 0.f;
#pragma unroll
    for (int t = 0; t < 16; ++t)
#pragma unroll
        for (int i = 0; i < 4; ++i) { const float pv = __builtin_amdgcn_exp2f(st[t][i] - mx); st[t][i] = pv; l += pv; }
    l += __shfl_xor(l, 16); l += __shfl_xor(l, 32);
    pg8::f32x4 o[8];
#pragma unroll
    for (int dm = 0; dm < 8; ++dm) o[dm] = (pg8::f32x4){0.f, 0.f, 0.f, 0.f};
#pragma unroll
    for (int s8 = 0; s8 < 8; ++s8) {
        const pg8::f32x4 pa = st[2 * s8], pb = st[2 * s8 + 1];
        const bf16x8v pf = __builtin_bit_cast(bf16x8v, (v4u){pk2(pa[0], pa[1]), pk2(pa[2], pa[3]), pk2(pb[0], pb[1]), pk2(pb[2], pb[3])});
        const LAS bf16* vbase = Vs + (32 * s8 + 4 * G + (qi >> 2)) * 136 + 4 * (qi & 3);
#pragma unroll
        for (int dm = 0; dm < 8; ++dm) {
            const s16x4v lo = lds_tr16(vbase + 16 * dm), hi = lds_tr16(vbase + 16 * 136 + 16 * dm);
            const bf16x8v vf = (bf16x8v){lo[0], lo[1], lo[2], lo[3], hi[0], hi[1], hi[2], hi[3]};
            o[dm] = __builtin_amdgcn_mfma_f32_16x16x32_bf16(vf, pf, o[dm], 0, 0, 0);
        }
    }
    const float inv = 1.f / l;
    bf16* op = (bf16*)(F.ws + WS_O2) + grow * 512 + h * 128 + 4 * G;
#pragma unroll
    for (int dm = 0; dm < 8; ++dm) *(GAS u64*)(op + 16 * dm) = (u64)pk2(o[dm][0] * inv, o[dm][1] * inv) | ((u64)pk2(o[dm][2] * inv, o[dm][3] * inv) << 32);
    __syncthreads();
}

__device__ __forceinline__ void phase_router(Frame& F, const In& in, const float* H2) {
    LAS float* wl = (LAS float*)F.lds; LAS float* part = (LAS float*)(F.lds + 131072); LAS float* ssq = part + 2 * 64 * 32; LAS float* rsl = ssq + 128;
    volatile LAS int* hist = (volatile LAS int*)(F.lds + TBL_OFF + 1024);
    const int tid = F.tid, lane = F.lane, w = F.wave;
    for (int i = tid; i < 1024 * 8; i += NTHREADS) { const int k = i >> 3, c4 = i & 7; const f32x4 v = ((const GAS f32x4*)in.router_w)[i] * in.norm_moe[k];
        *(LAS f32x4*)(wl + k * 32 + ((4 * c4 + 16 * ((k >> 7) & 1)) & 31)) = v; }
    if (tid < 32) hist[tid] = 0;
    __syncthreads();
    int* topi = (int*)(F.ws + WS_TOPI); float* topw = (float*)(F.ws + WS_TOPW); unsigned char* U3 = F.ws + WS_U3;
    for (int ch = F.vcu; ch < T / 64; ch += F.G) {
    const int t0 = ch * 64;
    {
        const int tg = w & 3, kh = w >> 2, ti = lane & 15, kq = lane >> 4, kbase = kh * 512 + kq * 128;
        const GAS f32x4* xr = (const GAS f32x4*)(H2 + (size_t)(t0 + 16 * tg + ti) * D + kbase);
        const LAS float* wb = wl + kbase * 32 + ((ti + 16 * (kq & 1)) & 31);
        const LAS float* wb2 = wl + kbase * 32 + ((ti + 16 + 16 * (kq & 1)) & 31);
        f32x4 c0 = (f32x4){0.f, 0.f, 0.f, 0.f}, c1 = c0; float sq = 0.f;
#pragma unroll 2
        for (int c8 = 0; c8 < 4; ++c8) {
            f32x4 x[8];
#pragma unroll
            for (int q = 0; q < 8; ++q) x[q] = xr[8 * c8 + q];
#pragma unroll
            for (int q = 0; q < 8; ++q) {
                const int kk = 4 * (8 * c8 + q);
                c0 = __builtin_amdgcn_mfma_f32_16x16x4f32(x[q].x, wb[(kk + 0) * 32], c0, 0, 0, 0); c1 = __builtin_amdgcn_mfma_f32_16x16x4f32(x[q].x, wb2[(kk + 0) * 32], c1, 0, 0, 0);
                c0 = __builtin_amdgcn_mfma_f32_16x16x4f32(x[q].y, wb[(kk + 1) * 32], c0, 0, 0, 0); c1 = __builtin_amdgcn_mfma_f32_16x16x4f32(x[q].y, wb2[(kk + 1) * 32], c1, 0, 0, 0);
                c0 = __builtin_amdgcn_mfma_f32_16x16x4f32(x[q].z, wb[(kk + 2) * 32], c0, 0, 0, 0); c1 = __builtin_amdgcn_mfma_f32_16x16x4f32(x[q].z, wb2[(kk + 2) * 32], c1, 0, 0, 0);
                c0 = __builtin_amdgcn_mfma_f32_16x16x4f32(x[q].w, wb[(kk + 3) * 32], c0, 0, 0, 0); c1 = __builtin_amdgcn_mfma_f32_16x16x4f32(x[q].w, wb2[(kk + 3) * 32], c1, 0, 0, 0);
                sq += (x[q].x * x[q].x + x[q].y * x[q].y) + (x[q].z * x[q].z + x[q].w * x[q].w);
            }
        }
        sq += __shfl_xor(sq, 16); sq += __shfl_xor(sq, 32);
        if (kq == 0) ssq[kh * 64 + 16 * tg + ti] = sq;
#pragma unroll
        for (int r = 0; r < 4; ++r) { LAS float* pp = part + (kh * 64 + 16 * tg + 4 * kq + r) * 32 + ti; pp[0] = c0[r]; pp[16] = c1[r]; }
    }
    __syncthreads();
    if (tid < 64) {
        const int t = t0 + tid; const float rstd = 1.f / sqrtf((ssq[tid] + ssq[64 + tid]) * (1.f / D) + EPS); rsl[tid] = rstd;
        LAS float* lg = part + tid * 32;
        for (int e = 0; e < 32; ++e) lg[e] = (lg[e] + lg[64 * 32 + e]) * rstd + in.router_b[e];
        float tv[4]; int tix[4];
#pragma unroll
        for (int k = 0; k < 4; ++k) { float bv = -INFINITY; int bi = 0; for (int e = 0; e < 32; ++e) { const float v = lg[e]; if (v > bv) { bv = v; bi = e; } } tv[k] = bv; tix[k] = bi; lg[bi] = -INFINITY; }
        const float e1 = __expf(tv[1] - tv[0]), e2 = __expf(tv[2] - tv[0]), e3 = __expf(tv[3] - tv[0]), inv = 1.f / (1.f + e1 + e2 + e3);
        topi[t * 4 + 0] = tix[0]; topi[t * 4 + 1] = tix[1]; topi[t * 4 + 2] = tix[2]; topi[t * 4 + 3] = tix[3];
        topw[t * 4 + 0] = inv; topw[t * 4 + 1] = e1 * inv; topw[t * 4 + 2] = e2 * inv; topw[t * 4 + 3] = e3 * inv;
#pragma unroll
        for (int k = 0; k < 4; ++k) __hip_atomic_fetch_add((LAS int*)(F.lds + TBL_OFF + 1024) + tix[k], 1, __ATOMIC_RELAXED, __HIP_MEMORY_SCOPE_WORKGROUP);
    }
    __syncthreads();
    for (int tl = w; tl < 64; tl += NWAVES) {
        const int t = t0 + tl; const float rstd = rsl[tl];
        const GAS f32x4* xr = (const GAS f32x4*)(H2 + (size_t)t * D) + lane; const GAS f32x4* gr = (const GAS f32x4*)in.norm_moe + lane; GAS unsigned* u3r = (GAS unsigned*)(U3 + (size_t)t * D) + lane;
#pragma unroll
        for (int j = 0; j < 4; ++j) { const f32x4 v = xr[64 * j] * gr[64 * j] * rstd; u3r[64 * j] = pg8::pack4_fp8(v); }
    }
    __syncthreads();
    }
    if (tid < 32) ((int*)(F.ws + WS_HIST))[F.vcu * 32 + tid] = hist[tid];
    __syncthreads();
}

__device__ __forceinline__ void phase_assign(Frame& F) {
    volatile LAS int* tb = (volatile LAS int*)(F.lds + TBL_OFF);
    LAS int* part = (LAS int*)F.lds;
    const int* HIST = (const int*)(F.ws + WS_HIST); const int tid = F.tid, e = tid & 31, pt = tid >> 5;
    { int tot = 0, bef = 0; for (int b = pt; b < F.G; b += 16) { const int h = HIST[b * 32 + e]; tot += h; bef += (b < F.vcu) ? h : 0; } part[pt * 64 + e] = tot; part[pt * 64 + 32 + e] = bef; }
    __syncthreads();
    if (tid < 32) { int tot = 0, bef = 0; for (int q = 0; q < 16; ++q) { tot += part[q * 64 + tid]; bef += part[q * 64 + 32 + tid]; } tb[64 + tid] = tot; tb[128 + tid] = bef; tb[160 + tid] = 0; }
    __syncthreads();
    if (tid == 0) { int acc = 0; for (int k = 0; k < NEXP; ++k) { tb[k] = acc; acc += (tb[64 + k] + 255) >> 8; } tb[32] = acc; }
    __syncthreads();
    if (tid < 32) { tb[128 + tid] += tb[tid] * 256; if (F.vcu == 0) ((unsigned*)(F.ws + WS_CTL + CTL_CNT))[tid] = (unsigned)tb[64 + tid]; }
    __syncthreads();
    int* rowtok = (int*)(F.ws + WS_CTL + CTL_ROWTOK); int* rowslot = (int*)(F.ws + WS_ROWSLOT); const int* topi = (const int*)(F.ws + WS_TOPI);
    if (F.vcu < NEXP) { const int x = F.vcu; for (int R = tb[x] * 256 + tb[64 + x] + tid; R < tb[x + 1] * 256; R += NTHREADS) rowslot[R] = -1; }
    for (int ch = F.vcu; ch < T / 64; ch += F.G)
    for (int a = ch * 256 + tid; a < ch * 256 + 256; a += NTHREADS) {
        const int x = topi[a];
        const int rank = __hip_atomic_fetch_add((LAS int*)(F.lds + TBL_OFF) + 160 + x, 1, __ATOMIC_RELAXED, __HIP_MEMORY_SCOPE_WORKGROUP);
        const int R = tb[128 + x] + rank; rowtok[R] = a >> 2; rowslot[R] = a;
    }
    __syncthreads();
}

__device__ __forceinline__ void build_tpre(Frame& F) {
    volatile LAS int* tpre = (volatile LAS int*)(F.lds + TBL_OFF);
    const unsigned* cnt = (const unsigned*)(F.ws + WS_CTL + CTL_CNT);
    if (F.tid == 0) { int acc = 0;
        for (int e = 0; e < NEXP; ++e) { tpre[e] = acc; const unsigned c = __hip_atomic_load(cnt + e, __ATOMIC_RELAXED, __HIP_MEMORY_SCOPE_AGENT); tpre[64 + e] = (int)c; acc += (int)((c + 255u) >> 8); }
        tpre[32] = acc; }
    __syncthreads();
}

__device__ __forceinline__ void phase_final(Frame& F, const In& in, const float* H2, float* OUT) {
    const int gw = F.vcu * NWAVES + F.wave, NGW = F.G * NWAVES, lane = F.lane;
    const bf16* Y = (const bf16*)(F.ws + WS_Y);
    for (int t = gw; t < T; t += NGW) {
        const GAS f32x4* xr = (const GAS f32x4*)(H2 + (size_t)t * D) + lane; const GAS f32x4* gr = (const GAS f32x4*)in.norm_final + lane;
        f32x4 v[4]; float s = 0.f;
#pragma unroll
        for (int j = 0; j < 4; ++j) v[j] = xr[64 * j];
#pragma unroll
        for (int k = 0; k < 4; ++k) { const GAS u64* yr = (const GAS u64*)(Y + (size_t)(t * 4 + k) * D) + lane;
#pragma unroll
            for (int j = 0; j < 4; ++j) { const u64 w = yr[64 * j]; const unsigned lo = (unsigned)w, hi = (unsigned)(w >> 32); v[j].x += bf_lo(lo); v[j].y += bf_hi(lo); v[j].z += bf_lo(hi); v[j].w += bf_hi(hi); } }
#pragma unroll
        for (int j = 0; j < 4; ++j) s += (v[j].x * v[j].x + v[j].y * v[j].y) + (v[j].z * v[j].z + v[j].w * v[j].w);
        const float rstd = 1.f / sqrtf(wave_sum(s) * (1.f / D) + EPS);
        GAS f32x4* orow = (GAS f32x4*)(OUT + (size_t)t * D) + lane;
#pragma unroll
        for (int j = 0; j < 4; ++j) orow[64 * j] = v[j] * gr[64 * j] * rstd;
    }
}
struct Args { const float* in[25]; float* out; unsigned char* ws; int ph_lo, ph_hi; };
#ifndef PG8_SP2
#define PG8_SP2 true
#endif
#ifndef PG8_ALIGN
#define PG8_ALIGN true
#endif
__global__ void __launch_bounds__(NTHREADS, 2) mega_fwd(Args args) {
    extern __shared__ __attribute__((aligned(16))) unsigned char lds[];
    Frame F;
    F.lds = (LAS unsigned char*)lds; F.MISC = (volatile LAS unsigned*)(F.lds + MISC_OFF);
    F.tid = threadIdx.x; F.lane = F.tid & 63; F.wave = __builtin_amdgcn_readfirstlane(F.tid >> 6);
    F.G = gridDim.x; { const int bx = blockIdx.x; F.vcu = (F.G % 8 == 0) ? (bx % 8) * (F.G / 8) + bx / 8 : bx; }
    F.ws = args.ws; F.ctl = (gu32*)(args.ws + WS_CTL);
    In in;
    in.x = args.in[0]; in.mem = args.in[1]; in.norm_mix = args.in[2]; in.w_in = args.in[3]; in.conv_w = args.in[4]; in.w_ba = args.in[5]; in.w_bc = args.in[6];
    in.w_gate = args.in[7]; in.b_gate = args.in[8]; in.w_out = args.in[9]; in.norm_cross = args.in[10]; in.norm_mem = args.in[11]; in.w_cq = args.in[12];
    in.w_ckv = args.in[13]; in.w_co = args.in[14]; in.norm_moe = args.in[15]; in.router_w = args.in[16]; in.router_b = args.in[17]; in.w_eg = args.in[18];
    in.b_eg = args.in[19]; in.w_eu = args.in[20]; in.b_eu = args.in[21]; in.w_ed = args.in[22]; in.b_ed = args.in[23]; in.norm_final = args.in[24];
    unsigned char* ws = args.ws;
    for (int u = F.tid; u < 64; u += NTHREADS) ((LAS unsigned*)(F.lds + MISC_OFF))[u] = 0u;
    __syncthreads();
    XcdBarrier bar; bar.bar = (unsigned*)(F.ctl + CW_BAR); bar.x = 0; bar.st = nullptr;
    if (N_LAUNCHES == 1) bar = xcd_barrier_post((unsigned*)(F.ctl + CW_BAR), F.MISC + 8);
    const int lo = args.ph_lo, hi = args.ph_hi;
#define IN(k) (lo <= (k) && (k) < hi)
#define SEAM(k) do { if (IN(k) && IN((k) + 1)) xcd_barrier(bar); } while (0)
    typedef pg8::bf16_t b16;

    if (IN(0)) { phase_prologue(F, in); } SEAM(0);

    if (IN(1)) {
        pg8::Gemm g{(const b16*)(ws + WS_U1), (const b16*)(ws + WS_W1T), T, NPROJ, D}; pg8::StaticOrder S; S.init(T, NPROJ, F.G, (int)blockIdx.x);
        pg8::EpiProj E{(b16*)(ws + WS_PROJ), in.b_gate};
        pg8::gemm_phase<pg8::EpiProj, pg8::StaticOrder, PG8_ALIGN, PG8_SP2>(F.lds, g, S, E);
    } SEAM(1);

    if (IN(2)) { for (int u = blockIdx.x; u < NBATCH * 3 * 8 * 32; u += F.G) dil_attn_unit_mfma(F, u); } SEAM(2);

    if (IN(3)) { phase_combine_conv(F, in); } SEAM(3);

    if (IN(4)) {
        { pg8::Gemm g{(const b16*)(ws + WS_YA), (const b16*)(ws + WS_WBA), T, D, 512}; pg8::StaticOrder S; S.init(T, D, F.G, (int)blockIdx.x);
          pg8::EpiMix<false> E{(b16*)(ws + WS_MIX), (const b16*)(ws + WS_PROJ)};
          pg8::gemm_phase<pg8::EpiMix<false>, pg8::StaticOrder, PG8_ALIGN, PG8_SP2>(F.lds, g, S, E); }
        { pg8::Gemm g{(const b16*)(ws + WS_YC), (const b16*)(ws + WS_WBC), T, D, D}; pg8::StaticOrder S; S.init(T, D, F.G, (int)blockIdx.x);
          pg8::EpiMix<true> E{(b16*)(ws + WS_MIX), (const b16*)(ws + WS_PROJ)};
          pg8::gemm_phase<pg8::EpiMix<true>, pg8::StaticOrder, PG8_ALIGN, PG8_SP2>(F.lds, g, S, E); }
    } SEAM(4);

    if (IN(5)) {
        { pg8::Gemm g{(const b16*)(ws + WS_MIX), (const b16*)(ws + WS_WO), T, D, D}; pg8::StaticOrder S; S.init(T, D, F.G, (int)blockIdx.x);
          pg8::EpiH1 E{in.x, (float*)(ws + WS_H1), (b16*)(ws + WS_H1B), (float*)(ws + WS_CTL + CTL_SS2)};
          pg8::gemm_phase<pg8::EpiH1, pg8::StaticOrder, PG8_ALIGN, PG8_SP2>(F.lds, g, S, E); }
        phase_expert_convert(F, in);
    } SEAM(5);

    if (IN(6)) {
        { pg8::Gemm g{(const b16*)(ws + WS_H1B), (const b16*)(ws + WS_WCQ), T, 512, D}; pg8::StaticOrder S; S.init(T, 512, F.G, (int)blockIdx.x);
          pg8::EpiQ2 E{(b16*)(ws + WS_Q2), (const float*)(ws + WS_CTL + CTL_SS2)};
          pg8::gemm_phase<pg8::EpiQ2, pg8::StaticOrder, PG8_ALIGN, PG8_SP2>(F.lds, g, S, E); }
        { pg8::Gemm g{(const b16*)(ws + WS_MN), (const b16*)(ws + WS_WCKV), NBATCH * NMEM, D, D}; pg8::StaticOrder S; S.init(NBATCH * NMEM, D, F.G, ((int)blockIdx.x + F.G - 128) % F.G);
          pg8::EpiPlain E{(b16*)(ws + WS_KV), D};
          pg8::gemm_phase<pg8::EpiPlain, pg8::StaticOrder, PG8_ALIGN, PG8_SP2>(F.lds, g, S, E); }
    } SEAM(6);

    if (IN(7)) { for (int u = blockIdx.x; u < NBATCH * 4 * 32; u += F.G) cross_attn_unit_mfma(F, u); } SEAM(7);

    if (IN(8)) {
        pg8::Gemm g{(const b16*)(ws + WS_O2), (const b16*)(ws + WS_WCO), T, D, 512}; pg8::StaticOrder S; S.init(T, D, F.G, (int)blockIdx.x);
        pg8::EpiH2 E{(const float*)(ws + WS_H1), args.out};
        pg8::gemm_phase<pg8::EpiH2, pg8::StaticOrder, PG8_ALIGN, PG8_SP2>(F.lds, g, S, E);
    } SEAM(8);

    if (IN(9)) { phase_router(F, in, args.out); } SEAM(9);

    if (IN(10)) { phase_assign(F); } SEAM(10);

    if (IN(11)) {
        build_tpre(F);
        pg8::Gemm g{(const b16*)(ws + WS_U3), (const b16*)(ws + WS_EXPGU), T, NEXP * 2048, D / 2};
        MoeOrder S{(const volatile LAS int*)(F.lds + TBL_OFF), 8, F.G, (int)blockIdx.x};
        LAS int* rowbuf = (LAS int*)(F.lds + ROWBUF_OFF); const int* rowtok = (const int*)(ws + WS_CTL + CTL_ROWTOK);
        { pg8::Unit uu; for (int i = 0; i < ROWBUF_UNITS && S.next(i, uu); ++i) if (F.tid < 256) rowbuf[256 * i + F.tid] = rowtok[uu.pm * 256 + F.tid]; }
        __syncthreads();
        pg8::EpiHdnF8 E{ws + WS_HDN, in.b_eg, in.b_eu};
        pg8::gemm_phase_gather<pg8::EpiHdnF8, MoeOrder, true>(F.lds, g, S, E, (const LAS int*)rowbuf);
    } SEAM(11);

    if (IN(12)) {
        build_tpre(F);
        pg8::Gemm g{(const b16*)(ws + WS_HDN), (const b16*)(ws + WS_EXPD), XS_ROWS, NEXP * 1024, D / 2};
        MoeOrder S{(const volatile LAS int*)(F.lds + TBL_OFF), 4, F.G, (int)blockIdx.x};
        pg8::EpiYF8 E{(b16*)(ws + WS_Y), in.b_ed, (const int*)(ws + WS_ROWSLOT), (const float*)(ws + WS_TOPW)};
        pg8::gemm_phase<pg8::EpiYF8, MoeOrder, PG8_ALIGN, PG8_SP2, true>(F.lds, g, S, E);
    } SEAM(12);

    if (IN(13)) { phase_final(F, in, args.out, args.out); }
#undef IN
#undef SEAM
}

extern "C" void kernel_launch(void* const* d_in, const int* in_sizes, int n_in, void* d_out, int out_size, void* d_ws, size_t ws_size, hipStream_t stream) {
    static int grid = 0;
    if (grid == 0) {
        if (n_in != 25 || in_sizes[0] != T * D || out_size != T * D || ws_size < WS_END) {
            fprintf(stderr, "kernel_launch: built for 25 inputs, x/out of %d floats, >= %zu bytes of workspace; got n_in %d, in0 %d, out %d, ws %zu; nothing launched\n", T * D, (size_t)WS_END, n_in, n_in > 0 ? in_sizes[0] : -1, out_size, ws_size);
            grid = -1; return; }
        int dev = 0, cus = 0, per_cu = 0;
        if (hipGetDevice(&dev) != hipSuccess || hipDeviceGetAttribute(&cus, hipDeviceAttributeMultiprocessorCount, dev) != hipSuccess) { fprintf(stderr, "kernel_launch: device query failed\n"); grid = -1; return; }
        if (hipFuncSetAttribute((const void*)mega_fwd, hipFuncAttributeMaxDynamicSharedMemorySize, LDS_BYTES) != hipSuccess) { fprintf(stderr, "kernel_launch: hipFuncSetAttribute(%d B LDS) failed\n", LDS_BYTES); grid = -1; return; }
        if (hipOccupancyMaxActiveBlocksPerMultiprocessor(&per_cu, (const void*)mega_fwd, NTHREADS, LDS_BYTES) != hipSuccess || per_cu < 1) { fprintf(stderr, "kernel_launch: occupancy query says %d workgroups per CU\n", per_cu); per_cu = 1; }
        (void)hipGetLastError();
        grid = cus < 256 ? cus : 256;
    }
    if (grid < 0) return;
    (void)hipMemsetAsync((char*)d_ws + WS_CTL, 0, CTL_ZERO_BYTES, stream);
    Args a{};
    for (int i = 0; i < 25; ++i) a.in[i] = (const float*)d_in[i];
    a.out = (float*)d_out; a.ws = (unsigned char*)d_ws;
    if (N_LAUNCHES == 1) {
        a.ph_lo = 0; a.ph_hi = N_PHASES;
        void* kargs[] = {&a};
        hipError_t e = hipLaunchCooperativeKernel((const void*)mega_fwd, dim3(grid), dim3(NTHREADS), kargs, LDS_BYTES, stream);
        if (e != hipSuccess) fprintf(stderr, "kernel_launch: cooperative launch failed: %s (grid %d)\n", hipGetErrorString(e), grid);
    } else {
        for (int p = 0; p < N_PHASES; ++p) { a.ph_lo = p; a.ph_hi = p + 1; hipLaunchKernelGGL(mega_fwd, dim3(grid), dim3(NTHREADS), LDS_BYTES, stream, a);
        }
    }
}
```

```cpp
#include <hip/hip_runtime.h>
#include <cstdio>
#include <cstdint>
namespace pg8 {
#define PG8_LAS __attribute__((address_space(3)))
typedef unsigned short bf16_t;
typedef short bf16x8 __attribute__((ext_vector_type(8)));
typedef float f32x4 __attribute__((ext_vector_type(4)));
typedef unsigned u32x4 __attribute__((ext_vector_type(4)));
constexpr int BM = 256, BK = 64, HALF = 128, HTB = HALF * BK * 2  , STAGE_BYTES = 8 * HTB, NXCD = 8, WGM = 8;

__host__ __device__ __forceinline__ int lds_byte(int r, int c) { const int st = (r >> 4) * 2 + (c >> 5), rr = r & 15, cc = c & 31, ob = rr * 64 + cc * 2; return st * 1024 + (ob ^ (((ob >> 9) & 1) << 5)); }
__host__ __device__ __forceinline__ void stage_rc(int b, int& R, int& C) { const int st = b / 1024, sb = b % 1024, swz = sb ^ (((sb >> 9) & 1) << 5); R = (st >> 1) * 16 + swz / 64; C = (st & 1) * 32 + (swz % 64) / 2; }
__host__ __device__ __forceinline__ int perm32(int rho) { const int n = rho >> 4, i = rho & 15; return 8 * (i >> 2) + 4 * n + (i & 3); }

struct Unit { int pm, pn; };
struct Gemm { const bf16_t* A; const bf16_t* Bt; int M, N, K; };

struct StaticOrder {
    int nM, nN, nwg, G, c;
    __host__ __device__ void init(int M, int N, int G_, int c_) { nM = M / BM; nN = N / BM; nwg = nM * nN; G = G_; c = c_; }
    __host__ __device__ bool next(int i, Unit& u) const {
        const long L = (long)i * G + c; if (L >= nwg) return false;
        int wgid = (int)L; { const int q = nwg / NXCD, r = nwg % NXCD, xcd = wgid % NXCD, off = wgid / NXCD; wgid = (xcd < r ? xcd * (q + 1) : r * (q + 1) + (xcd - r) * q) + off; }
        const int nig = WGM * nN, gid = wgid / nig, fm = gid * WGM, gsz = (nM - fm) < WGM ? (nM - fm) : WGM;
        u.pm = fm + ((wgid % nig) % gsz); u.pn = (wgid % nig) / gsz; return true;
    }
    __device__ __forceinline__ void a_ready(const Unit&) const {}
    __device__ __forceinline__ void done(const Unit&) const {}
};

__device__ __forceinline__ unsigned cvt_pk_bf16(float lo, float hi) { unsigned r; asm volatile("v_cvt_pk_bf16_f32 %0, %1, %2" : "=v"(r) : "v"(lo), "v"(hi)); return r; }
__device__ __forceinline__ float bflo(unsigned w) { return __builtin_bit_cast(float, w << 16); }
__device__ __forceinline__ float bfhi(unsigned w) { return __builtin_bit_cast(float, w & 0xffff0000u); }
__device__ __forceinline__ void unpack8(const u32x4 w, f32x4& a, f32x4& b) { a = (f32x4){bflo(w.x), bfhi(w.x), bflo(w.y), bfhi(w.y)}; b = (f32x4){bflo(w.z), bfhi(w.z), bflo(w.w), bfhi(w.w)}; }
__device__ __forceinline__ u32x4 pack8(const f32x4 a, const f32x4 b) { u32x4 w; w.x = cvt_pk_bf16(a[0], a[1]); w.y = cvt_pk_bf16(a[2], a[3]); w.z = cvt_pk_bf16(b[0], b[1]); w.w = cvt_pk_bf16(b[2], b[3]); return w; }
__device__ __forceinline__ float sigmoidf_fast(float x) { return __builtin_amdgcn_rcpf(1.0f + __builtin_amdgcn_exp2f(-1.4426950408889634f * x)); }
__device__ __forceinline__ f32x4 sig4(f32x4 v) { return (f32x4){sigmoidf_fast(v[0]), sigmoidf_fast(v[1]), sigmoidf_fast(v[2]), sigmoidf_fast(v[3])}; }

typedef int v8i32 __attribute__((ext_vector_type(8)));
typedef int v4i32 __attribute__((ext_vector_type(4)));
__device__ __forceinline__ void mfma_f8_inplace(f32x4& c, const v8i32& a, const v8i32& b, int scale) {
    asm volatile("s_nop 1\n\tv_mfma_scale_f32_16x16x128_f8f6f4 %0, %1, %2, %0, %3, %3 op_sel_hi:[0,0,0]" : "+v"(c) : "v"(a), "v"(b), "v"(scale)); }
template <bool F8> struct FragSel;
template <> struct FragSel<false> { struct A { bf16x8 f[4][2]; }; struct B { bf16x8 f[2][2]; }; };
template <> struct FragSel<true> { struct A { v8i32 f[4]; }; struct B { v8i32 f[2]; }; };
__device__ __forceinline__ unsigned pack4_fp8(const f32x4 v) { int w = 0; w = __builtin_amdgcn_cvt_pk_fp8_f32(v[0], v[1], w, false); w = __builtin_amdgcn_cvt_pk_fp8_f32(v[2], v[3], w, true); return (unsigned)w; }
constexpr float W8_SCALE = 32.f, W8_INV = 1.f / 32.f;
#define EPI_ROWS_BEGIN _Pragma("unroll") for (int ai = 0; ai < 2; ++ai) _Pragma("unroll") for (int m = 0; m < 4; ++m) { const int rowl = ai * HALF + wr * 64 + m * 16 + fr;
#define EPI_COLS_BEGIN _Pragma("unroll") for (int bj = 0; bj < 2; ++bj) { const int coll = bj * HALF + wc * 32 + 8 * fq; f32x4 v0 = acc[ai][bj][m][0], v1 = acc[ai][bj][m][1];
#define EPI_END }

struct EpiProj {
    static constexpr bool PERM = true, AFTER_DRAIN = false;
    bf16_t* O; const float* bgate;
    __device__ __forceinline__ void operator()(const f32x4 (&acc)[2][2][4][2], const Unit& u, int wr, int wc, int fr, int fq) const {
        const int row0 = u.pm * BM, col0 = u.pn * BM; const bool gate = col0 >= 7680;
        EPI_ROWS_BEGIN EPI_COLS_BEGIN
            const int row = row0 + rowl, col = col0 + coll;
            if (gate) { const f32x4 b0 = *(const f32x4*)(bgate + (col - 7680)), b1 = *(const f32x4*)(bgate + (col - 7680) + 4); v0 = sig4(v0 + b0); v1 = sig4(v1 + b1); }
            *(u32x4*)(O + (size_t)row * 9728 + col) = pack8(v0, v1);
        EPI_END EPI_END
    }
};
struct EpiPlain {
    static constexpr bool PERM = true, AFTER_DRAIN = false;
    bf16_t* O; int ldc;
    __device__ __forceinline__ void operator()(const f32x4 (&acc)[2][2][4][2], const Unit& u, int wr, int wc, int fr, int fq) const {
        const int row0 = u.pm * BM, col0 = u.pn * BM;
        EPI_ROWS_BEGIN EPI_COLS_BEGIN
            *(u32x4*)(O + (size_t)(row0 + rowl) * ldc + col0 + coll) = pack8(v0, v1);
        EPI_END EPI_END
    }
};
template <bool SECOND> struct EpiMix {
    static constexpr bool PERM = true, AFTER_DRAIN = false;
    bf16_t* MIX; const bf16_t* PROJ;
    __device__ __forceinline__ void operator()(const f32x4 (&acc)[2][2][4][2], const Unit& u, int wr, int wc, int fr, int fq) const {
        const int row0 = u.pm * BM, col0 = u.pn * BM;
        EPI_ROWS_BEGIN EPI_COLS_BEGIN
            const int row = row0 + rowl, col = col0 + coll;
            f32x4 g0, g1; unpack8(*(const u32x4*)(PROJ + (size_t)row * 9728 + (SECOND ? 8704 : 7680) + col), g0, g1);
            v0 = v0 * g0; v1 = v1 * g1;
            if (SECOND) { f32x4 t0, t1; unpack8(*(const u32x4*)(MIX + (size_t)row * 1024 + col), t0, t1); v0 = v0 + t0; v1 = v1 + t1; }
            *(u32x4*)(MIX + (size_t)row * 1024 + col) = pack8(v0, v1);
        EPI_END EPI_END
    }
};
struct EpiH1 {
    static constexpr bool PERM = true, AFTER_DRAIN = false;
    const float* X; float* H1; bf16_t* H1B; float* ss;
    __device__ __forceinline__ void operator()(const f32x4 (&acc)[2][2][4][2], const Unit& u, int wr, int wc, int fr, int fq) const {
        const int row0 = u.pm * BM, col0 = u.pn * BM;
        EPI_ROWS_BEGIN
            float s = 0.f; const int row = row0 + rowl;
            EPI_COLS_BEGIN
                const int col = col0 + coll; const size_t o = (size_t)row * 1024 + col;
                v0 = v0 + *(const f32x4*)(X + o); v1 = v1 + *(const f32x4*)(X + o + 4);
                *(f32x4*)(H1 + o) = v0; *(f32x4*)(H1 + o + 4) = v1; *(u32x4*)(H1B + o) = pack8(v0, v1);
                s += (v0[0] * v0[0] + v0[1] * v0[1]) + (v0[2] * v0[2] + v0[3] * v0[3]) + (v1[0] * v1[0] + v1[1] * v1[1]) + (v1[2] * v1[2] + v1[3] * v1[3]);
            EPI_END
            s += __shfl_xor(s, 16); s += __shfl_xor(s, 32);
            if (fq == 0) atomicAdd(ss + row, s);
        EPI_END
    }
};
struct EpiQ2 {
    static constexpr bool PERM = true, AFTER_DRAIN = false;
    bf16_t* Q2; const float* ss;
    __device__ __forceinline__ void operator()(const f32x4 (&acc)[2][2][4][2], const Unit& u, int wr, int wc, int fr, int fq) const {
        const int row0 = u.pm * BM, col0 = u.pn * BM;
        EPI_ROWS_BEGIN
            const int row = row0 + rowl; const float rs = __builtin_amdgcn_rsqf(__hip_atomic_load(ss + row, __ATOMIC_RELAXED, __HIP_MEMORY_SCOPE_AGENT) * (1.f / 1024.f) + 1e-6f);
            EPI_COLS_BEGIN
                *(u32x4*)(Q2 + (size_t)row * 512 + col0 + coll) = pack8(v0 * rs, v1 * rs);
            EPI_END
        EPI_END
    }
};
struct EpiH2 {
    static constexpr bool PERM = true, AFTER_DRAIN = false;
    const float* H1; float* OUT;
    __device__ __forceinline__ void operator()(const f32x4 (&acc)[2][2][4][2], const Unit& u, int wr, int wc, int fr, int fq) const {
        const int row0 = u.pm * BM, col0 = u.pn * BM;
        EPI_ROWS_BEGIN EPI_COLS_BEGIN
            const size_t o = (size_t)(row0 + rowl) * 1024 + col0 + coll;
            *(f32x4*)(OUT + o) = v0 + *(const f32x4*)(H1 + o); *(f32x4*)(OUT + o + 4) = v1 + *(const f32x4*)(H1 + o + 4);
        EPI_END EPI_END
    }
};
struct EpiHdn {
    static constexpr bool PERM = true, AFTER_DRAIN = false;
    bf16_t* HDN; const float* bg; const float* bu;
    __device__ __forceinline__ void operator()(const f32x4 (&acc)[2][2][4][2], const Unit& u, int wr, int wc, int fr, int fq) const {
        const int row0 = u.pm * BM, e = u.pn >> 3, hc = (u.pn & 7) * 128 + wc * 32 + 8 * fq;
        const float* pg = bg + e * 1024 + hc; const float* pu = bu + e * 1024 + hc;
        const f32x4 bg0 = *(const f32x4*)pg, bg1 = *(const f32x4*)(pg + 4), bu0 = *(const f32x4*)pu, bu1 = *(const f32x4*)(pu + 4);
        EPI_ROWS_BEGIN
            f32x4 g0 = acc[ai][0][m][0] + bg0, g1 = acc[ai][0][m][1] + bg1, l0 = acc[ai][1][m][0] + bu0, l1 = acc[ai][1][m][1] + bu1, h0, h1;
#pragma unroll
            for (int j = 0; j < 4; ++j) {
                const float ga = fminf(g0[j], 7.f), gb = fminf(g1[j], 7.f), la = fminf(fmaxf(l0[j], -7.f), 7.f), lb = fminf(fmaxf(l1[j], -7.f), 7.f);
                h0[j] = ga * sigmoidf_fast(1.702f * ga) * (la + 1.f); h1[j] = gb * sigmoidf_fast(1.702f * gb) * (lb + 1.f); }
            *(u32x4*)(HDN + (size_t)(row0 + rowl) * 1024 + hc) = pack8(h0, h1);
        EPI_END
    }
};
struct EpiHdnF8 {
    static constexpr bool PERM = true, AFTER_DRAIN = false;
    unsigned char* HDN; const float* bg; const float* bu;
    __device__ __forceinline__ void operator()(const f32x4 (&acc)[2][2][4][2], const Unit& u, int wr, int wc, int fr, int fq) const {
        const int row0 = u.pm * BM, e = u.pn >> 3, hc = (u.pn & 7) * 128 + wc * 32 + 8 * fq;
        const float* pg = bg + e * 1024 + hc; const float* pu = bu + e * 1024 + hc;
        const f32x4 bg0 = *(const f32x4*)pg, bg1 = *(const f32x4*)(pg + 4), bu0 = *(const f32x4*)pu, bu1 = *(const f32x4*)(pu + 4);
        EPI_ROWS_BEGIN
            f32x4 g0 = acc[ai][0][m][0] * W8_INV + bg0, g1 = acc[ai][0][m][1] * W8_INV + bg1, l0 = acc[ai][1][m][0] * W8_INV + bu0, l1 = acc[ai][1][m][1] * W8_INV + bu1, h0, h1;
#pragma unroll
            for (int j = 0; j < 4; ++j) {
                const float ga = fminf(g0[j], 7.f), gb = fminf(g1[j], 7.f), la = fminf(fmaxf(l0[j], -7.f), 7.f), lb = fminf(fmaxf(l1[j], -7.f), 7.f);
                h0[j] = ga * sigmoidf_fast(1.702f * ga) * (la + 1.f); h1[j] = gb * sigmoidf_fast(1.702f * gb) * (lb + 1.f); }
            *(unsigned long long*)(HDN + (size_t)(row0 + rowl) * 1024 + hc) = (unsigned long long)pack4_fp8(h0) | ((unsigned long long)pack4_fp8(h1) << 32);
        EPI_END
    }
};
struct EpiYF8 {
    static constexpr bool PERM = true, AFTER_DRAIN = false;
    bf16_t* Y; const float* bd; const int* rowslot; const float* topw;
    __device__ __forceinline__ void operator()(const f32x4 (&acc)[2][2][4][2], const Unit& u, int wr, int wc, int fr, int fq) const {
        const int row0 = u.pm * BM, e = u.pn >> 2, col0 = (u.pn & 3) * BM;
        EPI_ROWS_BEGIN
            const int slot = rowslot[row0 + rowl];
            if (slot >= 0) { const float w = topw[slot];
                EPI_COLS_BEGIN
                    const int col = col0 + coll; const float* pb = bd + e * 1024 + col;
                    v0 = (v0 * W8_INV + *(const f32x4*)pb) * w; v1 = (v1 * W8_INV + *(const f32x4*)(pb + 4)) * w;
                    *(u32x4*)(Y + (size_t)slot * 1024 + col) = pack8(v0, v1);
                EPI_END }
        EPI_END
    }
};
struct EpiY {
    static constexpr bool PERM = true, AFTER_DRAIN = false;
    bf16_t* Y; const float* bd; const int* rowslot; const float* topw;
    __device__ __forceinline__ void operator()(const f32x4 (&acc)[2][2][4][2], const Unit& u, int wr, int wc, int fr, int fq) const {
        const int row0 = u.pm * BM, e = u.pn >> 2, col0 = (u.pn & 3) * BM;
        EPI_ROWS_BEGIN
            const int slot = rowslot[row0 + rowl];
            if (slot >= 0) { const float w = topw[slot];
                EPI_COLS_BEGIN
                    const int col = col0 + coll; const float* pb = bd + e * 1024 + col;
                    v0 = (v0 + *(const f32x4*)pb) * w; v1 = (v1 + *(const f32x4*)(pb + 4)) * w;
                    *(u32x4*)(Y + (size_t)slot * 1024 + col) = pack8(v0, v1);
                EPI_END }
        EPI_END
    }
};
template <class Epi, class Sched, bool ALIGN_EPI = false, bool SP2 = false, bool F8 = false>
__device__ __forceinline__ void gemm_phase(PG8_LAS unsigned char* lds, const Gemm g, const Sched& S, const Epi& E) {
    const int tid = threadIdx.x, wid = __builtin_amdgcn_readfirstlane(tid >> 6), lane = tid & 63, wr = wid >> 2, wc = wid & 3, fr = lane & 15, fq = lane >> 4;
    const int K = g.K, nt = K / BK;
    unsigned voffA[2], voffB[2];
#pragma unroll
    for (int i = 0; i < 2; ++i) { int R, C; stage_rc(tid * 16 + i * 8192, R, C); const int Rb = Epi::PERM ? ((R & ~31) + perm32(R & 31)) : R;
        voffA[i] = (unsigned)(R * K + C) * 2u; voffB[i] = (unsigned)(Rb * K + C) * 2u; }
    const size_t kstep = (size_t)(BK * 2);
    const size_t hstep = (size_t)HALF * K * 2;
    const size_t tstep = 2 * hstep;
    const unsigned ldsw = (unsigned)wid * 1024u;
    const int aoff = F8 ? lds_byte(wr * 64 + fr, fq * 16) : lds_byte(wr * 64 + fr, fq * 8), boff = F8 ? lds_byte(wc * 32 + fr, fq * 16) : lds_byte(wc * 32 + fr, fq * 8);
#define PG8_SA(b, h) (((b) * 2 + (h)) * HTB)
#define PG8_SB(b, h) ((4 + (b) * 2 + (h)) * HTB)
#define PG8_STAGE(bufoff, gbase, voff) do { _Pragma("unroll") for (int _i = 0; _i < 2; ++_i) \
        __builtin_amdgcn_global_load_lds((const unsigned*)((const char*)(gbase) + (voff)[_i]), (PG8_LAS unsigned*)(lds + (bufoff) + ldsw + _i * 8192), 16, 0, 0); } while (0)
#define PG8_LDA(dst, b, h) do { _Pragma("unroll") for (int m = 0; m < 4; ++m) { if constexpr (F8) { const v4i32 lo_ = *(const PG8_LAS v4i32*)(lds + PG8_SA(b, h) + aoff + m * 2048), hi_ = *(const PG8_LAS v4i32*)(lds + PG8_SA(b, h) + aoff + m * 2048 + 16); \
        dst.f[m] = __builtin_shufflevector(lo_, hi_, 0, 1, 2, 3, 4, 5, 6, 7); } else { _Pragma("unroll") for (int k = 0; k < 2; ++k) dst.f[m][k] = *(const PG8_LAS bf16x8*)(lds + PG8_SA(b, h) + aoff + m * 2048 + k * 1024); } } } while (0)
#define PG8_LDB(dst, b, h) do { _Pragma("unroll") for (int n = 0; n < 2; ++n) { if constexpr (F8) { const v4i32 lo_ = *(const PG8_LAS v4i32*)(lds + PG8_SB(b, h) + boff + n * 2048), hi_ = *(const PG8_LAS v4i32*)(lds + PG8_SB(b, h) + boff + n * 2048 + 16); \
        dst.f[n] = __builtin_shufflevector(lo_, hi_, 0, 1, 2, 3, 4, 5, 6, 7); } else { _Pragma("unroll") for (int k = 0; k < 2; ++k) dst.f[n][k] = *(const PG8_LAS bf16x8*)(lds + PG8_SB(b, h) + boff + n * 2048 + k * 1024); } } } while (0)
#define PG8_MMA(ai, bj, At, Bt) do { __builtin_amdgcn_s_setprio(1); \
        if constexpr (F8) { _Pragma("unroll") for (int m = 0; m < 4; ++m) _Pragma("unroll") for (int n = 0; n < 2; ++n) \
            mfma_f8_inplace(acc[ai][bj][m][n], Bt.f[n], At.f[m], f8scale); } \
        else { _Pragma("unroll") for (int m = 0; m < 4; ++m) _Pragma("unroll") for (int n = 0; n < 2; ++n) _Pragma("unroll") for (int k = 0; k < 2; ++k) \
            acc[ai][bj][m][n] = __builtin_amdgcn_mfma_f32_16x16x32_bf16(Bt.f[n][k], At.f[m][k], acc[ai][bj][m][n], 0, 0, 0); } \
        __builtin_amdgcn_s_setprio(0); } while (0)
#define PG8_WAIT_V(n) asm volatile("s_waitcnt vmcnt(" #n ")" ::: "memory")
#define PG8_WAIT_L(n) asm volatile("s_waitcnt lgkmcnt(" #n ")" ::: "memory")
#define PG8_BAR __builtin_amdgcn_s_barrier()
#define PG8_SCHED __builtin_amdgcn_sched_barrier(0)
    int f8scale = 0x7F7F7F7F; asm volatile("" : "+v"(f8scale));
    Unit cur, nxt; int ui = 0;
    if (!S.next(0, cur)) return;
    f32x4 acc[2][2][4][2];
#pragma unroll
    for (int a = 0; a < 2; ++a)
#pragma unroll
        for (int b = 0; b < 2; ++b)
#pragma unroll
            for (int m = 0; m < 4; ++m)
#pragma unroll
                for (int n = 0; n < 2; ++n) acc[a][b][m][n] = (f32x4){0.f, 0.f, 0.f, 0.f};
    typename FragSel<F8>::A At; typename FragSel<F8>::B B0, B1;
    const char* cA = (const char*)g.A + (size_t)cur.pm * tstep; const char* cB = (const char*)g.Bt + (size_t)cur.pn * tstep;
    S.a_ready(cur);
    if constexpr (SP2) {
        PG8_STAGE(PG8_SB(0, 0), cB, voffB); PG8_STAGE(PG8_SB(0, 1), cB + hstep, voffB); PG8_STAGE(PG8_SA(0, 0), cA, voffA); PG8_STAGE(PG8_SA(0, 1), cA + hstep, voffA);
        if (wr == 1) PG8_BAR;
        PG8_WAIT_V(2); PG8_BAR;
        PG8_STAGE(PG8_SB(1, 0), cB + kstep, voffB); PG8_STAGE(PG8_SA(1, 0), cA + kstep, voffA); PG8_STAGE(PG8_SB(1, 1), cB + hstep + kstep, voffB);
        PG8_WAIT_V(6); PG8_BAR;
    } else {
        PG8_STAGE(PG8_SB(0, 0), cB, voffB); PG8_STAGE(PG8_SA(0, 0), cA, voffA); PG8_STAGE(PG8_SB(0, 1), cB + hstep, voffB); PG8_STAGE(PG8_SA(0, 1), cA + hstep, voffA);
        if (wr == 1) PG8_BAR;
        PG8_WAIT_V(4); PG8_BAR;
        PG8_STAGE(PG8_SB(1, 0), cB + kstep, voffB); PG8_STAGE(PG8_SA(1, 0), cA + kstep, voffA); PG8_STAGE(PG8_SB(1, 1), cB + hstep + kstep, voffB);
        PG8_WAIT_V(6); PG8_BAR;
    }
    for (;;) {
        const bool has_next = S.next(ui + 1, nxt);
        const char* nA = has_next ? (const char*)g.A + (size_t)nxt.pm * tstep : cA; const char* nB = has_next ? (const char*)g.Bt + (size_t)nxt.pn * tstep : cB;
#pragma unroll 1
        for (int t = 0; t < nt; t += 2) {
            const bool last = (t == nt - 2);
            const char* a1 = cA + (size_t)(t + 1) * kstep;
            const char* a2 = last ? nA : cA + (size_t)(t + 2) * kstep; const char* b2 = last ? nB : cB + (size_t)(t + 2) * kstep;
            const char* a3 = a2 + kstep; const char* b3 = b2 + kstep;
            if (last && has_next) S.a_ready(nxt);
            if constexpr (SP2) {
            PG8_LDB(B0, 0, 0); PG8_LDB(B1, 0, 1); PG8_SCHED; PG8_LDA(At, 0, 0); PG8_STAGE(PG8_SA(1, 1), a1 + hstep, voffA);
            PG8_WAIT_V(8); PG8_WAIT_L(0); PG8_BAR; PG8_MMA(0, 0, At, B0); PG8_MMA(0, 1, At, B1); PG8_BAR; PG8_SCHED;
            PG8_LDA(At, 0, 1); PG8_STAGE(PG8_SB(0, 0), b2, voffB); PG8_STAGE(PG8_SB(0, 1), b2 + hstep, voffB); PG8_STAGE(PG8_SA(0, 0), a2, voffA);
            PG8_WAIT_V(8); PG8_WAIT_L(0); PG8_BAR; PG8_MMA(1, 0, At, B0); PG8_MMA(1, 1, At, B1); PG8_BAR; PG8_SCHED;
            PG8_LDB(B0, 1, 0); PG8_LDB(B1, 1, 1); PG8_SCHED; PG8_LDA(At, 1, 0); PG8_STAGE(PG8_SA(0, 1), a2 + hstep, voffA);
            PG8_WAIT_V(8); PG8_WAIT_L(0); PG8_BAR; PG8_MMA(0, 0, At, B0); PG8_MMA(0, 1, At, B1); PG8_BAR; PG8_SCHED;
            PG8_LDA(At, 1, 1); PG8_STAGE(PG8_SB(1, 0), b3, voffB); PG8_STAGE(PG8_SB(1, 1), b3 + hstep, voffB); PG8_STAGE(PG8_SA(1, 0), a3, voffA);
            PG8_WAIT_V(8); PG8_WAIT_L(0); PG8_BAR; PG8_MMA(1, 0, At, B0); PG8_MMA(1, 1, At, B1); PG8_BAR; PG8_SCHED;
            } else {
            PG8_LDB(B0, 0, 0); PG8_SCHED; PG8_LDA(At, 0, 0); PG8_STAGE(PG8_SA(1, 1), a1 + hstep, voffA);
            PG8_WAIT_L(8); PG8_BAR; PG8_WAIT_L(0); PG8_MMA(0, 0, At, B0); PG8_BAR; PG8_SCHED;
            PG8_LDB(B1, 0, 1); PG8_STAGE(PG8_SB(0, 0), b2, voffB);
            PG8_BAR; PG8_WAIT_L(0); PG8_MMA(0, 1, At, B1); PG8_BAR;
            PG8_LDA(At, 0, 1); PG8_STAGE(PG8_SA(0, 0), a2, voffA);
            PG8_BAR; PG8_WAIT_L(0); PG8_MMA(1, 0, At, B0); PG8_BAR; PG8_SCHED;
            PG8_STAGE(PG8_SB(0, 1), b2 + hstep, voffB);
            PG8_WAIT_V(6); PG8_BAR; PG8_MMA(1, 1, At, B1); PG8_BAR;
            PG8_LDB(B0, 1, 0); PG8_SCHED; PG8_LDA(At, 1, 0); PG8_STAGE(PG8_SA(0, 1), a2 + hstep, voffA);
            PG8_WAIT_L(8); PG8_BAR; PG8_WAIT_L(0); PG8_MMA(0, 0, At, B0); PG8_BAR; PG8_SCHED;
            PG8_LDB(B1, 1, 1); PG8_STAGE(PG8_SB(1, 0), b3, voffB);
            PG8_BAR; PG8_WAIT_L(0); PG8_MMA(0, 1, At, B1); PG8_BAR;
            PG8_LDA(At, 1, 1); PG8_STAGE(PG8_SA(1, 0), a3, voffA);
            PG8_BAR; PG8_WAIT_L(0); PG8_MMA(1, 0, At, B0); PG8_BAR; PG8_SCHED;
            PG8_STAGE(PG8_SB(1, 1), b3 + hstep, voffB);
            PG8_WAIT_V(6); PG8_BAR; PG8_MMA(1, 1, At, B1); PG8_BAR;
            }
        }
        if constexpr (F8) asm volatile("s_nop 15\n\ts_nop 7" ::: "memory");
        if constexpr (ALIGN_EPI) { if (wr == 0) PG8_BAR; }
        if constexpr (!Epi::AFTER_DRAIN) { E(acc, cur, wr, wc, fr, fq); S.done(cur); }
        if (!has_next) break;
#pragma unroll
        for (int a = 0; a < 2; ++a)
#pragma unroll
            for (int b = 0; b < 2; ++b)
#pragma unroll
                for (int m = 0; m < 4; ++m)
#pragma unroll
                    for (int n = 0; n < 2; ++n) acc[a][b][m][n] = (f32x4){0.f, 0.f, 0.f, 0.f};
        cur = nxt; cA = nA; cB = nB; ++ui;
        if constexpr (ALIGN_EPI) { if (wr == 1) PG8_BAR; }
    }
    PG8_WAIT_V(0);
    if constexpr (!ALIGN_EPI) { if (wr == 0) PG8_BAR; }
    PG8_BAR;
    if constexpr (Epi::AFTER_DRAIN) { E.fused(acc, cur, wr, wc, fr, fq, lds, wid, lane); S.done(cur); }
#undef PG8_SA
#undef PG8_SB
#undef PG8_STAGE
#undef PG8_LDA
#undef PG8_LDB
#undef PG8_MMA
#undef PG8_WAIT_V
#undef PG8_WAIT_L
#undef PG8_BAR
#undef PG8_SCHED
}
}
namespace pg8 {
template <class Epi, class Sched, bool F8 = false>
__device__ __forceinline__ void gemm_phase_gather(PG8_LAS unsigned char* lds, const Gemm g, const Sched& S, const Epi& E, const PG8_LAS int* rowbuf) {
    const int tid = threadIdx.x, wid = __builtin_amdgcn_readfirstlane(tid >> 6), lane = tid & 63, wr = wid >> 2, wc = wid & 3, fr = lane & 15, fq = lane >> 4;
    const int K = g.K, nt = K / BK;
    unsigned colA[2], voffB[2]; int rowA[2];
#pragma unroll
    for (int i = 0; i < 2; ++i) { int R, C; stage_rc(tid * 16 + i * 8192, R, C); const int Rb = Epi::PERM ? ((R & ~31) + perm32(R & 31)) : R;
        rowA[i] = R; colA[i] = (unsigned)C * 2u; voffB[i] = (unsigned)(Rb * K + C) * 2u; }
    const size_t kstep = (size_t)(BK * 2), hstep = (size_t)HALF * K * 2, tstep = 2 * hstep;
    const unsigned rowbytes = (unsigned)K * 2u;
    const unsigned ldsw = (unsigned)wid * 1024u;
    const int aoff = F8 ? lds_byte(wr * 64 + fr, fq * 16) : lds_byte(wr * 64 + fr, fq * 8), boff = F8 ? lds_byte(wc * 32 + fr, fq * 16) : lds_byte(wc * 32 + fr, fq * 8);
#define PG8_SA(b, h) (((b) * 2 + (h)) * HTB)
#define PG8_SB(b, h) ((4 + (b) * 2 + (h)) * HTB)
#define PG8_STAGE(bufoff, gbase, voff) do { _Pragma("unroll") for (int _i = 0; _i < 2; ++_i) \
        __builtin_amdgcn_global_load_lds((const unsigned*)((const char*)(gbase) + (voff)[_i]), (PG8_LAS unsigned*)(lds + (bufoff) + ldsw + _i * 8192), 16, 0, 0); } while (0)
#define PG8_LDA(dst, b, h) do { _Pragma("unroll") for (int m = 0; m < 4; ++m) { if constexpr (F8) { const v4i32 lo_ = *(const PG8_LAS v4i32*)(lds + PG8_SA(b, h) + aoff + m * 2048), hi_ = *(const PG8_LAS v4i32*)(lds + PG8_SA(b, h) + aoff + m * 2048 + 16); \
        dst.f[m] = __builtin_shufflevector(lo_, hi_, 0, 1, 2, 3, 4, 5, 6, 7); } else { _Pragma("unroll") for (int k = 0; k < 2; ++k) dst.f[m][k] = *(const PG8_LAS bf16x8*)(lds + PG8_SA(b, h) + aoff + m * 2048 + k * 1024); } } } while (0)
#define PG8_LDB(dst, b, h) do { _Pragma("unroll") for (int n = 0; n < 2; ++n) { if constexpr (F8) { const v4i32 lo_ = *(const PG8_LAS v4i32*)(lds + PG8_SB(b, h) + boff + n * 2048), hi_ = *(const PG8_LAS v4i32*)(lds + PG8_SB(b, h) + boff + n * 2048 + 16); \
        dst.f[n] = __builtin_shufflevector(lo_, hi_, 0, 1, 2, 3, 4, 5, 6, 7); } else { _Pragma("unroll") for (int k = 0; k < 2; ++k) dst.f[n][k] = *(const PG8_LAS bf16x8*)(lds + PG8_SB(b, h) + boff + n * 2048 + k * 1024); } } } while (0)
#define PG8_MMA(ai, bj, At, Bt) do { __builtin_amdgcn_s_setprio(1); \
        if constexpr (F8) { _Pragma("unroll") for (int m = 0; m < 4; ++m) _Pragma("unroll") for (int n = 0; n < 2; ++n) \
            mfma_f8_inplace(acc[ai][bj][m][n], Bt.f[n], At.f[m], f8scale); } \
        else { _Pragma("unroll") for (int m = 0; m < 4; ++m) _Pragma("unroll") for (int n = 0; n < 2; ++n) _Pragma("unroll") for (int k = 0; k < 2; ++k) \
            acc[ai][bj][m][n] = __builtin_amdgcn_mfma_f32_16x16x32_bf16(Bt.f[n][k], At.f[m][k], acc[ai][bj][m][n], 0, 0, 0); } \
        __builtin_amdgcn_s_setprio(0); } while (0)
#define PG8_WAIT_V(n) asm volatile("s_waitcnt vmcnt(" #n ")" ::: "memory")
#define PG8_WAIT_L(n) asm volatile("s_waitcnt lgkmcnt(" #n ")" ::: "memory")
#define PG8_BAR __builtin_amdgcn_s_barrier()
#define PG8_SCHED __builtin_amdgcn_sched_barrier(0)
#define PG8_ROWS(dst, u_) do { _Pragma("unroll") for (int h_ = 0; h_ < 2; ++h_) _Pragma("unroll") for (int i_ = 0; i_ < 2; ++i_) dst[h_][i_] = (unsigned)rowbuf[256 * (u_) + 128 * h_ + rowA[i_]] * rowbytes + colA[i_]; } while (0)
    int f8scale = 0x7F7F7F7F; asm volatile("" : "+v"(f8scale));
    Unit cur, nxt; int ui = 0;
    if (!S.next(0, cur)) return;
    f32x4 acc[2][2][4][2];
#pragma unroll
    for (int a = 0; a < 2; ++a)
#pragma unroll
        for (int b = 0; b < 2; ++b)
#pragma unroll
            for (int m = 0; m < 4; ++m)
#pragma unroll
                for (int n = 0; n < 2; ++n) acc[a][b][m][n] = (f32x4){0.f, 0.f, 0.f, 0.f};
    typename FragSel<F8>::A At; typename FragSel<F8>::B B0, B1;
    const char* Ab = (const char*)g.A; const char* cB = (const char*)g.Bt + (size_t)cur.pn * tstep;
    unsigned ca[2][2], na[2][2];
    PG8_ROWS(ca, 0);
    PG8_STAGE(PG8_SB(0, 0), cB, voffB); PG8_STAGE(PG8_SB(0, 1), cB + hstep, voffB); PG8_STAGE(PG8_SA(0, 0), Ab, ca[0]); PG8_STAGE(PG8_SA(0, 1), Ab, ca[1]);
    if (wr == 1) PG8_BAR;
    PG8_WAIT_V(2); PG8_BAR;
    PG8_STAGE(PG8_SB(1, 0), cB + kstep, voffB); PG8_STAGE(PG8_SA(1, 0), Ab + kstep, ca[0]); PG8_STAGE(PG8_SB(1, 1), cB + hstep + kstep, voffB);
    PG8_WAIT_V(6); PG8_BAR;
    for (;;) {
        const bool has_next = S.next(ui + 1, nxt);
        const char* nB = has_next ? (const char*)g.Bt + (size_t)nxt.pn * tstep : cB;
        if (has_next) { PG8_ROWS(na, ui + 1); } else {
#pragma unroll
            for (int h_ = 0; h_ < 2; ++h_)
#pragma unroll
                for (int i_ = 0; i_ < 2; ++i_) na[h_][i_] = ca[h_][i_]; }
#pragma unroll 1
        for (int t = 0; t < nt; t += 2) {
            const bool last = (t == nt - 2);
            const char* a1 = Ab + (size_t)(t + 1) * kstep;
            const char* a2 = last ? Ab : Ab + (size_t)(t + 2) * kstep; const char* b2 = last ? nB : cB + (size_t)(t + 2) * kstep;
            const char* a3 = a2 + kstep; const char* b3 = b2 + kstep;
            unsigned o2[2][2];
#pragma unroll
            for (int h_ = 0; h_ < 2; ++h_)
#pragma unroll
                for (int i_ = 0; i_ < 2; ++i_) o2[h_][i_] = last ? na[h_][i_] : ca[h_][i_];
            PG8_LDB(B0, 0, 0); PG8_LDB(B1, 0, 1); PG8_SCHED; PG8_LDA(At, 0, 0); PG8_STAGE(PG8_SA(1, 1), a1, ca[1]);
            PG8_WAIT_V(8); PG8_WAIT_L(0); PG8_BAR; PG8_MMA(0, 0, At, B0); PG8_MMA(0, 1, At, B1); PG8_BAR; PG8_SCHED;
            PG8_LDA(At, 0, 1); PG8_STAGE(PG8_SB(0, 0), b2, voffB); PG8_STAGE(PG8_SB(0, 1), b2 + hstep, voffB); PG8_STAGE(PG8_SA(0, 0), a2, o2[0]);
            PG8_WAIT_V(8); PG8_WAIT_L(0); PG8_BAR; PG8_MMA(1, 0, At, B0); PG8_MMA(1, 1, At, B1); PG8_BAR; PG8_SCHED;
            PG8_LDB(B0, 1, 0); PG8_LDB(B1, 1, 1); PG8_SCHED; PG8_LDA(At, 1, 0); PG8_STAGE(PG8_SA(0, 1), a2, o2[1]);
            PG8_WAIT_V(8); PG8_WAIT_L(0); PG8_BAR; PG8_MMA(0, 0, At, B0); PG8_MMA(0, 1, At, B1); PG8_BAR; PG8_SCHED;
            PG8_LDA(At, 1, 1); PG8_STAGE(PG8_SB(1, 0), b3, voffB); PG8_STAGE(PG8_SB(1, 1), b3 + hstep, voffB); PG8_STAGE(PG8_SA(1, 0), a3, o2[0]);
            PG8_WAIT_V(8); PG8_WAIT_L(0); PG8_BAR; PG8_MMA(1, 0, At, B0); PG8_MMA(1, 1, At, B1); PG8_BAR; PG8_SCHED;
        }
        if constexpr (F8) asm volatile("s_nop 15\n\ts_nop 7" ::: "memory");
        if (wr == 0) PG8_BAR;
        E(acc, cur, wr, wc, fr, fq); S.done(cur);
        if (!has_next) break;
#pragma unroll
        for (int a = 0; a < 2; ++a)
#pragma unroll
            for (int b = 0; b < 2; ++b)
#pragma unroll
                for (int m = 0; m < 4; ++m)
#pragma unroll
                    for (int n = 0; n < 2; ++n) acc[a][b][m][n] = (f32x4){0.f, 0.f, 0.f, 0.f};
        cur = nxt; cB = nB; ++ui;
#pragma unroll
        for (int h_ = 0; h_ < 2; ++h_)
#pragma unroll
            for (int i_ = 0; i_ < 2; ++i_) ca[h_][i_] = na[h_][i_];
        if (wr == 1) PG8_BAR;
    }
    PG8_WAIT_V(0);
    PG8_BAR;
#undef PG8_ROWS
#undef PG8_SA
#undef PG8_SB
#undef PG8_STAGE
#undef PG8_LDA
#undef PG8_LDB
#undef PG8_MMA
#undef PG8_WAIT_V
#undef PG8_WAIT_L
#undef PG8_BAR
#undef PG8_SCHED
}
}
#define GAS __attribute__((address_space(1)))
#define LAS __attribute__((address_space(3)))
typedef unsigned short bf16;
typedef unsigned v4u __attribute__((ext_vector_type(4)));
typedef float f32x4 __attribute__((ext_vector_type(4)));
typedef short bf16x8 __attribute__((ext_vector_type(8)));
typedef GAS unsigned gu32;
typedef GAS unsigned long long gu64;
#define RLX_AGENT __ATOMIC_RELAXED, __HIP_MEMORY_SCOPE_AGENT
#define LDS_WAIT() asm volatile("s_waitcnt lgkmcnt(0)" ::: "memory")
#define VM_WAIT() asm volatile("s_waitcnt vmcnt(0)" ::: "memory")
__device__ __forceinline__ unsigned long long rt() { return __builtin_amdgcn_s_memrealtime(); }
__device__ __forceinline__ unsigned f2bf(float f) { unsigned u = __builtin_bit_cast(unsigned, f); return (u + 0x7fffu + ((u >> 16) & 1u)) >> 16; }
__device__ __forceinline__ unsigned pk2(float lo, float hi) { return f2bf(lo) | (f2bf(hi) << 16); }

#define XB_TMO      128
#define XB_XCNT(j)  (256  + 64 * (j))
#define XB_XSUB(j)  (1280 + 64 * (j))
#define XB_XGEN(j)  (2304 + 64 * (j))
#define XB_TOP      3328
#define XB_TOPGEN   3392
#define XCD_BAR_WORDS 3456
#define XB_SPIN_CAP (1u << 18)

__device__ __forceinline__ unsigned xb_ld(unsigned* p)              { return __hip_atomic_load(p, __ATOMIC_RELAXED, __HIP_MEMORY_SCOPE_AGENT); }
__device__ __forceinline__ unsigned xb_add(unsigned* p, unsigned v) { return __hip_atomic_fetch_add(p, v, __ATOMIC_RELAXED, __HIP_MEMORY_SCOPE_AGENT); }
__device__ __forceinline__ unsigned xb_xcc_id() { return (unsigned)__builtin_amdgcn_s_getreg((3 << 11) | 20) & 0xFu; }
#define XB_SPIN(cond, bar) do { unsigned _sp = 0; while (cond) { __builtin_amdgcn_s_sleep(1); \
    if ((++_sp & 255u) == 0u) { if (xb_ld(&(bar)[XB_TMO])) break; if (_sp > XB_SPIN_CAP) { atomicAdd(&(bar)[XB_TMO], 1u); break; } } } } while (0)

struct XcdBarrier {
    unsigned* bar; unsigned x;
    volatile LAS unsigned* st;
};

__device__ __forceinline__ XcdBarrier xcd_barrier_post(unsigned* bar, volatile LAS unsigned* st) {
    XcdBarrier b; b.bar = bar; b.x = xb_xcc_id(); b.st = st;
    if (threadIdx.x == 0) (void)xb_add(&bar[XB_XCNT(b.x)], 1u);
    return b;
}
__device__ __forceinline__ void xcd_barrier_complete(unsigned* bar, unsigned x, unsigned& nloc, unsigned& nx) {
    const unsigned G = gridDim.x * gridDim.y * gridDim.z;
    unsigned sum, cnt, mine, sp = 0u;
    for (;;) {
        sum = 0u; cnt = 0u; mine = 0u;
#pragma unroll
        for (unsigned j = 0; j < 16; ++j) { const unsigned c = xb_ld(&bar[XB_XCNT(j)]); sum += c; cnt += (c > 0u) ? 1u : 0u; mine = (j == x) ? c : mine; }
        if (sum == G) break;
        __builtin_amdgcn_s_sleep(1);
        if ((++sp & 255u) == 0u) { if (xb_ld(&bar[XB_TMO])) break; if (sp > XB_SPIN_CAP) { atomicAdd(&bar[XB_TMO], 1u); break; } }
    }
    nloc = mine > 0u ? mine : 1u; nx = cnt > 0u ? cnt : 1u;
}

__device__ __forceinline__ void xcd_barrier(const XcdBarrier& b) {
    asm volatile("s_waitcnt vmcnt(0)" ::: "memory");
    __syncthreads();
    if (threadIdx.x == 0) {
        unsigned* bar = b.bar;
        __builtin_amdgcn_s_waitcnt(0);
        unsigned nloc = b.st[0], nx = b.st[1];
        if (nloc == 0u) { xcd_barrier_complete(bar, b.x, nloc, nx); b.st[0] = nloc; b.st[1] = nx; }
        const unsigned old = xb_add(&bar[XB_XSUB(b.x)], 1u);
        const unsigned gen = old / nloc;
        if (old + 1u == (gen + 1u) * nloc) {
            __builtin_amdgcn_fence(__ATOMIC_RELEASE, "agent");
            asm volatile("s_waitcnt vmcnt(0)" ::: "memory");
            const unsigned og = xb_add(&bar[XB_TOP], 1u);
            const unsigned tg = og / nx;
            if (og + 1u == (tg + 1u) * nx) xb_add(&bar[XB_TOPGEN], 1u);
            else XB_SPIN(xb_ld(&bar[XB_TOPGEN]) == tg, bar);
            __builtin_amdgcn_fence(__ATOMIC_ACQUIRE, "agent");
            xb_add(&bar[XB_XGEN(b.x)], 1u);
            asm volatile("s_waitcnt vmcnt(0)" ::: "memory");
        } else {
            XB_SPIN(xb_ld(&bar[XB_XGEN(b.x)]) == gen, bar);
            __builtin_amdgcn_fence(__ATOMIC_ACQUIRE, "agent");
            asm volatile("s_waitcnt vmcnt(0)" ::: "memory");
        }
    }
    __syncthreads();
}
constexpr int NWAVES = 8, NTHREADS = 512;
constexpr int T = 16384, D = 1024, SEQ = 4096, NBATCH = 4, NMEM = 256, NEXP = 32, TOPK = 4;
constexpr int NPROJ = 9728;
constexpr int XS_ROWS = T * TOPK + NEXP * 256;
constexpr float EPS = 1e-6f, LOG2E = 1.4426950408889634f, LN2 = 0.6931471805599453f;
#ifndef MK_N_LAUNCHES
#define MK_N_LAUNCHES 1
#endif
constexpr int N_PHASES = 14;
constexpr int N_LAUNCHES = MK_N_LAUNCHES;

constexpr size_t MiB = 1u << 20;
constexpr size_t WS_CTL = 0, CTL_ZERO_BYTES = 1 * MiB;
constexpr size_t CTL_SS2 = 256 * 1024, CTL_CNT = 384 * 1024, CTL_CONVQ = 448 * 1024, CTL_P1DONE = 448 * 1024 + 256, CTL_ROWTOK = 640 * 1024;
constexpr size_t WS_WCQ = 1 * MiB, WS_WCO = 2 * MiB, WS_WO = 3 * MiB, WS_KV = 5 * MiB;
constexpr size_t WS_TOPI = 7 * MiB, WS_TOPW = WS_TOPI + 256 * 1024, WS_RSTD3 = WS_TOPW + 256 * 1024, WS_ROWSLOT = WS_RSTD3 + 64 * 1024;
constexpr size_t WS_EXPGU = 8 * MiB, WS_EXPD = 72 * MiB;
constexpr size_t WS_PROJ = 104 * MiB, WS_U1 = 408 * MiB, WS_W1T = 440 * MiB, WS_OG = 408 * MiB, WS_LSE = 456 * MiB;
constexpr size_t WS_WBA = 459 * MiB, WS_WBC = 460 * MiB, WS_YA = 462 * MiB, WS_YC = 478 * MiB, WS_MIX = 408 * MiB;
constexpr size_t WS_MN = 232 * MiB, WS_WCKV = 234 * MiB;
constexpr size_t WS_H1 = 104 * MiB, WS_H1B = 168 * MiB, WS_Q2 = 200 * MiB, WS_O2 = 216 * MiB;
constexpr size_t WS_U3 = 236 * MiB, WS_HDN = 252 * MiB, WS_Y = 324 * MiB, WS_END = 512 * MiB;
constexpr size_t WS_HIST = WS_ROWSLOT + 288 * 1024;
static_assert(WS_ROWSLOT + (size_t)XS_ROWS * 4 <= WS_HIST && WS_HIST + 256 * 32 * 4 <= WS_EXPGU && CTL_ROWTOK + (size_t)XS_ROWS * 4 <= CTL_ZERO_BYTES, "misc region");
static_assert(WS_U3 + (size_t)T * D <= WS_HDN && WS_HDN + (size_t)XS_ROWS * D <= WS_Y && WS_Y + (size_t)T * 4 * D * 2 <= WS_END && WS_YC + (size_t)T * D * 2 <= WS_END && WS_PROJ + (size_t)T * NPROJ * 2 <= WS_U1 && WS_LSE + 3u * T * 8 * 4 <= WS_WBA, "workspace map");
constexpr int CW_TMO = 0, CW_CODE = 1, CW_BAR = 4096;

constexpr int LDS_BYTES = 163840;
constexpr int TBL_OFF = 163840 - 2048;
constexpr int ROWBUF_OFF = 131072, ROWBUF_UNITS = 24;
constexpr int MISC_OFF = 163840 - 256;

struct Frame {
    LAS unsigned char* lds;
    volatile LAS unsigned* MISC;
    gu32* ctl;
    unsigned char* ws;
    int tid, lane, wave, vcu, G;
};
__device__ __forceinline__ float wave_sum(float v) {
#pragma unroll
    for (int o = 1; o < 64; o <<= 1) v += __shfl_xor(v, o);
    return v;
}
typedef unsigned long long u64;
__device__ __forceinline__ float bf_lo(unsigned w) { return __builtin_bit_cast(float, w << 16); }
__device__ __forceinline__ float bf_hi(unsigned w) { return __builtin_bit_cast(float, w & 0xffff0000u); }

__device__ __forceinline__ void transpose_item(const float* W, int K, int N, bf16* WT, int drow, int k0, int n0, const float* gain, LAS float* scr, int lane) {
    f32x4 wv[8];
#pragma unroll
    for (int i = 0; i < 8; ++i) wv[i] = *(const GAS f32x4*)(W + (size_t)(k0 + 8 * i + (lane >> 3)) * N + n0 + 4 * (lane & 7));
#pragma unroll
    for (int i = 0; i < 8; ++i) { const int kk = 8 * i + (lane >> 3); f32x4 w = wv[i]; if (gain) w = w * gain[k0 + kk]; LAS float* d = scr + kk * 33 + 4 * (lane & 7); d[0] = w.x; d[1] = w.y; d[2] = w.z; d[3] = w.w; }
    LDS_WAIT(); asm volatile("" ::: "memory");
    const int c = lane & 7;
#pragma unroll
    for (int j = 0; j < 4; ++j) { const int n = (lane >> 3) + 8 * j; const LAS float* s = scr + (8 * c) * 33 + n;
        v4u o; o.x = pk2(s[0 * 33], s[1 * 33]); o.y = pk2(s[2 * 33], s[3 * 33]); o.z = pk2(s[4 * 33], s[5 * 33]); o.w = pk2(s[6 * 33], s[7 * 33]);
        *(GAS v4u*)(WT + (size_t)(drow + n) * K + k0 + 8 * c) = o; }
    LDS_WAIT(); asm volatile("" ::: "memory");
}
__device__ __forceinline__ void transpose_item_f8(const float* W, int K, int N, unsigned char* WT, int drow, int k0, int n0, float scale, LAS float* scr, int lane) {
    f32x4 wv[8];
#pragma unroll
    for (int i = 0; i < 8; ++i) wv[i] = *(const GAS f32x4*)(W + (size_t)(k0 + 8 * i + (lane >> 3)) * N + n0 + 4 * (lane & 7));
#pragma unroll
    for (int i = 0; i < 8; ++i) { const int kk = 8 * i + (lane >> 3); const f32x4 w = wv[i] * scale; LAS float* d = scr + kk * 33 + 4 * (lane & 7); d[0] = w.x; d[1] = w.y; d[2] = w.z; d[3] = w.w; }
    LDS_WAIT(); asm volatile("" ::: "memory");
    const int n = lane >> 1;
#pragma unroll
    for (int j = 0; j < 2; ++j) { const int c = (lane & 1) + 2 * j; const LAS float* s = scr + (16 * c) * 33 + n; v4u o;
        { int w = 0; w = __builtin_amdgcn_cvt_pk_fp8_f32(s[0 * 33], s[1 * 33], w, false); w = __builtin_amdgcn_cvt_pk_fp8_f32(s[2 * 33], s[3 * 33], w, true); o.x = (unsigned)w; }
        { int w = 0; w = __builtin_amdgcn_cvt_pk_fp8_f32(s[4 * 33], s[5 * 33], w, false); w = __builtin_amdgcn_cvt_pk_fp8_f32(s[6 * 33], s[7 * 33], w, true); o.y = (unsigned)w; }
        { int w = 0; w = __builtin_amdgcn_cvt_pk_fp8_f32(s[8 * 33], s[9 * 33], w, false); w = __builtin_amdgcn_cvt_pk_fp8_f32(s[10 * 33], s[11 * 33], w, true); o.z = (unsigned)w; }
        { int w = 0; w = __builtin_amdgcn_cvt_pk_fp8_f32(s[12 * 33], s[13 * 33], w, false); w = __builtin_amdgcn_cvt_pk_fp8_f32(s[14 * 33], s[15 * 33], w, true); o.w = (unsigned)w; }
        *(GAS v4u*)(WT + (size_t)(drow + n) * K + k0 + 16 * c) = o; }
    LDS_WAIT(); asm volatile("" ::: "memory");
}
__device__ __forceinline__ bool transpose_mat(int& r, const float* W, int K, int N, bf16* WT, int drow0, const float* gain, LAS float* scr, int lane) {
    const int nblk = N / 32, items = (K / 64) * nblk;
    if (r < items) { const int kb = r / nblk, nb = r % nblk; transpose_item(W, K, N, WT, drow0 + 32 * nb, 64 * kb, 32 * nb, gain, scr, lane); return true; }
    r -= items; return false;
}
__device__ __forceinline__ void rms_row_to_bf16(const float* xrow, const float* gain, bf16* orow, int lane) {
    const GAS f32x4* xr = (const GAS f32x4*)xrow + lane; const GAS f32x4* gr = (const GAS f32x4*)gain + lane;
    f32x4 v[4]; float s = 0.f;
#pragma unroll
    for (int j = 0; j < 4; ++j) { v[j] = xr[64 * j]; s += (v[j].x * v[j].x + v[j].y * v[j].y) + (v[j].z * v[j].z + v[j].w * v[j].w); }
    const float rstd = 1.f / sqrtf(wave_sum(s) * (1.f / D) + EPS);
    GAS u64* o8 = (GAS u64*)orow + lane;
#pragma unroll
    for (int j = 0; j < 4; ++j) { const f32x4 g = gr[64 * j]; o8[64 * j] = (u64)pk2(v[j].x * rstd * g.x, v[j].y * rstd * g.y) | ((u64)pk2(v[j].z * rstd * g.z, v[j].w * rstd * g.w) << 32); }
}

__device__ __forceinline__ int xcd_remap(int wgid, int nwg) { const int q = nwg / 8, r = nwg % 8, xcd = wgid % 8, off = wgid / 8; return (xcd < r ? xcd * (q + 1) : r * (q + 1) + (xcd - r) * q) + off; }
struct MoeOrder {
    const volatile LAS int* tpre; int npn, G, c;
    __device__ __forceinline__ bool next(int i, pg8::Unit& u) const {
        const int total = __builtin_amdgcn_readfirstlane(tpre[32]) * npn; const long L = (long)i * G + c; if (L >= total) return false;
        const int U = xcd_remap((int)L, total);
        int e = 0;
#pragma unroll 1
        for (int k = 1; k < 32; ++k) if (__builtin_amdgcn_readfirstlane(tpre[k]) * npn <= U) e = k;
        const int t0 = __builtin_amdgcn_readfirstlane(tpre[e]), nt = __builtin_amdgcn_readfirstlane(tpre[e + 1]) - t0, Ul = U - t0 * npn;
        u.pm = t0 + Ul % nt; u.pn = e * npn + Ul / nt; return true;
    }
    __device__ __forceinline__ void a_ready(const pg8::Unit&) const {}
    __device__ __forceinline__ void done(const pg8::Unit&) const {}
};
struct In {
    const float *x, *mem, *norm_mix, *w_in, *conv_w, *w_ba, *w_bc, *w_gate, *b_gate, *w_out, *norm_cross, *norm_mem, *w_cq, *w_ckv, *w_co, *norm_moe,
                *router_w, *router_b, *w_eg, *b_eg, *w_eu, *b_eu, *w_ed, *b_ed, *norm_final;
};

__device__ __forceinline__ void phase_prologue(Frame& F, const In& in) {
    LAS float* scr = (LAS float*)(F.lds + F.wave * 16384);
    const int gw = F.vcu * NWAVES + F.wave, NGW = F.G * NWAVES;
    unsigned char* ws = F.ws;
    constexpr int NITEMS = 16 * 240 + 16 * 64 + 8 * 32 + 16 * 32 + 16 * 32 + 16 * 16 + 8 * 32;
    for (int it = gw; it < NITEMS; it += NGW) {
        int r = it;
        if (transpose_mat(r, in.w_in, 1024, 7680, (bf16*)(ws + WS_W1T), 0, nullptr, scr, F.lane)) continue;
        if (transpose_mat(r, in.w_gate, 1024, 2048, (bf16*)(ws + WS_W1T), 7680, nullptr, scr, F.lane)) continue;
        if (transpose_mat(r, in.w_ba, 512, 1024, (bf16*)(ws + WS_WBA), 0, nullptr, scr, F.lane)) continue;
        if (transpose_mat(r, in.w_bc, 1024, 1024, (bf16*)(ws + WS_WBC), 0, nullptr, scr, F.lane)) continue;
        if (transpose_mat(r, in.w_out, 1024, 1024, (bf16*)(ws + WS_WO), 0, nullptr, scr, F.lane)) continue;
        if (transpose_mat(r, in.w_cq, 1024, 512, (bf16*)(ws + WS_WCQ), 0, in.norm_cross, scr, F.lane)) continue;
        transpose_mat(r, in.w_co, 512, 1024, (bf16*)(ws + WS_WCO), 0, nullptr, scr, F.lane);
    }
    for (int m = gw; m < T; m += NGW) rms_row_to_bf16(in.x + (size_t)m * D, in.norm_mix, (bf16*)(ws + WS_U1) + (size_t)m * D, F.lane);
}
__device__ __forceinline__ void phase_mem_prologue(Frame& F, const In& in) {
    LAS float* scr = (LAS float*)(F.lds + F.wave * 16384);
    const int gw = F.vcu * NWAVES + F.wave, NGW = F.G * NWAVES;
    for (int it = gw; it < 16 * 32; it += NGW) { int r = it; transpose_mat(r, in.w_ckv, 1024, 1024, (bf16*)(F.ws + WS_WCKV), 0, nullptr, scr, F.lane); }
    for (int m = gw; m < NBATCH * NMEM; m += NGW) rms_row_to_bf16(in.mem + (size_t)m * D, in.norm_mem, (bf16*)(F.ws + WS_MN) + (size_t)m * D, F.lane);
}

constexpr int CONV_PER = 16 * 32, CONV_ITEMS = NEXP * 3 * CONV_PER;
__device__ __forceinline__ void convert_from_queue(Frame& F, const In& in, bool drain, unsigned nworkers) {
    LAS float* scr = (LAS float*)(F.lds + F.wave * 16384);
    volatile LAS unsigned* qslot = F.MISC + 16;
    unsigned* convq = (unsigned*)(F.ws + WS_CTL + CTL_CONVQ); unsigned* p1done = (unsigned*)(F.ws + WS_CTL + CTL_P1DONE);
    for (;;) {
        if (F.tid == 0) { unsigned q = 0xffffffffu;
            if (drain || __hip_atomic_load(p1done, __ATOMIC_RELAXED, __HIP_MEMORY_SCOPE_AGENT) < nworkers) q = __hip_atomic_fetch_add(convq, 8u, __ATOMIC_RELAXED, __HIP_MEMORY_SCOPE_AGENT);
            *qslot = q; }
        __syncthreads();
        const unsigned q = *qslot;
        __syncthreads();
        if (q >= (unsigned)CONV_ITEMS) break;
        const int it = (int)q + F.wave;
        const int mtx = it / CONV_PER, r = it % CONV_PER, e = mtx / 3, which = mtx % 3, kb = r / 32, nb = r % 32, n0 = 32 * nb;
        if (which == 0)      transpose_item_f8(in.w_eg + (size_t)e * D * D, D, D, F.ws + WS_EXPGU + (size_t)e * 2048 * D, (n0 >> 7) * 256 + (n0 & 127), 64 * kb, n0, pg8::W8_SCALE, scr, F.lane);
        else if (which == 1) transpose_item_f8(in.w_eu + (size_t)e * D * D, D, D, F.ws + WS_EXPGU + (size_t)e * 2048 * D, (n0 >> 7) * 256 + 128 + (n0 & 127), 64 * kb, n0, pg8::W8_SCALE, scr, F.lane);
        else                 transpose_item_f8(in.w_ed + (size_t)e * D * D, D, D, F.ws + WS_EXPD + (size_t)e * D * D, n0, 64 * kb, n0, pg8::W8_SCALE, scr, F.lane);
    }
}

typedef short s16x4v __attribute__((ext_vector_type(4)));
typedef short bf16x8v __attribute__((ext_vector_type(8)));
__device__ __forceinline__ s16x4v lds_tr16(const LAS bf16* p) { return __builtin_bit_cast(s16x4v, __builtin_amdgcn_ds_read_tr16_b64_v4i16((LAS s16x4v*)p)); }
__device__ __forceinline__ void dil_attn_unit_mfma(Frame& F, int unit) {
    const int rn = unit & 31, bgh = unit >> 5, h = bgh & 7, bg = bgh >> 3, g = bg % 3, b = bg / 3;
    const int dil = g == 0 ? 1 : (g == 1 ? 4 : 16), nper = 32 / dil, r = rn / nper, n = rn % nper;
    const bf16* PROJ = (const bf16*)(F.ws + WS_PROJ);
    LAS bf16* Ks = (LAS bf16*)F.lds; LAS bf16* Vs = Ks + 256 * 72;
    const int tid = F.tid, lane = F.lane, w = F.wave, qi = lane & 15, G = lane >> 4;
#pragma unroll
    for (int it = 0; it < 4; ++it) {
        const int row = (tid >> 3) + 64 * it, ch = tid & 7, j = 128 * (n - 1) + row;
        v4u kv = (v4u){0u, 0u, 0u, 0u}, vv = kv;
        if (j >= 0) { const size_t grow = (size_t)b * SEQ + (size_t)j * dil + r; const bf16* p = PROJ + grow * NPROJ + g * 1536 + h * 64 + ch * 8; kv = *(const GAS v4u*)(p + 512); vv = *(const GAS v4u*)(p + 1024); }
        *(LAS v4u*)(Ks + row * 72 + ch * 8) = kv; *(LAS v4u*)(Vs + row * 72 + ch * 8) = vv;
    }
    if (tid < 128) *(LAS v4u*)(Vs + (256 + (tid >> 3)) * 72 + (tid & 7) * 8) = (v4u){0u, 0u, 0u, 0u};
    const int ql = 16 * w + qi;
    const size_t growq = (size_t)b * SEQ + (size_t)(128 * n + ql) * dil + r;
    const bf16* qp = PROJ + growq * NPROJ + g * 1536 + h * 64 + 8 * G;
    const bf16x8v q0 = *(const GAS bf16x8v*)qp, q1 = *(const GAS bf16x8v*)(qp + 32);
    __syncthreads();
    pg8::f32x4 st[9];
#pragma unroll
    for (int t = 0; t < 9; ++t) {
        const LAS bf16* kp = Ks + (16 * (w + t) + qi) * 72 + 8 * G;
        const bf16x8v k0 = *(const LAS bf16x8v*)kp, k1 = *(const LAS bf16x8v*)(kp + 32);
        pg8::f32x4 a = (pg8::f32x4){0.f, 0.f, 0.f, 0.f};
        a = __builtin_amdgcn_mfma_f32_16x16x32_bf16(k0, q0, a, 0, 0, 0);
        a = __builtin_amdgcn_mfma_f32_16x16x32_bf16(k1, q1, a, 0, 0, 0);
        st[t] = a;
    }
    const float slope2 = exp2f(-(float)(h + 1)) * (float)dil * LOG2E, sc = 0.125f * LOG2E;
    const int jq = 128 * (n - 1);
    float mx = -1e30f;
#pragma unroll
    for (int t = 0; t < 9; ++t)
#pragma unroll
        for (int i = 0; i < 4; ++i) {
            const int kl = 16 * (w + t) + 4 * G + i, dk = kl - ql;
            const bool ok = dk >= 0 && dk <= 128 && (jq + kl) >= 0;
            const float sv = ok ? st[t][i] * sc - slope2 * (float)(128 - dk) : -1e30f;
            st[t][i] = sv; mx = fmaxf(mx, sv);
        }
    mx = fmaxf(mx, __shfl_xor(mx, 16)); mx = fmaxf(mx, __shfl_xor(mx, 32));
    float l = 0.f;
#pragma unroll
    for (int t = 0; t < 9; ++t)
#pragma unroll
        for (int i = 0; i < 4; ++i) { const float pv = st[t][i] > -1e29f ? __builtin_amdgcn_exp2f(st[t][i] - mx) : 0.f; st[t][i] = pv; l += pv; }
    l += __shfl_xor(l, 16); l += __shfl_xor(l, 32);
    pg8::f32x4 o[4];
#pragma unroll
    for (int dm = 0; dm < 4; ++dm) o[dm] = (pg8::f32x4){0.f, 0.f, 0.f, 0.f};
#pragma unroll
    for (int s5 = 0; s5 < 5; ++s5) {
        const pg8::f32x4 pa = st[2 * s5], pb = (2 * s5 + 1 < 9) ? st[2 * s5 + 1] : (pg8::f32x4){0.f, 0.f, 0.f, 0.f};
        bf16x8v pf;
        { const unsigned w0 = pk2(pa[0], pa[1]), w1 = pk2(pa[2], pa[3]), w2 = pk2(pb[0], pb[1]), w3 = pk2(pb[2], pb[3]);
          pf = __builtin_bit_cast(bf16x8v, (v4u){w0, w1, w2, w3}); }
        const LAS bf16* vbase = Vs + (16 * (w + 2 * s5) + 4 * G + (qi >> 2)) * 72 + 4 * (qi & 3);
#pragma unroll
        for (int dm = 0; dm < 4; ++dm) {
            const s16x4v lo = lds_tr16(vbase + 16 * dm), hi = lds_tr16(vbase + 16 * 72 + 16 * dm);
            const bf16x8v vf = (bf16x8v){lo[0], lo[1], lo[2], lo[3], hi[0], hi[1], hi[2], hi[3]};
            o[dm] = __builtin_amdgcn_mfma_f32_16x16x32_bf16(vf, pf, o[dm], 0, 0, 0);
        }
    }
    const float inv = 1.f / l;
    bf16* og = (bf16*)(F.ws + WS_OG) + ((size_t)g * T + growq) * 512 + h * 64 + 4 * G;
#pragma unroll
    for (int dm = 0; dm < 4; ++dm) *(GAS u64*)(og + 16 * dm) = (u64)pk2(o[dm][0] * inv, o[dm][1] * inv) | ((u64)pk2(o[dm][2] * inv, o[dm][3] * inv) << 32);
    if (G == 0) ((float*)(F.ws + WS_LSE))[((size_t)g * T + growq) * 8 + h] = (mx + __builtin_amdgcn_logf(l)) * LN2;
    __syncthreads();
}

__device__ __forceinline__ void phase_combine_conv(Frame& F, const In& in) {
    const int gw = F.vcu * NWAVES + F.wave, NGW = F.G * NWAVES, lane = F.lane;
    const bf16* PROJ = (const bf16*)(F.ws + WS_PROJ); const bf16* OG = (const bf16*)(F.ws + WS_OG); const float* LSE = (const float*)(F.ws + WS_LSE);
    for (int t = gw; t < T; t += NGW) {
        { const int head = lane >> 3;
          const float l0 = LSE[((size_t)0 * T + t) * 8 + head], l1 = LSE[((size_t)1 * T + t) * 8 + head], l2 = LSE[((size_t)2 * T + t) * 8 + head];
          const float mx = fmaxf(l0, fmaxf(l1, l2)); float w0 = __expf(l0 - mx), w1 = __expf(l1 - mx), w2 = __expf(l2 - mx); const float inv = 1.f / (w0 + w1 + w2); w0 *= inv; w1 *= inv; w2 *= inv;
          const v4u a = *(const GAS v4u*)(OG + ((size_t)0 * T + t) * 512 + 8 * lane), b = *(const GAS v4u*)(OG + ((size_t)1 * T + t) * 512 + 8 * lane), c = *(const GAS v4u*)(OG + ((size_t)2 * T + t) * 512 + 8 * lane);
          v4u o;
          o.x = pk2(w0 * bf_lo(a.x) + w1 * bf_lo(b.x) + w2 * bf_lo(c.x), w0 * bf_hi(a.x) + w1 * bf_hi(b.x) + w2 * bf_hi(c.x));
          o.y = pk2(w0 * bf_lo(a.y) + w1 * bf_lo(b.y) + w2 * bf_lo(c.y), w0 * bf_hi(a.y) + w1 * bf_hi(b.y) + w2 * bf_hi(c.y));
          o.z = pk2(w0 * bf_lo(a.z) + w1 * bf_lo(b.z) + w2 * bf_lo(c.z), w0 * bf_hi(a.z) + w1 * bf_hi(b.z) + w2 * bf_hi(c.z));
          o.w = pk2(w0 * bf_lo(a.w) + w1 * bf_lo(b.w) + w2 * bf_lo(c.w), w0 * bf_hi(a.w) + w1 * bf_hi(b.w) + w2 * bf_hi(c.w));
          *(GAS v4u*)((bf16*)(F.ws + WS_YA) + (size_t)t * 512 + 8 * lane) = o; }
        const int pos = t & (SEQ - 1);
#pragma unroll
        for (int half = 0; half < 2; ++half) {
            const int c = 8 * lane + 512 * half;
            float z[3][8];
#pragma unroll
            for (int dd = 0; dd < 3; ++dd) {
                const int back = 2 - dd;
                if (pos - back >= 0) { const bf16* p = PROJ + (size_t)(t - back) * NPROJ + 4608 + c; const v4u gc = *(const GAS v4u*)(p + 1024), xc = *(const GAS v4u*)(p + 2048);
                    z[dd][0] = bf_lo(gc.x) * bf_lo(xc.x); z[dd][1] = bf_hi(gc.x) * bf_hi(xc.x); z[dd][2] = bf_lo(gc.y) * bf_lo(xc.y); z[dd][3] = bf_hi(gc.y) * bf_hi(xc.y);
                    z[dd][4] = bf_lo(gc.z) * bf_lo(xc.z); z[dd][5] = bf_hi(gc.z) * bf_hi(xc.z); z[dd][6] = bf_lo(gc.w) * bf_lo(xc.w); z[dd][7] = bf_hi(gc.w) * bf_hi(xc.w); }
                else {
#pragma unroll
                    for (int i = 0; i < 8; ++i) z[dd][i] = 0.f; }
            }
            const v4u gb = *(const GAS v4u*)(PROJ + (size_t)t * NPROJ + 4608 + c);
            float y[8];
#pragma unroll
            for (int i = 0; i < 8; ++i) y[i] = in.conv_w[c + i] * z[0][i] + in.conv_w[1024 + c + i] * z[1][i] + in.conv_w[2048 + c + i] * z[2][i];
            v4u o; o.x = pk2(bf_lo(gb.x) * y[0], bf_hi(gb.x) * y[1]); o.y = pk2(bf_lo(gb.y) * y[2], bf_hi(gb.y) * y[3]); o.z = pk2(bf_lo(gb.z) * y[4], bf_hi(gb.z) * y[5]); o.w = pk2(bf_lo(gb.w) * y[6], bf_hi(gb.w) * y[7]);
            *(GAS v4u*)((bf16*)(F.ws + WS_YC) + (size_t)t * 1024 + c) = o;
        }
    }
}


__device__ __forceinline__ void cross_attn_unit_mfma(Frame& F, int unit) {
    const int qc = unit & 31, bh = unit >> 5, h = bh & 3, b = bh >> 2, tid = F.tid, lane = F.lane, w = F.wave, qi = lane & 15, G = lane >> 4;
    const bf16* KV = (const bf16*)(F.ws + WS_KV); const bf16* Q2 = (const bf16*)(F.ws + WS_Q2);
    LAS bf16* Ks = (LAS bf16*)F.lds; LAS bf16* Vs = Ks + 256 * 136;
#pragma unroll
    for (int it = 0; it < 8; ++it) {
        const int row = (tid >> 4) + 32 * it, ch = tid & 15; const bf16* p = KV + (size_t)(b * NMEM + row) * 1024 + h * 128 + ch * 8;
        *(LAS v4u*)(Ks + row * 136 + ch * 8) = *(const GAS v4u*)p; *(LAS v4u*)(Vs + row * 136 + ch * 8) = *(const GAS v4u*)(p + 512);
    }
    const size_t grow = (size_t)b * SEQ + 128 * qc + 16 * w + qi;
    bf16x8v q[4];
#pragma unroll
    for (int ks = 0; ks < 4; ++ks) q[ks] = *(const GAS bf16x8v*)(Q2 + grow * 512 + h * 128 + 32 * ks + 8 * G);
    __syncthreads();
    pg8::f32x4 st[16];
#pragma unroll
    for (int t = 0; t < 16; ++t) {
        const LAS bf16* kp = Ks + (16 * t + qi) * 136 + 8 * G;
        pg8::f32x4 a = (pg8::f32x4){0.f, 0.f, 0.f, 0.f};
#pragma unroll
        for (int ks = 0; ks < 4; ++ks) a = __builtin_amdgcn_mfma_f32_16x16x32_bf16(*(const LAS bf16x8v*)(kp + 32 * ks), q[ks], a, 0, 0, 0);
        st[t] = a;
    }
    const float sc = 0.08838834764831845f * LOG2E;
    float mx = -1e30f;
#pragma unroll
    for (int t = 0; t < 16; ++t)
#pragma unroll
        for (int i = 0; i < 4; ++i) { st[t][i] *= sc; mx = fmaxf(mx, st[t][i]); }
    mx = fmaxf(mx, __shfl_xor(mx, 16)); mx = fmaxf(mx, __shfl_xor(mx, 32));
    float l = 0.f;
#pragma unroll
    for (int t = 0; t < 16; ++t)
#pragma unroll
        for (int i = 0; i < 4; ++i) { const float pv = __builtin_amdgcn_exp2f(st[t][i] - mx); st[t][i] = pv; l += pv; }
    l += __shfl_xor(l, 16); l += __shfl_xor(l, 32);
    pg8::f32x4 o[8];
#pragma unroll
    for (int dm = 0; dm < 8; ++dm) o[dm] = (pg8::f32x4){0.f, 0.f, 0.f, 0.f};
#pragma unroll
    for (int s8 = 0; s8 < 8; ++s8) {
        const pg8::f32x4 pa = st[2 * s8], pb = st[2 * s8 + 1];
        const bf16x8v pf = __builtin_bit_cast(bf16x8v, (v4u){pk2(pa[0], pa[1]), pk2(pa[2], pa[3]), pk2(pb[0], pb[1]), pk2(pb[2], pb[3])});
        const LAS bf16* vbase = Vs + (32 * s8 + 4 * G + (qi >> 2)) * 136 + 4 * (qi & 3);
#pragma unroll
        for (int dm = 0; dm < 8; ++dm) {
            const s16x4v lo = lds_tr16(vbase + 16 * dm), hi = lds_tr16(vbase + 16 * 136 + 16 * dm);
            const bf16x8v vf = (bf16x8v){lo[0], lo[1], lo[2], lo[3], hi[0], hi[1], hi[2], hi[3]};
            o[dm] = __builtin_amdgcn_mfma_f32_16x16x32_bf16(vf, pf, o[dm], 0, 0, 0);
        }
    }
    const float inv = 1.f / l;
    bf16* op = (bf16*)(F.ws + WS_O2) + grow * 512 + h * 128 + 4 * G;
#pragma unroll
    for (int dm = 0; dm < 8; ++dm) *(GAS u64*)(op + 16 * dm) = (u64)pk2(o[dm][0] * inv, o[dm][1] * inv) | ((u64)pk2(o[dm][2] * inv, o[dm][3] * inv) << 32);
    __syncthreads();
}

__device__ __forceinline__ void phase_router(Frame& F, const In& in, const float* H2) {
    LAS float* wl = (LAS float*)F.lds; LAS float* part = (LAS float*)(F.lds + 131072); LAS float* ssq = part + 2 * 64 * 32; LAS float* rsl = ssq + 128;
    volatile LAS int* hist = (volatile LAS int*)(F.lds + TBL_OFF + 1024);
    const int tid = F.tid, lane = F.lane, w = F.wave;
    for (int i = tid; i < 1024 * 8; i += NTHREADS) { const int k = i >> 3, c4 = i & 7; const f32x4 v = ((const GAS f32x4*)in.router_w)[i] * in.norm_moe[k];
        *(LAS f32x4*)(wl + k * 32 + ((4 * c4 + 16 * ((k >> 7) & 1)) & 31)) = v; }
    if (tid < 32) hist[tid] = 0;
    __syncthreads();
    int* topi = (int*)(F.ws + WS_TOPI); float* topw = (float*)(F.ws + WS_TOPW); unsigned char* U3 = F.ws + WS_U3;
    for (int ch = F.vcu; ch < T / 64; ch += F.G) {
    const int t0 = ch * 64;
    {
        const int tg = w & 3, kh = w >> 2, ti = lane & 15, kq = lane >> 4, kbase = kh * 512 + kq * 128;
        const GAS f32x4* xr = (const GAS f32x4*)(H2 + (size_t)(t0 + 16 * tg + ti) * D + kbase);
        const LAS float* wb = wl + kbase * 32 + ((ti + 16 * (kq & 1)) & 31);
        const LAS float* wb2 = wl + kbase * 32 + ((ti + 16 + 16 * (kq & 1)) & 31);
        f32x4 c0 = (f32x4){0.f, 0.f, 0.f, 0.f}, c1 = c0; float sq = 0.f;
#pragma unroll 2
        for (int c8 = 0; c8 < 4; ++c8) {
            f32x4 x[8];
#pragma unroll
            for (int q = 0; q < 8; ++q) x[q] = xr[8 * c8 + q];
#pragma unroll
            for (int q = 0; q < 8; ++q) {
                const int kk = 4 * (8 * c8 + q);
                c0 = __builtin_amdgcn_mfma_f32_16x16x4f32(x[q].x, wb[(kk + 0) * 32], c0, 0, 0, 0); c1 = __builtin_amdgcn_mfma_f32_16x16x4f32(x[q].x, wb2[(kk + 0) * 32], c1, 0, 0, 0);
                c0 = __builtin_amdgcn_mfma_f32_16x16x4f32(x[q].y, wb[(kk + 1) * 32], c0, 0, 0, 0); c1 = __builtin_amdgcn_mfma_f32_16x16x4f32(x[q].y, wb2[(kk + 1) * 32], c1, 0, 0, 0);
                c0 = __builtin_amdgcn_mfma_f32_16x16x4f32(x[q].z, wb[(kk + 2) * 32], c0, 0, 0, 0); c1 = __builtin_amdgcn_mfma_f32_16x16x4f32(x[q].z, wb2[(kk + 2) * 32], c1, 0, 0, 0);
                c0 = __builtin_amdgcn_mfma_f32_16x16x4f32(x[q].w, wb[(kk + 3) * 32], c0, 0, 0, 0); c1 = __builtin_amdgcn_mfma_f32_16x16x4f32(x[q].w, wb2[(kk + 3) * 32], c1, 0, 0, 0);
                sq += (x[q].x * x[q].x + x[q].y * x[q].y) + (x[q].z * x[q].z + x[q].w * x[q].w);
            }
        }
        sq += __shfl_xor(sq, 16); sq += __shfl_xor(sq, 32);
        if (kq == 0) ssq[kh * 64 + 16 * tg + ti] = sq;
#pragma unroll
        for (int r = 0; r < 4; ++r) { LAS float* pp = part + (kh * 64 + 16 * tg + 4 * kq + r) * 32 + ti; pp[0] = c0[r]; pp[16] = c1[r]; }
    }
    __syncthreads();
    if (tid < 64) {
        const int t = t0 + tid; const float rstd = 1.f / sqrtf((ssq[tid] + ssq[64 + tid]) * (1.f / D) + EPS); rsl[tid] = rstd;
        LAS float* lg = part + tid * 32;
        for (int e = 0; e < 32; ++e) lg[e] = (lg[e] + lg[64 * 32 + e]) * rstd + in.router_b[e];
        float tv[4]; int tix[4];
#pragma unroll
        for (int k = 0; k < 4; ++k) { float bv = -INFINITY; int bi = 0; for (int e = 0; e < 32; ++e) { const float v = lg[e]; if (v > bv) { bv = v; bi = e; } } tv[k] = bv; tix[k] = bi; lg[bi] = -INFINITY; }
        const float e1 = __expf(tv[1] - tv[0]), e2 = __expf(tv[2] - tv[0]), e3 = __expf(tv[3] - tv[0]), inv = 1.f / (1.f + e1 + e2 + e3);
        topi[t * 4 + 0] = tix[0]; topi[t * 4 + 1] = tix[1]; topi[t * 4 + 2] = tix[2]; topi[t * 4 + 3] = tix[3];
        topw[t * 4 + 0] = inv; topw[t * 4 + 1] = e1 * inv; topw[t * 4 + 2] = e2 * inv; topw[t * 4 + 3] = e3 * inv;
#pragma unroll
        for (int k = 0; k < 4; ++k) __hip_atomic_fetch_add((LAS int*)(F.lds + TBL_OFF + 1024) + tix[k], 1, __ATOMIC_RELAXED, __HIP_MEMORY_SCOPE_WORKGROUP);
    }
    __syncthreads();
    for (int tl = w; tl < 64; tl += NWAVES) {
        const int t = t0 + tl; const float rstd = rsl[tl];
        const GAS f32x4* xr = (const GAS f32x4*)(H2 + (size_t)t * D) + lane; const GAS f32x4* gr = (const GAS f32x4*)in.norm_moe + lane; GAS unsigned* u3r = (GAS unsigned*)(U3 + (size_t)t * D) + lane;
#pragma unroll
        for (int j = 0; j < 4; ++j) { const f32x4 v = xr[64 * j] * gr[64 * j] * rstd; u3r[64 * j] = pg8::pack4_fp8(v); }
    }
    __syncthreads();
    }
    if (tid < 32) ((int*)(F.ws + WS_HIST))[F.vcu * 32 + tid] = hist[tid];
    __syncthreads();
}

__device__ __forceinline__ void phase_assign(Frame& F) {
    volatile LAS int* tb = (volatile LAS int*)(F.lds + TBL_OFF);
    LAS int* part = (LAS int*)F.lds;
    const int* HIST = (const int*)(F.ws + WS_HIST); const int tid = F.tid, e = tid & 31, pt = tid >> 5;
    { int tot = 0, bef = 0; for (int b = pt; b < F.G; b += 16) { const int h = HIST[b * 32 + e]; tot += h; bef += (b < F.vcu) ? h : 0; } part[pt * 64 + e] = tot; part[pt * 64 + 32 + e] = bef; }
    __syncthreads();
    if (tid < 32) { int tot = 0, bef = 0; for (int q = 0; q < 16; ++q) { tot += part[q * 64 + tid]; bef += part[q * 64 + 32 + tid]; } tb[64 + tid] = tot; tb[128 + tid] = bef; tb[160 + tid] = 0; }
    __syncthreads();
    if (tid == 0) { int acc = 0; for (int k = 0; k < NEXP; ++k) { tb[k] = acc; acc += (tb[64 + k] + 255) >> 8; } tb[32] = acc; }
    __syncthreads();
    if (tid < 32) { tb[128 + tid] += tb[tid] * 256; if (F.vcu == 0) ((unsigned*)(F.ws + WS_CTL + CTL_CNT))[tid] = (unsigned)tb[64 + tid]; }
    __syncthreads();
    int* rowtok = (int*)(F.ws + WS_CTL + CTL_ROWTOK); int* rowslot = (int*)(F.ws + WS_ROWSLOT); const int* topi = (const int*)(F.ws + WS_TOPI);
    if (F.vcu < NEXP) { const int x = F.vcu; for (int R = tb[x] * 256 + tb[64 + x] + tid; R < tb[x + 1] * 256; R += NTHREADS) rowslot[R] = -1; }
    for (int ch = F.vcu; ch < T / 64; ch += F.G)
    for (int a = ch * 256 + tid; a < ch * 256 + 256; a += NTHREADS) {
        const int x = topi[a];
        const int rank = __hip_atomic_fetch_add((LAS int*)(F.lds + TBL_OFF) + 160 + x, 1, __ATOMIC_RELAXED, __HIP_MEMORY_SCOPE_WORKGROUP);
        const int R = tb[128 + x] + rank; rowtok[R] = a >> 2; rowslot[R] = a;
    }
    __syncthreads();
}

__device__ __forceinline__ void build_tpre(Frame& F) {
    volatile LAS int* tpre = (volatile LAS int*)(F.lds + TBL_OFF);
    const unsigned* cnt = (const unsigned*)(F.ws + WS_CTL + CTL_CNT);
    if (F.tid == 0) { int acc = 0;
        for (int e = 0; e < NEXP; ++e) { tpre[e] = acc; const unsigned c = __hip_atomic_load(cnt + e, __ATOMIC_RELAXED, __HIP_MEMORY_SCOPE_AGENT); tpre[64 + e] = (int)c; acc += (int)((c + 255u) >> 8); }
        tpre[32] = acc; }
    __syncthreads();
}

__device__ __forceinline__ void phase_final(Frame& F, const In& in, const float* H2, float* OUT) {
    const int gw = F.vcu * NWAVES + F.wave, NGW = F.G * NWAVES, lane = F.lane;
    const bf16* Y = (const bf16*)(F.ws + WS_Y);
    for (int t = gw; t < T; t += NGW) {
        const GAS f32x4* xr = (const GAS f32x4*)(H2 + (size_t)t * D) + lane; const GAS f32x4* gr = (const GAS f32x4*)in.norm_final + lane;
        f32x4 v[4]; float s = 0.f;
#pragma unroll
        for (int j = 0; j < 4; ++j) v[j] = xr[64 * j];
#pragma unroll
        for (int k = 0; k < 4; ++k) { const GAS u64* yr = (const GAS u64*)(Y + (size_t)(t * 4 + k) * D) + lane;
#pragma unroll
            for (int j = 0; j < 4; ++j) { const u64 w = yr[64 * j]; const unsigned lo = (unsigned)w, hi = (unsigned)(w >> 32); v[j].x += bf_lo(lo); v[j].y += bf_hi(lo); v[j].z += bf_lo(hi); v[j].w += bf_hi(hi); } }
#pragma unroll
        for (int j = 0; j < 4; ++j) s += (v[j].x * v[j].x + v[j].y * v[j].y) + (v[j].z * v[j].z + v[j].w * v[j].w);
        const float rstd = 1.f / sqrtf(wave_sum(s) * (1.f / D) + EPS);
        GAS f32x4* orow = (GAS f32x4*)(OUT + (size_t)t * D) + lane;
#pragma unroll
        for (int j = 0; j < 4; ++j) orow[64 * j] = v[j] * gr[64 * j] * rstd;
    }
}
struct Args { const float* in[25]; float* out; unsigned char* ws; int ph_lo, ph_hi; };
#ifndef N_CONV_WG
#define N_CONV_WG 32
#endif
#ifndef PG8_SP2
#define PG8_SP2 true
#endif
#ifndef PG8_ALIGN
#define PG8_ALIGN true
#endif
__global__ void __launch_bounds__(NTHREADS, 2) mega_fwd(Args args) {
    extern __shared__ __attribute__((aligned(16))) unsigned char lds[];
    Frame F;
    F.lds = (LAS unsigned char*)lds; F.MISC = (volatile LAS unsigned*)(F.lds + MISC_OFF);
    F.tid = threadIdx.x; F.lane = F.tid & 63; F.wave = __builtin_amdgcn_readfirstlane(F.tid >> 6);
    F.G = gridDim.x; { const int bx = blockIdx.x; F.vcu = (F.G % 8 == 0) ? (bx % 8) * (F.G / 8) + bx / 8 : bx; }
    F.ws = args.ws; F.ctl = (gu32*)(args.ws + WS_CTL);
    In in;
    in.x = args.in[0]; in.mem = args.in[1]; in.norm_mix = args.in[2]; in.w_in = args.in[3]; in.conv_w = args.in[4]; in.w_ba = args.in[5]; in.w_bc = args.in[6];
    in.w_gate = args.in[7]; in.b_gate = args.in[8]; in.w_out = args.in[9]; in.norm_cross = args.in[10]; in.norm_mem = args.in[11]; in.w_cq = args.in[12];
    in.w_ckv = args.in[13]; in.w_co = args.in[14]; in.norm_moe = args.in[15]; in.router_w = args.in[16]; in.router_b = args.in[17]; in.w_eg = args.in[18];
    in.b_eg = args.in[19]; in.w_eu = args.in[20]; in.b_eu = args.in[21]; in.w_ed = args.in[22]; in.b_ed = args.in[23]; in.norm_final = args.in[24];
    unsigned char* ws = args.ws;
    for (int u = F.tid; u < 64; u += NTHREADS) ((LAS unsigned*)(F.lds + MISC_OFF))[u] = 0u;
    __syncthreads();
    XcdBarrier bar; bar.bar = (unsigned*)(F.ctl + CW_BAR); bar.x = 0; bar.st = nullptr;
    if (N_LAUNCHES == 1) bar = xcd_barrier_post((unsigned*)(F.ctl + CW_BAR), F.MISC + 8);
    const int lo = args.ph_lo, hi = args.ph_hi;
#define IN(k) (lo <= (k) && (k) < hi)
#define SEAM(k) do { if (IN(k) && IN((k) + 1)) xcd_barrier(bar); } while (0)
    typedef pg8::bf16_t b16;

    if (IN(0)) { phase_prologue(F, in); } SEAM(0);

    if (IN(1)) {
        const int NW1 = (F.G == 256) ? 256 - N_CONV_WG : F.G;
        if ((int)blockIdx.x < NW1) {
            pg8::Gemm g{(const b16*)(ws + WS_U1), (const b16*)(ws + WS_W1T), T, NPROJ, D}; pg8::StaticOrder S; S.init(T, NPROJ, NW1, (int)blockIdx.x);
            pg8::EpiProj E{(b16*)(ws + WS_PROJ), in.b_gate};
            pg8::gemm_phase<pg8::EpiProj, pg8::StaticOrder, PG8_ALIGN, PG8_SP2>(F.lds, g, S, E);
            if (F.tid == 0) __hip_atomic_fetch_add((unsigned*)(ws + WS_CTL + CTL_P1DONE), 1u, __ATOMIC_RELAXED, __HIP_MEMORY_SCOPE_AGENT);
        }
        convert_from_queue(F, in, false, (unsigned)NW1);
    } SEAM(1);

    if (IN(2)) { for (int u = blockIdx.x; u < NBATCH * 3 * 8 * 32; u += F.G) dil_attn_unit_mfma(F, u); } SEAM(2);

    if (IN(3)) { phase_combine_conv(F, in); } SEAM(3);

    if (IN(4)) {
        { pg8::Gemm g{(const b16*)(ws + WS_YA), (const b16*)(ws + WS_WBA), T, D, 512}; pg8::StaticOrder S; S.init(T, D, F.G, (int)blockIdx.x);
          pg8::EpiMix<false> E{(b16*)(ws + WS_MIX), (const b16*)(ws + WS_PROJ)};
          pg8::gemm_phase<pg8::EpiMix<false>, pg8::StaticOrder, PG8_ALIGN, PG8_SP2>(F.lds, g, S, E); }
        { pg8::Gemm g{(const b16*)(ws + WS_YC), (const b16*)(ws + WS_WBC), T, D, D}; pg8::StaticOrder S; S.init(T, D, F.G, (int)blockIdx.x);
          pg8::EpiMix<true> E{(b16*)(ws + WS_MIX), (const b16*)(ws + WS_PROJ)};
          pg8::gemm_phase<pg8::EpiMix<true>, pg8::StaticOrder, PG8_ALIGN, PG8_SP2>(F.lds, g, S, E); }
    } SEAM(4);

    if (IN(5)) {
        { pg8::Gemm g{(const b16*)(ws + WS_MIX), (const b16*)(ws + WS_WO), T, D, D}; pg8::StaticOrder S; S.init(T, D, F.G, (int)blockIdx.x);
          pg8::EpiH1 E{in.x, (float*)(ws + WS_H1), (b16*)(ws + WS_H1B), (float*)(ws + WS_CTL + CTL_SS2)};
          pg8::gemm_phase<pg8::EpiH1, pg8::StaticOrder, PG8_ALIGN, PG8_SP2>(F.lds, g, S, E); }
        convert_from_queue(F, in, true, 0u);
        phase_mem_prologue(F, in);
    } SEAM(5);

    if (IN(6)) {
        { pg8::Gemm g{(const b16*)(ws + WS_H1B), (const b16*)(ws + WS_WCQ), T, 512, D}; pg8::StaticOrder S; S.init(T, 512, F.G, (int)blockIdx.x);
          pg8::EpiQ2 E{(b16*)(ws + WS_Q2), (const float*)(ws + WS_CTL + CTL_SS2)};
          pg8::gemm_phase<pg8::EpiQ2, pg8::StaticOrder, PG8_ALIGN, PG8_SP2>(F.lds, g, S, E); }
        { pg8::Gemm g{(const b16*)(ws + WS_MN), (const b16*)(ws + WS_WCKV), NBATCH * NMEM, D, D}; pg8::StaticOrder S; S.init(NBATCH * NMEM, D, F.G, ((int)blockIdx.x + F.G - 128) % F.G);
          pg8::EpiPlain E{(b16*)(ws + WS_KV), D};
          pg8::gemm_phase<pg8::EpiPlain, pg8::StaticOrder, PG8_ALIGN, PG8_SP2>(F.lds, g, S, E); }
    } SEAM(6);

    if (IN(7)) { for (int u = blockIdx.x; u < NBATCH * 4 * 32; u += F.G) cross_attn_unit_mfma(F, u); } SEAM(7);

    if (IN(8)) {
        pg8::Gemm g{(const b16*)(ws + WS_O2), (const b16*)(ws + WS_WCO), T, D, 512}; pg8::StaticOrder S; S.init(T, D, F.G, (int)blockIdx.x);
        pg8::EpiH2 E{(const float*)(ws + WS_H1), args.out};
        pg8::gemm_phase<pg8::EpiH2, pg8::StaticOrder, PG8_ALIGN, PG8_SP2>(F.lds, g, S, E);
    } SEAM(8);

    if (IN(9)) { phase_router(F, in, args.out); } SEAM(9);

    if (IN(10)) { phase_assign(F); } SEAM(10);

    if (IN(11)) {
        build_tpre(F);
        pg8::Gemm g{(const b16*)(ws + WS_U3), (const b16*)(ws + WS_EXPGU), T, NEXP * 2048, D / 2};
        MoeOrder S{(const volatile LAS int*)(F.lds + TBL_OFF), 8, F.G, (int)blockIdx.x};
        LAS int* rowbuf = (LAS int*)(F.lds + ROWBUF_OFF); const int* rowtok = (const int*)(ws + WS_CTL + CTL_ROWTOK);
        { pg8::Unit uu; for (int i = 0; i < ROWBUF_UNITS && S.next(i, uu); ++i) if (F.tid < 256) rowbuf[256 * i + F.tid] = rowtok[uu.pm * 256 + F.tid]; }
        __syncthreads();
        pg8::EpiHdnF8 E{ws + WS_HDN, in.b_eg, in.b_eu};
        pg8::gemm_phase_gather<pg8::EpiHdnF8, MoeOrder, true>(F.lds, g, S, E, (const LAS int*)rowbuf);
    } SEAM(11);

    if (IN(12)) {
        build_tpre(F);
        pg8::Gemm g{(const b16*)(ws + WS_HDN), (const b16*)(ws + WS_EXPD), XS_ROWS, NEXP * 1024, D / 2};
        MoeOrder S{(const volatile LAS int*)(F.lds + TBL_OFF), 4, F.G, (int)blockIdx.x};
        pg8::EpiYF8 E{(b16*)(ws + WS_Y), in.b_ed, (const int*)(ws + WS_ROWSLOT), (const float*)(ws + WS_TOPW)};
        pg8::gemm_phase<pg8::EpiYF8, MoeOrder, PG8_ALIGN, PG8_SP2, true>(F.lds, g, S, E);
    } SEAM(12);

    if (IN(13)) { phase_final(F, in, args.out, args.out); }
#undef IN
#undef SEAM
}

extern "C" void kernel_launch(void* const* d_in, const int* in_sizes, int n_in, void* d_out, int out_size, void* d_ws, size_t ws_size, hipStream_t stream) {
    static int grid = 0;
    if (grid == 0) {
        if (n_in != 25 || in_sizes[0] != T * D || out_size != T * D || ws_size < WS_END) {
            fprintf(stderr, "kernel_launch: built for 25 inputs, x/out of %d floats, >= %zu bytes of workspace; got n_in %d, in0 %d, out %d, ws %zu; nothing launched\n", T * D, (size_t)WS_END, n_in, n_in > 0 ? in_sizes[0] : -1, out_size, ws_size);
            grid = -1; return; }
        int dev = 0, cus = 0, per_cu = 0;
        if (hipGetDevice(&dev) != hipSuccess || hipDeviceGetAttribute(&cus, hipDeviceAttributeMultiprocessorCount, dev) != hipSuccess) { fprintf(stderr, "kernel_launch: device query failed\n"); grid = -1; return; }
        if (hipFuncSetAttribute((const void*)mega_fwd, hipFuncAttributeMaxDynamicSharedMemorySize, LDS_BYTES) != hipSuccess) { fprintf(stderr, "kernel_launch: hipFuncSetAttribute(%d B LDS) failed\n", LDS_BYTES); grid = -1; return; }
        if (hipOccupancyMaxActiveBlocksPerMultiprocessor(&per_cu, (const void*)mega_fwd, NTHREADS, LDS_BYTES) != hipSuccess || per_cu < 1) { fprintf(stderr, "kernel_launch: occupancy query says %d workgroups per CU\n", per_cu); per_cu = 1; }
        (void)hipGetLastError();
        grid = cus < 256 ? cus : 256;
    }
    if (grid < 0) return;
    (void)hipMemsetAsync((char*)d_ws + WS_CTL, 0, CTL_ZERO_BYTES, stream);
    Args a{};
    for (int i = 0; i < 25; ++i) a.in[i] = (const float*)d_in[i];
    a.out = (float*)d_out; a.ws = (unsigned char*)d_ws;
    if (N_LAUNCHES == 1) {
        a.ph_lo = 0; a.ph_hi = N_PHASES;
        void* kargs[] = {&a};
        hipError_t e = hipLaunchCooperativeKernel((const void*)mega_fwd, dim3(grid), dim3(NTHREADS), kargs, LDS_BYTES, stream);
        if (e != hipSuccess) fprintf(stderr, "kernel_launch: cooperative launch failed: %s (grid %d)\n", hipGetErrorString(e), grid);
    } else {
        for (int p = 0; p < N_PHASES; ++p) { a.ph_lo = p; a.ph_hi = p + 1; hipLaunchKernelGGL(mega_fwd, dim3(grid), dim3(NTHREADS), LDS_BYTES, stream, a);
        }
    }
}
```

```cpp
#include <hip/hip_runtime.h>
#include <cstdio>
#include <cstdint>
namespace pg8 {
#define PG8_LAS __attribute__((address_space(3)))
typedef unsigned short bf16_t;
typedef short bf16x8 __attribute__((ext_vector_type(8)));
typedef float f32x4 __attribute__((ext_vector_type(4)));
typedef unsigned u32x4 __attribute__((ext_vector_type(4)));
constexpr int BM = 256, BK = 64, HALF = 128, HTB = HALF * BK * 2  , STAGE_BYTES = 8 * HTB, NXCD = 8, WGM = 8;

__host__ __device__ __forceinline__ int lds_byte(int r, int c) { const int st = (r >> 4) * 2 + (c >> 5), rr = r & 15, cc = c & 31, ob = rr * 64 + cc * 2; return st * 1024 + (ob ^ (((ob >> 9) & 1) << 5)); }
__host__ __device__ __forceinline__ void stage_rc(int b, int& R, int& C) { const int st = b / 1024, sb = b % 1024, swz = sb ^ (((sb >> 9) & 1) << 5); R = (st >> 1) * 16 + swz / 64; C = (st & 1) * 32 + (swz % 64) / 2; }
__host__ __device__ __forceinline__ int perm32(int rho) { const int n = rho >> 4, i = rho & 15; return 8 * (i >> 2) + 4 * n + (i & 3); }

struct Unit { int pm, pn; };
struct Gemm { const bf16_t* A; const bf16_t* Bt; int M, N, K; };

struct StaticOrder {
    int nM, nN, nwg, G, c;
    __host__ __device__ void init(int M, int N, int G_, int c_) { nM = M / BM; nN = N / BM; nwg = nM * nN; G = G_; c = c_; }
    __host__ __device__ bool next(int i, Unit& u) const {
        const long L = (long)i * G + c; if (L >= nwg) return false;
        int wgid = (int)L; { const int q = nwg / NXCD, r = nwg % NXCD, xcd = wgid % NXCD, off = wgid / NXCD; wgid = (xcd < r ? xcd * (q + 1) : r * (q + 1) + (xcd - r) * q) + off; }
        const int nig = WGM * nN, gid = wgid / nig, fm = gid * WGM, gsz = (nM - fm) < WGM ? (nM - fm) : WGM;
        u.pm = fm + ((wgid % nig) % gsz); u.pn = (wgid % nig) / gsz; return true;
    }
    __device__ __forceinline__ void a_ready(const Unit&) const {}
    __device__ __forceinline__ void done(const Unit&) const {}
};

__device__ __forceinline__ unsigned cvt_pk_bf16(float lo, float hi) { unsigned r; asm volatile("v_cvt_pk_bf16_f32 %0, %1, %2" : "=v"(r) : "v"(lo), "v"(hi)); return r; }
__device__ __forceinline__ float bflo(unsigned w) { return __builtin_bit_cast(float, w << 16); }
__device__ __forceinline__ float bfhi(unsigned w) { return __builtin_bit_cast(float, w & 0xffff0000u); }
__device__ __forceinline__ void unpack8(const u32x4 w, f32x4& a, f32x4& b) { a = (f32x4){bflo(w.x), bfhi(w.x), bflo(w.y), bfhi(w.y)}; b = (f32x4){bflo(w.z), bfhi(w.z), bflo(w.w), bfhi(w.w)}; }
__device__ __forceinline__ u32x4 pack8(const f32x4 a, const f32x4 b) { u32x4 w; w.x = cvt_pk_bf16(a[0], a[1]); w.y = cvt_pk_bf16(a[2], a[3]); w.z = cvt_pk_bf16(b[0], b[1]); w.w = cvt_pk_bf16(b[2], b[3]); return w; }
__device__ __forceinline__ float sigmoidf_fast(float x) { return __builtin_amdgcn_rcpf(1.0f + __builtin_amdgcn_exp2f(-1.4426950408889634f * x)); }
__device__ __forceinline__ f32x4 sig4(f32x4 v) { return (f32x4){sigmoidf_fast(v[0]), sigmoidf_fast(v[1]), sigmoidf_fast(v[2]), sigmoidf_fast(v[3])}; }

typedef int v8i32 __attribute__((ext_vector_type(8)));
typedef int v4i32 __attribute__((ext_vector_type(4)));
__device__ __forceinline__ void mfma_f8_inplace(f32x4& c, const v8i32& a, const v8i32& b, int scale) {
    asm volatile("s_nop 1\n\tv_mfma_scale_f32_16x16x128_f8f6f4 %0, %1, %2, %0, %3, %3 op_sel_hi:[0,0,0]" : "+v"(c) : "v"(a), "v"(b), "v"(scale)); }
template <bool F8> struct FragSel;
template <> struct FragSel<false> { struct A { bf16x8 f[4][2]; }; struct B { bf16x8 f[2][2]; }; };
template <> struct FragSel<true> { struct A { v8i32 f[4]; }; struct B { v8i32 f[2]; }; };
__device__ __forceinline__ unsigned pack4_fp8(const f32x4 v) { int w = 0; w = __builtin_amdgcn_cvt_pk_fp8_f32(v[0], v[1], w, false); w = __builtin_amdgcn_cvt_pk_fp8_f32(v[2], v[3], w, true); return (unsigned)w; }
constexpr float W8_SCALE = 32.f, W8_INV = 1.f / 32.f;
#define EPI_ROWS_BEGIN _Pragma("unroll") for (int ai = 0; ai < 2; ++ai) _Pragma("unroll") for (int m = 0; m < 4; ++m) { const int rowl = ai * HALF + wr * 64 + m * 16 + fr;
#define EPI_COLS_BEGIN _Pragma("unroll") for (int bj = 0; bj < 2; ++bj) { const int coll = bj * HALF + wc * 32 + 8 * fq; f32x4 v0 = acc[ai][bj][m][0], v1 = acc[ai][bj][m][1];
#define EPI_END }

struct EpiProj {
    static constexpr bool PERM = true, AFTER_DRAIN = false;
    bf16_t* O; const float* bgate;
    __device__ __forceinline__ void operator()(const f32x4 (&acc)[2][2][4][2], const Unit& u, int wr, int wc, int fr, int fq) const {
        const int row0 = u.pm * BM, col0 = u.pn * BM; const bool gate = col0 >= 7680;
        EPI_ROWS_BEGIN EPI_COLS_BEGIN
            const int row = row0 + rowl, col = col0 + coll;
            if (gate) { const f32x4 b0 = *(const f32x4*)(bgate + (col - 7680)), b1 = *(const f32x4*)(bgate + (col - 7680) + 4); v0 = sig4(v0 + b0); v1 = sig4(v1 + b1); }
            *(u32x4*)(O + (size_t)row * 9728 + col) = pack8(v0, v1);
        EPI_END EPI_END
    }
};
struct EpiPlain {
    static constexpr bool PERM = true, AFTER_DRAIN = false;
    bf16_t* O; int ldc;
    __device__ __forceinline__ void operator()(const f32x4 (&acc)[2][2][4][2], const Unit& u, int wr, int wc, int fr, int fq) const {
        const int row0 = u.pm * BM, col0 = u.pn * BM;
        EPI_ROWS_BEGIN EPI_COLS_BEGIN
            *(u32x4*)(O + (size_t)(row0 + rowl) * ldc + col0 + coll) = pack8(v0, v1);
        EPI_END EPI_END
    }
};
template <bool SECOND> struct EpiMix {
    static constexpr bool PERM = true, AFTER_DRAIN = false;
    bf16_t* MIX; const bf16_t* PROJ;
    __device__ __forceinline__ void operator()(const f32x4 (&acc)[2][2][4][2], const Unit& u, int wr, int wc, int fr, int fq) const {
        const int row0 = u.pm * BM, col0 = u.pn * BM;
        EPI_ROWS_BEGIN EPI_COLS_BEGIN
            const int row = row0 + rowl, col = col0 + coll;
            f32x4 g0, g1; unpack8(*(const u32x4*)(PROJ + (size_t)row * 9728 + (SECOND ? 8704 : 7680) + col), g0, g1);
            v0 = v0 * g0; v1 = v1 * g1;
            if (SECOND) { f32x4 t0, t1; unpack8(*(const u32x4*)(MIX + (size_t)row * 1024 + col), t0, t1); v0 = v0 + t0; v1 = v1 + t1; }
            *(u32x4*)(MIX + (size_t)row * 1024 + col) = pack8(v0, v1);
        EPI_END EPI_END
    }
};
struct EpiH1 {
    static constexpr bool PERM = true, AFTER_DRAIN = false;
    const float* X; float* H1; bf16_t* H1B; float* ss;
    __device__ __forceinline__ void operator()(const f32x4 (&acc)[2][2][4][2], const Unit& u, int wr, int wc, int fr, int fq) const {
        const int row0 = u.pm * BM, col0 = u.pn * BM;
        EPI_ROWS_BEGIN
            float s = 0.f; const int row = row0 + rowl;
            EPI_COLS_BEGIN
                const int col = col0 + coll; const size_t o = (size_t)row * 1024 + col;
                v0 = v0 + *(const f32x4*)(X + o); v1 = v1 + *(const f32x4*)(X + o + 4);
                *(f32x4*)(H1 + o) = v0; *(f32x4*)(H1 + o + 4) = v1; *(u32x4*)(H1B + o) = pack8(v0, v1);
                s += (v0[0] * v0[0] + v0[1] * v0[1]) + (v0[2] * v0[2] + v0[3] * v0[3]) + (v1[0] * v1[0] + v1[1] * v1[1]) + (v1[2] * v1[2] + v1[3] * v1[3]);
            EPI_END
            s += __shfl_xor(s, 16); s += __shfl_xor(s, 32);
            if (fq == 0) atomicAdd(ss + row, s);
        EPI_END
    }
};
struct EpiQ2 {
    static constexpr bool PERM = true, AFTER_DRAIN = false;
    bf16_t* Q2; const float* ss;
    __device__ __forceinline__ void operator()(const f32x4 (&acc)[2][2][4][2], const Unit& u, int wr, int wc, int fr, int fq) const {
        const int row0 = u.pm * BM, col0 = u.pn * BM;
        EPI_ROWS_BEGIN
            const int row = row0 + rowl; const float rs = __builtin_amdgcn_rsqf(__hip_atomic_load(ss + row, __ATOMIC_RELAXED, __HIP_MEMORY_SCOPE_AGENT) * (1.f / 1024.f) + 1e-6f);
            EPI_COLS_BEGIN
                *(u32x4*)(Q2 + (size_t)row * 512 + col0 + coll) = pack8(v0 * rs, v1 * rs);
            EPI_END
        EPI_END
    }
};
struct EpiH2 {
    static constexpr bool PERM = true, AFTER_DRAIN = false;
    const float* H1; float* OUT;
    __device__ __forceinline__ void operator()(const f32x4 (&acc)[2][2][4][2], const Unit& u, int wr, int wc, int fr, int fq) const {
        const int row0 = u.pm * BM, col0 = u.pn * BM;
        EPI_ROWS_BEGIN EPI_COLS_BEGIN
            const size_t o = (size_t)(row0 + rowl) * 1024 + col0 + coll;
            *(f32x4*)(OUT + o) = v0 + *(const f32x4*)(H1 + o); *(f32x4*)(OUT + o + 4) = v1 + *(const f32x4*)(H1 + o + 4);
        EPI_END EPI_END
    }
};
struct EpiHdn {
    static constexpr bool PERM = true, AFTER_DRAIN = false;
    bf16_t* HDN; const float* bg; const float* bu;
    __device__ __forceinline__ void operator()(const f32x4 (&acc)[2][2][4][2], const Unit& u, int wr, int wc, int fr, int fq) const {
        const int row0 = u.pm * BM, e = u.pn >> 3, hc = (u.pn & 7) * 128 + wc * 32 + 8 * fq;
        const float* pg = bg + e * 1024 + hc; const float* pu = bu + e * 1024 + hc;
        const f32x4 bg0 = *(const f32x4*)pg, bg1 = *(const f32x4*)(pg + 4), bu0 = *(const f32x4*)pu, bu1 = *(const f32x4*)(pu + 4);
        EPI_ROWS_BEGIN
            f32x4 g0 = acc[ai][0][m][0] + bg0, g1 = acc[ai][0][m][1] + bg1, l0 = acc[ai][1][m][0] + bu0, l1 = acc[ai][1][m][1] + bu1, h0, h1;
#pragma unroll
            for (int j = 0; j < 4; ++j) {
                const float ga = fminf(g0[j], 7.f), gb = fminf(g1[j], 7.f), la = fminf(fmaxf(l0[j], -7.f), 7.f), lb = fminf(fmaxf(l1[j], -7.f), 7.f);
                h0[j] = ga * sigmoidf_fast(1.702f * ga) * (la + 1.f); h1[j] = gb * sigmoidf_fast(1.702f * gb) * (lb + 1.f); }
            *(u32x4*)(HDN + (size_t)(row0 + rowl) * 1024 + hc) = pack8(h0, h1);
        EPI_END
    }
};
struct EpiHdnF8 {
    static constexpr bool PERM = true, AFTER_DRAIN = false;
    unsigned char* HDN; const float* bg; const float* bu;
    __device__ __forceinline__ void operator()(const f32x4 (&acc)[2][2][4][2], const Unit& u, int wr, int wc, int fr, int fq) const {
        const int row0 = u.pm * BM, e = u.pn >> 3, hc = (u.pn & 7) * 128 + wc * 32 + 8 * fq;
        const float* pg = bg + e * 1024 + hc; const float* pu = bu + e * 1024 + hc;
        const f32x4 bg0 = *(const f32x4*)pg, bg1 = *(const f32x4*)(pg + 4), bu0 = *(const f32x4*)pu, bu1 = *(const f32x4*)(pu + 4);
        EPI_ROWS_BEGIN
            f32x4 g0 = acc[ai][0][m][0] * W8_INV + bg0, g1 = acc[ai][0][m][1] * W8_INV + bg1, l0 = acc[ai][1][m][0] * W8_INV + bu0, l1 = acc[ai][1][m][1] * W8_INV + bu1, h0, h1;
#pragma unroll
            for (int j = 0; j < 4; ++j) {
                const float ga = fminf(g0[j], 7.f), gb = fminf(g1[j], 7.f), la = fminf(fmaxf(l0[j], -7.f), 7.f), lb = fminf(fmaxf(l1[j], -7.f), 7.f);
                h0[j] = ga * sigmoidf_fast(1.702f * ga) * (la + 1.f); h1[j] = gb * sigmoidf_fast(1.702f * gb) * (lb + 1.f); }
            *(unsigned long long*)(HDN + (size_t)(row0 + rowl) * 1024 + hc) = (unsigned long long)pack4_fp8(h0) | ((unsigned long long)pack4_fp8(h1) << 32);
        EPI_END
    }
};
struct EpiYF8 {
    static constexpr bool PERM = true, AFTER_DRAIN = false;
    bf16_t* Y; const float* bd; const int* rowslot; const float* topw;
    __device__ __forceinline__ void operator()(const f32x4 (&acc)[2][2][4][2], const Unit& u, int wr, int wc, int fr, int fq) const {
        const int row0 = u.pm * BM, e = u.pn >> 2, col0 = (u.pn & 3) * BM;
        EPI_ROWS_BEGIN
            const int slot = rowslot[row0 + rowl];
            if (slot >= 0) { const float w = topw[slot];
                EPI_COLS_BEGIN
                    const int col = col0 + coll; const float* pb = bd + e * 1024 + col;
                    v0 = (v0 * W8_INV + *(const f32x4*)pb) * w; v1 = (v1 * W8_INV + *(const f32x4*)(pb + 4)) * w;
                    *(u32x4*)(Y + (size_t)slot * 1024 + col) = pack8(v0, v1);
                EPI_END }
        EPI_END
    }
};
struct EpiY {
    static constexpr bool PERM = true, AFTER_DRAIN = false;
    bf16_t* Y; const float* bd; const int* rowslot; const float* topw;
    __device__ __forceinline__ void operator()(const f32x4 (&acc)[2][2][4][2], const Unit& u, int wr, int wc, int fr, int fq) const {
        const int row0 = u.pm * BM, e = u.pn >> 2, col0 = (u.pn & 3) * BM;
        EPI_ROWS_BEGIN
            const int slot = rowslot[row0 + rowl];
            if (slot >= 0) { const float w = topw[slot];
                EPI_COLS_BEGIN
                    const int col = col0 + coll; const float* pb = bd + e * 1024 + col;
                    v0 = (v0 + *(const f32x4*)pb) * w; v1 = (v1 + *(const f32x4*)(pb + 4)) * w;
                    *(u32x4*)(Y + (size_t)slot * 1024 + col) = pack8(v0, v1);
                EPI_END }
        EPI_END
    }
};
template <class Epi, class Sched, bool ALIGN_EPI = false, bool SP2 = false, bool F8 = false>
__device__ __forceinline__ void gemm_phase(PG8_LAS unsigned char* lds, const Gemm g, const Sched& S, const Epi& E) {
    const int tid = threadIdx.x, wid = __builtin_amdgcn_readfirstlane(tid >> 6), lane = tid & 63, wr = wid >> 2, wc = wid & 3, fr = lane & 15, fq = lane >> 4;
    const int K = g.K, nt = K / BK;
    unsigned voffA[2], voffB[2];
#pragma unroll
    for (int i = 0; i < 2; ++i) { int R, C; stage_rc(tid * 16 + i * 8192, R, C); const int Rb = Epi::PERM ? ((R & ~31) + perm32(R & 31)) : R;
        voffA[i] = (unsigned)(R * K + C) * 2u; voffB[i] = (unsigned)(Rb * K + C) * 2u; }
    const size_t kstep = (size_t)(BK * 2);
    const size_t hstep = (size_t)HALF * K * 2;
    const size_t tstep = 2 * hstep;
    const unsigned ldsw = (unsigned)wid * 1024u;
    const int aoff = F8 ? lds_byte(wr * 64 + fr, fq * 16) : lds_byte(wr * 64 + fr, fq * 8), boff = F8 ? lds_byte(wc * 32 + fr, fq * 16) : lds_byte(wc * 32 + fr, fq * 8);
#define PG8_SA(b, h) (((b) * 2 + (h)) * HTB)
#define PG8_SB(b, h) ((4 + (b) * 2 + (h)) * HTB)
#define PG8_STAGE(bufoff, gbase, voff) do { _Pragma("unroll") for (int _i = 0; _i < 2; ++_i) \
        __builtin_amdgcn_global_load_lds((const unsigned*)((const char*)(gbase) + (voff)[_i]), (PG8_LAS unsigned*)(lds + (bufoff) + ldsw + _i * 8192), 16, 0, 0); } while (0)
#define PG8_LDA(dst, b, h) do { _Pragma("unroll") for (int m = 0; m < 4; ++m) { if constexpr (F8) { const v4i32 lo_ = *(const PG8_LAS v4i32*)(lds + PG8_SA(b, h) + aoff + m * 2048), hi_ = *(const PG8_LAS v4i32*)(lds + PG8_SA(b, h) + aoff + m * 2048 + 16); \
        dst.f[m] = __builtin_shufflevector(lo_, hi_, 0, 1, 2, 3, 4, 5, 6, 7); } else { _Pragma("unroll") for (int k = 0; k < 2; ++k) dst.f[m][k] = *(const PG8_LAS bf16x8*)(lds + PG8_SA(b, h) + aoff + m * 2048 + k * 1024); } } } while (0)
#define PG8_LDB(dst, b, h) do { _Pragma("unroll") for (int n = 0; n < 2; ++n) { if constexpr (F8) { const v4i32 lo_ = *(const PG8_LAS v4i32*)(lds + PG8_SB(b, h) + boff + n * 2048), hi_ = *(const PG8_LAS v4i32*)(lds + PG8_SB(b, h) + boff + n * 2048 + 16); \
        dst.f[n] = __builtin_shufflevector(lo_, hi_, 0, 1, 2, 3, 4, 5, 6, 7); } else { _Pragma("unroll") for (int k = 0; k < 2; ++k) dst.f[n][k] = *(const PG8_LAS bf16x8*)(lds + PG8_SB(b, h) + boff + n * 2048 + k * 1024); } } } while (0)
#define PG8_MMA(ai, bj, At, Bt) do { __builtin_amdgcn_s_setprio(1); \
        if constexpr (F8) { _Pragma("unroll") for (int m = 0; m < 4; ++m) _Pragma("unroll") for (int n = 0; n < 2; ++n) \
            mfma_f8_inplace(acc[ai][bj][m][n], Bt.f[n], At.f[m], f8scale); } \
        else { _Pragma("unroll") for (int m = 0; m < 4; ++m) _Pragma("unroll") for (int n = 0; n < 2; ++n) _Pragma("unroll") for (int k = 0; k < 2; ++k) \
            acc[ai][bj][m][n] = __builtin_amdgcn_mfma_f32_16x16x32_bf16(Bt.f[n][k], At.f[m][k], acc[ai][bj][m][n], 0, 0, 0); } \
        __builtin_amdgcn_s_setprio(0); } while (0)
#define PG8_WAIT_V(n) asm volatile("s_waitcnt vmcnt(" #n ")" ::: "memory")
#define PG8_WAIT_L(n) asm volatile("s_waitcnt lgkmcnt(" #n ")" ::: "memory")
#define PG8_BAR __builtin_amdgcn_s_barrier()
#define PG8_SCHED __builtin_amdgcn_sched_barrier(0)
    int f8scale = 0x7F7F7F7F; asm volatile("" : "+v"(f8scale));
    Unit cur, nxt; int ui = 0;
    if (!S.next(0, cur)) return;
    f32x4 acc[2][2][4][2];
#pragma unroll
    for (int a = 0; a < 2; ++a)
#pragma unroll
        for (int b = 0; b < 2; ++b)
#pragma unroll
            for (int m = 0; m < 4; ++m)
#pragma unroll
                for (int n = 0; n < 2; ++n) acc[a][b][m][n] = (f32x4){0.f, 0.f, 0.f, 0.f};
    typename FragSel<F8>::A At; typename FragSel<F8>::B B0, B1;
    const char* cA = (const char*)g.A + (size_t)cur.pm * tstep; const char* cB = (const char*)g.Bt + (size_t)cur.pn * tstep;
    S.a_ready(cur);
    if constexpr (SP2) {
        PG8_STAGE(PG8_SB(0, 0), cB, voffB); PG8_STAGE(PG8_SB(0, 1), cB + hstep, voffB); PG8_STAGE(PG8_SA(0, 0), cA, voffA); PG8_STAGE(PG8_SA(0, 1), cA + hstep, voffA);
        if (wr == 1) PG8_BAR;
        PG8_WAIT_V(2); PG8_BAR;
        PG8_STAGE(PG8_SB(1, 0), cB + kstep, voffB); PG8_STAGE(PG8_SA(1, 0), cA + kstep, voffA); PG8_STAGE(PG8_SB(1, 1), cB + hstep + kstep, voffB);
        PG8_WAIT_V(6); PG8_BAR;
    } else {
        PG8_STAGE(PG8_SB(0, 0), cB, voffB); PG8_STAGE(PG8_SA(0, 0), cA, voffA); PG8_STAGE(PG8_SB(0, 1), cB + hstep, voffB); PG8_STAGE(PG8_SA(0, 1), cA + hstep, voffA);
        if (wr == 1) PG8_BAR;
        PG8_WAIT_V(4); PG8_BAR;
        PG8_STAGE(PG8_SB(1, 0), cB + kstep, voffB); PG8_STAGE(PG8_SA(1, 0), cA + kstep, voffA); PG8_STAGE(PG8_SB(1, 1), cB + hstep + kstep, voffB);
        PG8_WAIT_V(6); PG8_BAR;
    }
    for (;;) {
        const bool has_next = S.next(ui + 1, nxt);
        const char* nA = has_next ? (const char*)g.A + (size_t)nxt.pm * tstep : cA; const char* nB = has_next ? (const char*)g.Bt + (size_t)nxt.pn * tstep : cB;
#pragma unroll 1
        for (int t = 0; t < nt; t += 2) {
            const bool last = (t == nt - 2);
            const char* a1 = cA + (size_t)(t + 1) * kstep;
            const char* a2 = last ? nA : cA + (size_t)(t + 2) * kstep; const char* b2 = last ? nB : cB + (size_t)(t + 2) * kstep;
            const char* a3 = a2 + kstep; const char* b3 = b2 + kstep;
            if (last && has_next) S.a_ready(nxt);
            if constexpr (SP2) {
            PG8_LDB(B0, 0, 0); PG8_LDB(B1, 0, 1); PG8_SCHED; PG8_LDA(At, 0, 0); PG8_STAGE(PG8_SA(1, 1), a1 + hstep, voffA);
            PG8_WAIT_V(8); PG8_WAIT_L(0); PG8_BAR; PG8_MMA(0, 0, At, B0); PG8_MMA(0, 1, At, B1); PG8_BAR; PG8_SCHED;
            PG8_LDA(At, 0, 1); PG8_STAGE(PG8_SB(0, 0), b2, voffB); PG8_STAGE(PG8_SB(0, 1), b2 + hstep, voffB); PG8_STAGE(PG8_SA(0, 0), a2, voffA);
            PG8_WAIT_V(8); PG8_WAIT_L(0); PG8_BAR; PG8_MMA(1, 0, At, B0); PG8_MMA(1, 1, At, B1); PG8_BAR; PG8_SCHED;
            PG8_LDB(B0, 1, 0); PG8_LDB(B1, 1, 1); PG8_SCHED; PG8_LDA(At, 1, 0); PG8_STAGE(PG8_SA(0, 1), a2 + hstep, voffA);
            PG8_WAIT_V(8); PG8_WAIT_L(0); PG8_BAR; PG8_MMA(0, 0, At, B0); PG8_MMA(0, 1, At, B1); PG8_BAR; PG8_SCHED;
            PG8_LDA(At, 1, 1); PG8_STAGE(PG8_SB(1, 0), b3, voffB); PG8_STAGE(PG8_SB(1, 1), b3 + hstep, voffB); PG8_STAGE(PG8_SA(1, 0), a3, voffA);
            PG8_WAIT_V(8); PG8_WAIT_L(0); PG8_BAR; PG8_MMA(1, 0, At, B0); PG8_MMA(1, 1, At, B1); PG8_BAR; PG8_SCHED;
            } else {
            PG8_LDB(B0, 0, 0); PG8_SCHED; PG8_LDA(At, 0, 0); PG8_STAGE(PG8_SA(1, 1), a1 + hstep, voffA);
            PG8_WAIT_L(8); PG8_BAR; PG8_WAIT_L(0); PG8_MMA(0, 0, At, B0); PG8_BAR; PG8_SCHED;
            PG8_LDB(B1, 0, 1); PG8_STAGE(PG8_SB(0, 0), b2, voffB);
            PG8_BAR; PG8_WAIT_L(0); PG8_MMA(0, 1, At, B1); PG8_BAR;
            PG8_LDA(At, 0, 1); PG8_STAGE(PG8_SA(0, 0), a2, voffA);
            PG8_BAR; PG8_WAIT_L(0); PG8_MMA(1, 0, At, B0); PG8_BAR; PG8_SCHED;
            PG8_STAGE(PG8_SB(0, 1), b2 + hstep, voffB);
            PG8_WAIT_V(6); PG8_BAR; PG8_MMA(1, 1, At, B1); PG8_BAR;
            PG8_LDB(B0, 1, 0); PG8_SCHED; PG8_LDA(At, 1, 0); PG8_STAGE(PG8_SA(0, 1), a2 + hstep, voffA);
            PG8_WAIT_L(8); PG8_BAR; PG8_WAIT_L(0); PG8_MMA(0, 0, At, B0); PG8_BAR; PG8_SCHED;
            PG8_LDB(B1, 1, 1); PG8_STAGE(PG8_SB(1, 0), b3, voffB);
            PG8_BAR; PG8_WAIT_L(0); PG8_MMA(0, 1, At, B1); PG8_BAR;
            PG8_LDA(At, 1, 1); PG8_STAGE(PG8_SA(1, 0), a3, voffA);
            PG8_BAR; PG8_WAIT_L(0); PG8_MMA(1, 0, At, B0); PG8_BAR; PG8_SCHED;
            PG8_STAGE(PG8_SB(1, 1), b3 + hstep, voffB);
            PG8_WAIT_V(6); PG8_BAR; PG8_MMA(1, 1, At, B1); PG8_BAR;
            }
        }
        if constexpr (F8) asm volatile("s_nop 15\n\ts_nop 7" ::: "memory");
        if constexpr (ALIGN_EPI) { if (wr == 0) PG8_BAR; }
        if constexpr (!Epi::AFTER_DRAIN) { E(acc, cur, wr, wc, fr, fq); S.done(cur); }
        if (!has_next) break;
#pragma unroll
        for (int a = 0; a < 2; ++a)
#pragma unroll
            for (int b = 0; b < 2; ++b)
#pragma unroll
                for (int m = 0; m < 4; ++m)
#pragma unroll
                    for (int n = 0; n < 2; ++n) acc[a][b][m][n] = (f32x4){0.f, 0.f, 0.f, 0.f};
        cur = nxt; cA = nA; cB = nB; ++ui;
        if constexpr (ALIGN_EPI) { if (wr == 1) PG8_BAR; }
    }
    PG8_WAIT_V(0);
    if constexpr (!ALIGN_EPI) { if (wr == 0) PG8_BAR; }
    PG8_BAR;
    if constexpr (Epi::AFTER_DRAIN) { E.fused(acc, cur, wr, wc, fr, fq, lds, wid, lane); S.done(cur); }
#undef PG8_SA
#undef PG8_SB
#undef PG8_STAGE
#undef PG8_LDA
#undef PG8_LDB
#undef PG8_MMA
#undef PG8_WAIT_V
#undef PG8_WAIT_L
#undef PG8_BAR
#undef PG8_SCHED
}
}
namespace pg8 {
template <class Epi, class Sched, bool F8 = false>
__device__ __forceinline__ void gemm_phase_gather(PG8_LAS unsigned char* lds, const Gemm g, const Sched& S, const Epi& E, const PG8_LAS int* rowbuf) {
    const int tid = threadIdx.x, wid = __builtin_amdgcn_readfirstlane(tid >> 6), lane = tid & 63, wr = wid >> 2, wc = wid & 3, fr = lane & 15, fq = lane >> 4;
    const int K = g.K, nt = K / BK;
    unsigned colA[2], voffB[2]; int rowA[2];
#pragma unroll
    for (int i = 0; i < 2; ++i) { int R, C; stage_rc(tid * 16 + i * 8192, R, C); const int Rb = Epi::PERM ? ((R & ~31) + perm32(R & 31)) : R;
        rowA[i] = R; colA[i] = (unsigned)C * 2u; voffB[i] = (unsigned)(Rb * K + C) * 2u; }
    const size_t kstep = (size_t)(BK * 2), hstep = (size_t)HALF * K * 2, tstep = 2 * hstep;
    const unsigned rowbytes = (unsigned)K * 2u;
    const unsigned ldsw = (unsigned)wid * 1024u;
    const int aoff = F8 ? lds_byte(wr * 64 + fr, fq * 16) : lds_byte(wr * 64 + fr, fq * 8), boff = F8 ? lds_byte(wc * 32 + fr, fq * 16) : lds_byte(wc * 32 + fr, fq * 8);
#define PG8_SA(b, h) (((b) * 2 + (h)) * HTB)
#define PG8_SB(b, h) ((4 + (b) * 2 + (h)) * HTB)
#define PG8_STAGE(bufoff, gbase, voff) do { _Pragma("unroll") for (int _i = 0; _i < 2; ++_i) \
        __builtin_amdgcn_global_load_lds((const unsigned*)((const char*)(gbase) + (voff)[_i]), (PG8_LAS unsigned*)(lds + (bufoff) + ldsw + _i * 8192), 16, 0, 0); } while (0)
#define PG8_LDA(dst, b, h) do { _Pragma("unroll") for (int m = 0; m < 4; ++m) { if constexpr (F8) { const v4i32 lo_ = *(const PG8_LAS v4i32*)(lds + PG8_SA(b, h) + aoff + m * 2048), hi_ = *(const PG8_LAS v4i32*)(lds + PG8_SA(b, h) + aoff + m * 2048 + 16); \
        dst.f[m] = __builtin_shufflevector(lo_, hi_, 0, 1, 2, 3, 4, 5, 6, 7); } else { _Pragma("unroll") for (int k = 0; k < 2; ++k) dst.f[m][k] = *(const PG8_LAS bf16x8*)(lds + PG8_SA(b, h) + aoff + m * 2048 + k * 1024); } } } while (0)
#define PG8_LDB(dst, b, h) do { _Pragma("unroll") for (int n = 0; n < 2; ++n) { if constexpr (F8) { const v4i32 lo_ = *(const PG8_LAS v4i32*)(lds + PG8_SB(b, h) + boff + n * 2048), hi_ = *(const PG8_LAS v4i32*)(lds + PG8_SB(b, h) + boff + n * 2048 + 16); \
        dst.f[n] = __builtin_shufflevector(lo_, hi_, 0, 1, 2, 3, 4, 5, 6, 7); } else { _Pragma("unroll") for (int k = 0; k < 2; ++k) dst.f[n][k] = *(const PG8_LAS bf16x8*)(lds + PG8_SB(b, h) + boff + n * 2048 + k * 1024); } } } while (0)
#define PG8_MMA(ai, bj, At, Bt) do { __builtin_amdgcn_s_setprio(1); \
        if constexpr (F8) { _Pragma("unroll") for (int m = 0; m < 4; ++m) _Pragma("unroll") for (int n = 0; n < 2; ++n) \
            mfma_f8_inplace(acc[ai][bj][m][n], Bt.f[n], At.f[m], f8scale); } \
        else { _Pragma("unroll") for (int m = 0; m < 4; ++m) _Pragma("unroll") for (int n = 0; n < 2; ++n) _Pragma("unroll") for (int k = 0; k < 2; ++k) \
            acc[ai][bj][m][n] = __builtin_amdgcn_mfma_f32_16x16x32_bf16(Bt.f[n][k], At.f[m][k], acc[ai][bj][m][n], 0, 0, 0); } \
        __builtin_amdgcn_s_setprio(0); } while (0)
#define PG8_WAIT_V(n) asm volatile("s_waitcnt vmcnt(" #n ")" ::: "memory")
#define PG8_WAIT_L(n) asm volatile("s_waitcnt lgkmcnt(" #n ")" ::: "memory")
#define PG8_BAR __builtin_amdgcn_s_barrier()
#define PG8_SCHED __builtin_amdgcn_sched_barrier(0)
#define PG8_ROWS(dst, u_) do { _Pragma("unroll") for (int h_ = 0; h_ < 2; ++h_) _Pragma("unroll") for (int i_ = 0; i_ < 2; ++i_) dst[h_][i_] = (unsigned)rowbuf[256 * (u_) + 128 * h_ + rowA[i_]] * rowbytes + colA[i_]; } while (0)
    int f8scale = 0x7F7F7F7F; asm volatile("" : "+v"(f8scale));
    Unit cur, nxt; int ui = 0;
    if (!S.next(0, cur)) return;
    f32x4 acc[2][2][4][2];
#pragma unroll
    for (int a = 0; a < 2; ++a)
#pragma unroll
        for (int b = 0; b < 2; ++b)
#pragma unroll
            for (int m = 0; m < 4; ++m)
#pragma unroll
                for (int n = 0; n < 2; ++n) acc[a][b][m][n] = (f32x4){0.f, 0.f, 0.f, 0.f};
    typename FragSel<F8>::A At; typename FragSel<F8>::B B0, B1;
    const char* Ab = (const char*)g.A; const char* cB = (const char*)g.Bt + (size_t)cur.pn * tstep;
    unsigned ca[2][2], na[2][2];
    PG8_ROWS(ca, 0);
    PG8_STAGE(PG8_SB(0, 0), cB, voffB); PG8_STAGE(PG8_SB(0, 1), cB + hstep, voffB); PG8_STAGE(PG8_SA(0, 0), Ab, ca[0]); PG8_STAGE(PG8_SA(0, 1), Ab, ca[1]);
    if (wr == 1) PG8_BAR;
    PG8_WAIT_V(2); PG8_BAR;
    PG8_STAGE(PG8_SB(1, 0), cB + kstep, voffB); PG8_STAGE(PG8_SA(1, 0), Ab + kstep, ca[0]); PG8_STAGE(PG8_SB(1, 1), cB + hstep + kstep, voffB);
    PG8_WAIT_V(6); PG8_BAR;
    for (;;) {
        const bool has_next = S.next(ui + 1, nxt);
        const char* nB = has_next ? (const char*)g.Bt + (size_t)nxt.pn * tstep : cB;
        if (has_next) { PG8_ROWS(na, ui + 1); } else {
#pragma unroll
            for (int h_ = 0; h_ < 2; ++h_)
#pragma unroll
                for (int i_ = 0; i_ < 2; ++i_) na[h_][i_] = ca[h_][i_]; }
#pragma unroll 1
        for (int t = 0; t < nt; t += 2) {
            const bool last = (t == nt - 2);
            const char* a1 = Ab + (size_t)(t + 1) * kstep;
            const char* a2 = last ? Ab : Ab + (size_t)(t + 2) * kstep; const char* b2 = last ? nB : cB + (size_t)(t + 2) * kstep;
            const char* a3 = a2 + kstep; const char* b3 = b2 + kstep;
            unsigned o2[2][2];
#pragma unroll
            for (int h_ = 0; h_ < 2; ++h_)
#pragma unroll
                for (int i_ = 0; i_ < 2; ++i_) o2[h_][i_] = last ? na[h_][i_] : ca[h_][i_];
            PG8_LDB(B0, 0, 0); PG8_LDB(B1, 0, 1); PG8_SCHED; PG8_LDA(At, 0, 0); PG8_STAGE(PG8_SA(1, 1), a1, ca[1]);
            PG8_WAIT_V(8); PG8_WAIT_L(0); PG8_BAR; PG8_MMA(0, 0, At, B0); PG8_MMA(0, 1, At, B1); PG8_BAR; PG8_SCHED;
            PG8_LDA(At, 0, 1); PG8_STAGE(PG8_SB(0, 0), b2, voffB); PG8_STAGE(PG8_SB(0, 1), b2 + hstep, voffB); PG8_STAGE(PG8_SA(0, 0), a2, o2[0]);
            PG8_WAIT_V(8); PG8_WAIT_L(0); PG8_BAR; PG8_MMA(1, 0, At, B0); PG8_MMA(1, 1, At, B1); PG8_BAR; PG8_SCHED;
            PG8_LDB(B0, 1, 0); PG8_LDB(B1, 1, 1); PG8_SCHED; PG8_LDA(At, 1, 0); PG8_STAGE(PG8_SA(0, 1), a2, o2[1]);
            PG8_WAIT_V(8); PG8_WAIT_L(0); PG8_BAR; PG8_MMA(0, 0, At, B0); PG8_MMA(0, 1, At, B1); PG8_BAR; PG8_SCHED;
            PG8_LDA(At, 1, 1); PG8_STAGE(PG8_SB(1, 0), b3, voffB); PG8_STAGE(PG8_SB(1, 1), b3 + hstep, voffB); PG8_STAGE(PG8_SA(1, 0), a3, o2[0]);
            PG8_WAIT_V(8); PG8_WAIT_L(0); PG8_BAR; PG8_MMA(1, 0, At, B0); PG8_MMA(1, 1, At, B1); PG8_BAR; PG8_SCHED;
        }
        if constexpr (F8) asm volatile("s_nop 15\n\ts_nop 7" ::: "memory");
        if (wr == 0) PG8_BAR;
        E(acc, cur, wr, wc, fr, fq); S.done(cur);
        if (!has_next) break;
#pragma unroll
        for (int a = 0; a < 2; ++a)
#pragma unroll
            for (int b = 0; b < 2; ++b)
#pragma unroll
                for (int m = 0; m < 4; ++m)
#pragma unroll
                    for (int n = 0; n < 2; ++n) acc[a][b][m][n] = (f32x4){0.f, 0.f, 0.f, 0.f};
        cur = nxt; cB = nB; ++ui;
#pragma unroll
        for (int h_ = 0; h_ < 2; ++h_)
#pragma unroll
            for (int i_ = 0; i_ < 2; ++i_) ca[h_][i_] = na[h_][i_];
        if (wr == 1) PG8_BAR;
    }
    PG8_WAIT_V(0);
    PG8_BAR;
#undef PG8_ROWS
#undef PG8_SA
#undef PG8_SB
#undef PG8_STAGE
#undef PG8_LDA
#undef PG8_LDB
#undef PG8_MMA
#undef PG8_WAIT_V
#undef PG8_WAIT_L
#undef PG8_BAR
#undef PG8_SCHED
}
}
#define GAS __attribute__((address_space(1)))
#define LAS __attribute__((address_space(3)))
typedef unsigned short bf16;
typedef unsigned v4u __attribute__((ext_vector_type(4)));
typedef float f32x4 __attribute__((ext_vector_type(4)));
typedef short bf16x8 __attribute__((ext_vector_type(8)));
typedef GAS unsigned gu32;
typedef GAS unsigned long long gu64;
#define RLX_AGENT __ATOMIC_RELAXED, __HIP_MEMORY_SCOPE_AGENT
#define LDS_WAIT() asm volatile("s_waitcnt lgkmcnt(0)" ::: "memory")
#define VM_WAIT() asm volatile("s_waitcnt vmcnt(0)" ::: "memory")
__device__ __forceinline__ unsigned long long rt() { return __builtin_amdgcn_s_memrealtime(); }
__device__ __forceinline__ unsigned f2bf(float f) { unsigned u = __builtin_bit_cast(unsigned, f); return (u + 0x7fffu + ((u >> 16) & 1u)) >> 16; }
__device__ __forceinline__ unsigned pk2(float lo, float hi) { return f2bf(lo) | (f2bf(hi) << 16); }

#define XB_TMO      128
#define XB_XCNT(j)  (256  + 64 * (j))
#define XB_XSUB(j)  (1280 + 64 * (j))
#define XB_XGEN(j)  (2304 + 64 * (j))
#define XB_TOP      3328
#define XB_TOPGEN   3392
#define XCD_BAR_WORDS 3456
#define XB_SPIN_CAP (1u << 18)

__device__ __forceinline__ unsigned xb_ld(unsigned* p)              { return __hip_atomic_load(p, __ATOMIC_RELAXED, __HIP_MEMORY_SCOPE_AGENT); }
__device__ __forceinline__ unsigned xb_add(unsigned* p, unsigned v) { return __hip_atomic_fetch_add(p, v, __ATOMIC_RELAXED, __HIP_MEMORY_SCOPE_AGENT); }
__device__ __forceinline__ unsigned xb_xcc_id() { return (unsigned)__builtin_amdgcn_s_getreg((3 << 11) | 20) & 0xFu; }
#define XB_SPIN(cond, bar) do { unsigned _sp = 0; while (cond) { __builtin_amdgcn_s_sleep(1); \
    if ((++_sp & 255u) == 0u) { if (xb_ld(&(bar)[XB_TMO])) break; if (_sp > XB_SPIN_CAP) { atomicAdd(&(bar)[XB_TMO], 1u); break; } } } } while (0)

struct XcdBarrier {
    unsigned* bar; unsigned x;
    volatile LAS unsigned* st;
};

__device__ __forceinline__ XcdBarrier xcd_barrier_post(unsigned* bar, volatile LAS unsigned* st) {
    XcdBarrier b; b.bar = bar; b.x = xb_xcc_id(); b.st = st;
    if (threadIdx.x == 0) (void)xb_add(&bar[XB_XCNT(b.x)], 1u);
    return b;
}
__device__ __forceinline__ void xcd_barrier_complete(unsigned* bar, unsigned x, unsigned& nloc, unsigned& nx) {
    const unsigned G = gridDim.x * gridDim.y * gridDim.z;
    unsigned sum, cnt, mine, sp = 0u;
    for (;;) {
        sum = 0u; cnt = 0u; mine = 0u;
#pragma unroll
        for (unsigned j = 0; j < 16; ++j) { const unsigned c = xb_ld(&bar[XB_XCNT(j)]); sum += c; cnt += (c > 0u) ? 1u : 0u; mine = (j == x) ? c : mine; }
        if (sum == G) break;
        __builtin_amdgcn_s_sleep(1);
        if ((++sp & 255u) == 0u) { if (xb_ld(&bar[XB_TMO])) break; if (sp > XB_SPIN_CAP) { atomicAdd(&bar[XB_TMO], 1u); break; } }
    }
    nloc = mine > 0u ? mine : 1u; nx = cnt > 0u ? cnt : 1u;
}

__device__ __forceinline__ void xcd_barrier(const XcdBarrier& b) {
    asm volatile("s_waitcnt vmcnt(0)" ::: "memory");
    __syncthreads();
    if (threadIdx.x == 0) {
        unsigned* bar = b.bar;
        __builtin_amdgcn_s_waitcnt(0);
        unsigned nloc = b.st[0], nx = b.st[1];
        if (nloc == 0u) { xcd_barrier_complete(bar, b.x, nloc, nx); b.st[0] = nloc; b.st[1] = nx; }
        const unsigned old = xb_add(&bar[XB_XSUB(b.x)], 1u);
        const unsigned gen = old / nloc;
        if (old + 1u == (gen + 1u) * nloc) {
            __builtin_amdgcn_fence(__ATOMIC_RELEASE, "agent");
            asm volatile("s_waitcnt vmcnt(0)" ::: "memory");
            const unsigned og = xb_add(&bar[XB_TOP], 1u);
            const unsigned tg = og / nx;
            if (og + 1u == (tg + 1u) * nx) xb_add(&bar[XB_TOPGEN], 1u);
            else XB_SPIN(xb_ld(&bar[XB_TOPGEN]) == tg, bar);
            __builtin_amdgcn_fence(__ATOMIC_ACQUIRE, "agent");
            xb_add(&bar[XB_XGEN(b.x)], 1u);
            asm volatile("s_waitcnt vmcnt(0)" ::: "memory");
        } else {
            XB_SPIN(xb_ld(&bar[XB_XGEN(b.x)]) == gen, bar);
            __builtin_amdgcn_fence(__ATOMIC_ACQUIRE, "agent");
            asm volatile("s_waitcnt vmcnt(0)" ::: "memory");
        }
    }
    __syncthreads();
}
constexpr int NWAVES = 8, NTHREADS = 512;
constexpr int T = 16384, D = 1024, SEQ = 4096, NBATCH = 4, NMEM = 256, NEXP = 32, TOPK = 4;
constexpr int NPROJ = 9728;
constexpr int XS_ROWS = T * TOPK + NEXP * 256;
constexpr float EPS = 1e-6f, LOG2E = 1.4426950408889634f, LN2 = 0.6931471805599453f;
#ifndef MK_N_LAUNCHES
#define MK_N_LAUNCHES 1
#endif
constexpr int N_PHASES = 14;
constexpr int N_LAUNCHES = MK_N_LAUNCHES;

constexpr size_t MiB = 1u << 20;
constexpr size_t WS_CTL = 0, CTL_ZERO_BYTES = 1 * MiB;
constexpr size_t CTL_SS2 = 256 * 1024, CTL_CNT = 384 * 1024, CTL_CONVQ = 448 * 1024, CTL_P1DONE = 448 * 1024 + 256, CTL_ROWTOK = 640 * 1024;
constexpr size_t WS_WCQ = 1 * MiB, WS_WCO = 2 * MiB, WS_WO = 3 * MiB, WS_KV = 5 * MiB;
constexpr size_t WS_TOPI = 7 * MiB, WS_TOPW = WS_TOPI + 256 * 1024, WS_RSTD3 = WS_TOPW + 256 * 1024, WS_ROWSLOT = WS_RSTD3 + 64 * 1024;
constexpr size_t WS_EXPGU = 8 * MiB, WS_EXPD = 72 * MiB;
constexpr size_t WS_PROJ = 104 * MiB, WS_U1 = 408 * MiB, WS_W1T = 440 * MiB, WS_OG = 408 * MiB, WS_LSE = 456 * MiB;
constexpr size_t WS_WBA = 459 * MiB, WS_WBC = 460 * MiB, WS_YA = 462 * MiB, WS_YC = 478 * MiB, WS_MIX = 408 * MiB;
constexpr size_t WS_MN = 232 * MiB, WS_WCKV = 234 * MiB;
constexpr size_t WS_H1 = 104 * MiB, WS_H1B = 168 * MiB, WS_Q2 = 200 * MiB, WS_O2 = 216 * MiB;
constexpr size_t WS_U3 = 236 * MiB, WS_HDN = 252 * MiB, WS_Y = 324 * MiB, WS_END = 512 * MiB;
constexpr size_t WS_HIST = WS_ROWSLOT + 288 * 1024;
static_assert(WS_ROWSLOT + (size_t)XS_ROWS * 4 <= WS_HIST && WS_HIST + 256 * 32 * 4 <= WS_EXPGU && CTL_ROWTOK + (size_t)XS_ROWS * 4 <= CTL_ZERO_BYTES, "misc region");
static_assert(WS_U3 + (size_t)T * D <= WS_HDN && WS_HDN + (size_t)XS_ROWS * D <= WS_Y && WS_Y + (size_t)T * 4 * D * 2 <= WS_END && WS_YC + (size_t)T * D * 2 <= WS_END && WS_PROJ + (size_t)T * NPROJ * 2 <= WS_U1 && WS_LSE + 3u * T * 8 * 4 <= WS_WBA, "workspace map");
constexpr int CW_TMO = 0, CW_CODE = 1, CW_BAR = 4096;

constexpr int LDS_BYTES = 163840;
constexpr int TBL_OFF = 163840 - 2048;
constexpr int ROWBUF_OFF = 131072, ROWBUF_UNITS = 24;
constexpr int MISC_OFF = 163840 - 256;

struct Frame {
    LAS unsigned char* lds;
    volatile LAS unsigned* MISC;
    gu32* ctl;
    unsigned char* ws;
    int tid, lane, wave, vcu, G;
};
__device__ __forceinline__ float wave_sum(float v) {
#pragma unroll
    for (int o = 1; o < 64; o <<= 1) v += __shfl_xor(v, o);
    return v;
}
typedef unsigned long long u64;
__device__ __forceinline__ float bf_lo(unsigned w) { return __builtin_bit_cast(float, w << 16); }
__device__ __forceinline__ float bf_hi(unsigned w) { return __builtin_bit_cast(float, w & 0xffff0000u); }

__device__ __forceinline__ void transpose_item(const float* W, int K, int N, bf16* WT, int drow, int k0, int n0, const float* gain, LAS float* scr, int lane) {
    f32x4 wv[8];
#pragma unroll
    for (int i = 0; i < 8; ++i) wv[i] = *(const GAS f32x4*)(W + (size_t)(k0 + 8 * i + (lane >> 3)) * N + n0 + 4 * (lane & 7));
#pragma unroll
    for (int i = 0; i < 8; ++i) { const int kk = 8 * i + (lane >> 3); f32x4 w = wv[i]; if (gain) w = w * gain[k0 + kk]; LAS float* d = scr + kk * 33 + 4 * (lane & 7); d[0] = w.x; d[1] = w.y; d[2] = w.z; d[3] = w.w; }
    LDS_WAIT(); asm volatile("" ::: "memory");
    const int c = lane & 7;
#pragma unroll
    for (int j = 0; j < 4; ++j) { const int n = (lane >> 3) + 8 * j; const LAS float* s = scr + (8 * c) * 33 + n;
        v4u o; o.x = pk2(s[0 * 33], s[1 * 33]); o.y = pk2(s[2 * 33], s[3 * 33]); o.z = pk2(s[4 * 33], s[5 * 33]); o.w = pk2(s[6 * 33], s[7 * 33]);
        *(GAS v4u*)(WT + (size_t)(drow + n) * K + k0 + 8 * c) = o; }
    LDS_WAIT(); asm volatile("" ::: "memory");
}
__device__ __forceinline__ void transpose_item_f8(const float* W, int K, int N, unsigned char* WT, int drow, int k0, int n0, float scale, LAS float* scr, int lane) {
    f32x4 wv[8];
#pragma unroll
    for (int i = 0; i < 8; ++i) wv[i] = *(const GAS f32x4*)(W + (size_t)(k0 + 8 * i + (lane >> 3)) * N + n0 + 4 * (lane & 7));
#pragma unroll
    for (int i = 0; i < 8; ++i) { const int kk = 8 * i + (lane >> 3); const f32x4 w = wv[i] * scale; LAS float* d = scr + kk * 33 + 4 * (lane & 7); d[0] = w.x; d[1] = w.y; d[2] = w.z; d[3] = w.w; }
    LDS_WAIT(); asm volatile("" ::: "memory");
    const int n = lane >> 1;
#pragma unroll
    for (int j = 0; j < 2; ++j) { const int c = (lane & 1) + 2 * j; const LAS float* s = scr + (16 * c) * 33 + n; v4u o;
        { int w = 0; w = __builtin_amdgcn_cvt_pk_fp8_f32(s[0 * 33], s[1 * 33], w, false); w = __builtin_amdgcn_cvt_pk_fp8_f32(s[2 * 33], s[3 * 33], w, true); o.x = (unsigned)w; }
        { int w = 0; w = __builtin_amdgcn_cvt_pk_fp8_f32(s[4 * 33], s[5 * 33], w, false); w = __builtin_amdgcn_cvt_pk_fp8_f32(s[6 * 33], s[7 * 33], w, true); o.y = (unsigned)w; }
        { int w = 0; w = __builtin_amdgcn_cvt_pk_fp8_f32(s[8 * 33], s[9 * 33], w, false); w = __builtin_amdgcn_cvt_pk_fp8_f32(s[10 * 33], s[11 * 33], w, true); o.z = (unsigned)w; }
        { int w = 0; w = __builtin_amdgcn_cvt_pk_fp8_f32(s[12 * 33], s[13 * 33], w, false); w = __builtin_amdgcn_cvt_pk_fp8_f32(s[14 * 33], s[15 * 33], w, true); o.w = (unsigned)w; }
        *(GAS v4u*)(WT + (size_t)(drow + n) * K + k0 + 16 * c) = o; }
    LDS_WAIT(); asm volatile("" ::: "memory");
}
__device__ __forceinline__ bool transpose_mat(int& r, const float* W, int K, int N, bf16* WT, int drow0, const float* gain, LAS float* scr, int lane) {
    const int nblk = N / 32, items = (K / 64) * nblk;
    if (r < items) { const int kb = r / nblk, nb = r % nblk; transpose_item(W, K, N, WT, drow0 + 32 * nb, 64 * kb, 32 * nb, gain, scr, lane); return true; }
    r -= items; return false;
}
__device__ __forceinline__ void rms_row_to_bf16(const float* xrow, const float* gain, bf16* orow, int lane) {
    const GAS f32x4* xr = (const GAS f32x4*)xrow + lane; const GAS f32x4* gr = (const GAS f32x4*)gain + lane;
    f32x4 v[4]; float s = 0.f;
#pragma unroll
    for (int j = 0; j < 4; ++j) { v[j] = xr[64 * j]; s += (v[j].x * v[j].x + v[j].y * v[j].y) + (v[j].z * v[j].z + v[j].w * v[j].w); }
    const float rstd = 1.f / sqrtf(wave_sum(s) * (1.f / D) + EPS);
    GAS u64* o8 = (GAS u64*)orow + lane;
#pragma unroll
    for (int j = 0; j < 4; ++j) { const f32x4 g = gr[64 * j]; o8[64 * j] = (u64)pk2(v[j].x * rstd * g.x, v[j].y * rstd * g.y) | ((u64)pk2(v[j].z * rstd * g.z, v[j].w * rstd * g.w) << 32); }
}

__device__ __forceinline__ int xcd_remap(int wgid, int nwg) { const int q = nwg / 8, r = nwg % 8, xcd = wgid % 8, off = wgid / 8; return (xcd < r ? xcd * (q + 1) : r * (q + 1) + (xcd - r) * q) + off; }
struct MoeOrder {
    const volatile LAS int* tpre; int npn, G, c;
    __device__ __forceinline__ bool next(int i, pg8::Unit& u) const {
        const int total = __builtin_amdgcn_readfirstlane(tpre[32]) * npn; const long L = (long)i * G + c; if (L >= total) return false;
        const int U = xcd_remap((int)L, total);
        int e = 0;
#pragma unroll 1
        for (int k = 1; k < 32; ++k) if (__builtin_amdgcn_readfirstlane(tpre[k]) * npn <= U) e = k;
        const int t0 = __builtin_amdgcn_readfirstlane(tpre[e]), nt = __builtin_amdgcn_readfirstlane(tpre[e + 1]) - t0, Ul = U - t0 * npn;
        u.pm = t0 + Ul % nt; u.pn = e * npn + Ul / nt; return true;
    }
    __device__ __forceinline__ void a_ready(const pg8::Unit&) const {}
    __device__ __forceinline__ void done(const pg8::Unit&) const {}
};
struct In {
    const float *x, *mem, *norm_mix, *w_in, *conv_w, *w_ba, *w_bc, *w_gate, *b_gate, *w_out, *norm_cross, *norm_mem, *w_cq, *w_ckv, *w_co, *norm_moe,
                *router_w, *router_b, *w_eg, *b_eg, *w_eu, *b_eu, *w_ed, *b_ed, *norm_final;
};

__device__ __forceinline__ void phase_prologue(Frame& F, const In& in) {
    LAS float* scr = (LAS float*)(F.lds + F.wave * 16384);
    const int gw = F.vcu * NWAVES + F.wave, NGW = F.G * NWAVES;
    unsigned char* ws = F.ws;
    constexpr int NITEMS = 16 * 240 + 16 * 64 + 8 * 32 + 16 * 32 + 16 * 32 + 16 * 16 + 8 * 32;
    for (int it = gw; it < NITEMS; it += NGW) {
        int r = it;
        if (transpose_mat(r, in.w_in, 1024, 7680, (bf16*)(ws + WS_W1T), 0, nullptr, scr, F.lane)) continue;
        if (transpose_mat(r, in.w_gate, 1024, 2048, (bf16*)(ws + WS_W1T), 7680, nullptr, scr, F.lane)) continue;
        if (transpose_mat(r, in.w_ba, 512, 1024, (bf16*)(ws + WS_WBA), 0, nullptr, scr, F.lane)) continue;
        if (transpose_mat(r, in.w_bc, 1024, 1024, (bf16*)(ws + WS_WBC), 0, nullptr, scr, F.lane)) continue;
        if (transpose_mat(r, in.w_out, 1024, 1024, (bf16*)(ws + WS_WO), 0, nullptr, scr, F.lane)) continue;
        if (transpose_mat(r, in.w_cq, 1024, 512, (bf16*)(ws + WS_WCQ), 0, in.norm_cross, scr, F.lane)) continue;
        transpose_mat(r, in.w_co, 512, 1024, (bf16*)(ws + WS_WCO), 0, nullptr, scr, F.lane);
    }
    for (int m = gw; m < T; m += NGW) rms_row_to_bf16(in.x + (size_t)m * D, in.norm_mix, (bf16*)(ws + WS_U1) + (size_t)m * D, F.lane);
}
__device__ __forceinline__ void phase_mem_prologue(Frame& F, const In& in) {
    LAS float* scr = (LAS float*)(F.lds + F.wave * 16384);
    const int gw = F.vcu * NWAVES + F.wave, NGW = F.G * NWAVES;
    for (int it = gw; it < 16 * 32; it += NGW) { int r = it; transpose_mat(r, in.w_ckv, 1024, 1024, (bf16*)(F.ws + WS_WCKV), 0, nullptr, scr, F.lane); }
    for (int m = gw; m < NBATCH * NMEM; m += NGW) rms_row_to_bf16(in.mem + (size_t)m * D, in.norm_mem, (bf16*)(F.ws + WS_MN) + (size_t)m * D, F.lane);
}

constexpr int CONV_PER = 16 * 32, CONV_ITEMS = NEXP * 3 * CONV_PER;
__device__ __forceinline__ void convert_from_queue(Frame& F, const In& in, bool drain, unsigned nworkers) {
    LAS float* scr = (LAS float*)(F.lds + F.wave * 16384);
    volatile LAS unsigned* qslot = F.MISC + 16;
    unsigned* convq = (unsigned*)(F.ws + WS_CTL + CTL_CONVQ); unsigned* p1done = (unsigned*)(F.ws + WS_CTL + CTL_P1DONE);
    for (;;) {
        if (F.tid == 0) { unsigned q = 0xffffffffu;
            if (drain || __hip_atomic_load(p1done, __ATOMIC_RELAXED, __HIP_MEMORY_SCOPE_AGENT) < nworkers) q = __hip_atomic_fetch_add(convq, 8u, __ATOMIC_RELAXED, __HIP_MEMORY_SCOPE_AGENT);
            *qslot = q; }
        __syncthreads();
        const unsigned q = *qslot;
        __syncthreads();
        if (q >= (unsigned)CONV_ITEMS) break;
        const int it = (int)q + F.wave;
        const int mtx = it / CONV_PER, r = it % CONV_PER, e = mtx / 3, which = mtx % 3, kb = r / 32, nb = r % 32, n0 = 32 * nb;
        if (which == 0)      transpose_item_f8(in.w_eg + (size_t)e * D * D, D, D, F.ws + WS_EXPGU + (size_t)e * 2048 * D, (n0 >> 7) * 256 + (n0 & 127), 64 * kb, n0, pg8::W8_SCALE, scr, F.lane);
        else if (which == 1) transpose_item_f8(in.w_eu + (size_t)e * D * D, D, D, F.ws + WS_EXPGU + (size_t)e * 2048 * D, (n0 >> 7) * 256 + 128 + (n0 & 127), 64 * kb, n0, pg8::W8_SCALE, scr, F.lane);
        else                 transpose_item_f8(in.w_ed + (size_t)e * D * D, D, D, F.ws + WS_EXPD + (size_t)e * D * D, n0, 64 * kb, n0, pg8::W8_SCALE, scr, F.lane);
    }
}

typedef short s16x4v __attribute__((ext_vector_type(4)));
typedef short bf16x8v __attribute__((ext_vector_type(8)));
__device__ __forceinline__ s16x4v lds_tr16(const LAS bf16* p) { return __builtin_bit_cast(s16x4v, __builtin_amdgcn_ds_read_tr16_b64_v4i16((LAS s16x4v*)p)); }
struct DilUnit { int b, g, h, r, n, dil; };
__device__ __forceinline__ DilUnit dil_decode(int unit) {
    DilUnit d; const int rn = unit & 31, bgh = unit >> 5; d.h = bgh & 7; const int bg = bgh >> 3; d.g = bg % 3; d.b = bg / 3;
    d.dil = d.g == 0 ? 1 : (d.g == 1 ? 4 : 16); const int nper = 32 / d.dil; d.r = rn / nper; d.n = rn % nper; return d;
}
__device__ __forceinline__ void phase_dil_attn(Frame& F) {
    constexpr int NU = NBATCH * 3 * 8 * 32, SLOT = 128 * 72;
    const bf16* PROJ = (const bf16*)(F.ws + WS_PROJ);
    LAS bf16* Kr = (LAS bf16*)F.lds; LAS bf16* Vr = Kr + 3 * SLOT;
    const int tid = F.tid, lane = F.lane, w = F.wave, qi = lane & 15, G = lane >> 4;
    const int u0 = (int)((long)F.vcu * NU / F.G), u1 = (int)((long)(F.vcu + 1) * NU / F.G), nu = u1 - u0;
    if (nu <= 0) return;
    const int lrow = tid >> 3, ch = tid & 7;
    { const v4u z = (v4u){0u, 0u, 0u, 0u}; *(LAS v4u*)(Vr + 2 * SLOT + lrow * 72 + ch * 8) = z; *(LAS v4u*)(Vr + 2 * SLOT + (lrow + 64) * 72 + ch * 8) = z; }
    { const DilUnit d = dil_decode(u0);
#pragma unroll
      for (int blk = 0; blk < 2; ++blk) { const int nb = d.n - 1 + blk; if (nb < 0) continue; const int slot = blk == 0 ? 2 : 0;
#pragma unroll
          for (int it = 0; it < 2; ++it) { const int row = lrow + 64 * it; const size_t grow = (size_t)d.b * SEQ + (size_t)(128 * nb + row) * d.dil + d.r; const bf16* p = PROJ + grow * NPROJ + d.g * 1536 + d.h * 64 + ch * 8;
              *(LAS v4u*)(Kr + slot * SLOT + row * 72 + ch * 8) = *(const GAS v4u*)(p + 512); *(LAS v4u*)(Vr + slot * SLOT + row * 72 + ch * 8) = *(const GAS v4u*)(p + 1024); } } }
    __syncthreads();
    for (int i = 0; i < nu; ++i) {
        const DilUnit d = dil_decode(u0 + i);
        const int cs = i % 3, ps = (i + 2) % 3, ns = (i + 1) % 3;
        v4u nk[2], nv[2];
        const bool pre = (i + 1 < nu);
        if (pre) { const DilUnit e = dil_decode(u0 + i + 1);
#pragma unroll
            for (int it = 0; it < 2; ++it) { const int row = lrow + 64 * it; const size_t grow = (size_t)e.b * SEQ + (size_t)(128 * e.n + row) * e.dil + e.r; const bf16* p = PROJ + grow * NPROJ + e.g * 1536 + e.h * 64 + ch * 8;
                nk[it] = *(const GAS v4u*)(p + 512); nv[it] = *(const GAS v4u*)(p + 1024); } }
        const int ql = 16 * w + qi;
        const size_t growq = (size_t)d.b * SEQ + (size_t)(128 * d.n + ql) * d.dil + d.r;
        const bf16* qp = PROJ + growq * NPROJ + d.g * 1536 + d.h * 64 + 8 * G;
        const bf16x8v q0 = *(const GAS bf16x8v*)qp, q1 = *(const GAS bf16x8v*)(qp + 32);
        const LAS bf16* Kp = Kr + ps * SLOT; const LAS bf16* Kc = Kr + cs * SLOT; const LAS bf16* Vp = Vr + ps * SLOT; const LAS bf16* Vc = Vr + cs * SLOT;
        pg8::f32x4 st[9];
#pragma unroll
        for (int t = 0; t < 9; ++t) {
            const int tt = w + t; const LAS bf16* kp = (tt < 8 ? Kp : Kc) + (16 * (tt & 7) + qi) * 72 + 8 * G;
            const bf16x8v k0 = *(const LAS bf16x8v*)kp, k1 = *(const LAS bf16x8v*)(kp + 32);
            pg8::f32x4 a = (pg8::f32x4){0.f, 0.f, 0.f, 0.f};
            a = __builtin_amdgcn_mfma_f32_16x16x32_bf16(k0, q0, a, 0, 0, 0);
            a = __builtin_amdgcn_mfma_f32_16x16x32_bf16(k1, q1, a, 0, 0, 0);
            st[t] = a;
        }
        const float slope2 = exp2f(-(float)(d.h + 1)) * (float)d.dil * LOG2E, sc = 0.125f * LOG2E;
        const int jq = 128 * (d.n - 1);
        float mx = -1e30f;
#pragma unroll
        for (int t = 0; t < 9; ++t)
#pragma unroll
            for (int k = 0; k < 4; ++k) {
                const int kl = 16 * (w + t) + 4 * G + k, dk = kl - ql;
                const bool ok = dk >= 0 && dk <= 128 && (jq + kl) >= 0;
                const float sv = ok ? st[t][k] * sc - slope2 * (float)(128 - dk) : -1e30f;
                st[t][k] = sv; mx = fmaxf(mx, sv);
            }
        mx = fmaxf(mx, __shfl_xor(mx, 16)); mx = fmaxf(mx, __shfl_xor(mx, 32));
        float l = 0.f;
#pragma unroll
        for (int t = 0; t < 9; ++t)
#pragma unroll
            for (int k = 0; k < 4; ++k) { const float pv = st[t][k] > -1e29f ? __builtin_amdgcn_exp2f(st[t][k] - mx) : 0.f; st[t][k] = pv; l += pv; }
        l += __shfl_xor(l, 16); l += __shfl_xor(l, 32);
        pg8::f32x4 o[4];
#pragma unroll
        for (int dm = 0; dm < 4; ++dm) o[dm] = (pg8::f32x4){0.f, 0.f, 0.f, 0.f};
#pragma unroll
        for (int s5 = 0; s5 < 5; ++s5) {
            const pg8::f32x4 pa = st[2 * s5], pb = (2 * s5 + 1 < 9) ? st[2 * s5 + 1] : (pg8::f32x4){0.f, 0.f, 0.f, 0.f};
            const bf16x8v pf = __builtin_bit_cast(bf16x8v, (v4u){pk2(pa[0], pa[1]), pk2(pa[2], pa[3]), pk2(pb[0], pb[1]), pk2(pb[2], pb[3])});
            const int ta = w + 2 * s5, tb = (ta + 1 < 16) ? ta + 1 : ta;
            const LAS bf16* va = (ta < 8 ? Vp : Vc) + (16 * (ta & 7) + 4 * G + (qi >> 2)) * 72 + 4 * (qi & 3);
            const LAS bf16* vb = (tb < 8 ? Vp : Vc) + (16 * (tb & 7) + 4 * G + (qi >> 2)) * 72 + 4 * (qi & 3);
#pragma unroll
            for (int dm = 0; dm < 4; ++dm) {
                const s16x4v lo = lds_tr16(va + 16 * dm), hi = lds_tr16(vb + 16 * dm);
                const bf16x8v vf = (bf16x8v){lo[0], lo[1], lo[2], lo[3], hi[0], hi[1], hi[2], hi[3]};
                o[dm] = __builtin_amdgcn_mfma_f32_16x16x32_bf16(vf, pf, o[dm], 0, 0, 0);
            }
        }
        const float inv = 1.f / l;
        bf16* og = (bf16*)(F.ws + WS_OG) + ((size_t)d.g * T + growq) * 512 + d.h * 64 + 4 * G;
#pragma unroll
        for (int dm = 0; dm < 4; ++dm) *(GAS u64*)(og + 16 * dm) = (u64)pk2(o[dm][0] * inv, o[dm][1] * inv) | ((u64)pk2(o[dm][2] * inv, o[dm][3] * inv) << 32);
        if (G == 0) ((float*)(F.ws + WS_LSE))[((size_t)d.g * T + growq) * 8 + d.h] = (mx + __builtin_amdgcn_logf(l)) * LN2;
        if (pre) {
#pragma unroll
            for (int it = 0; it < 2; ++it) { const int row = lrow + 64 * it; *(LAS v4u*)(Kr + ns * SLOT + row * 72 + ch * 8) = nk[it]; *(LAS v4u*)(Vr + ns * SLOT + row * 72 + ch * 8) = nv[it]; } }
        __syncthreads();
    }
}

__device__ __forceinline__ void phase_combine_conv(Frame& F, const In& in) {
    const int gw = F.vcu * NWAVES + F.wave, NGW = F.G * NWAVES, lane = F.lane;
    const bf16* PROJ = (const bf16*)(F.ws + WS_PROJ); const bf16* OG = (const bf16*)(F.ws + WS_OG); const float* LSE = (const float*)(F.ws + WS_LSE);
    for (int t = gw; t < T; t += NGW) {
        { const int head = lane >> 3;
          const float l0 = LSE[((size_t)0 * T + t) * 8 + head], l1 = LSE[((size_t)1 * T + t) * 8 + head], l2 = LSE[((size_t)2 * T + t) * 8 + head];
          const float mx = fmaxf(l0, fmaxf(l1, l2)); float w0 = __expf(l0 - mx), w1 = __expf(l1 - mx), w2 = __expf(l2 - mx); const float inv = 1.f / (w0 + w1 + w2); w0 *= inv; w1 *= inv; w2 *= inv;
          const v4u a = *(const GAS v4u*)(OG + ((size_t)0 * T + t) * 512 + 8 * lane), b = *(const GAS v4u*)(OG + ((size_t)1 * T + t) * 512 + 8 * lane), c = *(const GAS v4u*)(OG + ((size_t)2 * T + t) * 512 + 8 * lane);
          v4u o;
          o.x = pk2(w0 * bf_lo(a.x) + w1 * bf_lo(b.x) + w2 * bf_lo(c.x), w0 * bf_hi(a.x) + w1 * bf_hi(b.x) + w2 * bf_hi(c.x));
          o.y = pk2(w0 * bf_lo(a.y) + w1 * bf_lo(b.y) + w2 * bf_lo(c.y), w0 * bf_hi(a.y) + w1 * bf_hi(b.y) + w2 * bf_hi(c.y));
          o.z = pk2(w0 * bf_lo(a.z) + w1 * bf_lo(b.z) + w2 * bf_lo(c.z), w0 * bf_hi(a.z) + w1 * bf_hi(b.z) + w2 * bf_hi(c.z));
          o.w = pk2(w0 * bf_lo(a.w) + w1 * bf_lo(b.w) + w2 * bf_lo(c.w), w0 * bf_hi(a.w) + w1 * bf_hi(b.w) + w2 * bf_hi(c.w));
          *(GAS v4u*)((bf16*)(F.ws + WS_YA) + (size_t)t * 512 + 8 * lane) = o; }
        const int pos = t & (SEQ - 1);
#pragma unroll
        for (int half = 0; half < 2; ++half) {
            const int c = 8 * lane + 512 * half;
            float z[3][8];
#pragma unroll
            for (int dd = 0; dd < 3; ++dd) {
                const int back = 2 - dd;
                if (pos - back >= 0) { const bf16* p = PROJ + (size_t)(t - back) * NPROJ + 4608 + c; const v4u gc = *(const GAS v4u*)(p + 1024), xc = *(const GAS v4u*)(p + 2048);
                    z[dd][0] = bf_lo(gc.x) * bf_lo(xc.x); z[dd][1] = bf_hi(gc.x) * bf_hi(xc.x); z[dd][2] = bf_lo(gc.y) * bf_lo(xc.y); z[dd][3] = bf_hi(gc.y) * bf_hi(xc.y);
                    z[dd][4] = bf_lo(gc.z) * bf_lo(xc.z); z[dd][5] = bf_hi(gc.z) * bf_hi(xc.z); z[dd][6] = bf_lo(gc.w) * bf_lo(xc.w); z[dd][7] = bf_hi(gc.w) * bf_hi(xc.w); }
                else {
#pragma unroll
                    for (int i = 0; i < 8; ++i) z[dd][i] = 0.f; }
            }
            const v4u gb = *(const GAS v4u*)(PROJ + (size_t)t * NPROJ + 4608 + c);
            float y[8];
#pragma unroll
            for (int i = 0; i < 8; ++i) y[i] = in.conv_w[c + i] * z[0][i] + in.conv_w[1024 + c + i] * z[1][i] + in.conv_w[2048 + c + i] * z[2][i];
            v4u o; o.x = pk2(bf_lo(gb.x) * y[0], bf_hi(gb.x) * y[1]); o.y = pk2(bf_lo(gb.y) * y[2], bf_hi(gb.y) * y[3]); o.z = pk2(bf_lo(gb.z) * y[4], bf_hi(gb.z) * y[5]); o.w = pk2(bf_lo(gb.w) * y[6], bf_hi(gb.w) * y[7]);
            *(GAS v4u*)((bf16*)(F.ws + WS_YC) + (size_t)t * 1024 + c) = o;
        }
    }
}


__device__ __forceinline__ void cross_attn_unit_mfma(Frame& F, int unit, bool stage) {
    const int qc = unit & 31, bh = unit >> 5, h = bh & 3, b = bh >> 2, tid = F.tid, lane = F.lane, w = F.wave, qi = lane & 15, G = lane >> 4;
    const bf16* KV = (const bf16*)(F.ws + WS_KV); const bf16* Q2 = (const bf16*)(F.ws + WS_Q2);
    LAS bf16* Ks = (LAS bf16*)F.lds; LAS bf16* Vs = Ks + 256 * 136;
    if (stage)
#pragma unroll
    for (int it = 0; it < 8; ++it) {
        const int row = (tid >> 4) + 32 * it, ch = tid & 15; const bf16* p = KV + (size_t)(b * NMEM + row) * 1024 + h * 128 + ch * 8;
        *(LAS v4u*)(Ks + row * 136 + ch * 8) = *(const GAS v4u*)p; *(LAS v4u*)(Vs + row * 136 + ch * 8) = *(const GAS v4u*)(p + 512);
    }
    const size_t grow = (size_t)b * SEQ + 128 * qc + 16 * w + qi;
    bf16x8v q[4];
#pragma unroll
    for (int ks = 0; ks < 4; ++ks) q[ks] = *(const GAS bf16x8v*)(Q2 + grow * 512 + h * 128 + 32 * ks + 8 * G);
    __syncthreads();
    pg8::f32x4 st[16];
#pragma unroll
    for (int t = 0; t < 16; ++t) {
        const LAS bf16* kp = Ks + (16 * t + qi) * 136 + 8 * G;
        pg8::f32x4 a = (pg8::f32x4){0.f, 0.f, 0.f, 0.f};
#pragma unroll
        for (int ks = 0; ks < 4; ++ks) a = __builtin_amdgcn_mfma_f32_16x16x32_bf16(*(const LAS bf16x8v*)(kp + 32 * ks), q[ks], a, 0, 0, 0);
        st[t] = a;
    }
    const float sc = 0.08838834764831845f * LOG2E;
    float mx = -1e30f;
#pragma unroll
    for (int t = 0; t < 16; ++t)
#pragma unroll
        for (int i = 0; i < 4; ++i) { st[t][i] *= sc; mx = fmaxf(mx, st[t][i]); }
    mx = fmaxf(mx, __shfl_xor(mx, 16)); mx = fmaxf(mx, __shfl_xor(mx, 32));
    float l = 0.f;
#pragma unroll
    for (int t = 0; t < 16; ++t)
#pragma unroll
        for (int i = 0; i < 4; ++i) { const float pv = __builtin_amdgcn_exp2f(st[t][i] - mx); st[t][i] = pv; l += pv; }
    l += __shfl_xor(l, 16); l += __shfl_xor(l, 32);
    pg8::f32x4 o[8];
#pragma unroll
    for (int dm = 0; dm < 8; ++dm) o[dm] = (pg8::f32x4){0.f, 0.f, 0.f, 0.f};
#pragma unroll
    for (int s8 = 0; s8 < 8; ++s8) {
        const pg8::f32x4 pa = st[2 * s8], pb = st[2 * s8 + 1];
        const bf16x8v pf = __builtin_bit_cast(bf16x8v, (v4u){pk2(pa[0], pa[1]), pk2(pa[2], pa[3]), pk2(pb[0], pb[1]), pk2(pb[2], pb[3])});
        const LAS bf16* vbase = Vs + (32 * s8 + 4 * G + (qi >> 2)) * 136 + 4 * (qi & 3);
#pragma unroll
        for (int dm = 0; dm < 8; ++dm) {
            const s16x4v lo = lds_tr16(vbase + 16 * dm), hi = lds_tr16(vbase + 16 * 136 + 16 * dm);
            const bf16x8v vf = (bf16x8v){lo[0], lo[1], lo[2], lo[3], hi[0], hi[1], hi[2], hi[3]};
            o[dm] = __builtin_amdgcn_mfma_f32_16x16x32_bf16(vf, pf, o[dm], 0, 0, 0);
        }
    }
    const float inv = 1.f / l;
    bf16* op = (bf16*)(F.ws + WS_O2) + grow * 512 + h * 128 + 4 * G;
#pragma unroll
    for (int dm = 0; dm < 8; ++dm) *(GAS u64*)(op + 16 * dm) = (u64)pk2(o[dm][0] * inv, o[dm][1] * inv) | ((u64)pk2(o[dm][2] * inv, o[dm][3] * inv) << 32);
    __syncthreads();
}

__device__ __forceinline__ void phase_router(Frame& F, const In& in, const float* H2) {
    LAS float* wl = (LAS float*)F.lds; LAS float* part = (LAS float*)(F.lds + 131072); LAS float* ssq = part + 2 * 64 * 32; LAS float* rsl = ssq + 128;
    volatile LAS int* hist = (volatile LAS int*)(F.lds + TBL_OFF + 1024);
    const int tid = F.tid, lane = F.lane, w = F.wave;
    for (int i = tid; i < 1024 * 8; i += NTHREADS) { const int k = i >> 3, c4 = i & 7; const f32x4 v = ((const GAS f32x4*)in.router_w)[i] * in.norm_moe[k];
        *(LAS f32x4*)(wl + k * 32 + ((4 * c4 + 16 * ((k >> 7) & 1)) & 31)) = v; }
    if (tid < 32) hist[tid] = 0;
    __syncthreads();
    int* topi = (int*)(F.ws + WS_TOPI); float* topw = (float*)(F.ws + WS_TOPW); unsigned char* U3 = F.ws + WS_U3;
    for (int ch = F.vcu; ch < T / 64; ch += F.G) {
    const int t0 = ch * 64;
    {
        const int tg = w & 3, kh = w >> 2, ti = lane & 15, kq = lane >> 4, kbase = kh * 512 + kq * 128;
        const GAS f32x4* xr = (const GAS f32x4*)(H2 + (size_t)(t0 + 16 * tg + ti) * D + kbase);
        const LAS float* wb = wl + kbase * 32 + ((ti + 16 * (kq & 1)) & 31);
        const LAS float* wb2 = wl + kbase * 32 + ((ti + 16 + 16 * (kq & 1)) & 31);
        f32x4 c0 = (f32x4){0.f, 0.f, 0.f, 0.f}, c1 = c0; float sq = 0.f;
#pragma unroll 2
        for (int c8 = 0; c8 < 4; ++c8) {
            f32x4 x[8];
#pragma unroll
            for (int q = 0; q < 8; ++q) x[q] = xr[8 * c8 + q];
#pragma unroll
            for (int q = 0; q < 8; ++q) {
                const int kk = 4 * (8 * c8 + q);
                c0 = __builtin_amdgcn_mfma_f32_16x16x4f32(x[q].x, wb[(kk + 0) * 32], c0, 0, 0, 0); c1 = __builtin_amdgcn_mfma_f32_16x16x4f32(x[q].x, wb2[(kk + 0) * 32], c1, 0, 0, 0);
                c0 = __builtin_amdgcn_mfma_f32_16x16x4f32(x[q].y, wb[(kk + 1) * 32], c0, 0, 0, 0); c1 = __builtin_amdgcn_mfma_f32_16x16x4f32(x[q].y, wb2[(kk + 1) * 32], c1, 0, 0, 0);
                c0 = __builtin_amdgcn_mfma_f32_16x16x4f32(x[q].z, wb[(kk + 2) * 32], c0, 0, 0, 0); c1 = __builtin_amdgcn_mfma_f32_16x16x4f32(x[q].z, wb2[(kk + 2) * 32], c1, 0, 0, 0);
                c0 = __builtin_amdgcn_mfma_f32_16x16x4f32(x[q].w, wb[(kk + 3) * 32], c0, 0, 0, 0); c1 = __builtin_amdgcn_mfma_f32_16x16x4f32(x[q].w, wb2[(kk + 3) * 32], c1, 0, 0, 0);
                sq += (x[q].x * x[q].x + x[q].y * x[q].y) + (x[q].z * x[q].z + x[q].w * x[q].w);
            }
        }
        sq += __shfl_xor(sq, 16); sq += __shfl_xor(sq, 32);
        if (kq == 0) ssq[kh * 64 + 16 * tg + ti] = sq;
#pragma unroll
        for (int r = 0; r < 4; ++r) { LAS float* pp = part + (kh * 64 + 16 * tg + 4 * kq + r) * 32 + ti; pp[0] = c0[r]; pp[16] = c1[r]; }
    }
    __syncthreads();
    if (tid < 64) {
        const int t = t0 + tid; const float rstd = 1.f / sqrtf((ssq[tid] + ssq[64 + tid]) * (1.f / D) + EPS); rsl[tid] = rstd;
        LAS float* lg = part + tid * 32;
        for (int e = 0; e < 32; ++e) lg[e] = (lg[e] + lg[64 * 32 + e]) * rstd + in.router_b[e];
        float tv[4]; int tix[4];
#pragma unroll
        for (int k = 0; k < 4; ++k) { float bv = -INFINITY; int bi = 0; for (int e = 0; e < 32; ++e) { const float v = lg[e]; if (v > bv) { bv = v; bi = e; } } tv[k] = bv; tix[k] = bi; lg[bi] = -INFINITY; }
        const float e1 = __expf(tv[1] - tv[0]), e2 = __expf(tv[2] - tv[0]), e3 = __expf(tv[3] - tv[0]), inv = 1.f / (1.f + e1 + e2 + e3);
        topi[t * 4 + 0] = tix[0]; topi[t * 4 + 1] = tix[1]; topi[t * 4 + 2] = tix[2]; topi[t * 4 + 3] = tix[3];
        topw[t * 4 + 0] = inv; topw[t * 4 + 1] = e1 * inv; topw[t * 4 + 2] = e2 * inv; topw[t * 4 + 3] = e3 * inv;
#pragma unroll
        for (int k = 0; k < 4; ++k) __hip_atomic_fetch_add((LAS int*)(F.lds + TBL_OFF + 1024) + tix[k], 1, __ATOMIC_RELAXED, __HIP_MEMORY_SCOPE_WORKGROUP);
    }
    __syncthreads();
    for (int tl = w; tl < 64; tl += NWAVES) {
        const int t = t0 + tl; const float rstd = rsl[tl];
        const GAS f32x4* xr = (const GAS f32x4*)(H2 + (size_t)t * D) + lane; const GAS f32x4* gr = (const GAS f32x4*)in.norm_moe + lane; GAS unsigned* u3r = (GAS unsigned*)(U3 + (size_t)t * D) + lane;
#pragma unroll
        for (int j = 0; j < 4; ++j) { const f32x4 v = xr[64 * j] * gr[64 * j] * rstd; u3r[64 * j] = pg8::pack4_fp8(v); }
    }
    __syncthreads();
    }
    if (tid < 32) ((int*)(F.ws + WS_HIST))[F.vcu * 32 + tid] = hist[tid];
    __syncthreads();
}

__device__ __forceinline__ void phase_assign(Frame& F) {
    volatile LAS int* tb = (volatile LAS int*)(F.lds + TBL_OFF);
    LAS int* part = (LAS int*)F.lds;
    const int* HIST = (const int*)(F.ws + WS_HIST); const int tid = F.tid, e = tid & 31, pt = tid >> 5;
    { int tot = 0, bef = 0; for (int b = pt; b < F.G; b += 16) { const int h = HIST[b * 32 + e]; tot += h; bef += (b < F.vcu) ? h : 0; } part[pt * 64 + e] = tot; part[pt * 64 + 32 + e] = bef; }
    __syncthreads();
    if (tid < 32) { int tot = 0, bef = 0; for (int q = 0; q < 16; ++q) { tot += part[q * 64 + tid]; bef += part[q * 64 + 32 + tid]; } tb[64 + tid] = tot; tb[128 + tid] = bef; tb[160 + tid] = 0; }
    __syncthreads();
    if (tid == 0) { int acc = 0; for (int k = 0; k < NEXP; ++k) { tb[k] = acc; acc += (tb[64 + k] + 255) >> 8; } tb[32] = acc; }
    __syncthreads();
    if (tid < 32) { tb[128 + tid] += tb[tid] * 256; if (F.vcu == 0) ((unsigned*)(F.ws + WS_CTL + CTL_CNT))[tid] = (unsigned)tb[64 + tid]; }
    __syncthreads();
    int* rowtok = (int*)(F.ws + WS_CTL + CTL_ROWTOK); int* rowslot = (int*)(F.ws + WS_ROWSLOT); const int* topi = (const int*)(F.ws + WS_TOPI);
    if (F.vcu < NEXP) { const int x = F.vcu; for (int R = tb[x] * 256 + tb[64 + x] + tid; R < tb[x + 1] * 256; R += NTHREADS) rowslot[R] = -1; }
    for (int ch = F.vcu; ch < T / 64; ch += F.G)
    for (int a = ch * 256 + tid; a < ch * 256 + 256; a += NTHREADS) {
        const int x = topi[a];
        const int rank = __hip_atomic_fetch_add((LAS int*)(F.lds + TBL_OFF) + 160 + x, 1, __ATOMIC_RELAXED, __HIP_MEMORY_SCOPE_WORKGROUP);
        const int R = tb[128 + x] + rank; rowtok[R] = a >> 2; rowslot[R] = a;
    }
    __syncthreads();
}

__device__ __forceinline__ void build_tpre(Frame& F) {
    volatile LAS int* tpre = (volatile LAS int*)(F.lds + TBL_OFF);
    const unsigned* cnt = (const unsigned*)(F.ws + WS_CTL + CTL_CNT);
    if (F.tid == 0) { int acc = 0;
        for (int e = 0; e < NEXP; ++e) { tpre[e] = acc; const unsigned c = __hip_atomic_load(cnt + e, __ATOMIC_RELAXED, __HIP_MEMORY_SCOPE_AGENT); tpre[64 + e] = (int)c; acc += (int)((c + 255u) >> 8); }
        tpre[32] = acc; }
    __syncthreads();
}

__device__ __forceinline__ void phase_final(Frame& F, const In& in, const float* H2, float* OUT) {
    const int gw = F.vcu * NWAVES + F.wave, NGW = F.G * NWAVES, lane = F.lane;
    const bf16* Y = (const bf16*)(F.ws + WS_Y);
    for (int t = gw; t < T; t += NGW) {
        const GAS f32x4* xr = (const GAS f32x4*)(H2 + (size_t)t * D) + lane; const GAS f32x4* gr = (const GAS f32x4*)in.norm_final + lane;
        f32x4 v[4]; float s = 0.f;
#pragma unroll
        for (int j = 0; j < 4; ++j) v[j] = xr[64 * j];
#pragma unroll
        for (int k = 0; k < 4; ++k) { const GAS u64* yr = (const GAS u64*)(Y + (size_t)(t * 4 + k) * D) + lane;
#pragma unroll
            for (int j = 0; j < 4; ++j) { const u64 w = yr[64 * j]; const unsigned lo = (unsigned)w, hi = (unsigned)(w >> 32); v[j].x += bf_lo(lo); v[j].y += bf_hi(lo); v[j].z += bf_lo(hi); v[j].w += bf_hi(hi); } }
#pragma unroll
        for (int j = 0; j < 4; ++j) s += (v[j].x * v[j].x + v[j].y * v[j].y) + (v[j].z * v[j].z + v[j].w * v[j].w);
        const float rstd = 1.f / sqrtf(wave_sum(s) * (1.f / D) + EPS);
        GAS f32x4* orow = (GAS f32x4*)(OUT + (size_t)t * D) + lane;
#pragma unroll
        for (int j = 0; j < 4; ++j) orow[64 * j] = v[j] * gr[64 * j] * rstd;
    }
}
struct Args { const float* in[25]; float* out; unsigned char* ws; int ph_lo, ph_hi; };
#ifndef N_CONV_WG
#define N_CONV_WG 32
#endif
#ifndef PG8_SP2
#define PG8_SP2 true
#endif
#ifndef PG8_ALIGN
#define PG8_ALIGN true
#endif
__global__ void __launch_bounds__(NTHREADS, 2) mega_fwd(Args args) {
    extern __shared__ __attribute__((aligned(16))) unsigned char lds[];
    Frame F;
    F.lds = (LAS unsigned char*)lds; F.MISC = (volatile LAS unsigned*)(F.lds + MISC_OFF);
    F.tid = threadIdx.x; F.lane = F.tid & 63; F.wave = __builtin_amdgcn_readfirstlane(F.tid >> 6);
    F.G = gridDim.x; { const int bx = blockIdx.x; F.vcu = (F.G % 8 == 0) ? (bx % 8) * (F.G / 8) + bx / 8 : bx; }
    F.ws = args.ws; F.ctl = (gu32*)(args.ws + WS_CTL);
    In in;
    in.x = args.in[0]; in.mem = args.in[1]; in.norm_mix = args.in[2]; in.w_in = args.in[3]; in.conv_w = args.in[4]; in.w_ba = args.in[5]; in.w_bc = args.in[6];
    in.w_gate = args.in[7]; in.b_gate = args.in[8]; in.w_out = args.in[9]; in.norm_cross = args.in[10]; in.norm_mem = args.in[11]; in.w_cq = args.in[12];
    in.w_ckv = args.in[13]; in.w_co = args.in[14]; in.norm_moe = args.in[15]; in.router_w = args.in[16]; in.router_b = args.in[17]; in.w_eg = args.in[18];
    in.b_eg = args.in[19]; in.w_eu = args.in[20]; in.b_eu = args.in[21]; in.w_ed = args.in[22]; in.b_ed = args.in[23]; in.norm_final = args.in[24];
    unsigned char* ws = args.ws;
    for (int u = F.tid; u < 64; u += NTHREADS) ((LAS unsigned*)(F.lds + MISC_OFF))[u] = 0u;
    __syncthreads();
    XcdBarrier bar; bar.bar = (unsigned*)(F.ctl + CW_BAR); bar.x = 0; bar.st = nullptr;
    if (N_LAUNCHES == 1) bar = xcd_barrier_post((unsigned*)(F.ctl + CW_BAR), F.MISC + 8);
    const int lo = args.ph_lo, hi = args.ph_hi;
#define IN(k) (lo <= (k) && (k) < hi)
#define SEAM(k) do { if (IN(k) && IN((k) + 1)) xcd_barrier(bar); } while (0)
    typedef pg8::bf16_t b16;

    if (IN(0)) { phase_prologue(F, in); } SEAM(0);

    if (IN(1)) {
        const int NW1 = (F.G == 256) ? 256 - N_CONV_WG : F.G;
        if ((int)blockIdx.x < NW1) {
            pg8::Gemm g{(const b16*)(ws + WS_U1), (const b16*)(ws + WS_W1T), T, NPROJ, D}; pg8::StaticOrder S; S.init(T, NPROJ, NW1, (int)blockIdx.x);
            pg8::EpiProj E{(b16*)(ws + WS_PROJ), in.b_gate};
            pg8::gemm_phase<pg8::EpiProj, pg8::StaticOrder, PG8_ALIGN, PG8_SP2>(F.lds, g, S, E);
            if (F.tid == 0) __hip_atomic_fetch_add((unsigned*)(ws + WS_CTL + CTL_P1DONE), 1u, __ATOMIC_RELAXED, __HIP_MEMORY_SCOPE_AGENT);
        }
        convert_from_queue(F, in, false, (unsigned)NW1);
    } SEAM(1);

    if (IN(2)) { phase_dil_attn(F); } SEAM(2);

    if (IN(3)) { phase_combine_conv(F, in); } SEAM(3);

    if (IN(4)) {
        { pg8::Gemm g{(const b16*)(ws + WS_YA), (const b16*)(ws + WS_WBA), T, D, 512}; pg8::StaticOrder S; S.init(T, D, F.G, (int)blockIdx.x);
          pg8::EpiMix<false> E{(b16*)(ws + WS_MIX), (const b16*)(ws + WS_PROJ)};
          pg8::gemm_phase<pg8::EpiMix<false>, pg8::StaticOrder, PG8_ALIGN, PG8_SP2>(F.lds, g, S, E); }
        { pg8::Gemm g{(const b16*)(ws + WS_YC), (const b16*)(ws + WS_WBC), T, D, D}; pg8::StaticOrder S; S.init(T, D, F.G, (int)blockIdx.x);
          pg8::EpiMix<true> E{(b16*)(ws + WS_MIX), (const b16*)(ws + WS_PROJ)};
          pg8::gemm_phase<pg8::EpiMix<true>, pg8::StaticOrder, PG8_ALIGN, PG8_SP2>(F.lds, g, S, E); }
    } SEAM(4);

    if (IN(5)) {
        { pg8::Gemm g{(const b16*)(ws + WS_MIX), (const b16*)(ws + WS_WO), T, D, D}; pg8::StaticOrder S; S.init(T, D, F.G, (int)blockIdx.x);
          pg8::EpiH1 E{in.x, (float*)(ws + WS_H1), (b16*)(ws + WS_H1B), (float*)(ws + WS_CTL + CTL_SS2)};
          pg8::gemm_phase<pg8::EpiH1, pg8::StaticOrder, PG8_ALIGN, PG8_SP2>(F.lds, g, S, E); }
        convert_from_queue(F, in, true, 0u);
        phase_mem_prologue(F, in);
    } SEAM(5);

    if (IN(6)) {
        { pg8::Gemm g{(const b16*)(ws + WS_H1B), (const b16*)(ws + WS_WCQ), T, 512, D}; pg8::StaticOrder S; S.init(T, 512, F.G, (int)blockIdx.x);
          pg8::EpiQ2 E{(b16*)(ws + WS_Q2), (const float*)(ws + WS_CTL + CTL_SS2)};
          pg8::gemm_phase<pg8::EpiQ2, pg8::StaticOrder, PG8_ALIGN, PG8_SP2>(F.lds, g, S, E); }
        { pg8::Gemm g{(const b16*)(ws + WS_MN), (const b16*)(ws + WS_WCKV), NBATCH * NMEM, D, D}; pg8::StaticOrder S; S.init(NBATCH * NMEM, D, F.G, ((int)blockIdx.x + F.G - 128) % F.G);
          pg8::EpiPlain E{(b16*)(ws + WS_KV), D};
          pg8::gemm_phase<pg8::EpiPlain, pg8::StaticOrder, PG8_ALIGN, PG8_SP2>(F.lds, g, S, E); }
    } SEAM(6);

    if (IN(7)) {
        constexpr int NU = NBATCH * 4 * 32; const int u0 = (int)((long)F.vcu * NU / F.G), u1 = (int)((long)(F.vcu + 1) * NU / F.G);
        for (int u = u0; u < u1; ++u) cross_attn_unit_mfma(F, u, u == u0 || (u >> 5) != ((u - 1) >> 5));
    } SEAM(7);

    if (IN(8)) {
        pg8::Gemm g{(const b16*)(ws + WS_O2), (const b16*)(ws + WS_WCO), T, D, 512}; pg8::StaticOrder S; S.init(T, D, F.G, (int)blockIdx.x);
        pg8::EpiH2 E{(const float*)(ws + WS_H1), args.out};
        pg8::gemm_phase<pg8::EpiH2, pg8::StaticOrder, PG8_ALIGN, PG8_SP2>(F.lds, g, S, E);
    } SEAM(8);

    if (IN(9)) { phase_router(F, in, args.out); } SEAM(9);

    if (IN(10)) { phase_assign(F); } SEAM(10);

    if (IN(11)) {
        build_tpre(F);
        pg8::Gemm g{(const b16*)(ws + WS_U3), (const b16*)(ws + WS_EXPGU), T, NEXP * 2048, D / 2};
        MoeOrder S{(const volatile LAS int*)(F.lds + TBL_OFF), 8, F.G, (int)blockIdx.x};
        LAS int* rowbuf = (LAS int*)(F.lds + ROWBUF_OFF); const int* rowtok = (const int*)(ws + WS_CTL + CTL_ROWTOK);
        { pg8::Unit uu; for (int i = 0; i < ROWBUF_UNITS && S.next(i, uu); ++i) if (F.tid < 256) rowbuf[256 * i + F.tid] = rowtok[uu.pm * 256 + F.tid]; }
        __syncthreads();
        pg8::EpiHdnF8 E{ws + WS_HDN, in.b_eg, in.b_eu};
        pg8::gemm_phase_gather<pg8::EpiHdnF8, MoeOrder, true>(F.lds, g, S, E, (const LAS int*)rowbuf);
    } SEAM(11);

    if (IN(12)) {
        build_tpre(F);
        pg8::Gemm g{(const b16*)(ws + WS_HDN), (const b16*)(ws + WS_EXPD), XS_ROWS, NEXP * 1024, D / 2};
        MoeOrder S{(const volatile LAS int*)(F.lds + TBL_OFF), 4, F.G, (int)blockIdx.x};
        pg8::EpiYF8 E{(b16*)(ws + WS_Y), in.b_ed, (const int*)(ws + WS_ROWSLOT), (const float*)(ws + WS_TOPW)};
        pg8::gemm_phase<pg8::EpiYF8, MoeOrder, PG8_ALIGN, PG8_SP2, true>(F.lds, g, S, E);
    } SEAM(12);

    if (IN(13)) { phase_final(F, in, args.out, args.out); }
#undef IN
#undef SEAM
}

extern "C" void kernel_launch(void* const* d_in, const int* in_sizes, int n_in, void* d_out, int out_size, void* d_ws, size_t ws_size, hipStream_t stream) {
    static int grid = 0;
    if (grid == 0) {
        if (n_in != 25 || in_sizes[0] != T * D || out_size != T * D || ws_size < WS_END) {
            fprintf(stderr, "kernel_launch: built for 25 inputs, x/out of %d floats, >= %zu bytes of workspace; got n_in %d, in0 %d, out %d, ws %zu; nothing launched\n", T * D, (size_t)WS_END, n_in, n_in > 0 ? in_sizes[0] : -1, out_size, ws_size);
            grid = -1; return; }
        int dev = 0, cus = 0, per_cu = 0;
        if (hipGetDevice(&dev) != hipSuccess || hipDeviceGetAttribute(&cus, hipDeviceAttributeMultiprocessorCount, dev) != hipSuccess) { fprintf(stderr, "kernel_launch: device query failed\n"); grid = -1; return; }
        if (hipFuncSetAttribute((const void*)mega_fwd, hipFuncAttributeMaxDynamicSharedMemorySize, LDS_BYTES) != hipSuccess) { fprintf(stderr, "kernel_launch: hipFuncSetAttribute(%d B LDS) failed\n", LDS_BYTES); grid = -1; return; }
        if (hipOccupancyMaxActiveBlocksPerMultiprocessor(&per_cu, (const void*)mega_fwd, NTHREADS, LDS_BYTES) != hipSuccess || per_cu < 1) { fprintf(stderr, "kernel_launch: occupancy query says %d workgroups per CU\n", per_cu); per_cu = 1; }
        (void)hipGetLastError();
        grid = cus < 256 ? cus : 256;
    }
    if (grid < 0) return;
    (void)hipMemsetAsync((char*)d_ws + WS_CTL, 0, CTL_ZERO_BYTES, stream);
    Args a{};
    for (int i = 0; i < 25; ++i) a.in[i] = (const float*)d_in[i];
    a.out = (float*)d_out; a.ws = (unsigned char*)d_ws;
    if (N_LAUNCHES == 1) {
        a.ph_lo = 0; a.ph_hi = N_PHASES;
        void* kargs[] = {&a};
        hipError_t e = hipLaunchCooperativeKernel((const void*)mega_fwd, dim3(grid), dim3(NTHREADS), kargs, LDS_BYTES, stream);
        if (e != hipSuccess) fprintf(stderr, "kernel_launch: cooperative launch failed: %s (grid %d)\n", hipGetErrorString(e), grid);
    } else {
        for (int p = 0; p < N_PHASES; ++p) { a.ph_lo = p; a.ph_hi = p + 1; hipLaunchKernelGGL(mega_fwd, dim3(grid), dim3(NTHREADS), LDS_BYTES, stream, a);
        }
    }
}
```
